# Optimizing an MI355X kernel written in HIP

```python
import jax, jax.numpy as jnp
from jax import lax
import numpy as np

D_MODEL = 1024
BATCH = 1
SEQ = 16384
DEPTH = 4

CHUNK = 64
MEM_LEN = 256
D_MIX = D_MODEL
HEAD_DIM = 64
SSM_WIDTH = D_MIX // 2
SSM_HEADS = SSM_WIDTH // HEAD_DIM
SSM_GROUPS = 2
SSM_STATE = 128
CONV_WIDTH = 4
CONV_DIM = SSM_WIDTH + 2 * SSM_GROUPS * SSM_STATE
SSM_IN = CONV_DIM + SSM_WIDTH + SSM_HEADS
RWKV_WIDTH = D_MIX // 4
RWKV_HEADS = RWKV_WIDTH // HEAD_DIM
DECAY_LORA = 64
AAA_LORA = 64
RWKV_IN = 4 * RWKV_WIDTH + DECAY_LORA + AAA_LORA
XATTN_WIDTH = D_MIX - SSM_WIDTH - RWKV_WIDTH
XATTN_HEADS = XATTN_WIDTH // HEAD_DIM
XATTN_IN = 2 * XATTN_WIDTH
IN_WIDTH = SSM_IN + RWKV_IN + XATTN_IN
NORM_EPS = 1e-6
LNX_EPS = 64e-5
L2_EPS = 1e-12

kernel_name = "hymba_ssd_rwkv7_memxattn_trunk"


def rmsnorm(x, w):
    xf = x.astype(jnp.float32)
    y = xf * lax.rsqrt(jnp.mean(xf * xf, axis=-1, keepdims=True) + NORM_EPS)
    return (y * w.astype(jnp.float32)).astype(x.dtype)


def causal_dwconv(u, w, b):
    L = u.shape[1]
    up = jnp.pad(u, ((0, 0), (CONV_WIDTH - 1, 0), (0, 0)))
    out = b
    for j in range(CONV_WIDTH):
        out = out + up[:, j:j + L, :] * w[j]
    return out


def ssd_chunked(xs, dt, A, Bg, Cg):
    b, l, h, p = xs.shape
    g, n = Bg.shape[2], Bg.shape[3]
    nc = l // CHUNK
    rep = h // g
    Bh = jnp.repeat(Bg, rep, axis=2).reshape(b, nc, CHUNK, h, n)
    Ch = jnp.repeat(Cg, rep, axis=2).reshape(b, nc, CHUNK, h, n)
    xdt = (xs * dt[..., None]).reshape(b, nc, CHUNK, h, p)
    a_cs = jnp.cumsum((dt * A).reshape(b, nc, CHUNK, h), axis=2)
    seg = a_cs[:, :, :, None, :] - a_cs[:, :, None, :, :]
    causal = jnp.tril(jnp.ones((CHUNK, CHUNK), dtype=bool))[None, None, :, :, None]
    decay_qs = jnp.exp(jnp.where(causal, seg, -jnp.inf))
    scores = jnp.einsum('bcqhn,bcshn->bcqsh', Ch, Bh) * decay_qs
    y_diag = jnp.einsum('bcqsh,bcshp->bcqhp', scores, xdt)
    decay_to_end = jnp.exp(a_cs[:, :, -1:, :] - a_cs)
    states = jnp.einsum('bcqhn,bcqhp->bchpn', Bh * decay_to_end[..., None], xdt)
    chunk_decay = jnp.exp(a_cs[:, :, -1, :])

    def step(carry, inp):
        st, dec = inp
        return carry * dec[:, :, None, None] + st, carry

    init = jnp.zeros((b, h, p, n), jnp.float32)
    _, prev = lax.scan(step, init, (jnp.moveaxis(states, 1, 0), jnp.moveaxis(chunk_decay, 1, 0)))
    prev = jnp.moveaxis(prev, 0, 1)
    y_off = jnp.einsum('bcqhn,bchpn->bcqhp', Ch * jnp.exp(a_cs)[..., None], prev)
    return (y_diag + y_off).reshape(b, l, h, p)


def mamba2_group(u, conv_w, conv_b, dt_bias, a_log, d_skip, norm_w):
    b, l, _ = u.shape
    xbc = jax.nn.silu(causal_dwconv(u[..., :CONV_DIM], conv_w, conv_b)).astype(jnp.float32)
    z = u[..., CONV_DIM:CONV_DIM + SSM_WIDTH].astype(jnp.float32)
    dt_raw = u[..., CONV_DIM + SSM_WIDTH:].astype(jnp.float32)
    xs = xbc[..., :SSM_WIDTH].reshape(b, l, SSM_HEADS, HEAD_DIM)
    Bg = xbc[..., SSM_WIDTH:SSM_WIDTH + SSM_GROUPS * SSM_STATE].reshape(b, l, SSM_GROUPS, SSM_STATE)
    Cg = xbc[..., SSM_WIDTH + SSM_GROUPS * SSM_STATE:].reshape(b, l, SSM_GROUPS, SSM_STATE)
    dt = jax.nn.softplus(dt_raw + dt_bias.astype(jnp.float32))
    A = -jnp.exp(a_log.astype(jnp.float32))
    y = ssd_chunked(xs, dt, A, Bg, Cg) + d_skip.astype(jnp.float32)[:, None] * xs
    y = y.reshape(b, l, SSM_WIDTH) * jax.nn.silu(z)
    yg = y.reshape(b, l, SSM_GROUPS, SSM_WIDTH // SSM_GROUPS)
    yg = yg * lax.rsqrt(jnp.mean(yg * yg, axis=-1, keepdims=True) + NORM_EPS)
    y = yg.reshape(b, l, SSM_WIDTH) * norm_w.astype(jnp.float32)
    return y.astype(u.dtype)


def rwkv7_recurrence(r, w, k, v, a_vec, b_vec):
    b, l, h, d = r.shape

    def step(S, inp):
        r_t, w_t, k_t, v_t, a_t, b_t = inp
        sa = jnp.einsum('bhij,bhj->bhi', S, a_t)
        S = S * w_t[:, :, None, :] + sa[..., None] * b_t[:, :, None, :] + v_t[..., None] * k_t[:, :, None, :]
        return S, jnp.einsum('bhij,bhj->bhi', S, r_t)

    S0 = jnp.zeros((b, h, d, d), jnp.float32)
    xs = (jnp.moveaxis(r, 1, 0), jnp.moveaxis(w, 1, 0), jnp.moveaxis(k, 1, 0),
          jnp.moveaxis(v, 1, 0), jnp.moveaxis(a_vec, 1, 0), jnp.moveaxis(b_vec, 1, 0))
    _, ys = lax.scan(step, S0, xs)
    return jnp.moveaxis(ys, 0, 1)


def rwkv7_group(u, mu, w0, w2, a0, a2, k_k, k_a, r_k, lnx_w, lnx_b):
    b, l, _ = u.shape
    prev = jnp.pad(u, ((0, 0), (1, 0), (0, 0)))[:, :l, :]
    us = (u + (prev - u) * mu).astype(jnp.float32)
    W = RWKV_WIDTH
    r, k, v, g = us[..., :W], us[..., W:2 * W], us[..., 2 * W:3 * W], us[..., 3 * W:4 * W]
    w_lat = us[..., 4 * W:4 * W + DECAY_LORA]
    a_lat = us[..., 4 * W + DECAY_LORA:]
    w_log = -jax.nn.softplus(-(w0.astype(jnp.float32) + jnp.tanh(w_lat) @ w2.astype(jnp.float32))) - 0.5
    decay = jnp.exp(-jnp.exp(w_log))
    a = jax.nn.sigmoid(a0.astype(jnp.float32) + a_lat @ a2.astype(jnp.float32))
    kk = (k * k_k.astype(jnp.float32)).reshape(b, l, RWKV_HEADS, HEAD_DIM)
    kk = kk / jnp.maximum(jnp.sqrt(jnp.sum(kk * kk, axis=-1, keepdims=True)), L2_EPS)
    k = k * (1.0 + (a - 1.0) * k_a.astype(jnp.float32))
    hs = lambda t: t.reshape(b, l, RWKV_HEADS, HEAD_DIM)
    rh, kh, vh, ah = hs(r), hs(k), hs(v), hs(a)
    y = rwkv7_recurrence(rh, hs(decay), kh, vh, -kk, kk * ah)
    mean = jnp.mean(y, axis=-1, keepdims=True)
    var = jnp.mean(jnp.square(y - mean), axis=-1, keepdims=True)
    y = (y - mean) * lax.rsqrt(var + LNX_EPS)
    y = y * lnx_w.astype(jnp.float32).reshape(RWKV_HEADS, HEAD_DIM) \
        + lnx_b.astype(jnp.float32).reshape(RWKV_HEADS, HEAD_DIM)
    bonus = jnp.sum(rh * kh * r_k.astype(jnp.float32), axis=-1, keepdims=True) * vh
    y = (y + bonus).reshape(b, l, W) * jax.nn.silu(g)
    return y.astype(u.dtype)


def memory_xattn_group(u, mem_k, mem_v):
    b, l, _ = u.shape
    q = u[..., :XATTN_WIDTH].reshape(b, l, XATTN_HEADS, HEAD_DIM)
    g = u[..., XATTN_WIDTH:]
    s = jnp.einsum('blhd,bmhd->bhlm', q.astype(jnp.float32), mem_k.astype(jnp.float32)) * (HEAD_DIM ** -0.5)
    p = jax.nn.softmax(s, axis=-1)
    o = jnp.einsum('bhlm,bmhd->blhd', p, mem_v.astype(jnp.float32)).reshape(b, l, XATTN_WIDTH)
    return (o * jax.nn.silu(g.astype(jnp.float32))).astype(u.dtype)


def setup_inputs(seed: int = 0) -> dict:
    key = jax.random.key(seed)
    ks = jax.random.split(key, 24)
    f32 = jnp.float32
    nrm = lambda k, shape, scale: jax.random.normal(k, shape, f32) * scale
    dt = jnp.exp(jax.random.uniform(ks[8], (DEPTH, SSM_HEADS), f32)
                 * (jnp.log(0.1) - jnp.log(0.001)) + jnp.log(0.001))
    return {
        "x": nrm(ks[0], (BATCH, SEQ, D_MODEL), 1.0),
        "mem": nrm(ks[1], (BATCH, MEM_LEN, D_MODEL), 1.0),
        "mem_norm_w": 1.0 + nrm(ks[2], (D_MODEL,), 0.02),
        "w_mem_kv": nrm(ks[3], (D_MODEL, 2 * XATTN_WIDTH), D_MODEL ** -0.5),
        "pre_norm_w": 1.0 + nrm(ks[4], (DEPTH, D_MODEL), 0.02),
        "w_in": nrm(ks[5], (DEPTH, D_MODEL, IN_WIDTH), D_MODEL ** -0.5),
        "conv_w": nrm(ks[6], (DEPTH, CONV_WIDTH, CONV_DIM), 0.5),
        "conv_b": nrm(ks[7], (DEPTH, CONV_DIM), 0.02),
        "dt_bias": dt + jnp.log(-jnp.expm1(-dt)),
        "a_log": jnp.log(jax.random.uniform(ks[9], (DEPTH, SSM_HEADS), f32, 1.0, 16.0)),
        "d_skip": 1.0 + nrm(ks[10], (DEPTH, SSM_HEADS), 0.1),
        "ssm_norm_w": 1.0 + nrm(ks[11], (DEPTH, SSM_WIDTH), 0.02),
        "shift_mu": jax.random.uniform(ks[12], (DEPTH, RWKV_IN), f32),
        "w0": jax.random.uniform(ks[13], (DEPTH, RWKV_WIDTH), f32, -4.0, 1.0),
        "w2": nrm(ks[14], (DEPTH, DECAY_LORA, RWKV_WIDTH), 0.1),
        "a0": nrm(ks[15], (DEPTH, RWKV_WIDTH), 0.1),
        "a2": nrm(ks[16], (DEPTH, AAA_LORA, RWKV_WIDTH), 0.3 * AAA_LORA ** -0.5),
        "k_k": 0.85 + nrm(ks[17], (DEPTH, RWKV_WIDTH), 0.02),
        "k_a": 1.0 + nrm(ks[18], (DEPTH, RWKV_WIDTH), 0.02),
        "r_k": nrm(ks[19], (DEPTH, RWKV_HEADS, HEAD_DIM), 0.1),
        "lnx_w": 1.0 + nrm(ks[20], (DEPTH, RWKV_WIDTH), 0.02),
        "lnx_b": nrm(ks[21], (DEPTH, RWKV_WIDTH), 0.02),
        "w_out": nrm(ks[22], (DEPTH, D_MIX, D_MODEL), D_MIX ** -0.5),
        "post_norm_w": 1.0 + nrm(ks[23], (DEPTH, D_MODEL), 0.02),
    }


def reference(x, mem, mem_norm_w, w_mem_kv, pre_norm_w, w_in, conv_w, conv_b, dt_bias, a_log,
              d_skip, ssm_norm_w, shift_mu, w0, w2, a0, a2, k_k, k_a, r_k, lnx_w, lnx_b,
              w_out, post_norm_w):
    b = mem.shape[0]
    kv = rmsnorm(mem, mem_norm_w) @ w_mem_kv
    mem_k = kv[..., :XATTN_WIDTH].reshape(b, MEM_LEN, XATTN_HEADS, HEAD_DIM)
    mem_v = kv[..., XATTN_WIDTH:].reshape(b, MEM_LEN, XATTN_HEADS, HEAD_DIM)
    for i in range(DEPTH):
        h = rmsnorm(x, pre_norm_w[i])
        u = h @ w_in[i]
        y_ssm = mamba2_group(u[..., :SSM_IN], conv_w[i], conv_b[i], dt_bias[i], a_log[i],
                             d_skip[i], ssm_norm_w[i])
        y_rwkv = rwkv7_group(u[..., SSM_IN:SSM_IN + RWKV_IN], shift_mu[i], w0[i], w2[i], a0[i],
                             a2[i], k_k[i], k_a[i], r_k[i], lnx_w[i], lnx_b[i])
        y_mem = memory_xattn_group(u[..., SSM_IN + RWKV_IN:], mem_k, mem_v)
        y = jnp.concatenate([y_ssm, y_rwkv, y_mem], axis=-1)
        x = x + rmsnorm(y @ w_out[i], post_norm_w[i])
    return x
```

```cpp
#include <hip/hip_runtime.h>
#include <cstdio>
#include <cstdint>
namespace pg8 {
#define PG8_LAS __attribute__((address_space(3)))
typedef unsigned short bf16_t;
typedef short bf16x8 __attribute__((ext_vector_type(8)));
typedef float f32x4 __attribute__((ext_vector_type(4)));
typedef unsigned u32x4 __attribute__((ext_vector_type(4)));
constexpr int BM = 256, BK = 64, HALF = 128, HTB = HALF * BK * 2  , STAGE_BYTES = 8 * HTB, NXCD = 8, WGM = 8;

__host__ __device__ __forceinline__ int lds_byte(int r, int c) { const int st = (r >> 4) * 2 + (c >> 5), rr = r & 15, cc = c & 31, ob = rr * 64 + cc * 2; return st * 1024 + (ob ^ (((ob >> 9) & 1) << 5)); }
__host__ __device__ __forceinline__ void stage_rc(int b, int& R, int& C) { const int st = b / 1024, sb = b % 1024, swz = sb ^ (((sb >> 9) & 1) << 5); R = (st >> 1) * 16 + swz / 64; C = (st & 1) * 32 + (swz % 64) / 2; }
__host__ __device__ __forceinline__ int perm32(int rho) { const int n = rho >> 4, i = rho & 15; return 8 * (i >> 2) + 4 * n + (i & 3); }

struct Unit { int pm, pn; };
struct Gemm { const bf16_t* A; const bf16_t* Bt; int M, N, K; };

struct StaticOrder {
    int nM, nN, nwg, G, c;
    __host__ __device__ void init(int M, int N, int G_, int c_) { nM = M / BM; nN = N / BM; nwg = nM * nN; G = G_; c = c_; }
    __host__ __device__ bool next(int i, Unit& u) const {
        const long L = (long)i * G + c; if (L >= nwg) return false;
        int wgid = (int)L; { const int q = nwg / NXCD, r = nwg % NXCD, xcd = wgid % NXCD, off = wgid / NXCD; wgid = (xcd < r ? xcd * (q + 1) : r * (q + 1) + (xcd - r) * q) + off; }
        const int nig = WGM * nN, gid = wgid / nig, fm = gid * WGM, gsz = (nM - fm) < WGM ? (nM - fm) : WGM;
        u.pm = fm + ((wgid % nig) % gsz); u.pn = (wgid % nig) / gsz; return true;
    }
    __device__ __forceinline__ void a_ready(const Unit&) const {}
    __device__ __forceinline__ void done(const Unit&) const {}
};


__device__ __forceinline__ unsigned cvt_pk_bf16(float lo, float hi) { unsigned r; asm volatile("v_cvt_pk_bf16_f32 %0, %1, %2" : "=v"(r) : "v"(lo), "v"(hi)); return r; }
struct EpiBf16 {
    static constexpr bool PERM = true, AFTER_DRAIN = false;
    bf16_t* O; int ldc;
    __device__ __forceinline__ void operator()(const f32x4 (&acc)[2][2][4][2], const Unit& u, int wr, int wc, int fr, int fq) const {
        const int row0 = u.pm * BM + wr * 64 + fr; const int col0 = u.pn * BM + wc * 32 + 8 * fq;
#pragma unroll
        for (int ai = 0; ai < 2; ++ai)
#pragma unroll
            for (int m = 0; m < 4; ++m) { bf16_t* rowp = O + (size_t)(row0 + ai * HALF + m * 16) * ldc + col0;
#pragma unroll
                for (int bj = 0; bj < 2; ++bj) { const f32x4 v0 = acc[ai][bj][m][0], v1 = acc[ai][bj][m][1];
                    u32x4 w; w.x = cvt_pk_bf16(v0[0], v0[1]); w.y = cvt_pk_bf16(v0[2], v0[3]); w.z = cvt_pk_bf16(v1[0], v1[1]); w.w = cvt_pk_bf16(v1[2], v1[3]);
                    *(u32x4*)(rowp + bj * HALF) = w; } }
    }
};
struct EpiF32 {
    static constexpr bool PERM = false, AFTER_DRAIN = false;
    float* C; int ldc;
    __device__ __forceinline__ void operator()(const f32x4 (&acc)[2][2][4][2], const Unit& u, int wr, int wc, int fr, int fq) const {
        const int row0 = u.pm * BM + wr * 64 + fr, col0 = u.pn * BM + wc * 32 + 4 * fq;
#pragma unroll
        for (int ai = 0; ai < 2; ++ai)
#pragma unroll
            for (int m = 0; m < 4; ++m) { float* rowp = C + (size_t)(row0 + ai * HALF + m * 16) * ldc + col0;
#pragma unroll
                for (int bj = 0; bj < 2; ++bj)
#pragma unroll
                    for (int n = 0; n < 2; ++n) *(f32x4*)(rowp + bj * HALF + n * 16) = acc[ai][bj][m][n]; }
    }
};

template <class Epi, class Sched, bool ALIGN_EPI = false, bool SP2 = false>
__device__ __forceinline__ void gemm_phase(PG8_LAS unsigned char* lds, const Gemm g, const Sched& S, const Epi& E) {
    const int tid = threadIdx.x, wid = __builtin_amdgcn_readfirstlane(tid >> 6), lane = tid & 63, wr = wid >> 2, wc = wid & 3, fr = lane & 15, fq = lane >> 4;
    const int K = g.K, nt = K / BK;
    unsigned voffA[2], voffB[2];
#pragma unroll
    for (int i = 0; i < 2; ++i) { int R, C; stage_rc(tid * 16 + i * 8192, R, C); const int Rb = Epi::PERM ? ((R & ~31) + perm32(R & 31)) : R;
        voffA[i] = (unsigned)(R * K + C) * 2u; voffB[i] = (unsigned)(Rb * K + C) * 2u; }
    const size_t kstep = (size_t)(BK * 2);
    const size_t hstep = (size_t)HALF * K * 2;
    const size_t tstep = 2 * hstep;
    const unsigned ldsw = (unsigned)wid * 1024u;
    const int aoff = lds_byte(wr * 64 + fr, fq * 8), boff = lds_byte(wc * 32 + fr, fq * 8);
#define PG8_SA(b, h) (((b) * 2 + (h)) * HTB)
#define PG8_SB(b, h) ((4 + (b) * 2 + (h)) * HTB)
#define PG8_STAGE(bufoff, gbase, voff) do { _Pragma("unroll") for (int _i = 0; _i < 2; ++_i) \
        __builtin_amdgcn_global_load_lds((const unsigned*)((const char*)(gbase) + (voff)[_i]), (PG8_LAS unsigned*)(lds + (bufoff) + ldsw + _i * 8192), 16, 0, 0); } while (0)
#define PG8_LDA(dst, b, h) do { _Pragma("unroll") for (int m = 0; m < 4; ++m) _Pragma("unroll") for (int k = 0; k < 2; ++k) dst[m][k] = *(const PG8_LAS bf16x8*)(lds + PG8_SA(b, h) + aoff + m * 2048 + k * 1024); } while (0)
#define PG8_LDB(dst, b, h) do { _Pragma("unroll") for (int n = 0; n < 2; ++n) _Pragma("unroll") for (int k = 0; k < 2; ++k) dst[n][k] = *(const PG8_LAS bf16x8*)(lds + PG8_SB(b, h) + boff + n * 2048 + k * 1024); } while (0)
#define PG8_MMA(ai, bj, At, Bt) do { __builtin_amdgcn_s_setprio(1); _Pragma("unroll") for (int m = 0; m < 4; ++m) _Pragma("unroll") for (int n = 0; n < 2; ++n) _Pragma("unroll") for (int k = 0; k < 2; ++k) \
        acc[ai][bj][m][n] = __builtin_amdgcn_mfma_f32_16x16x32_bf16(Bt[n][k], At[m][k], acc[ai][bj][m][n], 0, 0, 0); __builtin_amdgcn_s_setprio(0); } while (0)
#define PG8_WAIT_V(n) asm volatile("s_waitcnt vmcnt(" #n ")" ::: "memory")
#define PG8_WAIT_L(n) asm volatile("s_waitcnt lgkmcnt(" #n ")" ::: "memory")
#define PG8_BAR __builtin_amdgcn_s_barrier()
#define PG8_SCHED __builtin_amdgcn_sched_barrier(0)
    Unit cur, nxt; int ui = 0;
    if (!S.next(0, cur)) return;
    f32x4 acc[2][2][4][2];
#pragma unroll
    for (int a = 0; a < 2; ++a)
#pragma unroll
        for (int b = 0; b < 2; ++b)
#pragma unroll
            for (int m = 0; m < 4; ++m)
#pragma unroll
                for (int n = 0; n < 2; ++n) acc[a][b][m][n] = (f32x4){0.f, 0.f, 0.f, 0.f};
    bf16x8 At[4][2], B0[2][2], B1[2][2];
    const char* cA = (const char*)g.A + (size_t)cur.pm * tstep; const char* cB = (const char*)g.Bt + (size_t)cur.pn * tstep;
    S.a_ready(cur);
    if constexpr (SP2) {
        PG8_STAGE(PG8_SB(0, 0), cB, voffB); PG8_STAGE(PG8_SB(0, 1), cB + hstep, voffB); PG8_STAGE(PG8_SA(0, 0), cA, voffA); PG8_STAGE(PG8_SA(0, 1), cA + hstep, voffA);
        if (wr == 1) PG8_BAR;
        PG8_WAIT_V(2); PG8_BAR;
        PG8_STAGE(PG8_SB(1, 0), cB + kstep, voffB); PG8_STAGE(PG8_SA(1, 0), cA + kstep, voffA); PG8_STAGE(PG8_SB(1, 1), cB + hstep + kstep, voffB);
        PG8_WAIT_V(6); PG8_BAR;
    } else {
        PG8_STAGE(PG8_SB(0, 0), cB, voffB); PG8_STAGE(PG8_SA(0, 0), cA, voffA); PG8_STAGE(PG8_SB(0, 1), cB + hstep, voffB); PG8_STAGE(PG8_SA(0, 1), cA + hstep, voffA);
        if (wr == 1) PG8_BAR;
        PG8_WAIT_V(4); PG8_BAR;
        PG8_STAGE(PG8_SB(1, 0), cB + kstep, voffB); PG8_STAGE(PG8_SA(1, 0), cA + kstep, voffA); PG8_STAGE(PG8_SB(1, 1), cB + hstep + kstep, voffB);
        PG8_WAIT_V(6); PG8_BAR;
    }
    for (;;) {
        const bool has_next = S.next(ui + 1, nxt);
        const char* nA = has_next ? (const char*)g.A + (size_t)nxt.pm * tstep : cA; const char* nB = has_next ? (const char*)g.Bt + (size_t)nxt.pn * tstep : cB;
        for (int t = 0; t < nt; t += 2) {
            const bool last = (t == nt - 2);
            const char* a1 = cA + (size_t)(t + 1) * kstep;
            const char* a2 = last ? nA : cA + (size_t)(t + 2) * kstep; const char* b2 = last ? nB : cB + (size_t)(t + 2) * kstep;
            const char* a3 = a2 + kstep; const char* b3 = b2 + kstep;
            if (last && has_next) S.a_ready(nxt);
            if constexpr (SP2) {
            PG8_LDB(B0, 0, 0); PG8_LDB(B1, 0, 1); PG8_SCHED; PG8_LDA(At, 0, 0); PG8_STAGE(PG8_SA(1, 1), a1 + hstep, voffA);
            PG8_WAIT_V(8); PG8_WAIT_L(0); PG8_BAR; PG8_MMA(0, 0, At, B0); PG8_MMA(0, 1, At, B1); PG8_BAR; PG8_SCHED;
            PG8_LDA(At, 0, 1); PG8_STAGE(PG8_SB(0, 0), b2, voffB); PG8_STAGE(PG8_SB(0, 1), b2 + hstep, voffB); PG8_STAGE(PG8_SA(0, 0), a2, voffA);
            PG8_WAIT_V(8); PG8_WAIT_L(0); PG8_BAR; PG8_MMA(1, 0, At, B0); PG8_MMA(1, 1, At, B1); PG8_BAR; PG8_SCHED;
            PG8_LDB(B0, 1, 0); PG8_LDB(B1, 1, 1); PG8_SCHED; PG8_LDA(At, 1, 0); PG8_STAGE(PG8_SA(0, 1), a2 + hstep, voffA);
            PG8_WAIT_V(8); PG8_WAIT_L(0); PG8_BAR; PG8_MMA(0, 0, At, B0); PG8_MMA(0, 1, At, B1); PG8_BAR; PG8_SCHED;
            PG8_LDA(At, 1, 1); PG8_STAGE(PG8_SB(1, 0), b3, voffB); PG8_STAGE(PG8_SB(1, 1), b3 + hstep, voffB); PG8_STAGE(PG8_SA(1, 0), a3, voffA);
            PG8_WAIT_V(8); PG8_WAIT_L(0); PG8_BAR; PG8_MMA(1, 0, At, B0); PG8_MMA(1, 1, At, B1); PG8_BAR; PG8_SCHED;
            } else {
            PG8_LDB(B0, 0, 0); PG8_SCHED; PG8_LDA(At, 0, 0); PG8_STAGE(PG8_SA(1, 1), a1 + hstep, voffA);
            PG8_WAIT_L(8); PG8_BAR; PG8_WAIT_L(0); PG8_MMA(0, 0, At, B0); PG8_BAR; PG8_SCHED;
            PG8_LDB(B1, 0, 1); PG8_STAGE(PG8_SB(0, 0), b2, voffB);
            PG8_BAR; PG8_WAIT_L(0); PG8_MMA(0, 1, At, B1); PG8_BAR;
            PG8_LDA(At, 0, 1); PG8_STAGE(PG8_SA(0, 0), a2, voffA);
            PG8_BAR; PG8_WAIT_L(0); PG8_MMA(1, 0, At, B0); PG8_BAR; PG8_SCHED;
            PG8_STAGE(PG8_SB(0, 1), b2 + hstep, voffB);
            PG8_WAIT_V(6); PG8_BAR; PG8_MMA(1, 1, At, B1); PG8_BAR;
            PG8_LDB(B0, 1, 0); PG8_SCHED; PG8_LDA(At, 1, 0); PG8_STAGE(PG8_SA(0, 1), a2 + hstep, voffA);
            PG8_WAIT_L(8); PG8_BAR; PG8_WAIT_L(0); PG8_MMA(0, 0, At, B0); PG8_BAR; PG8_SCHED;
            PG8_LDB(B1, 1, 1); PG8_STAGE(PG8_SB(1, 0), b3, voffB);
            PG8_BAR; PG8_WAIT_L(0); PG8_MMA(0, 1, At, B1); PG8_BAR;
            PG8_LDA(At, 1, 1); PG8_STAGE(PG8_SA(1, 0), a3, voffA);
            PG8_BAR; PG8_WAIT_L(0); PG8_MMA(1, 0, At, B0); PG8_BAR; PG8_SCHED;
            PG8_STAGE(PG8_SB(1, 1), b3 + hstep, voffB);
            PG8_WAIT_V(6); PG8_BAR; PG8_MMA(1, 1, At, B1); PG8_BAR;
            }
        }
        if constexpr (ALIGN_EPI) { if (wr == 0) PG8_BAR; }
        if constexpr (!Epi::AFTER_DRAIN) { E(acc, cur, wr, wc, fr, fq); S.done(cur); }
        if (!has_next) break;
#pragma unroll
        for (int a = 0; a < 2; ++a)
#pragma unroll
            for (int b = 0; b < 2; ++b)
#pragma unroll
                for (int m = 0; m < 4; ++m)
#pragma unroll
                    for (int n = 0; n < 2; ++n) acc[a][b][m][n] = (f32x4){0.f, 0.f, 0.f, 0.f};
        cur = nxt; cA = nA; cB = nB; ++ui;
        if constexpr (ALIGN_EPI) { if (wr == 1) PG8_BAR; }
    }
    PG8_WAIT_V(0);
    if constexpr (!ALIGN_EPI) { if (wr == 0) PG8_BAR; }
    PG8_BAR;
    if constexpr (Epi::AFTER_DRAIN) { E.fused(acc, cur, wr, wc, fr, fq, lds, wid, lane); S.done(cur); }
#undef PG8_SA
#undef PG8_SB
#undef PG8_STAGE
#undef PG8_LDA
#undef PG8_LDB
#undef PG8_MMA
#undef PG8_WAIT_V
#undef PG8_WAIT_L
#undef PG8_BAR
#undef PG8_SCHED
}
}

constexpr int M = 16384, D = 1024, DEPTH = 4, NU = 3328, NWIN = 3208, NCHUNK = 256;
constexpr int MEM_LEN = 256;
constexpr int C_XS = 0, C_B = 512, C_C = 768, C_Z = 1024, C_R = 1536, C_K = 1792, C_V = 2048, C_G = 2304, C_WL = 2560, C_AL = 2624, C_DT = 2688, C_Q = 2816, C_GX = 3072;
constexpr float NORM_EPS = 1e-6f, LNX_EPS = 64e-5f;

#define LAS __attribute__((address_space(3)))
typedef unsigned short bf16;
typedef short bf16x8 __attribute__((ext_vector_type(8)));
typedef float f32x4 __attribute__((ext_vector_type(4)));

__device__ __forceinline__ unsigned f2bf(float f) { unsigned u = __float_as_uint(f); return (u + 0x7fffu + ((u >> 16) & 1u)) >> 16; }
__device__ __forceinline__ float bf2f(unsigned b) { return __uint_as_float(b << 16); }
__device__ __forceinline__ float wave_sum(float v) {
#pragma unroll
    for (int o = 1; o < 64; o <<= 1) v += __shfl_xor(v, o);
    return v;
}
__device__ __forceinline__ float silu_f(float x) { return x / (1.f + __expf(-x)); }
__device__ __forceinline__ float softplus_f(float x) { return fmaxf(x, 0.f) + log1pf(__expf(-fabsf(x))); }
__device__ __forceinline__ float sigmoid_f(float x) { return 1.f / (1.f + __expf(-x)); }

__device__ __forceinline__ bf16x8 ld_frag(const LAS bf16* base, int ld, int row0, int k0, int lane) {
    return *(const LAS bf16x8*)(base + (row0 + (lane & 15)) * ld + k0 + (lane >> 4) * 8);
}
#define MFMA16(a, b, c) __builtin_amdgcn_mfma_f32_16x16x32_bf16((a), (b), (c), 0, 0, 0)

struct Params {
    const float *x, *mem, *mem_norm_w, *w_mem_kv, *pre_norm_w, *w_in, *conv_w, *conv_b, *dt_bias, *a_log, *d_skip, *ssm_norm_w,
                *shift_mu, *w0, *w2, *a0, *a2, *k_k, *k_a, *r_k, *lnx_w, *lnx_b, *w_out, *post_norm_w;
    float* out;
    unsigned char* ws;
};
constexpr size_t MiB = 1u << 20;
constexpr size_t WS_CTL = 0, WS_WIN = 1 * MiB, WS_WOUT = 27 * MiB, WS_KV = 35 * MiB, WS_H = 36 * MiB, WS_U = 68 * MiB, WS_R = 172 * MiB, WS_END = 256 * MiB;
constexpr size_t WS_ST = WS_R, WS_CD = WS_R + 64 * MiB;
constexpr size_t WS_RPW = WS_R, WS_RPR = WS_R + 16 * MiB, WS_RPK = WS_R + 24 * MiB, WS_RPV = WS_R + 32 * MiB, WS_RPKK = WS_R + 40 * MiB, WS_RPB = WS_R + 48 * MiB;

__device__ __forceinline__ int win_src_col(int n) {
    if (n < 1536) return n;
    if (n < 2560) return n + 8;
    if (n < 2816) { const int j = n - 2560; if (j < 64) return 2568 + j; if (j < 128) return 2632 + (j - 64); if (j < 136) return 1536 + (j - 128); return -1; }
    return n - 120;
}
template <bool WIN>
__device__ __forceinline__ void transpose_tile(const float* src, int src_ld, bf16* dst, int K, int n0, int k0, LAS float* scr) {
    const int tx = threadIdx.x & 63, ty = threadIdx.x >> 6;
    const int sc = WIN ? win_src_col(n0 + tx) : (n0 + tx);
#pragma unroll
    for (int kk = ty; kk < 64; kk += 8) scr[kk * 65 + tx] = sc >= 0 ? src[(size_t)(k0 + kk) * src_ld + sc] : 0.f;
    __syncthreads();
#pragma unroll
    for (int nn = ty; nn < 64; nn += 8) dst[(size_t)(n0 + nn) * K + k0 + tx] = (bf16)f2bf(scr[tx * 65 + nn]);
    __syncthreads();
}
__device__ __forceinline__ void stage_prep_weights(const Params& P, LAS unsigned char* lds, int item) {
    LAS float* scr = (LAS float*)lds;
    constexpr int T_IN = (NU / 64) * (D / 64);
    constexpr int T_OUT = (D / 64) * (D / 64);
    if (item < DEPTH * T_IN) { const int l = item / T_IN, r = item % T_IN, nb = r / 16, kb = r % 16;
        transpose_tile<true>(P.w_in + (size_t)l * D * NWIN, NWIN, (bf16*)(P.ws + WS_WIN) + (size_t)l * NU * D, D, nb * 64, kb * 64, scr); }
    else { const int it = item - DEPTH * T_IN; const int l = it / T_OUT, r = it % T_OUT, nb = r / 16, kb = r % 16;
        transpose_tile<false>(P.w_out + (size_t)l * D * D, D, (bf16*)(P.ws + WS_WOUT) + (size_t)l * D * D, D, nb * 64, kb * 64, scr); }
}
constexpr int N_PREP_ITEMS = DEPTH * ((NU / 64) * (D / 64) + (D / 64) * (D / 64));

__device__ __forceinline__ void stage_memkv(const Params& P, LAS unsigned char* lds, int m) {
    LAS float* xs = (LAS float*)lds; LAS float* red = xs + 1024;
    const int tid = threadIdx.x;
    const float v0 = P.mem[(size_t)m * D + tid], v1 = P.mem[(size_t)m * D + 512 + tid];
    float s = wave_sum(v0 * v0 + v1 * v1);
    if ((tid & 63) == 0) red[tid >> 6] = s;
    __syncthreads();
    float tot = 0.f;
#pragma unroll
    for (int w = 0; w < 8; ++w) tot += red[w];
    const float rstd = rsqrtf(tot * (1.f / D) + NORM_EPS);
    xs[tid] = v0 * rstd * P.mem_norm_w[tid]; xs[512 + tid] = v1 * rstd * P.mem_norm_w[512 + tid];
    __syncthreads();
    float acc = 0.f;
#pragma unroll 8
    for (int k = 0; k < D; ++k) acc += xs[k] * P.w_mem_kv[(size_t)k * 512 + tid];
    ((float*)(P.ws + WS_KV))[(size_t)m * 512 + tid] = acc;
    __syncthreads();
}

__device__ __forceinline__ void prenorm_row(const float* xrow, const float* w, bf16* orow, int lane) {
    const f32x4* xr = (const f32x4*)xrow + lane; const f32x4* wr = (const f32x4*)w + lane;
    f32x4 v[4]; float s = 0.f;
#pragma unroll
    for (int j = 0; j < 4; ++j) { v[j] = xr[64 * j]; s += (v[j].x * v[j].x + v[j].y * v[j].y) + (v[j].z * v[j].z + v[j].w * v[j].w); }
    const float rstd = rsqrtf(wave_sum(s) * (1.f / D) + NORM_EPS);
    unsigned long long* o8 = (unsigned long long*)orow + lane;
#pragma unroll
    for (int j = 0; j < 4; ++j) { const f32x4 ww = wr[64 * j];
        const unsigned lo = f2bf(v[j].x * rstd * ww.x) | (f2bf(v[j].y * rstd * ww.y) << 16), hi = f2bf(v[j].z * rstd * ww.z) | (f2bf(v[j].w * rstd * ww.w) << 16);
        o8[64 * j] = (unsigned long long)lo | ((unsigned long long)hi << 32); }
}
__device__ __forceinline__ void post_row(const float* orow, const float* xin, const float* pw, float* xout, const float* nw, bf16* hrow, int lane) {
    const f32x4* orr = (const f32x4*)orow + lane; const f32x4* xr = (const f32x4*)xin + lane; const f32x4* pr = (const f32x4*)pw + lane;
    f32x4 v[4]; float s = 0.f;
#pragma unroll
    for (int j = 0; j < 4; ++j) { v[j] = orr[64 * j]; s += (v[j].x * v[j].x + v[j].y * v[j].y) + (v[j].z * v[j].z + v[j].w * v[j].w); }
    const float rstd = rsqrtf(wave_sum(s) * (1.f / D) + NORM_EPS);
    float s2 = 0.f;
#pragma unroll
    for (int j = 0; j < 4; ++j) { const f32x4 xx = xr[64 * j], pp = pr[64 * j]; v[j] = xx + v[j] * rstd * pp; s2 += (v[j].x * v[j].x + v[j].y * v[j].y) + (v[j].z * v[j].z + v[j].w * v[j].w);
        ((f32x4*)xout + lane)[64 * j] = v[j]; }
    if (hrow) {
        const float rstd2 = rsqrtf(wave_sum(s2) * (1.f / D) + NORM_EPS);
        const f32x4* wr = (const f32x4*)nw + lane; unsigned long long* o8 = (unsigned long long*)hrow + lane;
#pragma unroll
        for (int j = 0; j < 4; ++j) { const f32x4 ww = wr[64 * j];
            const unsigned lo = f2bf(v[j].x * rstd2 * ww.x) | (f2bf(v[j].y * rstd2 * ww.y) << 16), hi = f2bf(v[j].z * rstd2 * ww.z) | (f2bf(v[j].w * rstd2 * ww.w) << 16);
            o8[64 * j] = (unsigned long long)lo | ((unsigned long long)hi << 32); }
    }
}

constexpr int XA_KLD = 72, XA_VLD = 264, XA_PLD = 264;
constexpr int XA_LDS = (256 * XA_KLD + 64 * XA_VLD + 8 * 16 * XA_PLD) * 2;
__device__ __forceinline__ void stage_xattn(const Params& P, LAS unsigned char* lds, int item) {
    const int tid = threadIdx.x, lane = tid & 63, wave = tid >> 6, quad = lane >> 4, l15 = lane & 15;
    const int tile = item >> 2, h = item & 3, t0 = tile * 256;
    LAS bf16* Ks = (LAS bf16*)lds; LAS bf16* VT = Ks + 256 * XA_KLD; LAS bf16* Pw = VT + 64 * XA_VLD + wave * 16 * XA_PLD;
    const float* KV = (const float*)(P.ws + WS_KV);
    const bf16* U = (const bf16*)(P.ws + WS_U); bf16* Y = (bf16*)(P.ws + WS_H);
    for (int e = tid; e < 256 * 64; e += 512) { const int m = e >> 6, d = e & 63;
        Ks[m * XA_KLD + d] = (bf16)f2bf(KV[(size_t)m * 512 + h * 64 + d]);
        VT[d * XA_VLD + m] = (bf16)f2bf(KV[(size_t)m * 512 + 256 + h * 64 + d]); }
    __syncthreads();
    for (int rb = 0; rb < 2; ++rb) {
        const int tr = t0 + wave * 32 + rb * 16;
        bf16x8 a[2];
#pragma unroll
        for (int s = 0; s < 2; ++s) a[s] = *(const bf16x8*)(U + (size_t)(tr + l15) * NU + C_Q + h * 64 + s * 32 + quad * 8);
        f32x4 acc[16];
#pragma unroll
        for (int j = 0; j < 16; ++j) { acc[j] = (f32x4){0.f, 0.f, 0.f, 0.f};
#pragma unroll
            for (int s = 0; s < 2; ++s) acc[j] = MFMA16(a[s], ld_frag(Ks, XA_KLD, j * 16, s * 32, lane), acc[j]); }
        float mx[4], sm[4];
#pragma unroll
        for (int r = 0; r < 4; ++r) { float m_ = -3.0e38f;
#pragma unroll
            for (int j = 0; j < 16; ++j) { acc[j][r] *= 0.125f; m_ = fmaxf(m_, acc[j][r]); }
#pragma unroll
            for (int o = 1; o < 16; o <<= 1) m_ = fmaxf(m_, __shfl_xor(m_, o));
            mx[r] = m_; float s_ = 0.f;
#pragma unroll
            for (int j = 0; j < 16; ++j) { const float p = __expf(acc[j][r] - m_); s_ += p; Pw[(quad * 4 + r) * XA_PLD + j * 16 + l15] = (bf16)f2bf(p); }
#pragma unroll
            for (int o = 1; o < 16; o <<= 1) s_ += __shfl_xor(s_, o);
            sm[r] = s_; }
        __syncthreads();
        f32x4 o4[4];
#pragma unroll
        for (int jd = 0; jd < 4; ++jd) o4[jd] = (f32x4){0.f, 0.f, 0.f, 0.f};
#pragma unroll
        for (int ks = 0; ks < 8; ++ks) { const bf16x8 pa = ld_frag(Pw, XA_PLD, 0, ks * 32, lane);
#pragma unroll
            for (int jd = 0; jd < 4; ++jd) o4[jd] = MFMA16(pa, ld_frag(VT, XA_VLD, jd * 16, ks * 32, lane), o4[jd]); }
#pragma unroll
        for (int jd = 0; jd < 4; ++jd)
#pragma unroll
            for (int r = 0; r < 4; ++r) { const int t = tr + quad * 4 + r, d = jd * 16 + l15;
                const float g = bf2f(U[(size_t)t * NU + C_GX + h * 64 + d]);
                Y[(size_t)t * D + 768 + h * 64 + d] = (bf16)f2bf(o4[jd][r] / sm[r] * silu_f(g)); }
        __syncthreads();
    }
}

__device__ __forceinline__ void ssd_dt(const Params& P, int l, int c, int g, LAS float* dtS, LAS float* acS) {
    const int tid = threadIdx.x;
    if (tid < 256) { const int hh = tid >> 6, q = tid & 63, h = g * 4 + hh;
        const bf16* U = (const bf16*)(P.ws + WS_U);
        const float raw = bf2f(U[(size_t)(c * 64 + q) * NU + C_DT + h]);
        const float dt = softplus_f(raw + P.dt_bias[l * 8 + h]);
        const float A = -__expf(P.a_log[l * 8 + h]);
        float v = dt * A;
#pragma unroll
        for (int o = 1; o < 64; o <<= 1) { const float t = __shfl_up(v, o); if (q >= o) v += t; }
        dtS[hh * 64 + q] = dt; acS[hh * 64 + q] = v; }
}
constexpr int S1_LDS = 2048 + (4 * 64 * 72 + 128 * 72) * 2;
__device__ __forceinline__ void stage_ssd_s1(const Params& P, int l, LAS unsigned char* lds, int item) {
    const int tid = threadIdx.x, lane = tid & 63, wave = tid >> 6, quad = lane >> 4, l15 = lane & 15;
    const int c = item >> 1, g = item & 1, t0 = c * 64;
    LAS float* dtS = (LAS float*)lds; LAS float* acS = dtS + 256; LAS bf16* XT = (LAS bf16*)(lds + 2048); LAS bf16* BT = XT + 4 * 64 * 72;
    const bf16* U = (const bf16*)(P.ws + WS_U);
    ssd_dt(P, l, c, g, dtS, acS);
    __syncthreads();
    if (tid < 384) {
        const int j = tid, col = j < 256 ? C_XS + g * 256 + j : C_B + g * 128 + (j - 256);
        const float* cw = P.conv_w + (size_t)l * 4 * 1024; const float w0 = cw[col], w1 = cw[1024 + col], w2 = cw[2048 + col], w3 = cw[3072 + col], cb = P.conv_b[l * 1024 + col];
        float u0 = t0 >= 3 ? bf2f(U[(size_t)(t0 - 3) * NU + col]) : 0.f, u1 = t0 >= 2 ? bf2f(U[(size_t)(t0 - 2) * NU + col]) : 0.f, u2 = t0 >= 1 ? bf2f(U[(size_t)(t0 - 1) * NU + col]) : 0.f;
        for (int q = 0; q < 64; ++q) { const float u3 = bf2f(U[(size_t)(t0 + q) * NU + col]);
            float v = silu_f(cb + w0 * u0 + w1 * u1 + w2 * u2 + w3 * u3); u0 = u1; u1 = u2; u2 = u3;
            if (j < 256) { const int hh = j >> 6, p = j & 63; v *= dtS[hh * 64 + q] * __expf(acS[hh * 64 + 63] - acS[hh * 64 + q]); XT[(hh * 64 + p) * 72 + q] = (bf16)f2bf(v); }
            else BT[(j - 256) * 72 + q] = (bf16)f2bf(v); }
    }
    __syncthreads();
    { const int hh = wave >> 1, nh = wave & 1, h = g * 4 + hh;
        float* ST = (float*)(P.ws + WS_ST) + ((size_t)(c * 8 + h) * 64) * 128;
#pragma unroll
        for (int pb = 0; pb < 4; ++pb)
#pragma unroll
            for (int nb = 0; nb < 4; ++nb) { f32x4 acc = (f32x4){0.f, 0.f, 0.f, 0.f};
#pragma unroll
                for (int ks = 0; ks < 2; ++ks) acc = MFMA16(ld_frag(XT + hh * 64 * 72, 72, pb * 16, ks * 32, lane), ld_frag(BT, 72, nh * 64 + nb * 16, ks * 32, lane), acc);
#pragma unroll
                for (int r = 0; r < 4; ++r) ST[(size_t)(pb * 16 + quad * 4 + r) * 128 + nh * 64 + nb * 16 + l15] = acc[r]; }
        if (tid < 4) ((float*)(P.ws + WS_CD))[c * 8 + g * 4 + tid] = __expf(acS[tid * 64 + 63]);
    }
    __syncthreads();
}
__device__ __forceinline__ void stage_ssd_scan(const Params& P, int e) {
    float* ST = (float*)(P.ws + WS_ST); const float* CD = (const float*)(P.ws + WS_CD);
    const int h = e >> 13; float carry = 0.f;
    for (int c = 0; c < NCHUNK; ++c) { const size_t idx = (size_t)c * 65536 + e; const float v = ST[idx]; ST[idx] = carry; carry = carry * CD[c * 8 + h] + v; }
}
constexpr int S3_LDS = 3072 + (2 * 64 * 136 + 4 * 64 * 72 + 8 * 32 * 72) * 2;
__device__ __forceinline__ void stage_ssd_s3(const Params& P, int l, LAS unsigned char* lds, int item) {
    const int tid = threadIdx.x, lane = tid & 63, wave = tid >> 6, quad = lane >> 4, l15 = lane & 15;
    const int c = item >> 1, g = item & 1, t0 = c * 64;
    LAS float* dtS = (LAS float*)lds; LAS float* acS = dtS + 256; LAS float* red = acS + 256;
    LAS bf16* Cn = (LAS bf16*)(lds + 3072); LAS bf16* Bn = Cn + 64 * 136; LAS bf16* XT = Bn + 64 * 136; LAS bf16* SCw = XT + 4 * 64 * 72 + wave * 32 * 72;
    const bf16* U = (const bf16*)(P.ws + WS_U); bf16* Y = (bf16*)(P.ws + WS_H);
    ssd_dt(P, l, c, g, dtS, acS);
    __syncthreads();
    {
        const int j = tid, col = j < 256 ? C_XS + g * 256 + j : (j < 384 ? C_B + g * 128 + (j - 256) : C_C + g * 128 + (j - 384));
        const float* cw = P.conv_w + (size_t)l * 4 * 1024; const float w0 = cw[col], w1 = cw[1024 + col], w2 = cw[2048 + col], w3 = cw[3072 + col], cb = P.conv_b[l * 1024 + col];
        float u0 = t0 >= 3 ? bf2f(U[(size_t)(t0 - 3) * NU + col]) : 0.f, u1 = t0 >= 2 ? bf2f(U[(size_t)(t0 - 2) * NU + col]) : 0.f, u2 = t0 >= 1 ? bf2f(U[(size_t)(t0 - 1) * NU + col]) : 0.f;
        for (int q = 0; q < 64; ++q) { const float u3 = bf2f(U[(size_t)(t0 + q) * NU + col]);
            const float v = silu_f(cb + w0 * u0 + w1 * u1 + w2 * u2 + w3 * u3); u0 = u1; u1 = u2; u2 = u3;
            if (j < 256) { const int hh = j >> 6, p = j & 63; XT[(hh * 64 + p) * 72 + q] = (bf16)f2bf(v * dtS[hh * 64 + q]); }
            else if (j < 384) Bn[q * 136 + (j - 256)] = (bf16)f2bf(v);
            else Cn[q * 136 + (j - 384)] = (bf16)f2bf(v); }
    }
    __syncthreads();
    const int hh = wave >> 1, qh = wave & 1, h = g * 4 + hh;
#pragma unroll
    for (int qb = 0; qb < 2; ++qb)
#pragma unroll
        for (int sb = 0; sb < 4; ++sb) { f32x4 acc = (f32x4){0.f, 0.f, 0.f, 0.f};
#pragma unroll
            for (int ks = 0; ks < 4; ++ks) acc = MFMA16(ld_frag(Cn, 136, qh * 32 + qb * 16, ks * 32, lane), ld_frag(Bn, 136, sb * 16, ks * 32, lane), acc);
#pragma unroll
            for (int r = 0; r < 4; ++r) { const int q = qh * 32 + qb * 16 + quad * 4 + r, s = sb * 16 + l15;
                const float v = (s <= q) ? acc[r] * __expf(acS[hh * 64 + q] - acS[hh * 64 + s]) : 0.f;
                SCw[(qb * 16 + quad * 4 + r) * 72 + s] = (bf16)f2bf(v); } }
    __syncthreads();
    f32x4 y[2][4];
    const float* ST = (const float*)(P.ws + WS_ST) + ((size_t)(c * 8 + h) * 64) * 128;
#pragma unroll
    for (int qb = 0; qb < 2; ++qb)
#pragma unroll
        for (int pb = 0; pb < 4; ++pb) { f32x4 yd = (f32x4){0.f, 0.f, 0.f, 0.f}, yo = (f32x4){0.f, 0.f, 0.f, 0.f};
#pragma unroll
            for (int ks = 0; ks < 2; ++ks) yd = MFMA16(ld_frag(SCw, 72, qb * 16, ks * 32, lane), ld_frag(XT + hh * 64 * 72, 72, pb * 16, ks * 32, lane), yd);
#pragma unroll
            for (int ks = 0; ks < 4; ++ks) { const float* sp = ST + (size_t)(pb * 16 + l15) * 128 + ks * 32 + quad * 8; const f32x4 s0 = *(const f32x4*)sp, s1 = *(const f32x4*)(sp + 4);
                bf16x8 b; b[0] = (short)f2bf(s0[0]); b[1] = (short)f2bf(s0[1]); b[2] = (short)f2bf(s0[2]); b[3] = (short)f2bf(s0[3]); b[4] = (short)f2bf(s1[0]); b[5] = (short)f2bf(s1[1]); b[6] = (short)f2bf(s1[2]); b[7] = (short)f2bf(s1[3]);
                yo = MFMA16(ld_frag(Cn, 136, qh * 32 + qb * 16, ks * 32, lane), b, yo); }
#pragma unroll
            for (int r = 0; r < 4; ++r) { const int q = qh * 32 + qb * 16 + quad * 4 + r, p = pb * 16 + l15;
                const float xs = bf2f(XT[(hh * 64 + p) * 72 + q]) / dtS[hh * 64 + q];
                float v = yd[r] + __expf(acS[hh * 64 + q]) * yo[r] + P.d_skip[l * 8 + h] * xs;
                const float z = bf2f(U[(size_t)(t0 + q) * NU + C_Z + h * 64 + p]);
                y[qb][pb][r] = v * silu_f(z); } }
#pragma unroll
    for (int qb = 0; qb < 2; ++qb)
#pragma unroll
        for (int r = 0; r < 4; ++r) { float s = 0.f;
#pragma unroll
            for (int pb = 0; pb < 4; ++pb) s += y[qb][pb][r] * y[qb][pb][r];
#pragma unroll
            for (int o = 1; o < 16; o <<= 1) s += __shfl_xor(s, o);
            if (l15 == 0) red[hh * 64 + qh * 32 + qb * 16 + quad * 4 + r] = s; }
    __syncthreads();
#pragma unroll
    for (int qb = 0; qb < 2; ++qb)
#pragma unroll
        for (int r = 0; r < 4; ++r) { const int q = qh * 32 + qb * 16 + quad * 4 + r;
            const float tot = red[q] + red[64 + q] + red[128 + q] + red[192 + q]; const float rstd = rsqrtf(tot * (1.f / 256.f) + NORM_EPS);
#pragma unroll
            for (int pb = 0; pb < 4; ++pb) { const int p = pb * 16 + l15;
                Y[(size_t)(t0 + q) * D + h * 64 + p] = (bf16)f2bf(y[qb][pb][r] * rstd * P.ssm_norm_w[l * 512 + h * 64 + p]); } }
    __syncthreads();
}

constexpr int RP_LDS = 1024 + 2 * 64 * 256 * 4;
__device__ __forceinline__ void stage_rwkv_prep(const Params& P, int l, LAS unsigned char* lds, int item) {
    const int tid = threadIdx.x, half = tid >> 8, ch = tid & 255;
    LAS float* latw = (LAS float*)lds + half * 128; LAS float* lata = latw + 64;
    const bf16* U = (const bf16*)(P.ws + WS_U);
    const float* mu = P.shift_mu + (size_t)l * 1152;
    LAS float* w2s = (LAS float*)lds + 256; LAS float* a2s = w2s + 64 * 256;
    for (int e = tid; e < 64 * 256; e += 512) { w2s[e] = P.w2[(size_t)l * 64 * 256 + e]; a2s[e] = P.a2[(size_t)l * 64 * 256 + e]; }
    __syncthreads();
    const float w0c = P.w0[l * 256 + ch], a0c = P.a0[l * 256 + ch], kkc = P.k_k[l * 256 + ch], kac = P.k_a[l * 256 + ch];
    const float mur = mu[ch], muk = mu[256 + ch], muv = mu[512 + ch];
    const float mul = ch < 128 ? mu[1024 + ch] : 0.f;
    float* RPW = (float*)(P.ws + WS_RPW); bf16* RPR = (bf16*)(P.ws + WS_RPR); bf16* RPK = (bf16*)(P.ws + WS_RPK); bf16* RPV = (bf16*)(P.ws + WS_RPV); bf16* RPKK = (bf16*)(P.ws + WS_RPKK); bf16* RPB = (bf16*)(P.ws + WS_RPB);
    for (int i = 0; i < 32; ++i) {
        const int t = item * 64 + half * 32 + i;
        const bf16* uc = U + (size_t)t * NU; const bf16* up = uc - NU; const bool hp = t > 0;
        float cr = bf2f(uc[C_R + ch]), ck = bf2f(uc[C_K + ch]), cv = bf2f(uc[C_V + ch]);
        const float pr = hp ? bf2f(up[C_R + ch]) : 0.f, pk = hp ? bf2f(up[C_K + ch]) : 0.f, pv = hp ? bf2f(up[C_V + ch]) : 0.f;
        const float r = cr + (pr - cr) * mur, k = ck + (pk - ck) * muk, v = cv + (pv - cv) * muv;
        if (ch < 128) { const float cl = bf2f(uc[C_WL + ch]), pl = hp ? bf2f(up[C_WL + ch]) : 0.f; const float s = cl + (pl - cl) * mul;
            if (ch < 64) latw[ch] = tanhf(s); else lata[ch - 64] = s; }
        __syncthreads();
        float aw = w0c, aa = a0c;
#pragma unroll
        for (int j = 0; j < 64; ++j) { aw += latw[j] * w2s[j * 256 + ch]; aa += lata[j] * a2s[j * 256 + ch]; }
        const float wlog = -softplus_f(-aw) - 0.5f; const float decay = __expf(-__expf(wlog)); const float a = sigmoid_f(aa);
        float kk = k * kkc; const float ss = wave_sum(kk * kk); kk = kk / fmaxf(sqrtf(ss), 1e-12f);
        const float k2 = k * (1.f + (a - 1.f) * kac);
        const size_t o = (size_t)t * 256 + ch;
        RPW[o] = decay; RPR[o] = (bf16)f2bf(r); RPK[o] = (bf16)f2bf(k2); RPV[o] = (bf16)f2bf(v); RPKK[o] = (bf16)f2bf(kk); RPB[o] = (bf16)f2bf(kk * a);
        __syncthreads();
    }
}
__global__ void __launch_bounds__(64) k_rwkv_seq(Params P, int l) {
    __shared__ float vec[16][6][64];
    __shared__ float rkS[64];
    const int h = blockIdx.x, lane = threadIdx.x, chn = h * 64 + lane;
    const float* RPW = (const float*)(P.ws + WS_RPW); const bf16* RPR = (const bf16*)(P.ws + WS_RPR); const bf16* RPK = (const bf16*)(P.ws + WS_RPK); const bf16* RPV = (const bf16*)(P.ws + WS_RPV);
    const bf16* RPKK = (const bf16*)(P.ws + WS_RPKK); const bf16* RPB = (const bf16*)(P.ws + WS_RPB);
    const bf16* U = (const bf16*)(P.ws + WS_U); bf16* Y = (bf16*)(P.ws + WS_H);
    rkS[lane] = P.r_k[l * 256 + chn];
    const float lw = P.lnx_w[l * 256 + chn], lb = P.lnx_b[l * 256 + chn], mug = P.shift_mu[(size_t)l * 1152 + 768 + chn];
    float S[64];
#pragma unroll
    for (int j = 0; j < 64; ++j) S[j] = 0.f;
    for (int t0 = 0; t0 < M; t0 += 16) {
        __syncthreads();
#pragma unroll
        for (int tt = 0; tt < 16; ++tt) { const size_t o = (size_t)(t0 + tt) * 256 + chn;
            vec[tt][0][lane] = bf2f(RPR[o]); vec[tt][1][lane] = RPW[o]; vec[tt][2][lane] = bf2f(RPK[o]); vec[tt][3][lane] = bf2f(RPKK[o]); vec[tt][4][lane] = bf2f(RPB[o]); vec[tt][5][lane] = bf2f(RPV[o]); }
        __syncthreads();
        for (int tt = 0; tt < 16; ++tt) {
            const int t = t0 + tt;
            const float vi = vec[tt][5][lane];
            float sa0 = 0.f, sa1 = 0.f, sa2 = 0.f, sa3 = 0.f;
#pragma unroll
            for (int j = 0; j < 64; j += 4) { sa0 += S[j] * vec[tt][3][j]; sa1 += S[j + 1] * vec[tt][3][j + 1]; sa2 += S[j + 2] * vec[tt][3][j + 2]; sa3 += S[j + 3] * vec[tt][3][j + 3]; }
            const float sa = -((sa0 + sa1) + (sa2 + sa3));
            float y0 = 0.f, y1 = 0.f, bn = 0.f;
#pragma unroll
            for (int j = 0; j < 64; j += 2) {
                S[j] = S[j] * vec[tt][1][j] + sa * vec[tt][4][j] + vi * vec[tt][2][j];
                S[j + 1] = S[j + 1] * vec[tt][1][j + 1] + sa * vec[tt][4][j + 1] + vi * vec[tt][2][j + 1];
                y0 += S[j] * vec[tt][0][j]; y1 += S[j + 1] * vec[tt][0][j + 1];
                bn += vec[tt][0][j] * vec[tt][2][j] * rkS[j] + vec[tt][0][j + 1] * vec[tt][2][j + 1] * rkS[j + 1]; }
            const float y = y0 + y1;
            const float mean = wave_sum(y) * (1.f / 64.f); const float d = y - mean; const float var = wave_sum(d * d) * (1.f / 64.f);
            const float yn = d * rsqrtf(var + LNX_EPS) * lw + lb;
            const float cg = bf2f(U[(size_t)t * NU + C_G + chn]); const float pg = t > 0 ? bf2f(U[(size_t)(t - 1) * NU + C_G + chn]) : 0.f;
            const float gs = cg + (pg - cg) * mug;
            Y[(size_t)t * D + 512 + chn] = (bf16)f2bf((yn + bn * vi) * silu_f(gs));
        }
    }
}

constexpr int NT = 512;
constexpr int GEMM_LDS = pg8::STAGE_BYTES;
__global__ void __launch_bounds__(NT, 2) k_prep(Params P) {
    extern __shared__ __attribute__((aligned(16))) unsigned char lds[];
    for (int it = blockIdx.x; it < N_PREP_ITEMS; it += gridDim.x) stage_prep_weights(P, (LAS unsigned char*)lds, it);
    for (int m = blockIdx.x; m < MEM_LEN; m += gridDim.x) stage_memkv(P, (LAS unsigned char*)lds, m);
    const int gw = blockIdx.x * 8 + (threadIdx.x >> 6), NGW = gridDim.x * 8;
    for (int m = gw; m < M; m += NGW) prenorm_row(P.x + (size_t)m * D, P.pre_norm_w, (bf16*)(P.ws + WS_H) + (size_t)m * D, threadIdx.x & 63);
}
__global__ void __launch_bounds__(NT, 2) k_gemm_in(Params P, int l) {
    extern __shared__ __attribute__((aligned(16))) unsigned char lds[];
    pg8::Gemm g{(const bf16*)(P.ws + WS_H), (const bf16*)(P.ws + WS_WIN) + (size_t)l * NU * D, M, NU, D};
    pg8::StaticOrder S; S.init(M, NU, gridDim.x, blockIdx.x);
    pg8::EpiBf16 E{(bf16*)(P.ws + WS_U), NU};
    pg8::gemm_phase<pg8::EpiBf16, pg8::StaticOrder, true, true>((LAS unsigned char*)lds, g, S, E);
}
__global__ void __launch_bounds__(NT, 2) k_gemm_out(Params P, int l) {
    extern __shared__ __attribute__((aligned(16))) unsigned char lds[];
    pg8::Gemm g{(const bf16*)(P.ws + WS_H), (const bf16*)(P.ws + WS_WOUT) + (size_t)l * D * D, M, D, D};
    pg8::StaticOrder S; S.init(M, D, gridDim.x, blockIdx.x);
    pg8::EpiF32 E{(float*)(P.ws + WS_U), D};
    pg8::gemm_phase<pg8::EpiF32, pg8::StaticOrder, true, true>((LAS unsigned char*)lds, g, S, E);
}
__global__ void __launch_bounds__(NT, 2) k_post(Params P, int l) {
    const int gw = blockIdx.x * 8 + (threadIdx.x >> 6), NGW = gridDim.x * 8;
    const float* xin = l == 0 ? P.x : P.out;
    for (int m = gw; m < M; m += NGW)
        post_row((const float*)(P.ws + WS_U) + (size_t)m * D, xin + (size_t)m * D, P.post_norm_w + l * D, P.out + (size_t)m * D,
                 l + 1 < DEPTH ? P.pre_norm_w + (l + 1) * D : nullptr, l + 1 < DEPTH ? (bf16*)(P.ws + WS_H) + (size_t)m * D : nullptr, threadIdx.x & 63);
}
__global__ void __launch_bounds__(NT, 2) k_xattn(Params P) {
    extern __shared__ __attribute__((aligned(16))) unsigned char lds[];
    for (int it = blockIdx.x; it < (M / 256) * 4; it += gridDim.x) stage_xattn(P, (LAS unsigned char*)lds, it);
}
__global__ void __launch_bounds__(NT, 2) k_ssd_s1(Params P, int l) {
    extern __shared__ __attribute__((aligned(16))) unsigned char lds[];
    for (int it = blockIdx.x; it < NCHUNK * 2; it += gridDim.x) stage_ssd_s1(P, l, (LAS unsigned char*)lds, it);
}
__global__ void __launch_bounds__(NT, 2) k_ssd_scan(Params P) {
    const int e = blockIdx.x * NT + threadIdx.x;
    if (e < 65536) stage_ssd_scan(P, e);
}
__global__ void __launch_bounds__(NT, 2) k_ssd_s3(Params P, int l) {
    extern __shared__ __attribute__((aligned(16))) unsigned char lds[];
    for (int it = blockIdx.x; it < NCHUNK * 2; it += gridDim.x) stage_ssd_s3(P, l, (LAS unsigned char*)lds, it);
}
__global__ void __launch_bounds__(NT, 2) k_rwkv_prep(Params P, int l) {
    extern __shared__ __attribute__((aligned(16))) unsigned char lds[];
    for (int it = blockIdx.x; it < M / 64; it += gridDim.x) stage_rwkv_prep(P, l, (LAS unsigned char*)lds, it);
}

extern "C" void kernel_launch(void* const* d_in, const int* in_sizes, int n_in, void* d_out, int out_size, void* d_ws, size_t ws_size, hipStream_t stream) {
    static int grid = 0;
    if (grid == 0) {
        if (n_in != 24 || in_sizes[0] != M * D || out_size != M * D || ws_size < WS_END) { fprintf(stderr, "kernel_launch: unexpected shapes n_in %d in0 %d out %d ws %zu\n", n_in, n_in > 0 ? in_sizes[0] : -1, out_size, ws_size); grid = -1; return; }
        int dev = 0, cus = 0; hipGetDevice(&dev); hipDeviceGetAttribute(&cus, hipDeviceAttributeMultiprocessorCount, dev);
        hipFuncSetAttribute((const void*)k_prep, hipFuncAttributeMaxDynamicSharedMemorySize, 65536);
        hipFuncSetAttribute((const void*)k_gemm_in, hipFuncAttributeMaxDynamicSharedMemorySize, GEMM_LDS);
        hipFuncSetAttribute((const void*)k_gemm_out, hipFuncAttributeMaxDynamicSharedMemorySize, GEMM_LDS);
        hipFuncSetAttribute((const void*)k_xattn, hipFuncAttributeMaxDynamicSharedMemorySize, XA_LDS);
        hipFuncSetAttribute((const void*)k_ssd_s1, hipFuncAttributeMaxDynamicSharedMemorySize, S1_LDS);
        hipFuncSetAttribute((const void*)k_ssd_s3, hipFuncAttributeMaxDynamicSharedMemorySize, S3_LDS);
        hipFuncSetAttribute((const void*)k_rwkv_prep, hipFuncAttributeMaxDynamicSharedMemorySize, RP_LDS);
        (void)hipGetLastError();
        grid = cus > 0 ? cus : 256;
    }
    if (grid < 0) return;
    Params P{};
    const float** pp = (const float**)&P;
    for (int i = 0; i < 24; ++i) pp[i] = (const float*)d_in[i];
    P.out = (float*)d_out; P.ws = (unsigned char*)d_ws;
    hipLaunchKernelGGL(k_prep, dim3(grid), dim3(NT), 65536, stream, P);
    for (int l = 0; l < DEPTH; ++l) {
        hipLaunchKernelGGL(k_gemm_in, dim3(grid), dim3(NT), GEMM_LDS, stream, P, l);
        hipLaunchKernelGGL(k_xattn, dim3(grid), dim3(NT), XA_LDS, stream, P);
        hipLaunchKernelGGL(k_ssd_s1, dim3(grid), dim3(NT), S1_LDS, stream, P, l);
        hipLaunchKernelGGL(k_ssd_scan, dim3(128), dim3(NT), 0, stream, P);
        hipLaunchKernelGGL(k_ssd_s3, dim3(grid), dim3(NT), S3_LDS, stream, P, l);
        hipLaunchKernelGGL(k_rwkv_prep, dim3(grid), dim3(NT), RP_LDS, stream, P, l);
        hipLaunchKernelGGL(k_rwkv_seq, dim3(4), dim3(64), 0, stream, P, l);
        hipLaunchKernelGGL(k_gemm_out, dim3(grid), dim3(NT), GEMM_LDS, stream, P, l);
        hipLaunchKernelGGL(k_post, dim3(grid), dim3(NT), 0, stream, P, l);
    }
}
```

```cpp
#include <hip/hip_runtime.h>
#include <cstdio>
#include <cstdint>

__device__ __forceinline__ int otid() { int t = threadIdx.x; asm volatile("" : "+v"(t)); return t; }
namespace pg8 {
#define PG8_LAS __attribute__((address_space(3)))
typedef unsigned short bf16_t;
typedef short bf16x8 __attribute__((ext_vector_type(8)));
typedef float f32x4 __attribute__((ext_vector_type(4)));
typedef unsigned u32x4 __attribute__((ext_vector_type(4)));
constexpr int BM = 256, BK = 64, HALF = 128, HTB = HALF * BK * 2  , STAGE_BYTES = 8 * HTB, NXCD = 8, WGM = 8;

__host__ __device__ __forceinline__ int lds_byte(int r, int c) { const int st = (r >> 4) * 2 + (c >> 5), rr = r & 15, cc = c & 31, ob = rr * 64 + cc * 2; return st * 1024 + (ob ^ (((ob >> 9) & 1) << 5)); }
__host__ __device__ __forceinline__ void stage_rc(int b, int& R, int& C) { const int st = b / 1024, sb = b % 1024, swz = sb ^ (((sb >> 9) & 1) << 5); R = (st >> 1) * 16 + swz / 64; C = (st & 1) * 32 + (swz % 64) / 2; }
__host__ __device__ __forceinline__ int perm32(int rho) { const int n = rho >> 4, i = rho & 15; return 8 * (i >> 2) + 4 * n + (i & 3); }

struct Unit { int pm, pn; };
struct Gemm { const bf16_t* A; const bf16_t* Bt; int M, N, K; };

struct StaticOrder {
    int nM, nN, nwg, G, c;
    __host__ __device__ void init(int M, int N, int G_, int c_) { nM = M / BM; nN = N / BM; nwg = nM * nN; G = G_; c = c_; }
    __host__ __device__ bool next(int i, Unit& u) const {
        const long L = (long)i * G + c; if (L >= nwg) return false;
        int wgid = (int)L; { const int q = nwg / NXCD, r = nwg % NXCD, xcd = wgid % NXCD, off = wgid / NXCD; wgid = (xcd < r ? xcd * (q + 1) : r * (q + 1) + (xcd - r) * q) + off; }
        const int nig = WGM * nN, gid = wgid / nig, fm = gid * WGM, gsz = (nM - fm) < WGM ? (nM - fm) : WGM;
        u.pm = fm + ((wgid % nig) % gsz); u.pn = (wgid % nig) / gsz; return true;
    }
    __device__ __forceinline__ void a_ready(const Unit&) const {}
    __device__ __forceinline__ void done(const Unit&) const {}
};


__device__ __forceinline__ unsigned cvt_pk_bf16(float lo, float hi) { unsigned r; asm volatile("v_cvt_pk_bf16_f32 %0, %1, %2" : "=v"(r) : "v"(lo), "v"(hi)); return r; }
struct EpiBf16 {
    static constexpr bool PERM = true, AFTER_DRAIN = false;
    bf16_t* O; int ldc;
    __device__ __forceinline__ void operator()(const f32x4 (&acc)[2][2][4][2], const Unit& u, int wr, int wc, int fr, int fq) const {
        const int row0 = u.pm * BM + wr * 64 + fr; const int col0 = u.pn * BM + wc * 32 + 8 * fq;
#pragma unroll
        for (int ai = 0; ai < 2; ++ai)
#pragma unroll
            for (int m = 0; m < 4; ++m) { bf16_t* rowp = O + (size_t)(row0 + ai * HALF + m * 16) * ldc + col0;
#pragma unroll
                for (int bj = 0; bj < 2; ++bj) { const f32x4 v0 = acc[ai][bj][m][0], v1 = acc[ai][bj][m][1];
                    u32x4 w; w.x = cvt_pk_bf16(v0[0], v0[1]); w.y = cvt_pk_bf16(v0[2], v0[3]); w.z = cvt_pk_bf16(v1[0], v1[1]); w.w = cvt_pk_bf16(v1[2], v1[3]);
                    *(u32x4*)(rowp + bj * HALF) = w; } }
    }
};
struct EpiF32 {
    static constexpr bool PERM = false, AFTER_DRAIN = false;
    float* C; int ldc;
    __device__ __forceinline__ void operator()(const f32x4 (&acc)[2][2][4][2], const Unit& u, int wr, int wc, int fr, int fq) const {
        const int row0 = u.pm * BM + wr * 64 + fr, col0 = u.pn * BM + wc * 32 + 4 * fq;
#pragma unroll
        for (int ai = 0; ai < 2; ++ai)
#pragma unroll
            for (int m = 0; m < 4; ++m) { float* rowp = C + (size_t)(row0 + ai * HALF + m * 16) * ldc + col0;
#pragma unroll
                for (int bj = 0; bj < 2; ++bj)
#pragma unroll
                    for (int n = 0; n < 2; ++n) *(f32x4*)(rowp + bj * HALF + n * 16) = acc[ai][bj][m][n]; }
    }
};

template <class Epi, class Sched, bool ALIGN_EPI = false, bool SP2 = false>
__device__ __forceinline__ void gemm_phase(PG8_LAS unsigned char* lds, const Gemm g, const Sched& S, const Epi& E) {
    const int tid = otid(), wid = __builtin_amdgcn_readfirstlane(tid >> 6), lane = tid & 63, wr = wid >> 2, wc = wid & 3, fr = lane & 15, fq = lane >> 4;
    const int K = g.K, nt = K / BK;
    unsigned voffA[2], voffB[2];
#pragma unroll
    for (int i = 0; i < 2; ++i) { int R, C; stage_rc(tid * 16 + i * 8192, R, C); const int Rb = Epi::PERM ? ((R & ~31) + perm32(R & 31)) : R;
        voffA[i] = (unsigned)(R * K + C) * 2u; voffB[i] = (unsigned)(Rb * K + C) * 2u; }
    const size_t kstep = (size_t)(BK * 2);
    const size_t hstep = (size_t)HALF * K * 2;
    const size_t tstep = 2 * hstep;
    const unsigned ldsw = (unsigned)wid * 1024u;
    const int aoff = lds_byte(wr * 64 + fr, fq * 8), boff = lds_byte(wc * 32 + fr, fq * 8);
#define PG8_SA(b, h) (((b) * 2 + (h)) * HTB)
#define PG8_SB(b, h) ((4 + (b) * 2 + (h)) * HTB)
#define PG8_STAGE(bufoff, gbase, voff) do { _Pragma("unroll") for (int _i = 0; _i < 2; ++_i) \
        __builtin_amdgcn_global_load_lds((const unsigned*)((const char*)(gbase) + (voff)[_i]), (PG8_LAS unsigned*)(lds + (bufoff) + ldsw + _i * 8192), 16, 0, 0); } while (0)
#define PG8_LDA(dst, b, h) do { _Pragma("unroll") for (int m = 0; m < 4; ++m) _Pragma("unroll") for (int k = 0; k < 2; ++k) dst[m][k] = *(const PG8_LAS bf16x8*)(lds + PG8_SA(b, h) + aoff + m * 2048 + k * 1024); } while (0)
#define PG8_LDB(dst, b, h) do { _Pragma("unroll") for (int n = 0; n < 2; ++n) _Pragma("unroll") for (int k = 0; k < 2; ++k) dst[n][k] = *(const PG8_LAS bf16x8*)(lds + PG8_SB(b, h) + boff + n * 2048 + k * 1024); } while (0)
#define PG8_MMA(ai, bj, At, Bt) do { __builtin_amdgcn_s_setprio(1); _Pragma("unroll") for (int m = 0; m < 4; ++m) _Pragma("unroll") for (int n = 0; n < 2; ++n) _Pragma("unroll") for (int k = 0; k < 2; ++k) \
        acc[ai][bj][m][n] = __builtin_amdgcn_mfma_f32_16x16x32_bf16(Bt[n][k], At[m][k], acc[ai][bj][m][n], 0, 0, 0); __builtin_amdgcn_s_setprio(0); } while (0)
#define PG8_WAIT_V(n) asm volatile("s_waitcnt vmcnt(" #n ")" ::: "memory")
#define PG8_WAIT_L(n) asm volatile("s_waitcnt lgkmcnt(" #n ")" ::: "memory")
#define PG8_BAR __builtin_amdgcn_s_barrier()
#define PG8_SCHED __builtin_amdgcn_sched_barrier(0)
    Unit cur, nxt; int ui = 0;
    if (!S.next(0, cur)) return;
    f32x4 acc[2][2][4][2];
#pragma unroll
    for (int a = 0; a < 2; ++a)
#pragma unroll
        for (int b = 0; b < 2; ++b)
#pragma unroll
            for (int m = 0; m < 4; ++m)
#pragma unroll
                for (int n = 0; n < 2; ++n) acc[a][b][m][n] = (f32x4){0.f, 0.f, 0.f, 0.f};
    bf16x8 At[4][2], B0[2][2], B1[2][2];
    const char* cA = (const char*)g.A + (size_t)cur.pm * tstep; const char* cB = (const char*)g.Bt + (size_t)cur.pn * tstep;
    S.a_ready(cur);
    if constexpr (SP2) {
        PG8_STAGE(PG8_SB(0, 0), cB, voffB); PG8_STAGE(PG8_SB(0, 1), cB + hstep, voffB); PG8_STAGE(PG8_SA(0, 0), cA, voffA); PG8_STAGE(PG8_SA(0, 1), cA + hstep, voffA);
        if (wr == 1) PG8_BAR;
        PG8_WAIT_V(2); PG8_BAR;
        PG8_STAGE(PG8_SB(1, 0), cB + kstep, voffB); PG8_STAGE(PG8_SA(1, 0), cA + kstep, voffA); PG8_STAGE(PG8_SB(1, 1), cB + hstep + kstep, voffB);
        PG8_WAIT_V(6); PG8_BAR;
    } else {
        PG8_STAGE(PG8_SB(0, 0), cB, voffB); PG8_STAGE(PG8_SA(0, 0), cA, voffA); PG8_STAGE(PG8_SB(0, 1), cB + hstep, voffB); PG8_STAGE(PG8_SA(0, 1), cA + hstep, voffA);
        if (wr == 1) PG8_BAR;
        PG8_WAIT_V(4); PG8_BAR;
        PG8_STAGE(PG8_SB(1, 0), cB + kstep, voffB); PG8_STAGE(PG8_SA(1, 0), cA + kstep, voffA); PG8_STAGE(PG8_SB(1, 1), cB + hstep + kstep, voffB);
        PG8_WAIT_V(6); PG8_BAR;
    }
    for (;;) {
        const bool has_next = S.next(ui + 1, nxt);
        const char* nA = has_next ? (const char*)g.A + (size_t)nxt.pm * tstep : cA; const char* nB = has_next ? (const char*)g.Bt + (size_t)nxt.pn * tstep : cB;
        for (int t = 0; t < nt; t += 2) {
            const bool last = (t == nt - 2);
            const char* a1 = cA + (size_t)(t + 1) * kstep;
            const char* a2 = last ? nA : cA + (size_t)(t + 2) * kstep; const char* b2 = last ? nB : cB + (size_t)(t + 2) * kstep;
            const char* a3 = a2 + kstep; const char* b3 = b2 + kstep;
            if (last && has_next) S.a_ready(nxt);
            if constexpr (SP2) {
            PG8_LDB(B0, 0, 0); PG8_LDB(B1, 0, 1); PG8_SCHED; PG8_LDA(At, 0, 0); PG8_STAGE(PG8_SA(1, 1), a1 + hstep, voffA);
            PG8_WAIT_V(8); PG8_WAIT_L(0); PG8_BAR; PG8_MMA(0, 0, At, B0); PG8_MMA(0, 1, At, B1); PG8_BAR; PG8_SCHED;
            PG8_LDA(At, 0, 1); PG8_STAGE(PG8_SB(0, 0), b2, voffB); PG8_STAGE(PG8_SB(0, 1), b2 + hstep, voffB); PG8_STAGE(PG8_SA(0, 0), a2, voffA);
            PG8_WAIT_V(8); PG8_WAIT_L(0); PG8_BAR; PG8_MMA(1, 0, At, B0); PG8_MMA(1, 1, At, B1); PG8_BAR; PG8_SCHED;
            PG8_LDB(B0, 1, 0); PG8_LDB(B1, 1, 1); PG8_SCHED; PG8_LDA(At, 1, 0); PG8_STAGE(PG8_SA(0, 1), a2 + hstep, voffA);
            PG8_WAIT_V(8); PG8_WAIT_L(0); PG8_BAR; PG8_MMA(0, 0, At, B0); PG8_MMA(0, 1, At, B1); PG8_BAR; PG8_SCHED;
            PG8_LDA(At, 1, 1); PG8_STAGE(PG8_SB(1, 0), b3, voffB); PG8_STAGE(PG8_SB(1, 1), b3 + hstep, voffB); PG8_STAGE(PG8_SA(1, 0), a3, voffA);
            PG8_WAIT_V(8); PG8_WAIT_L(0); PG8_BAR; PG8_MMA(1, 0, At, B0); PG8_MMA(1, 1, At, B1); PG8_BAR; PG8_SCHED;
            } else {
            PG8_LDB(B0, 0, 0); PG8_SCHED; PG8_LDA(At, 0, 0); PG8_STAGE(PG8_SA(1, 1), a1 + hstep, voffA);
            PG8_WAIT_L(8); PG8_BAR; PG8_WAIT_L(0); PG8_MMA(0, 0, At, B0); PG8_BAR; PG8_SCHED;
            PG8_LDB(B1, 0, 1); PG8_STAGE(PG8_SB(0, 0), b2, voffB);
            PG8_BAR; PG8_WAIT_L(0); PG8_MMA(0, 1, At, B1); PG8_BAR;
            PG8_LDA(At, 0, 1); PG8_STAGE(PG8_SA(0, 0), a2, voffA);
            PG8_BAR; PG8_WAIT_L(0); PG8_MMA(1, 0, At, B0); PG8_BAR; PG8_SCHED;
            PG8_STAGE(PG8_SB(0, 1), b2 + hstep, voffB);
            PG8_WAIT_V(6); PG8_BAR; PG8_MMA(1, 1, At, B1); PG8_BAR;
            PG8_LDB(B0, 1, 0); PG8_SCHED; PG8_LDA(At, 1, 0); PG8_STAGE(PG8_SA(0, 1), a2 + hstep, voffA);
            PG8_WAIT_L(8); PG8_BAR; PG8_WAIT_L(0); PG8_MMA(0, 0, At, B0); PG8_BAR; PG8_SCHED;
            PG8_LDB(B1, 1, 1); PG8_STAGE(PG8_SB(1, 0), b3, voffB);
            PG8_BAR; PG8_WAIT_L(0); PG8_MMA(0, 1, At, B1); PG8_BAR;
            PG8_LDA(At, 1, 1); PG8_STAGE(PG8_SA(1, 0), a3, voffA);
            PG8_BAR; PG8_WAIT_L(0); PG8_MMA(1, 0, At, B0); PG8_BAR; PG8_SCHED;
            PG8_STAGE(PG8_SB(1, 1), b3 + hstep, voffB);
            PG8_WAIT_V(6); PG8_BAR; PG8_MMA(1, 1, At, B1); PG8_BAR;
            }
        }
        if constexpr (ALIGN_EPI) { if (wr == 0) PG8_BAR; }
        if constexpr (!Epi::AFTER_DRAIN) { E(acc, cur, wr, wc, fr, fq); S.done(cur); }
        if (!has_next) break;
#pragma unroll
        for (int a = 0; a < 2; ++a)
#pragma unroll
            for (int b = 0; b < 2; ++b)
#pragma unroll
                for (int m = 0; m < 4; ++m)
#pragma unroll
                    for (int n = 0; n < 2; ++n) acc[a][b][m][n] = (f32x4){0.f, 0.f, 0.f, 0.f};
        cur = nxt; cA = nA; cB = nB; ++ui;
        if constexpr (ALIGN_EPI) { if (wr == 1) PG8_BAR; }
    }
    PG8_WAIT_V(0);
    if constexpr (!ALIGN_EPI) { if (wr == 0) PG8_BAR; }
    PG8_BAR;
    if constexpr (Epi::AFTER_DRAIN) { E.fused(acc, cur, wr, wc, fr, fq, lds, wid, lane); S.done(cur); }
#undef PG8_SA
#undef PG8_SB
#undef PG8_STAGE
#undef PG8_LDA
#undef PG8_LDB
#undef PG8_MMA
#undef PG8_WAIT_V
#undef PG8_WAIT_L
#undef PG8_BAR
#undef PG8_SCHED
}
}

constexpr int M = 16384, D = 1024, DEPTH = 4, NU = 3328, NWIN = 3208, NCHUNK = 256;
constexpr int MEM_LEN = 256;
constexpr int C_XS = 0, C_B = 512, C_C = 768, C_Z = 1024, C_R = 1536, C_K = 1792, C_V = 2048, C_G = 2304, C_WL = 2560, C_AL = 2624, C_DT = 2688, C_Q = 2816, C_GX = 3072;
constexpr float NORM_EPS = 1e-6f, LNX_EPS = 64e-5f;

#define LAS __attribute__((address_space(3)))
typedef unsigned short bf16;
typedef short bf16x8 __attribute__((ext_vector_type(8)));
typedef float f32x4 __attribute__((ext_vector_type(4)));

__device__ __forceinline__ unsigned f2bf(float f) { unsigned u = __float_as_uint(f); return (u + 0x7fffu + ((u >> 16) & 1u)) >> 16; }
__device__ __forceinline__ float bf2f(unsigned b) { return __uint_as_float(b << 16); }
__device__ __forceinline__ float wave_sum(float v) {
#pragma unroll
    for (int o = 1; o < 64; o <<= 1) v += __shfl_xor(v, o);
    return v;
}
__device__ __forceinline__ float silu_f(float x) { return x / (1.f + __expf(-x)); }
__device__ __forceinline__ float softplus_f(float x) { return fmaxf(x, 0.f) + log1pf(__expf(-fabsf(x))); }
__device__ __forceinline__ float sigmoid_f(float x) { return 1.f / (1.f + __expf(-x)); }

__device__ __forceinline__ bf16x8 ld_frag(const LAS bf16* base, int ld, int row0, int k0, int lane) {
    return *(const LAS bf16x8*)(base + (row0 + (lane & 15)) * ld + k0 + (lane >> 4) * 8);
}
#define MFMA16(a, b, c) __builtin_amdgcn_mfma_f32_16x16x32_bf16((a), (b), (c), 0, 0, 0)

#define XB_TMO      128
#define XB_XCNT(j)  (256  + 64 * (j))
#define XB_XSUB(j)  (1280 + 64 * (j))
#define XB_XGEN(j)  (2304 + 64 * (j))
#define XB_TOP      3328
#define XB_TOPGEN   3392
#define XCD_BAR_WORDS 3456
#define XB_SPIN_CAP (1u << 22)

__device__ __forceinline__ unsigned xb_ld(unsigned* p)              { return __hip_atomic_load(p, __ATOMIC_RELAXED, __HIP_MEMORY_SCOPE_AGENT); }
__device__ __forceinline__ unsigned xb_add(unsigned* p, unsigned v) { return __hip_atomic_fetch_add(p, v, __ATOMIC_RELAXED, __HIP_MEMORY_SCOPE_AGENT); }
__device__ __forceinline__ unsigned xb_xcc_id() { return (unsigned)__builtin_amdgcn_s_getreg((3 << 11) | 20) & 0xFu; }
#define XB_SPIN(cond, bar) do { unsigned _sp = 0; while (cond) { __builtin_amdgcn_s_sleep(1); \
    if ((++_sp & 255u) == 0u) { if (xb_ld(&(bar)[XB_TMO])) break; if (_sp > XB_SPIN_CAP) { atomicAdd(&(bar)[XB_TMO], 1u); break; } } } } while (0)

struct XcdBarrier {
    unsigned* bar; unsigned x;
    volatile LAS unsigned* st;
};

__device__ __forceinline__ XcdBarrier xcd_barrier_post(unsigned* bar, volatile LAS unsigned* st) {
    XcdBarrier b; b.bar = bar; b.x = xb_xcc_id(); b.st = st;
    if (otid() == 0) (void)xb_add(&bar[XB_XCNT(b.x)], 1u);
    return b;
}
__device__ __forceinline__ void xcd_barrier_complete(unsigned* bar, unsigned x, unsigned& nloc, unsigned& nx) {
    const unsigned G = gridDim.x * gridDim.y * gridDim.z;
    unsigned sum, cnt, mine, sp = 0u;
    for (;;) {
        sum = 0u; cnt = 0u; mine = 0u;
#pragma unroll
        for (unsigned j = 0; j < 16; ++j) { const unsigned c = xb_ld(&bar[XB_XCNT(j)]); sum += c; cnt += (c > 0u) ? 1u : 0u; mine = (j == x) ? c : mine; }
        if (sum == G) break;
        __builtin_amdgcn_s_sleep(1);
        if ((++sp & 255u) == 0u) { if (xb_ld(&bar[XB_TMO])) break; if (sp > XB_SPIN_CAP) { atomicAdd(&bar[XB_TMO], 1u); break; } }
    }
    nloc = mine > 0u ? mine : 1u; nx = cnt > 0u ? cnt : 1u;
}

__device__ __forceinline__ void xcd_barrier(const XcdBarrier& b) {
    asm volatile("s_waitcnt vmcnt(0)" ::: "memory");
    __syncthreads();
    if (otid() == 0) {
        unsigned* bar = b.bar;
        __builtin_amdgcn_s_waitcnt(0);
        unsigned nloc = b.st[0], nx = b.st[1];
        if (nloc == 0u) { xcd_barrier_complete(bar, b.x, nloc, nx); b.st[0] = nloc; b.st[1] = nx; }
        const unsigned old = xb_add(&bar[XB_XSUB(b.x)], 1u);
        const unsigned gen = old / nloc;
        if (old + 1u == (gen + 1u) * nloc) {
            __builtin_amdgcn_fence(__ATOMIC_RELEASE, "agent");
            asm volatile("s_waitcnt vmcnt(0)" ::: "memory");
            const unsigned og = xb_add(&bar[XB_TOP], 1u);
            const unsigned tg = og / nx;
            if (og + 1u == (tg + 1u) * nx) xb_add(&bar[XB_TOPGEN], 1u);
            else XB_SPIN(xb_ld(&bar[XB_TOPGEN]) == tg, bar);
            __builtin_amdgcn_fence(__ATOMIC_ACQUIRE, "agent");
            xb_add(&bar[XB_XGEN(b.x)], 1u);
            asm volatile("s_waitcnt vmcnt(0)" ::: "memory");
        } else {
            XB_SPIN(xb_ld(&bar[XB_XGEN(b.x)]) == gen, bar);
            __builtin_amdgcn_fence(__ATOMIC_ACQUIRE, "agent");
            asm volatile("s_waitcnt vmcnt(0)" ::: "memory");
        }
    }
    __syncthreads();
}


struct Params {
    const float *x, *mem, *mem_norm_w, *w_mem_kv, *pre_norm_w, *w_in, *conv_w, *conv_b, *dt_bias, *a_log, *d_skip, *ssm_norm_w,
                *shift_mu, *w0, *w2, *a0, *a2, *k_k, *k_a, *r_k, *lnx_w, *lnx_b, *w_out, *post_norm_w;
    float* out;
    unsigned char* ws;
};
constexpr size_t MiB = 1u << 20;
constexpr size_t WS_CTL = 0, WS_WIN = 1 * MiB, WS_WOUT = 27 * MiB, WS_KV = 35 * MiB, WS_H = 36 * MiB, WS_U = 68 * MiB, WS_R = 172 * MiB, WS_END = 256 * MiB;
constexpr size_t WS_ST = WS_R, WS_CD = WS_R + 64 * MiB;
constexpr size_t WS_RPW = WS_R, WS_RPR = WS_R + 16 * MiB, WS_RPK = WS_R + 24 * MiB, WS_RPV = WS_R + 32 * MiB, WS_RPKK = WS_R + 40 * MiB, WS_RPB = WS_R + 48 * MiB;

__device__ __forceinline__ int win_src_col(int n) {
    if (n < 1536) return n;
    if (n < 2560) return n + 8;
    if (n < 2816) { const int j = n - 2560; if (j < 64) return 2568 + j; if (j < 128) return 2632 + (j - 64); if (j < 136) return 1536 + (j - 128); return -1; }
    return n - 120;
}
template <bool WIN>
__device__ __forceinline__ void transpose_tile(const float* src, int src_ld, bf16* dst, int K, int n0, int k0, LAS float* scr) {
    const int tx = otid() & 63, ty = otid() >> 6;
    const int sc = WIN ? win_src_col(n0 + tx) : (n0 + tx);
#pragma unroll
    for (int kk = ty; kk < 64; kk += 8) scr[kk * 65 + tx] = sc >= 0 ? src[(size_t)(k0 + kk) * src_ld + sc] : 0.f;
    __syncthreads();
#pragma unroll
    for (int nn = ty; nn < 64; nn += 8) dst[(size_t)(n0 + nn) * K + k0 + tx] = (bf16)f2bf(scr[tx * 65 + nn]);
    __syncthreads();
}
__device__ __forceinline__ void stage_prep_weights(const Params& P, LAS unsigned char* lds, int item) {
    LAS float* scr = (LAS float*)lds;
    constexpr int T_IN = (NU / 64) * (D / 64);
    constexpr int T_OUT = (D / 64) * (D / 64);
    if (item < DEPTH * T_IN) { const int l = item / T_IN, r = item % T_IN, nb = r / 16, kb = r % 16;
        transpose_tile<true>(P.w_in + (size_t)l * D * NWIN, NWIN, (bf16*)(P.ws + WS_WIN) + (size_t)l * NU * D, D, nb * 64, kb * 64, scr); }
    else { const int it = item - DEPTH * T_IN; const int l = it / T_OUT, r = it % T_OUT, nb = r / 16, kb = r % 16;
        transpose_tile<false>(P.w_out + (size_t)l * D * D, D, (bf16*)(P.ws + WS_WOUT) + (size_t)l * D * D, D, nb * 64, kb * 64, scr); }
}
constexpr int N_PREP_ITEMS = DEPTH * ((NU / 64) * (D / 64) + (D / 64) * (D / 64));

__device__ __forceinline__ void stage_memkv(const Params& P, LAS unsigned char* lds, int m) {
    LAS float* xs = (LAS float*)lds; LAS float* red = xs + 1024;
    const int tid = otid();
    const float v0 = P.mem[(size_t)m * D + tid], v1 = P.mem[(size_t)m * D + 512 + tid];
    float s = wave_sum(v0 * v0 + v1 * v1);
    if ((tid & 63) == 0) red[tid >> 6] = s;
    __syncthreads();
    float tot = 0.f;
#pragma unroll
    for (int w = 0; w < 8; ++w) tot += red[w];
    const float rstd = rsqrtf(tot * (1.f / D) + NORM_EPS);
    xs[tid] = v0 * rstd * P.mem_norm_w[tid]; xs[512 + tid] = v1 * rstd * P.mem_norm_w[512 + tid];
    __syncthreads();
    float acc = 0.f;
#pragma unroll 8
    for (int k = 0; k < D; ++k) acc += xs[k] * P.w_mem_kv[(size_t)k * 512 + tid];
    ((float*)(P.ws + WS_KV))[(size_t)m * 512 + tid] = acc;
    __syncthreads();
}

__device__ __forceinline__ void prenorm_row(const float* xrow, const float* w, bf16* orow, int lane) {
    const f32x4* xr = (const f32x4*)xrow + lane; const f32x4* wr = (const f32x4*)w + lane;
    f32x4 v[4]; float s = 0.f;
#pragma unroll
    for (int j = 0; j < 4; ++j) { v[j] = xr[64 * j]; s += (v[j].x * v[j].x + v[j].y * v[j].y) + (v[j].z * v[j].z + v[j].w * v[j].w); }
    const float rstd = rsqrtf(wave_sum(s) * (1.f / D) + NORM_EPS);
    unsigned long long* o8 = (unsigned long long*)orow + lane;
#pragma unroll
    for (int j = 0; j < 4; ++j) { const f32x4 ww = wr[64 * j];
        const unsigned lo = f2bf(v[j].x * rstd * ww.x) | (f2bf(v[j].y * rstd * ww.y) << 16), hi = f2bf(v[j].z * rstd * ww.z) | (f2bf(v[j].w * rstd * ww.w) << 16);
        o8[64 * j] = (unsigned long long)lo | ((unsigned long long)hi << 32); }
}
__device__ __forceinline__ void post_row(const float* orow, const float* xin, const float* pw, float* xout, const float* nw, bf16* hrow, int lane) {
    const f32x4* orr = (const f32x4*)orow + lane; const f32x4* xr = (const f32x4*)xin + lane; const f32x4* pr = (const f32x4*)pw + lane;
    f32x4 v[4]; float s = 0.f;
#pragma unroll
    for (int j = 0; j < 4; ++j) { v[j] = orr[64 * j]; s += (v[j].x * v[j].x + v[j].y * v[j].y) + (v[j].z * v[j].z + v[j].w * v[j].w); }
    const float rstd = rsqrtf(wave_sum(s) * (1.f / D) + NORM_EPS);
    float s2 = 0.f;
#pragma unroll
    for (int j = 0; j < 4; ++j) { const f32x4 xx = xr[64 * j], pp = pr[64 * j]; v[j] = xx + v[j] * rstd * pp; s2 += (v[j].x * v[j].x + v[j].y * v[j].y) + (v[j].z * v[j].z + v[j].w * v[j].w);
        ((f32x4*)xout + lane)[64 * j] = v[j]; }
    if (hrow) {
        const float rstd2 = rsqrtf(wave_sum(s2) * (1.f / D) + NORM_EPS);
        const f32x4* wr = (const f32x4*)nw + lane; unsigned long long* o8 = (unsigned long long*)hrow + lane;
#pragma unroll
        for (int j = 0; j < 4; ++j) { const f32x4 ww = wr[64 * j];
            const unsigned lo = f2bf(v[j].x * rstd2 * ww.x) | (f2bf(v[j].y * rstd2 * ww.y) << 16), hi = f2bf(v[j].z * rstd2 * ww.z) | (f2bf(v[j].w * rstd2 * ww.w) << 16);
            o8[64 * j] = (unsigned long long)lo | ((unsigned long long)hi << 32); }
    }
}

constexpr int XA_KLD = 72, XA_VLD = 264, XA_PLD = 264;
constexpr int XA_LDS = (256 * XA_KLD + 64 * XA_VLD + 8 * 16 * XA_PLD) * 2;
__device__ __forceinline__ void stage_xattn(const Params& P, LAS unsigned char* lds, int item) {
    const int tid = otid(), lane = tid & 63, wave = tid >> 6, quad = lane >> 4, l15 = lane & 15;
    const int tile = item >> 2, h = item & 3, t0 = tile * 256;
    LAS bf16* Ks = (LAS bf16*)lds; LAS bf16* VT = Ks + 256 * XA_KLD; LAS bf16* Pw = VT + 64 * XA_VLD + wave * 16 * XA_PLD;
    const float* KV = (const float*)(P.ws + WS_KV);
    const bf16* U = (const bf16*)(P.ws + WS_U); bf16* Y = (bf16*)(P.ws + WS_H);
    for (int e = tid; e < 256 * 64; e += 512) { const int m = e >> 6, d = e & 63;
        Ks[m * XA_KLD + d] = (bf16)f2bf(KV[(size_t)m * 512 + h * 64 + d]);
        VT[d * XA_VLD + m] = (bf16)f2bf(KV[(size_t)m * 512 + 256 + h * 64 + d]); }
    __syncthreads();
    for (int rb = 0; rb < 2; ++rb) {
        const int tr = t0 + wave * 32 + rb * 16;
        bf16x8 a[2];
#pragma unroll
        for (int s = 0; s < 2; ++s) a[s] = *(const bf16x8*)(U + (size_t)(tr + l15) * NU + C_Q + h * 64 + s * 32 + quad * 8);
        f32x4 acc[16];
#pragma unroll
        for (int j = 0; j < 16; ++j) { acc[j] = (f32x4){0.f, 0.f, 0.f, 0.f};
#pragma unroll
            for (int s = 0; s < 2; ++s) acc[j] = MFMA16(a[s], ld_frag(Ks, XA_KLD, j * 16, s * 32, lane), acc[j]); }
        float mx[4], sm[4];
#pragma unroll
        for (int r = 0; r < 4; ++r) { float m_ = -3.0e38f;
#pragma unroll
            for (int j = 0; j < 16; ++j) { acc[j][r] *= 0.125f; m_ = fmaxf(m_, acc[j][r]); }
#pragma unroll
            for (int o = 1; o < 16; o <<= 1) m_ = fmaxf(m_, __shfl_xor(m_, o));
            mx[r] = m_; float s_ = 0.f;
#pragma unroll
            for (int j = 0; j < 16; ++j) { const float p = __expf(acc[j][r] - m_); s_ += p; Pw[(quad * 4 + r) * XA_PLD + j * 16 + l15] = (bf16)f2bf(p); }
#pragma unroll
            for (int o = 1; o < 16; o <<= 1) s_ += __shfl_xor(s_, o);
            sm[r] = s_; }
        __syncthreads();
        f32x4 o4[4];
#pragma unroll
        for (int jd = 0; jd < 4; ++jd) o4[jd] = (f32x4){0.f, 0.f, 0.f, 0.f};
#pragma unroll
        for (int ks = 0; ks < 8; ++ks) { const bf16x8 pa = ld_frag(Pw, XA_PLD, 0, ks * 32, lane);
#pragma unroll
            for (int jd = 0; jd < 4; ++jd) o4[jd] = MFMA16(pa, ld_frag(VT, XA_VLD, jd * 16, ks * 32, lane), o4[jd]); }
#pragma unroll
        for (int jd = 0; jd < 4; ++jd)
#pragma unroll
            for (int r = 0; r < 4; ++r) { const int t = tr + quad * 4 + r, d = jd * 16 + l15;
                const float g = bf2f(U[(size_t)t * NU + C_GX + h * 64 + d]);
                Y[(size_t)t * D + 768 + h * 64 + d] = (bf16)f2bf(o4[jd][r] / sm[r] * silu_f(g)); }
        __syncthreads();
    }
}

__device__ __forceinline__ void ssd_dt(const Params& P, int l, int c, int g, LAS float* dtS, LAS float* acS) {
    const int tid = otid();
    if (tid < 256) { const int hh = tid >> 6, q = tid & 63, h = g * 4 + hh;
        const bf16* U = (const bf16*)(P.ws + WS_U);
        const float raw = bf2f(U[(size_t)(c * 64 + q) * NU + C_DT + h]);
        const float dt = softplus_f(raw + P.dt_bias[l * 8 + h]);
        const float A = -__expf(P.a_log[l * 8 + h]);
        float v = dt * A;
#pragma unroll
        for (int o = 1; o < 64; o <<= 1) { const float t = __shfl_up(v, o); if (q >= o) v += t; }
        dtS[hh * 64 + q] = dt; acS[hh * 64 + q] = v; }
}
constexpr int S1_LDS = 2048 + (4 * 64 * 72 + 128 * 72) * 2;
__device__ __forceinline__ void stage_ssd_s1(const Params& P, int l, LAS unsigned char* lds, int item) {
    const int tid = otid(), lane = tid & 63, wave = tid >> 6, quad = lane >> 4, l15 = lane & 15;
    const int c = item >> 1, g = item & 1, t0 = c * 64;
    LAS float* dtS = (LAS float*)lds; LAS float* acS = dtS + 256; LAS bf16* XT = (LAS bf16*)(lds + 2048); LAS bf16* BT = XT + 4 * 64 * 72;
    const bf16* U = (const bf16*)(P.ws + WS_U);
    ssd_dt(P, l, c, g, dtS, acS);
    __syncthreads();
    if (tid < 384) {
        const int j = tid, col = j < 256 ? C_XS + g * 256 + j : C_B + g * 128 + (j - 256);
        const float* cw = P.conv_w + (size_t)l * 4 * 1024; const float w0 = cw[col], w1 = cw[1024 + col], w2 = cw[2048 + col], w3 = cw[3072 + col], cb = P.conv_b[l * 1024 + col];
        float u0 = t0 >= 3 ? bf2f(U[(size_t)(t0 - 3) * NU + col]) : 0.f, u1 = t0 >= 2 ? bf2f(U[(size_t)(t0 - 2) * NU + col]) : 0.f, u2 = t0 >= 1 ? bf2f(U[(size_t)(t0 - 1) * NU + col]) : 0.f;
        for (int q = 0; q < 64; ++q) { const float u3 = bf2f(U[(size_t)(t0 + q) * NU + col]);
            float v = silu_f(cb + w0 * u0 + w1 * u1 + w2 * u2 + w3 * u3); u0 = u1; u1 = u2; u2 = u3;
            if (j < 256) { const int hh = j >> 6, p = j & 63; v *= dtS[hh * 64 + q] * __expf(acS[hh * 64 + 63] - acS[hh * 64 + q]); XT[(hh * 64 + p) * 72 + q] = (bf16)f2bf(v); }
            else BT[(j - 256) * 72 + q] = (bf16)f2bf(v); }
    }
    __syncthreads();
    { const int hh = wave >> 1, nh = wave & 1, h = g * 4 + hh;
        float* ST = (float*)(P.ws + WS_ST) + ((size_t)(c * 8 + h) * 64) * 128;
#pragma unroll
        for (int pb = 0; pb < 4; ++pb)
#pragma unroll
            for (int nb = 0; nb < 4; ++nb) { f32x4 acc = (f32x4){0.f, 0.f, 0.f, 0.f};
#pragma unroll
                for (int ks = 0; ks < 2; ++ks) acc = MFMA16(ld_frag(XT + hh * 64 * 72, 72, pb * 16, ks * 32, lane), ld_frag(BT, 72, nh * 64 + nb * 16, ks * 32, lane), acc);
#pragma unroll
                for (int r = 0; r < 4; ++r) ST[(size_t)(pb * 16 + quad * 4 + r) * 128 + nh * 64 + nb * 16 + l15] = acc[r]; }
        if (tid < 4) ((float*)(P.ws + WS_CD))[c * 8 + g * 4 + tid] = __expf(acS[tid * 64 + 63]);
    }
    __syncthreads();
}
__device__ __forceinline__ void stage_ssd_scan(const Params& P, int e) {
    float* ST = (float*)(P.ws + WS_ST); const float* CD = (const float*)(P.ws + WS_CD);
    const int h = e >> 13; float carry = 0.f;
    for (int c = 0; c < NCHUNK; ++c) { const size_t idx = (size_t)c * 65536 + e; const float v = ST[idx]; ST[idx] = carry; carry = carry * CD[c * 8 + h] + v; }
}
constexpr int S3_LDS = 3072 + (2 * 64 * 136 + 4 * 64 * 72 + 8 * 32 * 72) * 2;
__device__ __forceinline__ void stage_ssd_s3(const Params& P, int l, LAS unsigned char* lds, int item) {
    const int tid = otid(), lane = tid & 63, wave = tid >> 6, quad = lane >> 4, l15 = lane & 15;
    const int c = item >> 1, g = item & 1, t0 = c * 64;
    LAS float* dtS = (LAS float*)lds; LAS float* acS = dtS + 256; LAS float* red = acS + 256;
    LAS bf16* Cn = (LAS bf16*)(lds + 3072); LAS bf16* Bn = Cn + 64 * 136; LAS bf16* XT = Bn + 64 * 136; LAS bf16* SCw = XT + 4 * 64 * 72 + wave * 32 * 72;
    const bf16* U = (const bf16*)(P.ws + WS_U); bf16* Y = (bf16*)(P.ws + WS_H);
    ssd_dt(P, l, c, g, dtS, acS);
    __syncthreads();
    {
        const int j = tid, col = j < 256 ? C_XS + g * 256 + j : (j < 384 ? C_B + g * 128 + (j - 256) : C_C + g * 128 + (j - 384));
        const float* cw = P.conv_w + (size_t)l * 4 * 1024; const float w0 = cw[col], w1 = cw[1024 + col], w2 = cw[2048 + col], w3 = cw[3072 + col], cb = P.conv_b[l * 1024 + col];
        float u0 = t0 >= 3 ? bf2f(U[(size_t)(t0 - 3) * NU + col]) : 0.f, u1 = t0 >= 2 ? bf2f(U[(size_t)(t0 - 2) * NU + col]) : 0.f, u2 = t0 >= 1 ? bf2f(U[(size_t)(t0 - 1) * NU + col]) : 0.f;
        for (int q = 0; q < 64; ++q) { const float u3 = bf2f(U[(size_t)(t0 + q) * NU + col]);
            const float v = silu_f(cb + w0 * u0 + w1 * u1 + w2 * u2 + w3 * u3); u0 = u1; u1 = u2; u2 = u3;
            if (j < 256) { const int hh = j >> 6, p = j & 63; XT[(hh * 64 + p) * 72 + q] = (bf16)f2bf(v * dtS[hh * 64 + q]); }
            else if (j < 384) Bn[q * 136 + (j - 256)] = (bf16)f2bf(v);
            else Cn[q * 136 + (j - 384)] = (bf16)f2bf(v); }
    }
    __syncthreads();
    const int hh = wave >> 1, qh = wave & 1, h = g * 4 + hh;
#pragma unroll
    for (int qb = 0; qb < 2; ++qb)
#pragma unroll
        for (int sb = 0; sb < 4; ++sb) { f32x4 acc = (f32x4){0.f, 0.f, 0.f, 0.f};
#pragma unroll
            for (int ks = 0; ks < 4; ++ks) acc = MFMA16(ld_frag(Cn, 136, qh * 32 + qb * 16, ks * 32, lane), ld_frag(Bn, 136, sb * 16, ks * 32, lane), acc);
#pragma unroll
            for (int r = 0; r < 4; ++r) { const int q = qh * 32 + qb * 16 + quad * 4 + r, s = sb * 16 + l15;
                const float v = (s <= q) ? acc[r] * __expf(acS[hh * 64 + q] - acS[hh * 64 + s]) : 0.f;
                SCw[(qb * 16 + quad * 4 + r) * 72 + s] = (bf16)f2bf(v); } }
    __syncthreads();
    f32x4 y[2][4];
    const float* ST = (const float*)(P.ws + WS_ST) + ((size_t)(c * 8 + h) * 64) * 128;
#pragma unroll
    for (int qb = 0; qb < 2; ++qb)
#pragma unroll
        for (int pb = 0; pb < 4; ++pb) { f32x4 yd = (f32x4){0.f, 0.f, 0.f, 0.f}, yo = (f32x4){0.f, 0.f, 0.f, 0.f};
#pragma unroll
            for (int ks = 0; ks < 2; ++ks) yd = MFMA16(ld_frag(SCw, 72, qb * 16, ks * 32, lane), ld_frag(XT + hh * 64 * 72, 72, pb * 16, ks * 32, lane), yd);
#pragma unroll
            for (int ks = 0; ks < 4; ++ks) { const float* sp = ST + (size_t)(pb * 16 + l15) * 128 + ks * 32 + quad * 8; const f32x4 s0 = *(const f32x4*)sp, s1 = *(const f32x4*)(sp + 4);
                bf16x8 b; b[0] = (short)f2bf(s0[0]); b[1] = (short)f2bf(s0[1]); b[2] = (short)f2bf(s0[2]); b[3] = (short)f2bf(s0[3]); b[4] = (short)f2bf(s1[0]); b[5] = (short)f2bf(s1[1]); b[6] = (short)f2bf(s1[2]); b[7] = (short)f2bf(s1[3]);
                yo = MFMA16(ld_frag(Cn, 136, qh * 32 + qb * 16, ks * 32, lane), b, yo); }
#pragma unroll
            for (int r = 0; r < 4; ++r) { const int q = qh * 32 + qb * 16 + quad * 4 + r, p = pb * 16 + l15;
                const float xs = bf2f(XT[(hh * 64 + p) * 72 + q]) / dtS[hh * 64 + q];
                float v = yd[r] + __expf(acS[hh * 64 + q]) * yo[r] + P.d_skip[l * 8 + h] * xs;
                const float z = bf2f(U[(size_t)(t0 + q) * NU + C_Z + h * 64 + p]);
                y[qb][pb][r] = v * silu_f(z); } }
#pragma unroll
    for (int qb = 0; qb < 2; ++qb)
#pragma unroll
        for (int r = 0; r < 4; ++r) { float s = 0.f;
#pragma unroll
            for (int pb = 0; pb < 4; ++pb) s += y[qb][pb][r] * y[qb][pb][r];
#pragma unroll
            for (int o = 1; o < 16; o <<= 1) s += __shfl_xor(s, o);
            if (l15 == 0) red[hh * 64 + qh * 32 + qb * 16 + quad * 4 + r] = s; }
    __syncthreads();
#pragma unroll
    for (int qb = 0; qb < 2; ++qb)
#pragma unroll
        for (int r = 0; r < 4; ++r) { const int q = qh * 32 + qb * 16 + quad * 4 + r;
            const float tot = red[q] + red[64 + q] + red[128 + q] + red[192 + q]; const float rstd = rsqrtf(tot * (1.f / 256.f) + NORM_EPS);
#pragma unroll
            for (int pb = 0; pb < 4; ++pb) { const int p = pb * 16 + l15;
                Y[(size_t)(t0 + q) * D + h * 64 + p] = (bf16)f2bf(y[qb][pb][r] * rstd * P.ssm_norm_w[l * 512 + h * 64 + p]); } }
    __syncthreads();
}

constexpr int RP_LDS = 1024 + 2 * 64 * 256 * 4;
__device__ __forceinline__ void stage_rwkv_prep(const Params& P, int l, LAS unsigned char* lds, int item) {
    const int tid = otid(), half = tid >> 8, ch = tid & 255;
    LAS float* latw = (LAS float*)lds + half * 128; LAS float* lata = latw + 64;
    const bf16* U = (const bf16*)(P.ws + WS_U);
    const float* mu = P.shift_mu + (size_t)l * 1152;
    LAS float* w2s = (LAS float*)lds + 256; LAS float* a2s = w2s + 64 * 256;
    for (int e = tid; e < 64 * 256; e += 512) { w2s[e] = P.w2[(size_t)l * 64 * 256 + e]; a2s[e] = P.a2[(size_t)l * 64 * 256 + e]; }
    __syncthreads();
    const float w0c = P.w0[l * 256 + ch], a0c = P.a0[l * 256 + ch], kkc = P.k_k[l * 256 + ch], kac = P.k_a[l * 256 + ch];
    const float mur = mu[ch], muk = mu[256 + ch], muv = mu[512 + ch];
    const float mul = ch < 128 ? mu[1024 + ch] : 0.f;
    float* RPW = (float*)(P.ws + WS_RPW); bf16* RPR = (bf16*)(P.ws + WS_RPR); bf16* RPK = (bf16*)(P.ws + WS_RPK); bf16* RPV = (bf16*)(P.ws + WS_RPV); bf16* RPKK = (bf16*)(P.ws + WS_RPKK); bf16* RPB = (bf16*)(P.ws + WS_RPB);
    for (int i = 0; i < 32; ++i) {
        const int t = item * 64 + half * 32 + i;
        const bf16* uc = U + (size_t)t * NU; const bf16* up = uc - NU; const bool hp = t > 0;
        float cr = bf2f(uc[C_R + ch]), ck = bf2f(uc[C_K + ch]), cv = bf2f(uc[C_V + ch]);
        const float pr = hp ? bf2f(up[C_R + ch]) : 0.f, pk = hp ? bf2f(up[C_K + ch]) : 0.f, pv = hp ? bf2f(up[C_V + ch]) : 0.f;
        const float r = cr + (pr - cr) * mur, k = ck + (pk - ck) * muk, v = cv + (pv - cv) * muv;
        if (ch < 128) { const float cl = bf2f(uc[C_WL + ch]), pl = hp ? bf2f(up[C_WL + ch]) : 0.f; const float s = cl + (pl - cl) * mul;
            if (ch < 64) latw[ch] = tanhf(s); else lata[ch - 64] = s; }
        __syncthreads();
        float aw = w0c, aa = a0c;
#pragma unroll
        for (int j = 0; j < 64; ++j) { aw += latw[j] * w2s[j * 256 + ch]; aa += lata[j] * a2s[j * 256 + ch]; }
        const float wlog = -softplus_f(-aw) - 0.5f; const float decay = __expf(-__expf(wlog)); const float a = sigmoid_f(aa);
        float kk = k * kkc; const float ss = wave_sum(kk * kk); kk = kk / fmaxf(sqrtf(ss), 1e-12f);
        const float k2 = k * (1.f + (a - 1.f) * kac);
        const size_t o = (size_t)t * 256 + ch;
        RPW[o] = decay; RPR[o] = (bf16)f2bf(r); RPK[o] = (bf16)f2bf(k2); RPV[o] = (bf16)f2bf(v); RPKK[o] = (bf16)f2bf(kk); RPB[o] = (bf16)f2bf(kk * a);
        __syncthreads();
    }
}
typedef float vec_t[6][64];
__device__ __forceinline__ void stage_rwkv_seq(const Params& P, int l, LAS unsigned char* lds, int h) {
    LAS vec_t* vec = (LAS vec_t*)lds; LAS float* rkS = (LAS float*)(lds + 16 * 6 * 64 * 4);
    const int lane = otid() & 63, chn = h * 64 + lane;
    const float* RPW = (const float*)(P.ws + WS_RPW); const bf16* RPR = (const bf16*)(P.ws + WS_RPR); const bf16* RPK = (const bf16*)(P.ws + WS_RPK); const bf16* RPV = (const bf16*)(P.ws + WS_RPV);
    const bf16* RPKK = (const bf16*)(P.ws + WS_RPKK); const bf16* RPB = (const bf16*)(P.ws + WS_RPB);
    const bf16* U = (const bf16*)(P.ws + WS_U); bf16* Y = (bf16*)(P.ws + WS_H);
    const float rkl = P.r_k[l * 256 + chn];
    const float lw = P.lnx_w[l * 256 + chn], lb = P.lnx_b[l * 256 + chn], mug = P.shift_mu[(size_t)l * 1152 + 768 + chn];
    float S[64];
#pragma unroll
    for (int j = 0; j < 64; ++j) S[j] = 0.f;
    for (int t0 = 0; t0 < M; t0 += 16) {
        asm volatile("s_waitcnt lgkmcnt(0)" ::: "memory");
#pragma unroll 2
        for (int tt = 0; tt < 16; ++tt) { const size_t o = (size_t)(t0 + tt) * 256 + chn;
            vec[tt][0][lane] = bf2f(RPR[o]); vec[tt][1][lane] = RPW[o]; vec[tt][2][lane] = bf2f(RPK[o]); vec[tt][3][lane] = bf2f(RPKK[o]); vec[tt][4][lane] = bf2f(RPB[o]); vec[tt][5][lane] = bf2f(RPV[o]); }
        asm volatile("s_waitcnt vmcnt(0) lgkmcnt(0)" ::: "memory");
#pragma unroll 1
        for (int tt = 0; tt < 16; ++tt) {
            const int t = t0 + tt;
            const float vi = vec[tt][5][lane];
            const float bn = wave_sum(vec[tt][0][lane] * vec[tt][2][lane] * rkl);
            float sa = 0.f;
#pragma unroll
            for (int jb = 0; jb < 64; jb += 16) {
#pragma unroll
                for (int j = jb; j < jb + 16; ++j) sa += S[j] * vec[tt][3][j];
                asm volatile("" ::: "memory"); }
            sa = -sa;
            float y0 = 0.f, y1 = 0.f;
#pragma unroll
            for (int jb = 0; jb < 64; jb += 8) {
#pragma unroll
                for (int j = jb; j < jb + 8; j += 2) {
                    S[j] = S[j] * vec[tt][1][j] + sa * vec[tt][4][j] + vi * vec[tt][2][j];
                    S[j + 1] = S[j + 1] * vec[tt][1][j + 1] + sa * vec[tt][4][j + 1] + vi * vec[tt][2][j + 1];
                    y0 += S[j] * vec[tt][0][j]; y1 += S[j + 1] * vec[tt][0][j + 1]; }
                asm volatile("" ::: "memory"); }
            const float y = y0 + y1;
            const float mean = wave_sum(y) * (1.f / 64.f); const float d = y - mean; const float var = wave_sum(d * d) * (1.f / 64.f);
            const float yn = d * rsqrtf(var + LNX_EPS) * lw + lb;
            const float cg = bf2f(U[(size_t)t * NU + C_G + chn]); const float pg = t > 0 ? bf2f(U[(size_t)(t - 1) * NU + C_G + chn]) : 0.f;
            const float gs = cg + (pg - cg) * mug;
            Y[(size_t)t * D + 512 + chn] = (bf16)f2bf((yn + bn * vi) * silu_f(gs));
        }
    }
}


constexpr int NT = 512;
constexpr int LDS_BYTES = 147456, MISC_OFF = LDS_BYTES - 256;
constexpr int CW_BAR = 4096;
static_assert(XA_LDS <= MISC_OFF && S3_LDS <= MISC_OFF && RP_LDS <= MISC_OFF && pg8::STAGE_BYTES <= MISC_OFF, "LDS map");

__global__ void __launch_bounds__(NT, 2) mega_fwd(Params P) {
    extern __shared__ __attribute__((aligned(16))) unsigned char lds_raw[];
    LAS unsigned char* lds = (LAS unsigned char*)lds_raw;
    volatile LAS unsigned* MISC = (volatile LAS unsigned*)(lds + MISC_OFF);
    const int tid = otid(), wave = __builtin_amdgcn_readfirstlane(tid >> 6), G = gridDim.x, bx = blockIdx.x;
    if (tid < 64) MISC[tid] = 0u;
    __syncthreads();
    XcdBarrier bar = xcd_barrier_post((unsigned*)(P.ws + WS_CTL) + CW_BAR, MISC + 8);
#define GRID_BAR() xcd_barrier(bar)
    const int gw = bx * 8 + wave, NGW = G * 8;
    for (int it = bx; it < N_PREP_ITEMS; it += G) stage_prep_weights(P, lds, it);
    for (int m = bx; m < MEM_LEN; m += G) stage_memkv(P, lds, m);
    for (int m = gw; m < M; m += NGW) prenorm_row(P.x + (size_t)m * D, P.pre_norm_w, (bf16*)(P.ws + WS_H) + (size_t)m * D, tid & 63);
    GRID_BAR();
#pragma unroll 1
    for (int l = 0; l < DEPTH; ++l) {
        const int tid = otid(), wave = __builtin_amdgcn_readfirstlane(tid >> 6), gw = bx * 8 + wave;
        {   pg8::Gemm g{(const bf16*)(P.ws + WS_H), (const bf16*)(P.ws + WS_WIN) + (size_t)l * NU * D, M, NU, D};
            pg8::StaticOrder S; S.init(M, NU, G, bx);
            pg8::EpiBf16 E{(bf16*)(P.ws + WS_U), NU};
            pg8::gemm_phase<pg8::EpiBf16, pg8::StaticOrder, true, true>(lds, g, S, E); }
        GRID_BAR();
        for (int it = bx; it < (M / 256) * 4; it += G) stage_xattn(P, lds, it);
        for (int it = bx; it < NCHUNK * 2; it += G) stage_ssd_s1(P, l, lds, it);
        GRID_BAR();
        for (int e = bx * NT + tid; e < 65536; e += G * NT) stage_ssd_scan(P, e);
        GRID_BAR();
        for (int it = bx; it < NCHUNK * 2; it += G) stage_ssd_s3(P, l, lds, it);
        GRID_BAR();
        for (int it = bx; it < M / 64; it += G) stage_rwkv_prep(P, l, lds, it);
        GRID_BAR();
        if (bx < 4 && wave == 0) stage_rwkv_seq(P, l, lds, bx);
        GRID_BAR();
        {   pg8::Gemm g{(const bf16*)(P.ws + WS_H), (const bf16*)(P.ws + WS_WOUT) + (size_t)l * D * D, M, D, D};
            pg8::StaticOrder S; S.init(M, D, G, bx);
            pg8::EpiF32 E{(float*)(P.ws + WS_U), D};
            pg8::gemm_phase<pg8::EpiF32, pg8::StaticOrder, true, true>(lds, g, S, E); }
        GRID_BAR();
        {   const float* xin = l == 0 ? P.x : P.out;
            for (int m = gw; m < M; m += NGW)
                post_row((const float*)(P.ws + WS_U) + (size_t)m * D, xin + (size_t)m * D, P.post_norm_w + l * D, P.out + (size_t)m * D,
                         l + 1 < DEPTH ? P.pre_norm_w + (l + 1) * D : nullptr, l + 1 < DEPTH ? (bf16*)(P.ws + WS_H) + (size_t)m * D : nullptr, tid & 63); }
        if (l + 1 < DEPTH) GRID_BAR();
    }
}

extern "C" void kernel_launch(void* const* d_in, const int* in_sizes, int n_in, void* d_out, int out_size, void* d_ws, size_t ws_size, hipStream_t stream) {
    static int grid = 0;
    if (grid == 0) {
        if (n_in != 24 || in_sizes[0] != M * D || out_size != M * D || ws_size < WS_END) { fprintf(stderr, "kernel_launch: unexpected shapes n_in %d in0 %d out %d ws %zu\n", n_in, n_in > 0 ? in_sizes[0] : -1, out_size, ws_size); grid = -1; return; }
        int dev = 0, cus = 0, per_cu = 0;
        if (hipGetDevice(&dev) != hipSuccess || hipDeviceGetAttribute(&cus, hipDeviceAttributeMultiprocessorCount, dev) != hipSuccess) { grid = -1; return; }
        if (hipFuncSetAttribute((const void*)mega_fwd, hipFuncAttributeMaxDynamicSharedMemorySize, LDS_BYTES) != hipSuccess) { fprintf(stderr, "kernel_launch: hipFuncSetAttribute failed\n"); grid = -1; return; }
        if (hipOccupancyMaxActiveBlocksPerMultiprocessor(&per_cu, (const void*)mega_fwd, NT, LDS_BYTES) != hipSuccess || per_cu < 1) fprintf(stderr, "kernel_launch: occupancy query says %d\n", per_cu);
        (void)hipGetLastError();
        grid = cus;
    }
    if (grid < 0) return;
    if (hipMemsetAsync((char*)d_ws + WS_CTL, 0, 1 * MiB, stream) != hipSuccess) return;
    Params P{};
    const float** pp = (const float**)&P;
    for (int i = 0; i < 24; ++i) pp[i] = (const float*)d_in[i];
    P.out = (float*)d_out; P.ws = (unsigned char*)d_ws;
    hipLaunchKernelGGL(mega_fwd, dim3(grid), dim3(NT), LDS_BYTES, stream, P);
}
```

```cpp
#include <hip/hip_runtime.h>
#include <cstdio>
#include <cstdint>

__device__ __forceinline__ int otid() { int t = threadIdx.x; asm volatile("" : "+v"(t)); return t; }
namespace pg8 {
#define PG8_LAS __attribute__((address_space(3)))
typedef unsigned short bf16_t;
typedef short bf16x8 __attribute__((ext_vector_type(8)));
typedef float f32x4 __attribute__((ext_vector_type(4)));
typedef unsigned u32x4 __attribute__((ext_vector_type(4)));
constexpr int BM = 256, BK = 64, HALF = 128, HTB = HALF * BK * 2  , STAGE_BYTES = 8 * HTB, NXCD = 8, WGM = 8;

__host__ __device__ __forceinline__ int lds_byte(int r, int c) { const int st = (r >> 4) * 2 + (c >> 5), rr = r & 15, cc = c & 31, ob = rr * 64 + cc * 2; return st * 1024 + (ob ^ (((ob >> 9) & 1) << 5)); }
__host__ __device__ __forceinline__ void stage_rc(int b, int& R, int& C) { const int st = b / 1024, sb = b % 1024, swz = sb ^ (((sb >> 9) & 1) << 5); R = (st >> 1) * 16 + swz / 64; C = (st & 1) * 32 + (swz % 64) / 2; }
__host__ __device__ __forceinline__ int perm32(int rho) { const int n = rho >> 4, i = rho & 15; return 8 * (i >> 2) + 4 * n + (i & 3); }

struct Unit { int pm, pn; };
struct Gemm { const bf16_t* A; const bf16_t* Bt; int M, N, K; };

struct StaticOrder {
    int nM, nN, nwg, G, c;
    __host__ __device__ void init(int M, int N, int G_, int c_) { nM = M / BM; nN = N / BM; nwg = nM * nN; G = G_; c = c_; }
    __host__ __device__ bool next(int i, Unit& u) const {
        const long L = (long)i * G + c; if (L >= nwg) return false;
        int wgid = (int)L; { const int q = nwg / NXCD, r = nwg % NXCD, xcd = wgid % NXCD, off = wgid / NXCD; wgid = (xcd < r ? xcd * (q + 1) : r * (q + 1) + (xcd - r) * q) + off; }
        const int nig = WGM * nN, gid = wgid / nig, fm = gid * WGM, gsz = (nM - fm) < WGM ? (nM - fm) : WGM;
        u.pm = fm + ((wgid % nig) % gsz); u.pn = (wgid % nig) / gsz; return true;
    }
    __device__ __forceinline__ void a_ready(const Unit&) const {}
    __device__ __forceinline__ void done(const Unit&) const {}
};


__device__ __forceinline__ unsigned cvt_pk_bf16(float lo, float hi) { unsigned r; asm volatile("v_cvt_pk_bf16_f32 %0, %1, %2" : "=v"(r) : "v"(lo), "v"(hi)); return r; }
struct EpiBf16 {
    static constexpr bool PERM = true, AFTER_DRAIN = false;
    bf16_t* O; int ldc;
    __device__ __forceinline__ void operator()(const f32x4 (&acc)[2][2][4][2], const Unit& u, int wr, int wc, int fr, int fq) const {
        const int row0 = u.pm * BM + wr * 64 + fr; const int col0 = u.pn * BM + wc * 32 + 8 * fq;
#pragma unroll
        for (int ai = 0; ai < 2; ++ai)
#pragma unroll
            for (int m = 0; m < 4; ++m) { bf16_t* rowp = O + (size_t)(row0 + ai * HALF + m * 16) * ldc + col0;
#pragma unroll
                for (int bj = 0; bj < 2; ++bj) { const f32x4 v0 = acc[ai][bj][m][0], v1 = acc[ai][bj][m][1];
                    u32x4 w; w.x = cvt_pk_bf16(v0[0], v0[1]); w.y = cvt_pk_bf16(v0[2], v0[3]); w.z = cvt_pk_bf16(v1[0], v1[1]); w.w = cvt_pk_bf16(v1[2], v1[3]);
                    *(u32x4*)(rowp + bj * HALF) = w; } }
    }
};
struct EpiF32 {
    static constexpr bool PERM = false, AFTER_DRAIN = false;
    float* C; int ldc;
    __device__ __forceinline__ void operator()(const f32x4 (&acc)[2][2][4][2], const Unit& u, int wr, int wc, int fr, int fq) const {
        const int row0 = u.pm * BM + wr * 64 + fr, col0 = u.pn * BM + wc * 32 + 4 * fq;
#pragma unroll
        for (int ai = 0; ai < 2; ++ai)
#pragma unroll
            for (int m = 0; m < 4; ++m) { float* rowp = C + (size_t)(row0 + ai * HALF + m * 16) * ldc + col0;
#pragma unroll
                for (int bj = 0; bj < 2; ++bj)
#pragma unroll
                    for (int n = 0; n < 2; ++n) *(f32x4*)(rowp + bj * HALF + n * 16) = acc[ai][bj][m][n]; }
    }
};

template <class Epi, class Sched, bool ALIGN_EPI = false, bool SP2 = false>
__device__ __forceinline__ void gemm_phase(PG8_LAS unsigned char* lds, const Gemm g, const Sched& S, const Epi& E) {
    const int tid = otid(), wid = __builtin_amdgcn_readfirstlane(tid >> 6), lane = tid & 63, wr = wid >> 2, wc = wid & 3, fr = lane & 15, fq = lane >> 4;
    const int K = g.K, nt = K / BK;
    unsigned voffA[2], voffB[2];
#pragma unroll
    for (int i = 0; i < 2; ++i) { int R, C; stage_rc(tid * 16 + i * 8192, R, C); const int Rb = Epi::PERM ? ((R & ~31) + perm32(R & 31)) : R;
        voffA[i] = (unsigned)(R * K + C) * 2u; voffB[i] = (unsigned)(Rb * K + C) * 2u; }
    const size_t kstep = (size_t)(BK * 2);
    const size_t hstep = (size_t)HALF * K * 2;
    const size_t tstep = 2 * hstep;
    const unsigned ldsw = (unsigned)wid * 1024u;
    const int aoff = lds_byte(wr * 64 + fr, fq * 8), boff = lds_byte(wc * 32 + fr, fq * 8);
#define PG8_SA(b, h) (((b) * 2 + (h)) * HTB)
#define PG8_SB(b, h) ((4 + (b) * 2 + (h)) * HTB)
#define PG8_STAGE(bufoff, gbase, voff) do { _Pragma("unroll") for (int _i = 0; _i < 2; ++_i) \
        __builtin_amdgcn_global_load_lds((const unsigned*)((const char*)(gbase) + (voff)[_i]), (PG8_LAS unsigned*)(lds + (bufoff) + ldsw + _i * 8192), 16, 0, 0); } while (0)
#define PG8_LDA(dst, b, h) do { _Pragma("unroll") for (int m = 0; m < 4; ++m) _Pragma("unroll") for (int k = 0; k < 2; ++k) dst[m][k] = *(const PG8_LAS bf16x8*)(lds + PG8_SA(b, h) + aoff + m * 2048 + k * 1024); } while (0)
#define PG8_LDB(dst, b, h) do { _Pragma("unroll") for (int n = 0; n < 2; ++n) _Pragma("unroll") for (int k = 0; k < 2; ++k) dst[n][k] = *(const PG8_LAS bf16x8*)(lds + PG8_SB(b, h) + boff + n * 2048 + k * 1024); } while (0)
#define PG8_MMA(ai, bj, At, Bt) do { __builtin_amdgcn_s_setprio(1); _Pragma("unroll") for (int m = 0; m < 4; ++m) _Pragma("unroll") for (int n = 0; n < 2; ++n) _Pragma("unroll") for (int k = 0; k < 2; ++k) \
        acc[ai][bj][m][n] = __builtin_amdgcn_mfma_f32_16x16x32_bf16(Bt[n][k], At[m][k], acc[ai][bj][m][n], 0, 0, 0); __builtin_amdgcn_s_setprio(0); } while (0)
#define PG8_WAIT_V(n) asm volatile("s_waitcnt vmcnt(" #n ")" ::: "memory")
#define PG8_WAIT_L(n) asm volatile("s_waitcnt lgkmcnt(" #n ")" ::: "memory")
#define PG8_BAR __builtin_amdgcn_s_barrier()
#define PG8_SCHED __builtin_amdgcn_sched_barrier(0)
    Unit cur, nxt; int ui = 0;
    if (!S.next(0, cur)) return;
    f32x4 acc[2][2][4][2];
#pragma unroll
    for (int a = 0; a < 2; ++a)
#pragma unroll
        for (int b = 0; b < 2; ++b)
#pragma unroll
            for (int m = 0; m < 4; ++m)
#pragma unroll
                for (int n = 0; n < 2; ++n) acc[a][b][m][n] = (f32x4){0.f, 0.f, 0.f, 0.f};
    bf16x8 At[4][2], B0[2][2], B1[2][2];
    const char* cA = (const char*)g.A + (size_t)cur.pm * tstep; const char* cB = (const char*)g.Bt + (size_t)cur.pn * tstep;
    S.a_ready(cur);
    if constexpr (SP2) {
        PG8_STAGE(PG8_SB(0, 0), cB, voffB); PG8_STAGE(PG8_SB(0, 1), cB + hstep, voffB); PG8_STAGE(PG8_SA(0, 0), cA, voffA); PG8_STAGE(PG8_SA(0, 1), cA + hstep, voffA);
        if (wr == 1) PG8_BAR;
        PG8_WAIT_V(2); PG8_BAR;
        PG8_STAGE(PG8_SB(1, 0), cB + kstep, voffB); PG8_STAGE(PG8_SA(1, 0), cA + kstep, voffA); PG8_STAGE(PG8_SB(1, 1), cB + hstep + kstep, voffB);
        PG8_WAIT_V(6); PG8_BAR;
    } else {
        PG8_STAGE(PG8_SB(0, 0), cB, voffB); PG8_STAGE(PG8_SA(0, 0), cA, voffA); PG8_STAGE(PG8_SB(0, 1), cB + hstep, voffB); PG8_STAGE(PG8_SA(0, 1), cA + hstep, voffA);
        if (wr == 1) PG8_BAR;
        PG8_WAIT_V(4); PG8_BAR;
        PG8_STAGE(PG8_SB(1, 0), cB + kstep, voffB); PG8_STAGE(PG8_SA(1, 0), cA + kstep, voffA); PG8_STAGE(PG8_SB(1, 1), cB + hstep + kstep, voffB);
        PG8_WAIT_V(6); PG8_BAR;
    }
    for (;;) {
        const bool has_next = S.next(ui + 1, nxt);
        const char* nA = has_next ? (const char*)g.A + (size_t)nxt.pm * tstep : cA; const char* nB = has_next ? (const char*)g.Bt + (size_t)nxt.pn * tstep : cB;
        for (int t = 0; t < nt; t += 2) {
            const bool last = (t == nt - 2);
            const char* a1 = cA + (size_t)(t + 1) * kstep;
            const char* a2 = last ? nA : cA + (size_t)(t + 2) * kstep; const char* b2 = last ? nB : cB + (size_t)(t + 2) * kstep;
            const char* a3 = a2 + kstep; const char* b3 = b2 + kstep;
            if (last && has_next) S.a_ready(nxt);
            if constexpr (SP2) {
            PG8_LDB(B0, 0, 0); PG8_LDB(B1, 0, 1); PG8_SCHED; PG8_LDA(At, 0, 0); PG8_STAGE(PG8_SA(1, 1), a1 + hstep, voffA);
            PG8_WAIT_V(8); PG8_WAIT_L(0); PG8_BAR; PG8_MMA(0, 0, At, B0); PG8_MMA(0, 1, At, B1); PG8_BAR; PG8_SCHED;
            PG8_LDA(At, 0, 1); PG8_STAGE(PG8_SB(0, 0), b2, voffB); PG8_STAGE(PG8_SB(0, 1), b2 + hstep, voffB); PG8_STAGE(PG8_SA(0, 0), a2, voffA);
            PG8_WAIT_V(8); PG8_WAIT_L(0); PG8_BAR; PG8_MMA(1, 0, At, B0); PG8_MMA(1, 1, At, B1); PG8_BAR; PG8_SCHED;
            PG8_LDB(B0, 1, 0); PG8_LDB(B1, 1, 1); PG8_SCHED; PG8_LDA(At, 1, 0); PG8_STAGE(PG8_SA(0, 1), a2 + hstep, voffA);
            PG8_WAIT_V(8); PG8_WAIT_L(0); PG8_BAR; PG8_MMA(0, 0, At, B0); PG8_MMA(0, 1, At, B1); PG8_BAR; PG8_SCHED;
            PG8_LDA(At, 1, 1); PG8_STAGE(PG8_SB(1, 0), b3, voffB); PG8_STAGE(PG8_SB(1, 1), b3 + hstep, voffB); PG8_STAGE(PG8_SA(1, 0), a3, voffA);
            PG8_WAIT_V(8); PG8_WAIT_L(0); PG8_BAR; PG8_MMA(1, 0, At, B0); PG8_MMA(1, 1, At, B1); PG8_BAR; PG8_SCHED;
            } else {
            PG8_LDB(B0, 0, 0); PG8_SCHED; PG8_LDA(At, 0, 0); PG8_STAGE(PG8_SA(1, 1), a1 + hstep, voffA);
            PG8_WAIT_L(8); PG8_BAR; PG8_WAIT_L(0); PG8_MMA(0, 0, At, B0); PG8_BAR; PG8_SCHED;
            PG8_LDB(B1, 0, 1); PG8_STAGE(PG8_SB(0, 0), b2, voffB);
            PG8_BAR; PG8_WAIT_L(0); PG8_MMA(0, 1, At, B1); PG8_BAR;
            PG8_LDA(At, 0, 1); PG8_STAGE(PG8_SA(0, 0), a2, voffA);
            PG8_BAR; PG8_WAIT_L(0); PG8_MMA(1, 0, At, B0); PG8_BAR; PG8_SCHED;
            PG8_STAGE(PG8_SB(0, 1), b2 + hstep, voffB);
            PG8_WAIT_V(6); PG8_BAR; PG8_MMA(1, 1, At, B1); PG8_BAR;
            PG8_LDB(B0, 1, 0); PG8_SCHED; PG8_LDA(At, 1, 0); PG8_STAGE(PG8_SA(0, 1), a2 + hstep, voffA);
            PG8_WAIT_L(8); PG8_BAR; PG8_WAIT_L(0); PG8_MMA(0, 0, At, B0); PG8_BAR; PG8_SCHED;
            PG8_LDB(B1, 1, 1); PG8_STAGE(PG8_SB(1, 0), b3, voffB);
            PG8_BAR; PG8_WAIT_L(0); PG8_MMA(0, 1, At, B1); PG8_BAR;
            PG8_LDA(At, 1, 1); PG8_STAGE(PG8_SA(1, 0), a3, voffA);
            PG8_BAR; PG8_WAIT_L(0); PG8_MMA(1, 0, At, B0); PG8_BAR; PG8_SCHED;
            PG8_STAGE(PG8_SB(1, 1), b3 + hstep, voffB);
            PG8_WAIT_V(6); PG8_BAR; PG8_MMA(1, 1, At, B1); PG8_BAR;
            }
        }
        if constexpr (ALIGN_EPI) { if (wr == 0) PG8_BAR; }
        if constexpr (!Epi::AFTER_DRAIN) { E(acc, cur, wr, wc, fr, fq); S.done(cur); }
        if (!has_next) break;
#pragma unroll
        for (int a = 0; a < 2; ++a)
#pragma unroll
            for (int b = 0; b < 2; ++b)
#pragma unroll
                for (int m = 0; m < 4; ++m)
#pragma unroll
                    for (int n = 0; n < 2; ++n) acc[a][b][m][n] = (f32x4){0.f, 0.f, 0.f, 0.f};
        cur = nxt; cA = nA; cB = nB; ++ui;
        if constexpr (ALIGN_EPI) { if (wr == 1) PG8_BAR; }
    }
    PG8_WAIT_V(0);
    if constexpr (!ALIGN_EPI) { if (wr == 0) PG8_BAR; }
    PG8_BAR;
    if constexpr (Epi::AFTER_DRAIN) { E.fused(acc, cur, wr, wc, fr, fq, lds, wid, lane); S.done(cur); }
#undef PG8_SA
#undef PG8_SB
#undef PG8_STAGE
#undef PG8_LDA
#undef PG8_LDB
#undef PG8_MMA
#undef PG8_WAIT_V
#undef PG8_WAIT_L
#undef PG8_BAR
#undef PG8_SCHED
}
}

constexpr int M = 16384, D = 1024, DEPTH = 4, NU = 3328, NWIN = 3208, NCHUNK = 256;
constexpr int MEM_LEN = 256;
constexpr int C_XS = 0, C_B = 512, C_C = 768, C_Z = 1024, C_R = 1536, C_K = 1792, C_V = 2048, C_G = 2304, C_WL = 2560, C_AL = 2624, C_DT = 2688, C_Q = 2816, C_GX = 3072;
constexpr float NORM_EPS = 1e-6f, LNX_EPS = 64e-5f;

#define LAS __attribute__((address_space(3)))
typedef unsigned short bf16;
typedef short bf16x8 __attribute__((ext_vector_type(8)));
typedef float f32x4 __attribute__((ext_vector_type(4)));

__device__ __forceinline__ unsigned f2bf(float f) { unsigned u = __float_as_uint(f); return (u + 0x7fffu + ((u >> 16) & 1u)) >> 16; }
__device__ __forceinline__ float bf2f(unsigned b) { return __uint_as_float(b << 16); }
__device__ __forceinline__ float wave_sum(float v) {
#pragma unroll
    for (int o = 1; o < 64; o <<= 1) v += __shfl_xor(v, o);
    return v;
}
__device__ __forceinline__ float silu_f(float x) { return x / (1.f + __expf(-x)); }
__device__ __forceinline__ float softplus_f(float x) { return fmaxf(x, 0.f) + log1pf(__expf(-fabsf(x))); }
__device__ __forceinline__ float sigmoid_f(float x) { return 1.f / (1.f + __expf(-x)); }

__device__ __forceinline__ bf16x8 ld_frag(const LAS bf16* base, int ld, int row0, int k0, int lane) {
    return *(const LAS bf16x8*)(base + (row0 + (lane & 15)) * ld + k0 + (lane >> 4) * 8);
}
#define MFMA16(a, b, c) __builtin_amdgcn_mfma_f32_16x16x32_bf16((a), (b), (c), 0, 0, 0)

#define XB_TMO      128
#define XB_XCNT(j)  (256  + 64 * (j))
#define XB_XSUB(j)  (1280 + 64 * (j))
#define XB_XGEN(j)  (2304 + 64 * (j))
#define XB_TOP      3328
#define XB_TOPGEN   3392
#define XCD_BAR_WORDS 3456
#define XB_SPIN_CAP (1u << 22)

__device__ __forceinline__ unsigned xb_ld(unsigned* p)              { return __hip_atomic_load(p, __ATOMIC_RELAXED, __HIP_MEMORY_SCOPE_AGENT); }
__device__ __forceinline__ unsigned xb_add(unsigned* p, unsigned v) { return __hip_atomic_fetch_add(p, v, __ATOMIC_RELAXED, __HIP_MEMORY_SCOPE_AGENT); }
__device__ __forceinline__ unsigned xb_xcc_id() { return (unsigned)__builtin_amdgcn_s_getreg((3 << 11) | 20) & 0xFu; }
#define XB_SPIN(cond, bar) do { unsigned _sp = 0; while (cond) { __builtin_amdgcn_s_sleep(1); \
    if ((++_sp & 255u) == 0u) { if (xb_ld(&(bar)[XB_TMO])) break; if (_sp > XB_SPIN_CAP) { atomicAdd(&(bar)[XB_TMO], 1u); break; } } } } while (0)

struct XcdBarrier {
    unsigned* bar; unsigned x;
    volatile LAS unsigned* st;
};

__device__ __forceinline__ XcdBarrier xcd_barrier_post(unsigned* bar, volatile LAS unsigned* st) {
    XcdBarrier b; b.bar = bar; b.x = xb_xcc_id(); b.st = st;
    if (otid() == 0) (void)xb_add(&bar[XB_XCNT(b.x)], 1u);
    return b;
}
__device__ __forceinline__ void xcd_barrier_complete(unsigned* bar, unsigned x, unsigned& nloc, unsigned& nx) {
    const unsigned G = gridDim.x * gridDim.y * gridDim.z;
    unsigned sum, cnt, mine, sp = 0u;
    for (;;) {
        sum = 0u; cnt = 0u; mine = 0u;
#pragma unroll
        for (unsigned j = 0; j < 16; ++j) { const unsigned c = xb_ld(&bar[XB_XCNT(j)]); sum += c; cnt += (c > 0u) ? 1u : 0u; }
        mine = xb_ld(&bar[XB_XCNT(x)]);
        if (sum == G) break;
        __builtin_amdgcn_s_sleep(1);
        if ((++sp & 255u) == 0u) { if (xb_ld(&bar[XB_TMO])) break; if (sp > XB_SPIN_CAP) { atomicAdd(&bar[XB_TMO], 1u); break; } }
    }
    nloc = mine > 0u ? mine : 1u; nx = cnt > 0u ? cnt : 1u;
}

__device__ __forceinline__ void xcd_barrier(const XcdBarrier& b) {
    asm volatile("s_waitcnt vmcnt(0)" ::: "memory");
    __syncthreads();
    if (otid() == 0) {
        unsigned* bar = b.bar;
        __builtin_amdgcn_s_waitcnt(0);
        unsigned nloc = b.st[0], nx = b.st[1];
        if (nloc == 0u) { xcd_barrier_complete(bar, b.x, nloc, nx); b.st[0] = nloc; b.st[1] = nx; }
        const unsigned old = xb_add(&bar[XB_XSUB(b.x)], 1u);
        const unsigned gen = old / nloc;
        if (old + 1u == (gen + 1u) * nloc) {
            __builtin_amdgcn_fence(__ATOMIC_RELEASE, "agent");
            asm volatile("s_waitcnt vmcnt(0)" ::: "memory");
            const unsigned og = xb_add(&bar[XB_TOP], 1u);
            const unsigned tg = og / nx;
            if (og + 1u == (tg + 1u) * nx) xb_add(&bar[XB_TOPGEN], 1u);
            else XB_SPIN(xb_ld(&bar[XB_TOPGEN]) == tg, bar);
            __builtin_amdgcn_fence(__ATOMIC_ACQUIRE, "agent");
            xb_add(&bar[XB_XGEN(b.x)], 1u);
            asm volatile("s_waitcnt vmcnt(0)" ::: "memory");
        } else {
            XB_SPIN(xb_ld(&bar[XB_XGEN(b.x)]) == gen, bar);
            __builtin_amdgcn_fence(__ATOMIC_ACQUIRE, "agent");
            asm volatile("s_waitcnt vmcnt(0)" ::: "memory");
        }
    }
    __syncthreads();
}


struct Params {
    const float *x, *mem, *mem_norm_w, *w_mem_kv, *pre_norm_w, *w_in, *conv_w, *conv_b, *dt_bias, *a_log, *d_skip, *ssm_norm_w,
                *shift_mu, *w0, *w2, *a0, *a2, *k_k, *k_a, *r_k, *lnx_w, *lnx_b, *w_out, *post_norm_w;
    float* out;
    unsigned char* ws;
};
constexpr size_t MiB = 1u << 20;
constexpr size_t WS_CTL = 0, WS_WIN = 1 * MiB, WS_WOUT = 27 * MiB, WS_KV = 35 * MiB, WS_H = 36 * MiB, WS_U = 68 * MiB, WS_R = 172 * MiB, WS_END = 256 * MiB;
constexpr size_t WS_ST = WS_R, WS_CD = WS_R + 32 * MiB, WS_BS = WS_CD + 65536;
constexpr size_t WS_Q1 = WS_R + 34 * MiB, WS_Y0 = WS_R + 42 * MiB, WS_PCT = WS_R + 50 * MiB, WS_GC = WS_R + 58 * MiB, WS_PGT = WS_R + 74 * MiB, WS_GG = WS_R + 75 * MiB;
static_assert(WS_GG + 64 * 16384 <= WS_END && WS_BS + (size_t)16384 * 16 <= WS_Q1, "ws map");


constexpr size_t WS_PB = 128 * 1024;
constexpr int PB_PRENW = 1024, PB_CONVW = 5120, PB_CONVB = 21504, PB_DTB = 25600, PB_ALOG = 25632, PB_DSKIP = 25664, PB_SSMNW = 25728, PB_MU = 27776, PB_W0 = 32384, PB_W2 = 33408,
              PB_A0 = 98944, PB_A2 = 99968, PB_KK = 165504, PB_KA = 166528, PB_RK = 167552, PB_LNW = 168576, PB_LNB = 169600, PB_POSTNW = 170624, PB_END = 174720;
static_assert(WS_PB + (size_t)PB_END * 4 <= 1 * MiB, "blob inside the control MiB");
#define PBP(P, off) ((const float*)((P).ws + WS_PB) + (off))
__device__ __forceinline__ int win_src_col(int n) {
    if (n < 1536) return n;
    if (n < 2560) return n + 8;
    if (n < 2816) { const int j = n - 2560; if (j < 64) return 2568 + j; if (j < 128) return 2632 + (j - 64); if (j < 136) return 1536 + (j - 128); return -1; }
    return n - 120;
}
template <bool WIN>
__device__ __forceinline__ void transpose_tile(const float* src, int src_ld, bf16* dst, int K, int n0, int k0, LAS float* scr) {
    const int tx = otid() & 63, ty = otid() >> 6;
    const int sc = WIN ? win_src_col(n0 + tx) : (n0 + tx);
#pragma unroll
    for (int kk = ty; kk < 64; kk += 8) scr[kk * 65 + tx] = sc >= 0 ? src[(size_t)(k0 + kk) * src_ld + sc] : 0.f;
    __syncthreads();
#pragma unroll
    for (int nn = ty; nn < 64; nn += 8) dst[(size_t)(n0 + nn) * K + k0 + tx] = (bf16)f2bf(scr[tx * 65 + nn]);
    __syncthreads();
}
__device__ __forceinline__ void stage_prep_weights(const Params& P, LAS unsigned char* lds, int item) {
    LAS float* scr = (LAS float*)lds;
    constexpr int T_IN = (NU / 64) * (D / 64);
    constexpr int T_OUT = (D / 64) * (D / 64);
    if (item < DEPTH * T_IN) { const int l = item / T_IN, r = item % T_IN, nb = r / 16, kb = r % 16;
        transpose_tile<true>(P.w_in + (size_t)l * D * NWIN, NWIN, (bf16*)(P.ws + WS_WIN) + (size_t)l * NU * D, D, nb * 64, kb * 64, scr); }
    else { const int it = item - DEPTH * T_IN; const int l = it / T_OUT, r = it % T_OUT, nb = r / 16, kb = r % 16;
        transpose_tile<false>(P.w_out + (size_t)l * D * D, D, (bf16*)(P.ws + WS_WOUT) + (size_t)l * D * D, D, nb * 64, kb * 64, scr); }
}
constexpr int N_PREP_ITEMS = DEPTH * ((NU / 64) * (D / 64) + (D / 64) * (D / 64));


__device__ __forceinline__ void stage_blob(const Params& P, int gtid, int gthreads) {
    float* pb = (float*)(P.ws + WS_PB);
#define CPY(src, off, n) for (int i = gtid; i < (n); i += gthreads) pb[(off) + i] = (src)[i];
    CPY(P.mem_norm_w, 0, 1024) CPY(P.pre_norm_w, PB_PRENW, 4096) CPY(P.conv_w, PB_CONVW, 16384) CPY(P.conv_b, PB_CONVB, 4096) CPY(P.dt_bias, PB_DTB, 32) CPY(P.a_log, PB_ALOG, 32) CPY(P.d_skip, PB_DSKIP, 32)
    CPY(P.ssm_norm_w, PB_SSMNW, 2048) CPY(P.shift_mu, PB_MU, 4608) CPY(P.w0, PB_W0, 1024) CPY(P.w2, PB_W2, 65536) CPY(P.a0, PB_A0, 1024) CPY(P.a2, PB_A2, 65536) CPY(P.k_k, PB_KK, 1024) CPY(P.k_a, PB_KA, 1024)
    CPY(P.r_k, PB_RK, 1024) CPY(P.lnx_w, PB_LNW, 1024) CPY(P.lnx_b, PB_LNB, 1024) CPY(P.post_norm_w, PB_POSTNW, 4096)
#undef CPY
}
__device__ __forceinline__ void stage_memkv(const Params& P, LAS unsigned char* lds, int m) {
    LAS float* xs = (LAS float*)lds; LAS float* red = xs + 1024;
    const int tid = otid();
    const float v0 = P.mem[(size_t)m * D + tid], v1 = P.mem[(size_t)m * D + 512 + tid];
    float s = wave_sum(v0 * v0 + v1 * v1);
    if ((tid & 63) == 0) red[tid >> 6] = s;
    __syncthreads();
    float tot = 0.f;
#pragma unroll
    for (int w = 0; w < 8; ++w) tot += red[w];
    const float rstd = rsqrtf(tot * (1.f / D) + NORM_EPS);
    xs[tid] = v0 * rstd * P.mem_norm_w[tid]; xs[512 + tid] = v1 * rstd * P.mem_norm_w[512 + tid];
    __syncthreads();
    float acc = 0.f;
#pragma unroll 8
    for (int k = 0; k < D; ++k) acc += xs[k] * P.w_mem_kv[(size_t)k * 512 + tid];
    ((float*)(P.ws + WS_KV))[(size_t)m * 512 + tid] = acc;
    __syncthreads();
}

__device__ __forceinline__ void prenorm_row(const float* xrow, const float* w, bf16* orow, int lane) {
    const f32x4* xr = (const f32x4*)xrow + lane; const f32x4* wr = (const f32x4*)w + lane;
    f32x4 v[4]; float s = 0.f;
#pragma unroll
    for (int j = 0; j < 4; ++j) { v[j] = xr[64 * j]; s += (v[j].x * v[j].x + v[j].y * v[j].y) + (v[j].z * v[j].z + v[j].w * v[j].w); }
    const float rstd = rsqrtf(wave_sum(s) * (1.f / D) + NORM_EPS);
    unsigned long long* o8 = (unsigned long long*)orow + lane;
#pragma unroll
    for (int j = 0; j < 4; ++j) { const f32x4 ww = wr[64 * j];
        const unsigned lo = f2bf(v[j].x * rstd * ww.x) | (f2bf(v[j].y * rstd * ww.y) << 16), hi = f2bf(v[j].z * rstd * ww.z) | (f2bf(v[j].w * rstd * ww.w) << 16);
        o8[64 * j] = (unsigned long long)lo | ((unsigned long long)hi << 32); }
}
__device__ __forceinline__ void post_row(const float* orow, const float* xin, const float* pw, float* xout, const float* nw, bf16* hrow, int lane) {
    const f32x4* orr = (const f32x4*)orow + lane; const f32x4* xr = (const f32x4*)xin + lane; const f32x4* pr = (const f32x4*)pw + lane;
    f32x4 v[4]; float s = 0.f;
#pragma unroll
    for (int j = 0; j < 4; ++j) { v[j] = orr[64 * j]; s += (v[j].x * v[j].x + v[j].y * v[j].y) + (v[j].z * v[j].z + v[j].w * v[j].w); }
    const float rstd = rsqrtf(wave_sum(s) * (1.f / D) + NORM_EPS);
    float s2 = 0.f;
#pragma unroll
    for (int j = 0; j < 4; ++j) { const f32x4 xx = xr[64 * j], pp = pr[64 * j]; v[j] = xx + v[j] * rstd * pp; s2 += (v[j].x * v[j].x + v[j].y * v[j].y) + (v[j].z * v[j].z + v[j].w * v[j].w);
        ((f32x4*)xout + lane)[64 * j] = v[j]; }
    if (hrow) {
        const float rstd2 = rsqrtf(wave_sum(s2) * (1.f / D) + NORM_EPS);
        const f32x4* wr = (const f32x4*)nw + lane; unsigned long long* o8 = (unsigned long long*)hrow + lane;
#pragma unroll
        for (int j = 0; j < 4; ++j) { const f32x4 ww = wr[64 * j];
            const unsigned lo = f2bf(v[j].x * rstd2 * ww.x) | (f2bf(v[j].y * rstd2 * ww.y) << 16), hi = f2bf(v[j].z * rstd2 * ww.z) | (f2bf(v[j].w * rstd2 * ww.w) << 16);
            o8[64 * j] = (unsigned long long)lo | ((unsigned long long)hi << 32); }
    }
}

constexpr int XA_KLD = 72, XA_VLD = 264, XA_PLD = 264;
constexpr int XA_LDS = (256 * XA_KLD + 64 * XA_VLD + 8 * 16 * XA_PLD) * 2;
__device__ __forceinline__ void stage_xattn(const Params& P, LAS unsigned char* lds, int item) {
    const int tid = otid(), lane = tid & 63, wave = tid >> 6, quad = lane >> 4, l15 = lane & 15;
    const int tile = item >> 2, h = item & 3, t0 = tile * 256;
    LAS bf16* Ks = (LAS bf16*)lds; LAS bf16* VT = Ks + 256 * XA_KLD; LAS bf16* Pw = VT + 64 * XA_VLD + wave * 16 * XA_PLD;
    const float* KV = (const float*)(P.ws + WS_KV);
    const bf16* U = (const bf16*)(P.ws + WS_U); bf16* Y = (bf16*)(P.ws + WS_H);
    for (int e = tid; e < 256 * 64; e += 512) { const int m = e >> 6, d = e & 63;
        Ks[m * XA_KLD + d] = (bf16)f2bf(KV[(size_t)m * 512 + h * 64 + d]);
        VT[d * XA_VLD + m] = (bf16)f2bf(KV[(size_t)m * 512 + 256 + h * 64 + d]); }
    __syncthreads();
    for (int rb = 0; rb < 2; ++rb) {
        const int tr = t0 + wave * 32 + rb * 16;
        bf16x8 a[2];
#pragma unroll
        for (int s = 0; s < 2; ++s) a[s] = *(const bf16x8*)(U + (size_t)(tr + l15) * NU + C_Q + h * 64 + s * 32 + quad * 8);
        f32x4 acc[16];
#pragma unroll
        for (int j = 0; j < 16; ++j) { acc[j] = (f32x4){0.f, 0.f, 0.f, 0.f};
#pragma unroll
            for (int s = 0; s < 2; ++s) acc[j] = MFMA16(a[s], ld_frag(Ks, XA_KLD, j * 16, s * 32, lane), acc[j]); }
        float mx[4], sm[4];
#pragma unroll
        for (int r = 0; r < 4; ++r) { float m_ = -3.0e38f;
#pragma unroll
            for (int j = 0; j < 16; ++j) { acc[j][r] *= 0.125f; m_ = fmaxf(m_, acc[j][r]); }
#pragma unroll
            for (int o = 1; o < 16; o <<= 1) m_ = fmaxf(m_, __shfl_xor(m_, o));
            mx[r] = m_; float s_ = 0.f;
#pragma unroll
            for (int j = 0; j < 16; ++j) { const float p = __expf(acc[j][r] - m_); s_ += p; Pw[(quad * 4 + r) * XA_PLD + j * 16 + l15] = (bf16)f2bf(p); }
#pragma unroll
            for (int o = 1; o < 16; o <<= 1) s_ += __shfl_xor(s_, o);
            sm[r] = s_; }
        __syncthreads();
        f32x4 o4[4];
#pragma unroll
        for (int jd = 0; jd < 4; ++jd) o4[jd] = (f32x4){0.f, 0.f, 0.f, 0.f};
#pragma unroll
        for (int ks = 0; ks < 8; ++ks) { const bf16x8 pa = ld_frag(Pw, XA_PLD, 0, ks * 32, lane);
#pragma unroll
            for (int jd = 0; jd < 4; ++jd) o4[jd] = MFMA16(pa, ld_frag(VT, XA_VLD, jd * 16, ks * 32, lane), o4[jd]); }
#pragma unroll
        for (int jd = 0; jd < 4; ++jd)
#pragma unroll
            for (int r = 0; r < 4; ++r) { const int t = tr + quad * 4 + r, d = jd * 16 + l15;
                const float g = bf2f(U[(size_t)t * NU + C_GX + h * 64 + d]);
                Y[(size_t)t * D + 768 + h * 64 + d] = (bf16)f2bf(o4[jd][r] / sm[r] * silu_f(g)); }
        __syncthreads();
    }
}

__device__ __forceinline__ void ssd_dt(const Params& P, int l, int c, int g, LAS float* dtS, LAS float* acS) {
    const int tid = otid();
    if (tid < 256) { const int hh = tid >> 6, q = tid & 63, h = g * 4 + hh;
        const bf16* U = (const bf16*)(P.ws + WS_U);
        const float raw = bf2f(U[(size_t)(c * 64 + q) * NU + C_DT + h]);
        const float dt = softplus_f(raw + PBP(P, PB_DTB)[l * 8 + h]);
        const float A = -__expf(PBP(P, PB_ALOG)[l * 8 + h]);
        float v = dt * A;
#pragma unroll
        for (int o = 1; o < 64; o <<= 1) { const float t = __shfl_up(v, o); if (q >= o) v += t; }
        dtS[hh * 64 + q] = dt; acS[hh * 64 + q] = v; }
}
constexpr int S1_LDS = 2048 + (4 * 64 * 72 + 128 * 72) * 2;
__device__ __forceinline__ void stage_ssd_s1(const Params& P, int l, LAS unsigned char* lds, int item) {
    const int tid = otid(), lane = tid & 63, wave = tid >> 6, quad = lane >> 4, l15 = lane & 15;
    const int c = item >> 1, g = item & 1, t0 = c * 64;
    LAS float* dtS = (LAS float*)lds; LAS float* acS = dtS + 256; LAS bf16* XT = (LAS bf16*)(lds + 2048); LAS bf16* BT = XT + 4 * 64 * 72;
    const bf16* U = (const bf16*)(P.ws + WS_U);
    ssd_dt(P, l, c, g, dtS, acS);
    __syncthreads();
    if (tid < 384) {
        const int j = tid, col = j < 256 ? C_XS + g * 256 + j : C_B + g * 128 + (j - 256);
        const float* cw = PBP(P, PB_CONVW) + (size_t)l * 4 * 1024; const float w0 = cw[col], w1 = cw[1024 + col], w2 = cw[2048 + col], w3 = cw[3072 + col], cb = PBP(P, PB_CONVB)[l * 1024 + col];
        float u0 = t0 >= 3 ? bf2f(U[(size_t)(t0 - 3) * NU + col]) : 0.f, u1 = t0 >= 2 ? bf2f(U[(size_t)(t0 - 2) * NU + col]) : 0.f, u2 = t0 >= 1 ? bf2f(U[(size_t)(t0 - 1) * NU + col]) : 0.f;
        for (int q = 0; q < 64; ++q) { const float u3 = bf2f(U[(size_t)(t0 + q) * NU + col]);
            float v = silu_f(cb + w0 * u0 + w1 * u1 + w2 * u2 + w3 * u3); u0 = u1; u1 = u2; u2 = u3;
            if (j < 256) { const int hh = j >> 6, p = j & 63; v *= dtS[hh * 64 + q] * __expf(acS[hh * 64 + 63] - acS[hh * 64 + q]); XT[(hh * 64 + p) * 72 + q] = (bf16)f2bf(v); }
            else BT[(j - 256) * 72 + q] = (bf16)f2bf(v); }
    }
    __syncthreads();
    { const int hh = wave >> 1, nh = wave & 1, h = g * 4 + hh;
        bf16* ST = (bf16*)(P.ws + WS_ST) + ((size_t)(c * 8 + h) * 64) * 128;
#pragma unroll
        for (int pb = 0; pb < 4; ++pb)
#pragma unroll
            for (int nb = 0; nb < 4; ++nb) { f32x4 acc = (f32x4){0.f, 0.f, 0.f, 0.f};
#pragma unroll
                for (int ks = 0; ks < 2; ++ks) acc = MFMA16(ld_frag(XT + hh * 64 * 72, 72, pb * 16, ks * 32, lane), ld_frag(BT, 72, nh * 64 + nb * 16, ks * 32, lane), acc);
#pragma unroll
                for (int r = 0; r < 4; ++r) ST[(size_t)(pb * 16 + quad * 4 + r) * 128 + nh * 64 + nb * 16 + l15] = (bf16)f2bf(acc[r]); }
        if (tid < 4) ((float*)(P.ws + WS_CD))[c * 8 + g * 4 + tid] = __expf(acS[tid * 64 + 63]);
    }
    __syncthreads();
}
__device__ __forceinline__ void stage_ssd_scan(const Params& P, int e) {
    bf16* ST = (bf16*)(P.ws + WS_ST); const float* CD = (const float*)(P.ws + WS_CD);
    const int h = e >> 13; float carry = 0.f;
#pragma unroll 8
    for (int c = 0; c < NCHUNK; ++c) { const size_t idx = (size_t)c * 65536 + e; const float v = bf2f(ST[idx]); ST[idx] = (bf16)f2bf(carry); carry = carry * CD[c * 8 + h] + v; }
}
constexpr int S3_LDS = 3072 + (2 * 64 * 136 + 4 * 64 * 72 + 8 * 32 * 72) * 2;
__device__ __forceinline__ void stage_ssd_s3(const Params& P, int l, LAS unsigned char* lds, int item) {
    const int tid = otid(), lane = tid & 63, wave = tid >> 6, quad = lane >> 4, l15 = lane & 15;
    const int c = item >> 1, g = item & 1, t0 = c * 64;
    LAS float* dtS = (LAS float*)lds; LAS float* acS = dtS + 256; LAS float* red = acS + 256;
    LAS bf16* Cn = (LAS bf16*)(lds + 3072); LAS bf16* Bn = Cn + 64 * 136; LAS bf16* XT = Bn + 64 * 136; LAS bf16* SCw = XT + 4 * 64 * 72 + wave * 32 * 72;
    const bf16* U = (const bf16*)(P.ws + WS_U); bf16* Y = (bf16*)(P.ws + WS_H);
    ssd_dt(P, l, c, g, dtS, acS);
    __syncthreads();
    {
        const int j = tid, col = j < 256 ? C_XS + g * 256 + j : (j < 384 ? C_B + g * 128 + (j - 256) : C_C + g * 128 + (j - 384));
        const float* cw = PBP(P, PB_CONVW) + (size_t)l * 4 * 1024; const float w0 = cw[col], w1 = cw[1024 + col], w2 = cw[2048 + col], w3 = cw[3072 + col], cb = PBP(P, PB_CONVB)[l * 1024 + col];
        float u0 = t0 >= 3 ? bf2f(U[(size_t)(t0 - 3) * NU + col]) : 0.f, u1 = t0 >= 2 ? bf2f(U[(size_t)(t0 - 2) * NU + col]) : 0.f, u2 = t0 >= 1 ? bf2f(U[(size_t)(t0 - 1) * NU + col]) : 0.f;
        for (int q = 0; q < 64; ++q) { const float u3 = bf2f(U[(size_t)(t0 + q) * NU + col]);
            const float v = silu_f(cb + w0 * u0 + w1 * u1 + w2 * u2 + w3 * u3); u0 = u1; u1 = u2; u2 = u3;
            if (j < 256) { const int hh = j >> 6, p = j & 63; XT[(hh * 64 + p) * 72 + q] = (bf16)f2bf(v * dtS[hh * 64 + q]); }
            else if (j < 384) Bn[q * 136 + (j - 256)] = (bf16)f2bf(v);
            else Cn[q * 136 + (j - 384)] = (bf16)f2bf(v); }
    }
    __syncthreads();
    const int hh = wave >> 1, qh = wave & 1, h = g * 4 + hh;
#pragma unroll
    for (int qb = 0; qb < 2; ++qb)
#pragma unroll
        for (int sb = 0; sb < 4; ++sb) { f32x4 acc = (f32x4){0.f, 0.f, 0.f, 0.f};
#pragma unroll
            for (int ks = 0; ks < 4; ++ks) acc = MFMA16(ld_frag(Cn, 136, qh * 32 + qb * 16, ks * 32, lane), ld_frag(Bn, 136, sb * 16, ks * 32, lane), acc);
#pragma unroll
            for (int r = 0; r < 4; ++r) { const int q = qh * 32 + qb * 16 + quad * 4 + r, s = sb * 16 + l15;
                const float v = (s <= q) ? acc[r] * __expf(acS[hh * 64 + q] - acS[hh * 64 + s]) : 0.f;
                SCw[(qb * 16 + quad * 4 + r) * 72 + s] = (bf16)f2bf(v); } }
    __syncthreads();
    f32x4 y[2][4];
    const bf16* ST = (const bf16*)(P.ws + WS_ST) + ((size_t)(c * 8 + h) * 64) * 128;
#pragma unroll
    for (int qb = 0; qb < 2; ++qb)
#pragma unroll
        for (int pb = 0; pb < 4; ++pb) { f32x4 yd = (f32x4){0.f, 0.f, 0.f, 0.f}, yo = (f32x4){0.f, 0.f, 0.f, 0.f};
#pragma unroll
            for (int ks = 0; ks < 2; ++ks) yd = MFMA16(ld_frag(SCw, 72, qb * 16, ks * 32, lane), ld_frag(XT + hh * 64 * 72, 72, pb * 16, ks * 32, lane), yd);
#pragma unroll
            for (int ks = 0; ks < 4; ++ks) yo = MFMA16(ld_frag(Cn, 136, qh * 32 + qb * 16, ks * 32, lane), *(const bf16x8*)(ST + (size_t)(pb * 16 + l15) * 128 + ks * 32 + quad * 8), yo);
#pragma unroll
            for (int r = 0; r < 4; ++r) { const int q = qh * 32 + qb * 16 + quad * 4 + r, p = pb * 16 + l15;
                const float xs = bf2f(XT[(hh * 64 + p) * 72 + q]) / dtS[hh * 64 + q];
                float v = yd[r] + __expf(acS[hh * 64 + q]) * yo[r] + PBP(P, PB_DSKIP)[l * 8 + h] * xs;
                const float z = bf2f(U[(size_t)(t0 + q) * NU + C_Z + h * 64 + p]);
                y[qb][pb][r] = v * silu_f(z); } }
#pragma unroll
    for (int qb = 0; qb < 2; ++qb)
#pragma unroll
        for (int r = 0; r < 4; ++r) { float s = 0.f;
#pragma unroll
            for (int pb = 0; pb < 4; ++pb) s += y[qb][pb][r] * y[qb][pb][r];
#pragma unroll
            for (int o = 1; o < 16; o <<= 1) s += __shfl_xor(s, o);
            if (l15 == 0) red[hh * 64 + qh * 32 + qb * 16 + quad * 4 + r] = s; }
    __syncthreads();
#pragma unroll
    for (int qb = 0; qb < 2; ++qb)
#pragma unroll
        for (int r = 0; r < 4; ++r) { const int q = qh * 32 + qb * 16 + quad * 4 + r;
            const float tot = red[q] + red[64 + q] + red[128 + q] + red[192 + q]; const float rstd = rsqrtf(tot * (1.f / 256.f) + NORM_EPS);
#pragma unroll
            for (int pb = 0; pb < 4; ++pb) { const int p = pb * 16 + l15;
                Y[(size_t)(t0 + q) * D + h * 64 + p] = (bf16)f2bf(y[qb][pb][r] * rstd * PBP(P, PB_SSMNW)[l * 512 + h * 64 + p]); } }
    __syncthreads();
}

constexpr int RW_AT = 0, RW_RT = 9216, RW_KT = 18432, RW_BT = 27648, RW_VT = 36864, RW_KHT = 46080, RW_BHT = 55296, RW_X1T = 64512, RW_X2T = 73728,
              RW_MAK = 82944, RW_MRK = 92160, RW_MRB = 101376, RW_MAB = 110592, RW_TOT = 128000, RW_WC = 130048, RW_AAF = 130304, RW_END = 146688;
constexpr int RW_RHS2 = RW_KT;
constexpr int RW_LATW = RW_X1T, RW_LATA = RW_X2T, RW_W2T = RW_MAK, RW_A2T = RW_MRK, RW_AWF = RW_MAB;
__device__ __forceinline__ float tanh_f(float x) { return 1.f - 2.f / (1.f + __expf(2.f * x)); }
__device__ __forceinline__ float us2f(short s) { return bf2f((unsigned)(unsigned short)s); }

__device__ __forceinline__ void stage_rwkv_p1(const Params& P, int l, LAS unsigned char* lds, int pi) {
    const int tid = otid(), lane = tid & 63, wave = __builtin_amdgcn_readfirstlane(tid >> 6), quad = lane >> 4, l15 = lane & 15;
    const int c = pi >> 2, h = pi & 3, t0 = c * 64;
    LAS bf16* At = (LAS bf16*)(lds + RW_AT); LAS bf16* Rt = (LAS bf16*)(lds + RW_RT); LAS bf16* Kt = (LAS bf16*)(lds + RW_KT); LAS bf16* Bt = (LAS bf16*)(lds + RW_BT);
    LAS bf16* VT = (LAS bf16*)(lds + RW_VT); LAS bf16* KhT = (LAS bf16*)(lds + RW_KHT); LAS bf16* BhT = (LAS bf16*)(lds + RW_BHT);
    LAS bf16* X1T = (LAS bf16*)(lds + RW_X1T); LAS bf16* X2T = (LAS bf16*)(lds + RW_X2T);
    LAS bf16* Mak = (LAS bf16*)(lds + RW_MAK); LAS bf16* Mrk = (LAS bf16*)(lds + RW_MRK); LAS bf16* Mrb = (LAS bf16*)(lds + RW_MRB);
    LAS float* Mab = (LAS float*)(lds + RW_MAB); LAS float* RHS2 = (LAS float*)(lds + RW_RHS2);
    LAS float* tot = (LAS float*)(lds + RW_TOT); LAS float* wCs = (LAS float*)(lds + RW_WC); LAS float* aaF = (LAS float*)(lds + RW_AAF); LAS float* awF = (LAS float*)(lds + RW_AWF);
    LAS bf16* latw = (LAS bf16*)(lds + RW_LATW); LAS bf16* lata = (LAS bf16*)(lds + RW_LATA); LAS bf16* w2T = (LAS bf16*)(lds + RW_W2T); LAS bf16* a2T = (LAS bf16*)(lds + RW_A2T);
    const bf16* U = (const bf16*)(P.ws + WS_U);
    const float* mu = PBP(P, PB_MU) + (size_t)l * 1152;
    {   const int t = tid >> 3, jg = tid & 7, tg = t0 + t;
        const bf16* uc = U + (size_t)tg * NU + C_WL + jg * 8;
        const bf16x8 cw = *(const bf16x8*)uc, ca = *(const bf16x8*)(uc + 64);
        bf16x8 pw = (bf16x8){0, 0, 0, 0, 0, 0, 0, 0}, pa = pw;
        if (tg > 0) { pw = *(const bf16x8*)(uc - NU); pa = *(const bf16x8*)(uc - NU + 64); }
        bf16x8 ow, oa, w2v, a2v;
#pragma unroll
        for (int jj = 0; jj < 8; ++jj) { const int j = jg * 8 + jj;
            const float cv = us2f(cw[jj]), pv = us2f(pw[jj]); ow[jj] = (short)f2bf(tanh_f(cv + (pv - cv) * mu[1024 + j]));
            const float cv2 = us2f(ca[jj]), pv2 = us2f(pa[jj]); oa[jj] = (short)f2bf(cv2 + (pv2 - cv2) * mu[1088 + j]);
            w2v[jj] = (short)f2bf(PBP(P, PB_W2)[((size_t)l * 64 + j) * 256 + h * 64 + t]); a2v[jj] = (short)f2bf(PBP(P, PB_A2)[((size_t)l * 64 + j) * 256 + h * 64 + t]); }
        *(LAS bf16x8*)(latw + t * 72 + jg * 8) = ow; *(LAS bf16x8*)(lata + t * 72 + jg * 8) = oa;
        *(LAS bf16x8*)(w2T + t * 72 + jg * 8) = w2v; *(LAS bf16x8*)(a2T + t * 72 + jg * 8) = a2v;
    }
    __syncthreads();
    {   const int tb = wave & 3; const bool isA = wave >= 4;
        const LAS bf16* Am = isA ? lata : latw; const LAS bf16* Bm = isA ? a2T : w2T; LAS float* Of = isA ? aaF : awF; const int ofs = isA ? 64 : 68;
#pragma unroll
        for (int cb = 0; cb < 4; ++cb) { f32x4 acc = (f32x4){0.f, 0.f, 0.f, 0.f};
#pragma unroll
            for (int ks = 0; ks < 2; ++ks) acc = MFMA16(ld_frag(Am, 72, tb * 16, ks * 32, lane), ld_frag(Bm, 72, cb * 16, ks * 32, lane), acc);
#pragma unroll
            for (int r = 0; r < 4; ++r) Of[(tb * 16 + quad * 4 + r) * ofs + cb * 16 + l15] = acc[r]; }
    }
    __syncthreads();
    {   const int t = tid >> 3, cg = tid & 7, tg = t0 + t, ch0 = cg * 8, gch = h * 64 + ch0;
        const bf16* uc = U + (size_t)tg * NU + gch;
        const bf16x8 cr = *(const bf16x8*)(uc + C_R), ck = *(const bf16x8*)(uc + C_K), cv = *(const bf16x8*)(uc + C_V);
        bf16x8 pr = (bf16x8){0, 0, 0, 0, 0, 0, 0, 0}, pk = pr, pv = pr;
        if (tg > 0) { pr = *(const bf16x8*)(uc - NU + C_R); pk = *(const bf16x8*)(uc - NU + C_K); pv = *(const bf16x8*)(uc - NU + C_V); }
        float rr[8], k2[8], vv[8], kkn[8], aS[8], lw[8], Lc[8];
        float ss = 0.f, bsum = 0.f;
#pragma unroll
        for (int jj = 0; jj < 8; ++jj) { const int gc = gch + jj, pc = l * 256 + gc;
            float a_ = us2f(cr[jj]), b_ = us2f(pr[jj]); const float r = a_ + (b_ - a_) * mu[gc];
            a_ = us2f(ck[jj]); b_ = us2f(pk[jj]); const float k = a_ + (b_ - a_) * mu[256 + gc];
            a_ = us2f(cv[jj]); b_ = us2f(pv[jj]); const float v = a_ + (b_ - a_) * mu[512 + gc];
            const float aw = awF[t * 68 + ch0 + jj] + PBP(P, PB_W0)[pc], aa = aaF[t * 64 + ch0 + jj] + PBP(P, PB_A0)[pc];
            lw[jj] = -0.60653066f * sigmoid_f(aw); const float a = sigmoid_f(aa);
            const float kr = k * PBP(P, PB_KK)[pc]; ss += kr * kr; kkn[jj] = kr;
            k2[jj] = k * (1.f + (a - 1.f) * PBP(P, PB_KA)[pc]); aS[jj] = a; rr[jj] = r; vv[jj] = v;
            bsum += r * k2[jj] * PBP(P, PB_RK)[pc]; Lc[jj] = lw[jj]; }
#pragma unroll
        for (int o = 1; o < 8; o <<= 1) { ss += __shfl_xor(ss, o); bsum += __shfl_xor(bsum, o); }
        const float inv = 1.f / fmaxf(sqrtf(ss), 1e-12f);
        if (cg == 0) ((float*)(P.ws + WS_BS))[(size_t)tg * 4 + h] = bsum;
#pragma unroll
        for (int o = 8; o < 64; o <<= 1)
#pragma unroll
            for (int jj = 0; jj < 8; ++jj) { const float tmp = __shfl_up(Lc[jj], o); if (lane >= o) Lc[jj] += tmp; }
        if ((lane >> 3) == 7) {
#pragma unroll
            for (int jj = 0; jj < 8; ++jj) tot[wave * 64 + ch0 + jj] = Lc[jj]; }
        __syncthreads();
        bf16x8 oA, oR, oK, oB;
#pragma unroll
        for (int jj = 0; jj < 8; ++jj) { float base = 0.f, LC = 0.f;
#pragma unroll
            for (int w2 = 0; w2 < 8; ++w2) { const float tv = tot[w2 * 64 + ch0 + jj]; base += w2 < wave ? tv : 0.f; LC += tv; }
            const float L = Lc[jj] + base; const float kk = kkn[jj] * inv, b = kk * aS[jj];
            const float eL = __expf(L), eiL = __expf(-L), eh = __expf(LC - L);
            const float at = -kk * __expf(L - lw[jj]); aaF[t * 64 + ch0 + jj] = at;
            oA[jj] = (short)f2bf(at); oR[jj] = (short)f2bf(rr[jj] * eL); oK[jj] = (short)f2bf(k2[jj] * eiL); oB[jj] = (short)f2bf(b * eiL);
            VT[(ch0 + jj) * 72 + t] = (bf16)f2bf(vv[jj]); KhT[(ch0 + jj) * 72 + t] = (bf16)f2bf(k2[jj] * eh); BhT[(ch0 + jj) * 72 + t] = (bf16)f2bf(b * eh);
            if (t == 63) wCs[ch0 + jj] = __expf(LC); }
        *(LAS bf16x8*)(At + t * 72 + ch0) = oA; *(LAS bf16x8*)(Rt + t * 72 + ch0) = oR; *(LAS bf16x8*)(Kt + t * 72 + ch0) = oK; *(LAS bf16x8*)(Bt + t * 72 + ch0) = oB;
    }
    __syncthreads();
    {   const int mat = wave >> 1, half = wave & 1;
        const LAS bf16* Am = mat < 2 ? At : Rt; const LAS bf16* Bm = (mat == 0 || mat == 3) ? Bt : Kt;
        LAS bf16* Ob = mat == 1 ? Mak : (mat == 2 ? Mrk : Mrb);
#pragma unroll
        for (int tbi = 0; tbi < 2; ++tbi)
#pragma unroll
            for (int sb = 0; sb < 4; ++sb) { const int tb = half * 2 + tbi; f32x4 acc = (f32x4){0.f, 0.f, 0.f, 0.f};
                if (sb <= tb) {
#pragma unroll
                    for (int ks = 0; ks < 2; ++ks) acc = MFMA16(ld_frag(Am, 72, tb * 16, ks * 32, lane), ld_frag(Bm, 72, sb * 16, ks * 32, lane), acc); }
#pragma unroll
                for (int r = 0; r < 4; ++r) { const int t = tb * 16 + quad * 4 + r, s_ = sb * 16 + l15;
                    const bool keep = mat < 2 ? (s_ < t) : (s_ <= t); const float val = keep ? acc[r] : 0.f;
                    if (mat == 0) Mab[t * 68 + s_] = val; else Ob[t * 72 + s_] = (bf16)f2bf(val); } }
    }
    __syncthreads();
#pragma unroll
    for (int i2 = 0; i2 < 2; ++i2) { const int tile = wave * 2 + i2, tb = tile >> 2, ib = tile & 3; f32x4 acc = (f32x4){0.f, 0.f, 0.f, 0.f};
#pragma unroll
        for (int ks = 0; ks < 2; ++ks) acc = MFMA16(ld_frag(Mak, 72, tb * 16, ks * 32, lane), ld_frag(VT, 72, ib * 16, ks * 32, lane), acc);
#pragma unroll
        for (int r = 0; r < 4; ++r) RHS2[(tb * 16 + quad * 4 + r) * 68 + ib * 16 + l15] = acc[r]; }
    __syncthreads();
    if (wave < 2) {
        float x[64];
        const LAS float* rhs = wave == 0 ? (const LAS float*)aaF : (const LAS float*)RHS2; const int rs = wave == 0 ? 64 : 68;
        unsigned mab_a = (unsigned)(uintptr_t)Mab, rhs_a = (unsigned)(uintptr_t)rhs + 4u * lane; asm volatile("" : "+v"(mab_a), "+v"(rhs_a));
        const LAS float* MabV = (const LAS float*)(uintptr_t)mab_a; const LAS float* rhsV = (const LAS float*)(uintptr_t)rhs_a;
#pragma unroll
        for (int t = 0; t < 64; ++t) {
            float a0 = rhsV[t * rs], a1 = 0.f;
#pragma unroll
            for (int s_ = 0; s_ + 1 < t; s_ += 2) { a0 += MabV[t * 68 + s_] * x[s_]; a1 += MabV[t * 68 + s_ + 1] * x[s_ + 1]; }
            if (t & 1) a0 += MabV[t * 68 + t - 1] * x[t - 1];
            float xt = a0 + a1;
            asm volatile("" : "+v"(xt) :: "memory");
            x[t] = xt; }
        LAS bf16* XT = wave == 0 ? X1T : X2T;
#pragma unroll
        for (int t8 = 0; t8 < 8; ++t8) { bf16x8 o;
#pragma unroll
            for (int jj = 0; jj < 8; ++jj) o[jj] = (short)f2bf(x[t8 * 8 + jj]);
            *(LAS bf16x8*)(XT + lane * 72 + t8 * 8) = o; }
    }
    __syncthreads();
    {   const int mat = wave >> 1, half = wave & 1;
        bf16* Q1g = (bf16*)(P.ws + WS_Q1) + (size_t)pi * 4096; bf16* Y0g = (bf16*)(P.ws + WS_Y0) + (size_t)pi * 4096;
        bf16* PcTg = (bf16*)(P.ws + WS_PCT) + (size_t)pi * 4096; float* Gcg = (float*)(P.ws + WS_GC) + (size_t)pi * 4096;
        const LAS bf16* A1 = mat == 0 ? Mrb : (mat == 1 ? Mrk : (mat == 2 ? BhT : VT));
        const LAS bf16* B1 = mat == 0 ? X1T : (mat == 1 ? VT : (mat == 2 ? X1T : KhT));
        const LAS bf16* A2 = mat == 1 ? Mrb : X2T; const LAS bf16* B2 = mat == 1 ? X2T : BhT;
#pragma unroll
        for (int rbi = 0; rbi < 2; ++rbi)
#pragma unroll
            for (int cb = 0; cb < 4; ++cb) { const int rb = half * 2 + rbi; f32x4 acc = (f32x4){0.f, 0.f, 0.f, 0.f};
#pragma unroll
                for (int ks = 0; ks < 2; ++ks) acc = MFMA16(ld_frag(A1, 72, rb * 16, ks * 32, lane), ld_frag(B1, 72, cb * 16, ks * 32, lane), acc);
                if (mat == 1 || mat == 3) {
#pragma unroll
                    for (int ks = 0; ks < 2; ++ks) acc = MFMA16(ld_frag(A2, 72, rb * 16, ks * 32, lane), ld_frag(B2, 72, cb * 16, ks * 32, lane), acc); }
#pragma unroll
                for (int r = 0; r < 4; ++r) { const int row = rb * 16 + quad * 4 + r, col = cb * 16 + l15;
                    if (mat == 0) Q1g[row * 64 + col] = (bf16)f2bf(acc[r] + bf2f(Rt[row * 72 + col]));
                    else if (mat == 1) Y0g[row * 64 + col] = (bf16)f2bf(acc[r]);
                    else if (mat == 2) PcTg[row * 64 + col] = (bf16)f2bf(acc[r] + (row == col ? wCs[row] : 0.f));
                    else Gcg[row * 64 + col] = acc[r]; } }
    }
    __syncthreads();
}

__device__ __forceinline__ void stage_rwkv_compose(const Params& P, LAS unsigned char* lds, int task) {
    const int tid = otid(), lane = tid & 63, wave = __builtin_amdgcn_readfirstlane(tid >> 6), quad = lane >> 4, l15 = lane & 15;
    const int gI = task >> 2, h = task & 3, kind = wave >> 2, rb = wave & 3;
    LAS bf16* Ab = (LAS bf16*)lds + wave * 16 * 72;
    f32x4 acc[4];
#pragma unroll
    for (int cb = 0; cb < 4; ++cb)
#pragma unroll
        for (int r = 0; r < 4; ++r) acc[cb][r] = (kind == 0 && (rb * 16 + quad * 4 + r) == (cb * 16 + l15)) ? 1.f : 0.f;
    for (int st = 0; st < 16; ++st) {
        const int pi = (gI * 16 + st) * 4 + h;
        const bf16* PcTg = (const bf16*)(P.ws + WS_PCT) + (size_t)pi * 4096; const float* Gcg = (const float*)(P.ws + WS_GC) + (size_t)pi * 4096;
#pragma unroll
        for (int cb = 0; cb < 4; ++cb)
#pragma unroll
            for (int r = 0; r < 4; ++r) Ab[(quad * 4 + r) * 72 + cb * 16 + l15] = (bf16)f2bf(acc[cb][r]);
        asm volatile("s_waitcnt lgkmcnt(0)" ::: "memory");
        const bf16x8 a0 = ld_frag(Ab, 72, 0, 0, lane), a1 = ld_frag(Ab, 72, 0, 32, lane);
#pragma unroll
        for (int cb = 0; cb < 4; ++cb) { f32x4 n = (f32x4){0.f, 0.f, 0.f, 0.f};
            if (kind == 1) {
#pragma unroll
                for (int r = 0; r < 4; ++r) n[r] = Gcg[(rb * 16 + quad * 4 + r) * 64 + cb * 16 + l15]; }
            const bf16* bp = PcTg + (cb * 16 + l15) * 64 + quad * 8;
            n = MFMA16(a0, *(const bf16x8*)bp, n); n = MFMA16(a1, *(const bf16x8*)(bp + 32), n);
            acc[cb] = n; }
        asm volatile("s_waitcnt lgkmcnt(0)" ::: "memory");
    }
    bf16* PgTg = (bf16*)(P.ws + WS_PGT) + (size_t)task * 4096; float* Ggg = (float*)(P.ws + WS_GG) + (size_t)task * 4096;
#pragma unroll
    for (int cb = 0; cb < 4; ++cb)
#pragma unroll
        for (int r = 0; r < 4; ++r) { const int row = rb * 16 + quad * 4 + r, col = cb * 16 + l15;
            if (kind == 0) PgTg[col * 64 + row] = (bf16)f2bf(acc[cb][r]); else Ggg[row * 64 + col] = acc[cb][r]; }
}

__device__ __forceinline__ void stage_rwkv_out(const Params& P, int l, LAS unsigned char* lds, int task) {
    const int tid = otid(), lane = tid & 63, wave = __builtin_amdgcn_readfirstlane(tid >> 6), quad = lane >> 4, l15 = lane & 15;
    const int gI = task >> 2, h = task & 3;
    LAS bf16* Sb = (LAS bf16*)lds;
    const bf16* U = (const bf16*)(P.ws + WS_U); bf16* Y = (bf16*)(P.ws + WS_H);
    f32x4 acc[4];
#pragma unroll
    for (int cb = 0; cb < 4; ++cb) acc[cb] = (f32x4){0.f, 0.f, 0.f, 0.f};
    if (wave < 4) {
        const int rb = wave;
        for (int g2 = 0; g2 < gI; ++g2) {
            const bf16* PgTg = (const bf16*)(P.ws + WS_PGT) + (size_t)(g2 * 4 + h) * 4096; const float* Ggg = (const float*)(P.ws + WS_GG) + (size_t)(g2 * 4 + h) * 4096;
#pragma unroll
            for (int cb = 0; cb < 4; ++cb)
#pragma unroll
                for (int r = 0; r < 4; ++r) Sb[(rb * 16 + quad * 4 + r) * 72 + cb * 16 + l15] = (bf16)f2bf(acc[cb][r]);
            asm volatile("s_waitcnt lgkmcnt(0)" ::: "memory");
            const bf16x8 a0 = ld_frag(Sb, 72, rb * 16, 0, lane), a1 = ld_frag(Sb, 72, rb * 16, 32, lane);
#pragma unroll
            for (int cb = 0; cb < 4; ++cb) { f32x4 n;
#pragma unroll
                for (int r = 0; r < 4; ++r) n[r] = Ggg[(rb * 16 + quad * 4 + r) * 64 + cb * 16 + l15];
                const bf16* bp = PgTg + (cb * 16 + l15) * 64 + quad * 8;
                n = MFMA16(a0, *(const bf16x8*)bp, n); n = MFMA16(a1, *(const bf16x8*)(bp + 32), n);
                acc[cb] = n; }
            asm volatile("s_waitcnt lgkmcnt(0)" ::: "memory");
        }
    }
    for (int st = 0; st < 16; ++st) {
        const int c = gI * 16 + st, pi = c * 4 + h;
        LAS bf16* Sc = Sb + (st & 1) * 64 * 72;
        if (wave < 4) {
#pragma unroll
            for (int cb = 0; cb < 4; ++cb)
#pragma unroll
                for (int r = 0; r < 4; ++r) Sc[(wave * 16 + quad * 4 + r) * 72 + cb * 16 + l15] = (bf16)f2bf(acc[cb][r]);
        }
        __syncthreads();
        if (wave < 4) {
            const int rb = wave;
            const bf16* PcTg = (const bf16*)(P.ws + WS_PCT) + (size_t)pi * 4096; const float* Gcg = (const float*)(P.ws + WS_GC) + (size_t)pi * 4096;
            const bf16x8 a0 = ld_frag(Sc, 72, rb * 16, 0, lane), a1 = ld_frag(Sc, 72, rb * 16, 32, lane);
#pragma unroll
            for (int cb = 0; cb < 4; ++cb) { f32x4 n;
#pragma unroll
                for (int r = 0; r < 4; ++r) n[r] = Gcg[(rb * 16 + quad * 4 + r) * 64 + cb * 16 + l15];
                const bf16* bp = PcTg + (cb * 16 + l15) * 64 + quad * 8;
                n = MFMA16(a0, *(const bf16x8*)bp, n); n = MFMA16(a1, *(const bf16x8*)(bp + 32), n);
                acc[cb] = n; }
        } else {
            const int tb = wave - 4;
            const bf16* Q1g = (const bf16*)(P.ws + WS_Q1) + (size_t)pi * 4096; const bf16* Y0g = (const bf16*)(P.ws + WS_Y0) + (size_t)pi * 4096;
            const bf16* qp = Q1g + (tb * 16 + l15) * 64 + quad * 8;
            const bf16x8 q0 = *(const bf16x8*)qp, q1 = *(const bf16x8*)(qp + 32);
            f32x4 y[4];
#pragma unroll
            for (int ib = 0; ib < 4; ++ib) {
#pragma unroll
                for (int r = 0; r < 4; ++r) y[ib][r] = bf2f(Y0g[(tb * 16 + quad * 4 + r) * 64 + ib * 16 + l15]);
                y[ib] = MFMA16(q0, ld_frag(Sc, 72, ib * 16, 0, lane), y[ib]); y[ib] = MFMA16(q1, ld_frag(Sc, 72, ib * 16, 32, lane), y[ib]); }
#pragma unroll
            for (int r = 0; r < 4; ++r) {
                float s = (y[0][r] + y[1][r]) + (y[2][r] + y[3][r]);
#pragma unroll
                for (int o = 1; o < 16; o <<= 1) s += __shfl_xor(s, o);
                const float mean = s * (1.f / 64.f);
                float q = 0.f;
#pragma unroll
                for (int ib = 0; ib < 4; ++ib) { const float d = y[ib][r] - mean; q += d * d; }
#pragma unroll
                for (int o = 1; o < 16; o <<= 1) q += __shfl_xor(q, o);
                const float rstd = rsqrtf(q * (1.f / 64.f) + LNX_EPS);
                const int tg = c * 64 + tb * 16 + quad * 4 + r;
                const float bs = ((const float*)(P.ws + WS_BS))[(size_t)tg * 4 + h];
                const bf16* uc = U + (size_t)tg * NU;
#pragma unroll
                for (int ib = 0; ib < 4; ++ib) { const int chn = h * 64 + ib * 16 + l15, pc = l * 256 + chn;
                    const float cv = bf2f(uc[C_V + chn]), cg = bf2f(uc[C_G + chn]);
                    const float pv = tg > 0 ? bf2f(uc[C_V + chn - NU]) : 0.f, pg = tg > 0 ? bf2f(uc[C_G + chn - NU]) : 0.f;
                    const float v = cv + (pv - cv) * PBP(P, PB_MU)[(size_t)l * 1152 + 512 + chn], g = cg + (pg - cg) * PBP(P, PB_MU)[(size_t)l * 1152 + 768 + chn];
                    const float yn = (y[ib][r] - mean) * rstd * PBP(P, PB_LNW)[pc] + PBP(P, PB_LNB)[pc];
                    Y[(size_t)tg * D + 512 + chn] = (bf16)f2bf((yn + bs * v) * silu_f(g)); }
            }
        }
    }
    __syncthreads();
}

constexpr int NT = 512;
constexpr int LDS_BYTES = 147456, MISC_OFF = LDS_BYTES - 256;
constexpr int CW_BAR = 4096;
static_assert(XA_LDS <= MISC_OFF && S3_LDS <= MISC_OFF && RW_END <= MISC_OFF && pg8::STAGE_BYTES <= MISC_OFF, "LDS map");

__global__ void __launch_bounds__(NT, 2) mega_fwd(Params P) {
    extern __shared__ __attribute__((aligned(16))) unsigned char lds_raw[];
    LAS unsigned char* lds_base = (LAS unsigned char*)lds_raw;
    volatile LAS unsigned* MISC = (volatile LAS unsigned*)(lds_base + MISC_OFF);
    const int tid = otid(), wave = __builtin_amdgcn_readfirstlane(tid >> 6), G = gridDim.x, bx = blockIdx.x;
    if (tid < 64) MISC[tid] = 0u;
    __syncthreads();
    XcdBarrier bar = xcd_barrier_post((unsigned*)(P.ws + WS_CTL) + CW_BAR, MISC + 8);
    {
        LAS unsigned char* lds = lds_base; const int gw = bx * 8 + wave, NGW = G * 8;
        stage_blob(P, bx * NT + tid, G * NT);
        for (int it = bx; it < N_PREP_ITEMS; it += G) stage_prep_weights(P, lds, it);
        for (int m = bx; m < MEM_LEN; m += G) stage_memkv(P, lds, m);
        for (int m = gw; m < M; m += NGW) prenorm_row(P.x + (size_t)m * D, P.pre_norm_w, (bf16*)(P.ws + WS_H) + (size_t)m * D, tid & 63);
        xcd_barrier(bar);
    }
    constexpr int NPH = 1 + DEPTH * 6;
#pragma unroll 1
    for (int ph = 1; ph < NPH; ++ph) {
        Params Q; Q.ws = P.ws; Q.out = P.out; Q.x = P.x;
        asm volatile("" : "+s"(Q.ws), "+s"(Q.out), "+s"(Q.x));
        unsigned lds_a = (unsigned)(uintptr_t)lds_base; asm volatile("" : "+s"(lds_a)); LAS unsigned char* lds = (LAS unsigned char*)(uintptr_t)lds_a;
        int bx = blockIdx.x, G = gridDim.x; asm volatile("" : "+s"(bx), "+s"(G));
        const int tid = otid(), wave = __builtin_amdgcn_readfirstlane(tid >> 6), gw = bx * 8 + wave, NGW = G * 8;
        const int l = (ph - 1) / 6, sub = (ph - 1) % 6;
        if (sub == 0) {
            pg8::Gemm g{(const bf16*)(Q.ws + WS_H), (const bf16*)(Q.ws + WS_WIN) + (size_t)l * NU * D, M, NU, D};
            pg8::StaticOrder S; S.init(M, NU, G, bx);
            pg8::EpiBf16 E{(bf16*)(Q.ws + WS_U), NU};
            pg8::gemm_phase<pg8::EpiBf16, pg8::StaticOrder, true, true>(lds, g, S, E);
        } else if (sub == 1) {
            for (int it = bx; it < (M / 256) * 4; it += G) stage_xattn(Q, lds, it);
            for (int it = bx; it < NCHUNK * 2; it += G) stage_ssd_s1(Q, l, lds, it);
            for (int it = bx; it < NCHUNK * 4; it += G) stage_rwkv_p1(Q, l, lds, it);
        } else if (sub == 2) {
            if (bx < 64) stage_rwkv_compose(Q, lds, bx);
            else for (int e = (bx - 64) * NT + tid; e < 65536; e += (G - 64) * NT) stage_ssd_scan(Q, e);
        } else if (sub == 3) {
            if (bx < 64) stage_rwkv_out(Q, l, lds, bx);
            else for (int it = bx - 64; it < NCHUNK * 2; it += G - 64) stage_ssd_s3(Q, l, lds, it);
        } else if (sub == 4) {
            pg8::Gemm g{(const bf16*)(Q.ws + WS_H), (const bf16*)(Q.ws + WS_WOUT) + (size_t)l * D * D, M, D, D};
            pg8::StaticOrder S; S.init(M, D, G, bx);
            pg8::EpiF32 E{(float*)(Q.ws + WS_U), D};
            pg8::gemm_phase<pg8::EpiF32, pg8::StaticOrder, true, true>(lds, g, S, E);
        } else {
            const float* xin = l == 0 ? Q.x : Q.out;
            for (int m = gw; m < M; m += NGW)
                post_row((const float*)(Q.ws + WS_U) + (size_t)m * D, xin + (size_t)m * D, PBP(Q, PB_POSTNW) + l * D, Q.out + (size_t)m * D,
                         l + 1 < DEPTH ? PBP(Q, PB_PRENW) + (l + 1) * D : nullptr, l + 1 < DEPTH ? (bf16*)(Q.ws + WS_H) + (size_t)m * D : nullptr, tid & 63);
        }
        if (ph + 1 < NPH) { XcdBarrier b2 = bar; asm volatile("" : "+s"(b2.x), "+s"(b2.bar)); xcd_barrier(b2); }
    }
}

extern "C" void kernel_launch(void* const* d_in, const int* in_sizes, int n_in, void* d_out, int out_size, void* d_ws, size_t ws_size, hipStream_t stream) {
    static int grid = 0;
    if (grid == 0) {
        if (n_in != 24 || in_sizes[0] != M * D || out_size != M * D || ws_size < WS_END) { fprintf(stderr, "kernel_launch: unexpected shapes n_in %d in0 %d out %d ws %zu\n", n_in, n_in > 0 ? in_sizes[0] : -1, out_size, ws_size); grid = -1; return; }
        int dev = 0, cus = 0, per_cu = 0;
        if (hipGetDevice(&dev) != hipSuccess || hipDeviceGetAttribute(&cus, hipDeviceAttributeMultiprocessorCount, dev) != hipSuccess) { grid = -1; return; }
        if (hipFuncSetAttribute((const void*)mega_fwd, hipFuncAttributeMaxDynamicSharedMemorySize, LDS_BYTES) != hipSuccess) { fprintf(stderr, "kernel_launch: hipFuncSetAttribute failed\n"); grid = -1; return; }
        if (hipOccupancyMaxActiveBlocksPerMultiprocessor(&per_cu, (const void*)mega_fwd, NT, LDS_BYTES) != hipSuccess || per_cu < 1) fprintf(stderr, "kernel_launch: occupancy query says %d\n", per_cu);
        (void)hipGetLastError();
        grid = cus;
    }
    if (grid < 0) return;
    if (hipMemsetAsync((char*)d_ws + WS_CTL, 0, 1 * MiB, stream) != hipSuccess) return;
    Params P{};
    const float** pp = (const float**)&P;
    for (int i = 0; i < 24; ++i) pp[i] = (const float*)d_in[i];
    P.out = (float*)d_out; P.ws = (unsigned char*)d_ws;
    hipLaunchKernelGGL(mega_fwd, dim3(grid), dim3(NT), LDS_BYTES, stream, P);
}
```

```cpp
#include <hip/hip_runtime.h>
#include <cstdio>
#include <cstdint>

__device__ __forceinline__ int otid() { int t = threadIdx.x; asm volatile("" : "+v"(t)); return t; }
namespace pg8 {
#define PG8_LAS __attribute__((address_space(3)))
typedef unsigned short bf16_t;
typedef short bf16x8 __attribute__((ext_vector_type(8)));
typedef float f32x4 __attribute__((ext_vector_type(4)));
typedef unsigned u32x4 __attribute__((ext_vector_type(4)));
constexpr int BM = 256, BK = 64, HALF = 128, HTB = HALF * BK * 2  , STAGE_BYTES = 8 * HTB, NXCD = 8, WGM = 8;

__host__ __device__ __forceinline__ int lds_byte(int r, int c) { const int st = (r >> 4) * 2 + (c >> 5), rr = r & 15, cc = c & 31, ob = rr * 64 + cc * 2; return st * 1024 + (ob ^ (((ob >> 9) & 1) << 5)); }
__host__ __device__ __forceinline__ void stage_rc(int b, int& R, int& C) { const int st = b / 1024, sb = b % 1024, swz = sb ^ (((sb >> 9) & 1) << 5); R = (st >> 1) * 16 + swz / 64; C = (st & 1) * 32 + (swz % 64) / 2; }
__host__ __device__ __forceinline__ int perm32(int rho) { const int n = rho >> 4, i = rho & 15; return 8 * (i >> 2) + 4 * n + (i & 3); }

struct Unit { int pm, pn; };
struct Gemm { const bf16_t* A; const bf16_t* Bt; int M, N, K; };

struct StaticOrder {
    int nM, nN, nwg, G, c;
    __host__ __device__ void init(int M, int N, int G_, int c_) { nM = M / BM; nN = N / BM; nwg = nM * nN; G = G_; c = c_; }
    __host__ __device__ bool next(int i, Unit& u) const {
        const long L = (long)i * G + c; if (L >= nwg) return false;
        int wgid = (int)L; { const int q = nwg / NXCD, r = nwg % NXCD, xcd = wgid % NXCD, off = wgid / NXCD; wgid = (xcd < r ? xcd * (q + 1) : r * (q + 1) + (xcd - r) * q) + off; }
        const int nig = WGM * nN, gid = wgid / nig, fm = gid * WGM, gsz = (nM - fm) < WGM ? (nM - fm) : WGM;
        u.pm = fm + ((wgid % nig) % gsz); u.pn = (wgid % nig) / gsz; return true;
    }
    __device__ __forceinline__ void a_ready(const Unit&) const {}
    __device__ __forceinline__ void done(const Unit&) const {}
};


__device__ __forceinline__ unsigned cvt_pk_bf16(float lo, float hi) { unsigned r; asm volatile("v_cvt_pk_bf16_f32 %0, %1, %2" : "=v"(r) : "v"(lo), "v"(hi)); return r; }
struct EpiBf16 {
    static constexpr bool PERM = true, AFTER_DRAIN = false;
    bf16_t* O; int ldc;
    __device__ __forceinline__ void operator()(const f32x4 (&acc)[2][2][4][2], const Unit& u, int wr, int wc, int fr, int fq) const {
        const int row0 = u.pm * BM + wr * 64 + fr; const int col0 = u.pn * BM + wc * 32 + 8 * fq;
#pragma unroll
        for (int ai = 0; ai < 2; ++ai)
#pragma unroll
            for (int m = 0; m < 4; ++m) { bf16_t* rowp = O + (size_t)(row0 + ai * HALF + m * 16) * ldc + col0;
#pragma unroll
                for (int bj = 0; bj < 2; ++bj) { const f32x4 v0 = acc[ai][bj][m][0], v1 = acc[ai][bj][m][1];
                    u32x4 w; w.x = cvt_pk_bf16(v0[0], v0[1]); w.y = cvt_pk_bf16(v0[2], v0[3]); w.z = cvt_pk_bf16(v1[0], v1[1]); w.w = cvt_pk_bf16(v1[2], v1[3]);
                    *(u32x4*)(rowp + bj * HALF) = w; } }
    }
};
struct EpiF32 {
    static constexpr bool PERM = false, AFTER_DRAIN = false;
    float* C; int ldc;
    __device__ __forceinline__ void operator()(const f32x4 (&acc)[2][2][4][2], const Unit& u, int wr, int wc, int fr, int fq) const {
        const int row0 = u.pm * BM + wr * 64 + fr, col0 = u.pn * BM + wc * 32 + 4 * fq;
#pragma unroll
        for (int ai = 0; ai < 2; ++ai)
#pragma unroll
            for (int m = 0; m < 4; ++m) { float* rowp = C + (size_t)(row0 + ai * HALF + m * 16) * ldc + col0;
#pragma unroll
                for (int bj = 0; bj < 2; ++bj)
#pragma unroll
                    for (int n = 0; n < 2; ++n) *(f32x4*)(rowp + bj * HALF + n * 16) = acc[ai][bj][m][n]; }
    }
};

template <class Epi, class Sched, bool ALIGN_EPI = false, bool SP2 = false>
__device__ __forceinline__ void gemm_phase(PG8_LAS unsigned char* lds, const Gemm g, const Sched& S, const Epi& E) {
    const int tid = otid(), wid = __builtin_amdgcn_readfirstlane(tid >> 6), lane = tid & 63, wr = wid >> 2, wc = wid & 3, fr = lane & 15, fq = lane >> 4;
    const int K = g.K, nt = K / BK;
    unsigned voffA[2], voffB[2];
#pragma unroll
    for (int i = 0; i < 2; ++i) { int R, C; stage_rc(tid * 16 + i * 8192, R, C); const int Rb = Epi::PERM ? ((R & ~31) + perm32(R & 31)) : R;
        voffA[i] = (unsigned)(R * K + C) * 2u; voffB[i] = (unsigned)(Rb * K + C) * 2u; }
    const size_t kstep = (size_t)(BK * 2);
    const size_t hstep = (size_t)HALF * K * 2;
    const size_t tstep = 2 * hstep;
    const unsigned ldsw = (unsigned)wid * 1024u;
    const int aoff = lds_byte(wr * 64 + fr, fq * 8), boff = lds_byte(wc * 32 + fr, fq * 8);
#define PG8_SA(b, h) (((b) * 2 + (h)) * HTB)
#define PG8_SB(b, h) ((4 + (b) * 2 + (h)) * HTB)
#define PG8_STAGE(bufoff, gbase, voff) do { _Pragma("unroll") for (int _i = 0; _i < 2; ++_i) \
        __builtin_amdgcn_global_load_lds((const unsigned*)((const char*)(gbase) + (voff)[_i]), (PG8_LAS unsigned*)(lds + (bufoff) + ldsw + _i * 8192), 16, 0, 0); } while (0)
#define PG8_LDA(dst, b, h) do { _Pragma("unroll") for (int m = 0; m < 4; ++m) _Pragma("unroll") for (int k = 0; k < 2; ++k) dst[m][k] = *(const PG8_LAS bf16x8*)(lds + PG8_SA(b, h) + aoff + m * 2048 + k * 1024); } while (0)
#define PG8_LDB(dst, b, h) do { _Pragma("unroll") for (int n = 0; n < 2; ++n) _Pragma("unroll") for (int k = 0; k < 2; ++k) dst[n][k] = *(const PG8_LAS bf16x8*)(lds + PG8_SB(b, h) + boff + n * 2048 + k * 1024); } while (0)
#define PG8_MMA(ai, bj, At, Bt) do { __builtin_amdgcn_s_setprio(1); _Pragma("unroll") for (int m = 0; m < 4; ++m) _Pragma("unroll") for (int n = 0; n < 2; ++n) _Pragma("unroll") for (int k = 0; k < 2; ++k) \
        acc[ai][bj][m][n] = __builtin_amdgcn_mfma_f32_16x16x32_bf16(Bt[n][k], At[m][k], acc[ai][bj][m][n], 0, 0, 0); __builtin_amdgcn_s_setprio(0); } while (0)
#define PG8_WAIT_V(n) asm volatile("s_waitcnt vmcnt(" #n ")" ::: "memory")
#define PG8_WAIT_L(n) asm volatile("s_waitcnt lgkmcnt(" #n ")" ::: "memory")
#define PG8_BAR __builtin_amdgcn_s_barrier()
#define PG8_SCHED __builtin_amdgcn_sched_barrier(0)
    Unit cur, nxt; int ui = 0;
    if (!S.next(0, cur)) return;
    f32x4 acc[2][2][4][2];
#pragma unroll
    for (int a = 0; a < 2; ++a)
#pragma unroll
        for (int b = 0; b < 2; ++b)
#pragma unroll
            for (int m = 0; m < 4; ++m)
#pragma unroll
                for (int n = 0; n < 2; ++n) acc[a][b][m][n] = (f32x4){0.f, 0.f, 0.f, 0.f};
    bf16x8 At[4][2], B0[2][2], B1[2][2];
    const char* cA = (const char*)g.A + (size_t)cur.pm * tstep; const char* cB = (const char*)g.Bt + (size_t)cur.pn * tstep;
    S.a_ready(cur);
    if constexpr (SP2) {
        PG8_STAGE(PG8_SB(0, 0), cB, voffB); PG8_STAGE(PG8_SB(0, 1), cB + hstep, voffB); PG8_STAGE(PG8_SA(0, 0), cA, voffA); PG8_STAGE(PG8_SA(0, 1), cA + hstep, voffA);
        if (wr == 1) PG8_BAR;
        PG8_WAIT_V(2); PG8_BAR;
        PG8_STAGE(PG8_SB(1, 0), cB + kstep, voffB); PG8_STAGE(PG8_SA(1, 0), cA + kstep, voffA); PG8_STAGE(PG8_SB(1, 1), cB + hstep + kstep, voffB);
        PG8_WAIT_V(6); PG8_BAR;
    } else {
        PG8_STAGE(PG8_SB(0, 0), cB, voffB); PG8_STAGE(PG8_SA(0, 0), cA, voffA); PG8_STAGE(PG8_SB(0, 1), cB + hstep, voffB); PG8_STAGE(PG8_SA(0, 1), cA + hstep, voffA);
        if (wr == 1) PG8_BAR;
        PG8_WAIT_V(4); PG8_BAR;
        PG8_STAGE(PG8_SB(1, 0), cB + kstep, voffB); PG8_STAGE(PG8_SA(1, 0), cA + kstep, voffA); PG8_STAGE(PG8_SB(1, 1), cB + hstep + kstep, voffB);
        PG8_WAIT_V(6); PG8_BAR;
    }
    for (;;) {
        const bool has_next = S.next(ui + 1, nxt);
        const char* nA = has_next ? (const char*)g.A + (size_t)nxt.pm * tstep : cA; const char* nB = has_next ? (const char*)g.Bt + (size_t)nxt.pn * tstep : cB;
        for (int t = 0; t < nt; t += 2) {
            const bool last = (t == nt - 2);
            const char* a1 = cA + (size_t)(t + 1) * kstep;
            const char* a2 = last ? nA : cA + (size_t)(t + 2) * kstep; const char* b2 = last ? nB : cB + (size_t)(t + 2) * kstep;
            const char* a3 = a2 + kstep; const char* b3 = b2 + kstep;
            if (last && has_next) S.a_ready(nxt);
            if constexpr (SP2) {
            PG8_LDB(B0, 0, 0); PG8_LDB(B1, 0, 1); PG8_SCHED; PG8_LDA(At, 0, 0); PG8_STAGE(PG8_SA(1, 1), a1 + hstep, voffA);
            PG8_WAIT_V(8); PG8_WAIT_L(0); PG8_BAR; PG8_MMA(0, 0, At, B0); PG8_MMA(0, 1, At, B1); PG8_BAR; PG8_SCHED;
            PG8_LDA(At, 0, 1); PG8_STAGE(PG8_SB(0, 0), b2, voffB); PG8_STAGE(PG8_SB(0, 1), b2 + hstep, voffB); PG8_STAGE(PG8_SA(0, 0), a2, voffA);
            PG8_WAIT_V(8); PG8_WAIT_L(0); PG8_BAR; PG8_MMA(1, 0, At, B0); PG8_MMA(1, 1, At, B1); PG8_BAR; PG8_SCHED;
            PG8_LDB(B0, 1, 0); PG8_LDB(B1, 1, 1); PG8_SCHED; PG8_LDA(At, 1, 0); PG8_STAGE(PG8_SA(0, 1), a2 + hstep, voffA);
            PG8_WAIT_V(8); PG8_WAIT_L(0); PG8_BAR; PG8_MMA(0, 0, At, B0); PG8_MMA(0, 1, At, B1); PG8_BAR; PG8_SCHED;
            PG8_LDA(At, 1, 1); PG8_STAGE(PG8_SB(1, 0), b3, voffB); PG8_STAGE(PG8_SB(1, 1), b3 + hstep, voffB); PG8_STAGE(PG8_SA(1, 0), a3, voffA);
            PG8_WAIT_V(8); PG8_WAIT_L(0); PG8_BAR; PG8_MMA(1, 0, At, B0); PG8_MMA(1, 1, At, B1); PG8_BAR; PG8_SCHED;
            } else {
            PG8_LDB(B0, 0, 0); PG8_SCHED; PG8_LDA(At, 0, 0); PG8_STAGE(PG8_SA(1, 1), a1 + hstep, voffA);
            PG8_WAIT_L(8); PG8_BAR; PG8_WAIT_L(0); PG8_MMA(0, 0, At, B0); PG8_BAR; PG8_SCHED;
            PG8_LDB(B1, 0, 1); PG8_STAGE(PG8_SB(0, 0), b2, voffB);
            PG8_BAR; PG8_WAIT_L(0); PG8_MMA(0, 1, At, B1); PG8_BAR;
            PG8_LDA(At, 0, 1); PG8_STAGE(PG8_SA(0, 0), a2, voffA);
            PG8_BAR; PG8_WAIT_L(0); PG8_MMA(1, 0, At, B0); PG8_BAR; PG8_SCHED;
            PG8_STAGE(PG8_SB(0, 1), b2 + hstep, voffB);
            PG8_WAIT_V(6); PG8_BAR; PG8_MMA(1, 1, At, B1); PG8_BAR;
            PG8_LDB(B0, 1, 0); PG8_SCHED; PG8_LDA(At, 1, 0); PG8_STAGE(PG8_SA(0, 1), a2 + hstep, voffA);
            PG8_WAIT_L(8); PG8_BAR; PG8_WAIT_L(0); PG8_MMA(0, 0, At, B0); PG8_BAR; PG8_SCHED;
            PG8_LDB(B1, 1, 1); PG8_STAGE(PG8_SB(1, 0), b3, voffB);
            PG8_BAR; PG8_WAIT_L(0); PG8_MMA(0, 1, At, B1); PG8_BAR;
            PG8_LDA(At, 1, 1); PG8_STAGE(PG8_SA(1, 0), a3, voffA);
            PG8_BAR; PG8_WAIT_L(0); PG8_MMA(1, 0, At, B0); PG8_BAR; PG8_SCHED;
            PG8_STAGE(PG8_SB(1, 1), b3 + hstep, voffB);
            PG8_WAIT_V(6); PG8_BAR; PG8_MMA(1, 1, At, B1); PG8_BAR;
            }
        }
        if constexpr (ALIGN_EPI) { if (wr == 0) PG8_BAR; }
        if constexpr (!Epi::AFTER_DRAIN) { E(acc, cur, wr, wc, fr, fq); S.done(cur); }
        if (!has_next) break;
#pragma unroll
        for (int a = 0; a < 2; ++a)
#pragma unroll
            for (int b = 0; b < 2; ++b)
#pragma unroll
                for (int m = 0; m < 4; ++m)
#pragma unroll
                    for (int n = 0; n < 2; ++n) acc[a][b][m][n] = (f32x4){0.f, 0.f, 0.f, 0.f};
        cur = nxt; cA = nA; cB = nB; ++ui;
        if constexpr (ALIGN_EPI) { if (wr == 1) PG8_BAR; }
    }
    PG8_WAIT_V(0);
    if constexpr (!ALIGN_EPI) { if (wr == 0) PG8_BAR; }
    PG8_BAR;
    if constexpr (Epi::AFTER_DRAIN) { E.fused(acc, cur, wr, wc, fr, fq, lds, wid, lane); S.done(cur); }
#undef PG8_SA
#undef PG8_SB
#undef PG8_STAGE
#undef PG8_LDA
#undef PG8_LDB
#undef PG8_MMA
#undef PG8_WAIT_V
#undef PG8_WAIT_L
#undef PG8_BAR
#undef PG8_SCHED
}
}

constexpr int M = 16384, D = 1024, DEPTH = 4, NU = 3328, NWIN = 3208, NCHUNK = 256;
constexpr int MEM_LEN = 256;
constexpr int C_XS = 0, C_B = 512, C_C = 768, C_Z = 1024, C_R = 1536, C_K = 1792, C_V = 2048, C_G = 2304, C_WL = 2560, C_AL = 2624, C_DT = 2688, C_Q = 2816, C_GX = 3072;
constexpr float NORM_EPS = 1e-6f, LNX_EPS = 64e-5f;

#define LAS __attribute__((address_space(3)))
typedef unsigned short bf16;
typedef short bf16x8 __attribute__((ext_vector_type(8)));
typedef float f32x4 __attribute__((ext_vector_type(4)));

__device__ __forceinline__ unsigned f2bf(float f) { unsigned u = __float_as_uint(f); return (u + 0x7fffu + ((u >> 16) & 1u)) >> 16; }
__device__ __forceinline__ float bf2f(unsigned b) { return __uint_as_float(b << 16); }
__device__ __forceinline__ float us2f(short s) { return bf2f((unsigned)(unsigned short)s); }
__device__ __forceinline__ float wave_sum(float v) {
#pragma unroll
    for (int o = 1; o < 64; o <<= 1) v += __shfl_xor(v, o);
    return v;
}
__device__ __forceinline__ float silu_f(float x) { return x / (1.f + __expf(-x)); }
__device__ __forceinline__ float softplus_f(float x) { return fmaxf(x, 0.f) + log1pf(__expf(-fabsf(x))); }
__device__ __forceinline__ float sigmoid_f(float x) { return 1.f / (1.f + __expf(-x)); }

__device__ __forceinline__ bf16x8 ld_frag(const LAS bf16* base, int ld, int row0, int k0, int lane) {
    return *(const LAS bf16x8*)(base + (row0 + (lane & 15)) * ld + k0 + (lane >> 4) * 8);
}
#define MFMA16(a, b, c) __builtin_amdgcn_mfma_f32_16x16x32_bf16((a), (b), (c), 0, 0, 0)

#define XB_TMO      128
#define XB_XCNT(j)  (256  + 64 * (j))
#define XB_XSUB(j)  (1280 + 64 * (j))
#define XB_XGEN(j)  (2304 + 64 * (j))
#define XB_TOP      3328
#define XB_TOPGEN   3392
#define XCD_BAR_WORDS 3456
#define XB_SPIN_CAP (1u << 22)

__device__ __forceinline__ unsigned xb_ld(unsigned* p)              { return __hip_atomic_load(p, __ATOMIC_RELAXED, __HIP_MEMORY_SCOPE_AGENT); }
__device__ __forceinline__ unsigned xb_add(unsigned* p, unsigned v) { return __hip_atomic_fetch_add(p, v, __ATOMIC_RELAXED, __HIP_MEMORY_SCOPE_AGENT); }
__device__ __forceinline__ unsigned xb_xcc_id() { return (unsigned)__builtin_amdgcn_s_getreg((3 << 11) | 20) & 0xFu; }
#define XB_SPIN(cond, bar) do { unsigned _sp = 0; while (cond) { __builtin_amdgcn_s_sleep(1); \
    if ((++_sp & 255u) == 0u) { if (xb_ld(&(bar)[XB_TMO])) break; if (_sp > XB_SPIN_CAP) { atomicAdd(&(bar)[XB_TMO], 1u); break; } } } } while (0)

struct XcdBarrier {
    unsigned* bar; unsigned x;
    volatile LAS unsigned* st;
};

__device__ __forceinline__ XcdBarrier xcd_barrier_post(unsigned* bar, volatile LAS unsigned* st) {
    XcdBarrier b; b.bar = bar; b.x = xb_xcc_id(); b.st = st;
    if (otid() == 0) (void)xb_add(&bar[XB_XCNT(b.x)], 1u);
    return b;
}
__device__ __forceinline__ void xcd_barrier_complete(unsigned* bar, unsigned x, unsigned& nloc, unsigned& nx) {
    const unsigned G = gridDim.x * gridDim.y * gridDim.z;
    unsigned sum, cnt, mine, sp = 0u;
    for (;;) {
        sum = 0u; cnt = 0u; mine = 0u;
#pragma unroll
        for (unsigned j = 0; j < 16; ++j) { const unsigned c = xb_ld(&bar[XB_XCNT(j)]); sum += c; cnt += (c > 0u) ? 1u : 0u; }
        mine = xb_ld(&bar[XB_XCNT(x)]);
        if (sum == G) break;
        __builtin_amdgcn_s_sleep(1);
        if ((++sp & 255u) == 0u) { if (xb_ld(&bar[XB_TMO])) break; if (sp > XB_SPIN_CAP) { atomicAdd(&bar[XB_TMO], 1u); break; } }
    }
    nloc = mine > 0u ? mine : 1u; nx = cnt > 0u ? cnt : 1u;
}

__device__ __forceinline__ void xcd_barrier(const XcdBarrier& b) {
    asm volatile("s_waitcnt vmcnt(0)" ::: "memory");
    __syncthreads();
    if (otid() == 0) {
        unsigned* bar = b.bar;
        __builtin_amdgcn_s_waitcnt(0);
        unsigned nloc = b.st[0], nx = b.st[1];
        if (nloc == 0u) { xcd_barrier_complete(bar, b.x, nloc, nx); b.st[0] = nloc; b.st[1] = nx; }
        const unsigned old = xb_add(&bar[XB_XSUB(b.x)], 1u);
        const unsigned gen = old / nloc;
        if (old + 1u == (gen + 1u) * nloc) {
            __builtin_amdgcn_fence(__ATOMIC_RELEASE, "agent");
            asm volatile("s_waitcnt vmcnt(0)" ::: "memory");
            const unsigned og = xb_add(&bar[XB_TOP], 1u);
            const unsigned tg = og / nx;
            if (og + 1u == (tg + 1u) * nx) xb_add(&bar[XB_TOPGEN], 1u);
            else XB_SPIN(xb_ld(&bar[XB_TOPGEN]) == tg, bar);
            __builtin_amdgcn_fence(__ATOMIC_ACQUIRE, "agent");
            xb_add(&bar[XB_XGEN(b.x)], 1u);
            asm volatile("s_waitcnt vmcnt(0)" ::: "memory");
        } else {
            XB_SPIN(xb_ld(&bar[XB_XGEN(b.x)]) == gen, bar);
            __builtin_amdgcn_fence(__ATOMIC_ACQUIRE, "agent");
            asm volatile("s_waitcnt vmcnt(0)" ::: "memory");
        }
    }
    __syncthreads();
}


struct Params {
    const float *x, *mem, *mem_norm_w, *w_mem_kv, *pre_norm_w, *w_in, *conv_w, *conv_b, *dt_bias, *a_log, *d_skip, *ssm_norm_w,
                *shift_mu, *w0, *w2, *a0, *a2, *k_k, *k_a, *r_k, *lnx_w, *lnx_b, *w_out, *post_norm_w;
    float* out;
    unsigned char* ws;
};
constexpr size_t MiB = 1u << 20;
constexpr size_t WS_CTL = 0, WS_WIN = 1 * MiB, WS_WOUT = 27 * MiB, WS_KV = 35 * MiB, WS_H = 36 * MiB, WS_U = 68 * MiB, WS_R = 172 * MiB, WS_END = 256 * MiB;
constexpr size_t WS_ST = WS_R, WS_CD = WS_R + 32 * MiB, WS_BS = WS_CD + 65536;
constexpr size_t WS_Q1 = WS_R + 34 * MiB, WS_Y0 = WS_R + 42 * MiB, WS_PCT = WS_R + 50 * MiB, WS_GC = WS_R + 58 * MiB, WS_S0 = WS_R + 66 * MiB, WS_PGT = WS_R + 74 * MiB, WS_GG = WS_R + 75 * MiB;
static_assert(WS_GG + 64 * 8192 <= WS_END && WS_BS + (size_t)16384 * 16 <= WS_Q1, "ws map");


constexpr size_t WS_PB = 128 * 1024;
constexpr int PB_PRENW = 1024, PB_CONVW = 5120, PB_CONVB = 21504, PB_DTB = 25600, PB_ALOG = 25632, PB_DSKIP = 25664, PB_SSMNW = 25728, PB_MU = 27776, PB_W0 = 32384, PB_W2 = 33408,
              PB_A0 = 98944, PB_A2 = 99968, PB_KK = 165504, PB_KA = 166528, PB_RK = 167552, PB_LNW = 168576, PB_LNB = 169600, PB_POSTNW = 170624, PB_END = 174720;
static_assert(WS_PB + (size_t)PB_END * 4 <= 1 * MiB, "blob inside the control MiB");
#define PBP(P, off) ((const float*)((P).ws + WS_PB) + (off))
__device__ __forceinline__ int win_src_col(int n) {
    if (n < 1536) return n;
    if (n < 2560) return n + 8;
    if (n < 2816) { const int j = n - 2560; if (j < 64) return 2568 + j; if (j < 128) return 2632 + (j - 64); if (j < 136) return 1536 + (j - 128); return -1; }
    return n - 120;
}
template <bool WIN>
__device__ __forceinline__ void transpose_tile(const float* src, int src_ld, bf16* dst, int K, int n0, int k0, LAS float* scr) {
    const int tx = otid() & 63, ty = otid() >> 6;
    const int sc = WIN ? win_src_col(n0 + tx) : (n0 + tx);
#pragma unroll
    for (int kk = ty; kk < 64; kk += 8) scr[kk * 65 + tx] = sc >= 0 ? src[(size_t)(k0 + kk) * src_ld + sc] : 0.f;
    __syncthreads();
#pragma unroll
    for (int nn = ty; nn < 64; nn += 8) dst[(size_t)(n0 + nn) * K + k0 + tx] = (bf16)f2bf(scr[tx * 65 + nn]);
    __syncthreads();
}
__device__ __forceinline__ void stage_prep_weights(const Params& P, LAS unsigned char* lds, int item) {
    LAS float* scr = (LAS float*)lds;
    constexpr int T_IN = (NU / 64) * (D / 64);
    constexpr int T_OUT = (D / 64) * (D / 64);
    if (item < DEPTH * T_IN) { const int l = item / T_IN, r = item % T_IN, nb = r / 16, kb = r % 16;
        transpose_tile<true>(P.w_in + (size_t)l * D * NWIN, NWIN, (bf16*)(P.ws + WS_WIN) + (size_t)l * NU * D, D, nb * 64, kb * 64, scr); }
    else { const int it = item - DEPTH * T_IN; const int l = it / T_OUT, r = it % T_OUT, nb = r / 16, kb = r % 16;
        transpose_tile<false>(P.w_out + (size_t)l * D * D, D, (bf16*)(P.ws + WS_WOUT) + (size_t)l * D * D, D, nb * 64, kb * 64, scr); }
}
constexpr int N_PREP_ITEMS = DEPTH * ((NU / 64) * (D / 64) + (D / 64) * (D / 64));


__device__ __forceinline__ void stage_blob(const Params& P, int gtid, int gthreads) {
    float* pb = (float*)(P.ws + WS_PB);
#define CPY(src, off, n) for (int i = gtid; i < (n); i += gthreads) pb[(off) + i] = (src)[i];
    CPY(P.mem_norm_w, 0, 1024) CPY(P.pre_norm_w, PB_PRENW, 4096) CPY(P.conv_w, PB_CONVW, 16384) CPY(P.conv_b, PB_CONVB, 4096) CPY(P.dt_bias, PB_DTB, 32) CPY(P.a_log, PB_ALOG, 32) CPY(P.d_skip, PB_DSKIP, 32)
    CPY(P.ssm_norm_w, PB_SSMNW, 2048) CPY(P.shift_mu, PB_MU, 4608) CPY(P.w0, PB_W0, 1024) CPY(P.w2, PB_W2, 65536) CPY(P.a0, PB_A0, 1024) CPY(P.a2, PB_A2, 65536) CPY(P.k_k, PB_KK, 1024) CPY(P.k_a, PB_KA, 1024)
    CPY(P.r_k, PB_RK, 1024) CPY(P.lnx_w, PB_LNW, 1024) CPY(P.lnx_b, PB_LNB, 1024) CPY(P.post_norm_w, PB_POSTNW, 4096)
#undef CPY
}
__device__ __forceinline__ void stage_memkv(const Params& P, LAS unsigned char* lds, int m) {
    LAS float* xs = (LAS float*)lds; LAS float* red = xs + 1024;
    const int tid = otid();
    const float v0 = P.mem[(size_t)m * D + tid], v1 = P.mem[(size_t)m * D + 512 + tid];
    float s = wave_sum(v0 * v0 + v1 * v1);
    if ((tid & 63) == 0) red[tid >> 6] = s;
    __syncthreads();
    float tot = 0.f;
#pragma unroll
    for (int w = 0; w < 8; ++w) tot += red[w];
    const float rstd = rsqrtf(tot * (1.f / D) + NORM_EPS);
    xs[tid] = v0 * rstd * P.mem_norm_w[tid]; xs[512 + tid] = v1 * rstd * P.mem_norm_w[512 + tid];
    __syncthreads();
    float acc = 0.f;
#pragma unroll 8
    for (int k = 0; k < D; ++k) acc += xs[k] * P.w_mem_kv[(size_t)k * 512 + tid];
    ((float*)(P.ws + WS_KV))[(size_t)m * 512 + tid] = acc;
    __syncthreads();
}

__device__ __forceinline__ void prenorm_row(const float* xrow, const float* w, bf16* orow, int lane) {
    const f32x4* xr = (const f32x4*)xrow + lane; const f32x4* wr = (const f32x4*)w + lane;
    f32x4 v[4]; float s = 0.f;
#pragma unroll
    for (int j = 0; j < 4; ++j) { v[j] = xr[64 * j]; s += (v[j].x * v[j].x + v[j].y * v[j].y) + (v[j].z * v[j].z + v[j].w * v[j].w); }
    const float rstd = rsqrtf(wave_sum(s) * (1.f / D) + NORM_EPS);
    unsigned long long* o8 = (unsigned long long*)orow + lane;
#pragma unroll
    for (int j = 0; j < 4; ++j) { const f32x4 ww = wr[64 * j];
        const unsigned lo = f2bf(v[j].x * rstd * ww.x) | (f2bf(v[j].y * rstd * ww.y) << 16), hi = f2bf(v[j].z * rstd * ww.z) | (f2bf(v[j].w * rstd * ww.w) << 16);
        o8[64 * j] = (unsigned long long)lo | ((unsigned long long)hi << 32); }
}
__device__ __forceinline__ void post_row(const float* orow, const float* xin, const float* pw, float* xout, const float* nw, bf16* hrow, int lane) {
    const f32x4* orr = (const f32x4*)orow + lane; const f32x4* xr = (const f32x4*)xin + lane; const f32x4* pr = (const f32x4*)pw + lane;
    f32x4 v[4]; float s = 0.f;
#pragma unroll
    for (int j = 0; j < 4; ++j) { v[j] = orr[64 * j]; s += (v[j].x * v[j].x + v[j].y * v[j].y) + (v[j].z * v[j].z + v[j].w * v[j].w); }
    const float rstd = rsqrtf(wave_sum(s) * (1.f / D) + NORM_EPS);
    float s2 = 0.f;
#pragma unroll
    for (int j = 0; j < 4; ++j) { const f32x4 xx = xr[64 * j], pp = pr[64 * j]; v[j] = xx + v[j] * rstd * pp; s2 += (v[j].x * v[j].x + v[j].y * v[j].y) + (v[j].z * v[j].z + v[j].w * v[j].w);
        ((f32x4*)xout + lane)[64 * j] = v[j]; }
    if (hrow) {
        const float rstd2 = rsqrtf(wave_sum(s2) * (1.f / D) + NORM_EPS);
        const f32x4* wr = (const f32x4*)nw + lane; unsigned long long* o8 = (unsigned long long*)hrow + lane;
#pragma unroll
        for (int j = 0; j < 4; ++j) { const f32x4 ww = wr[64 * j];
            const unsigned lo = f2bf(v[j].x * rstd2 * ww.x) | (f2bf(v[j].y * rstd2 * ww.y) << 16), hi = f2bf(v[j].z * rstd2 * ww.z) | (f2bf(v[j].w * rstd2 * ww.w) << 16);
            o8[64 * j] = (unsigned long long)lo | ((unsigned long long)hi << 32); }
    }
}

constexpr int XA_KLD = 72, XA_VLD = 264, XA_PLD = 264;
constexpr int XA_LDS = (256 * XA_KLD + 64 * XA_VLD + 8 * 16 * XA_PLD) * 2;
__device__ __forceinline__ void stage_xattn(const Params& P, LAS unsigned char* lds, int item) {
    const int tid = otid(), lane = tid & 63, wave = tid >> 6, quad = lane >> 4, l15 = lane & 15;
    const int tile = item >> 2, h = item & 3, t0 = tile * 256;
    LAS bf16* Ks = (LAS bf16*)lds; LAS bf16* VT = Ks + 256 * XA_KLD; LAS bf16* Pw = VT + 64 * XA_VLD + wave * 16 * XA_PLD;
    const float* KV = (const float*)(P.ws + WS_KV);
    const bf16* U = (const bf16*)(P.ws + WS_U); bf16* Y = (bf16*)(P.ws + WS_H);
    for (int e = tid; e < 256 * 64; e += 512) { const int m = e >> 6, d = e & 63;
        Ks[m * XA_KLD + d] = (bf16)f2bf(KV[(size_t)m * 512 + h * 64 + d]);
        VT[d * XA_VLD + m] = (bf16)f2bf(KV[(size_t)m * 512 + 256 + h * 64 + d]); }
    __syncthreads();
    for (int rb = 0; rb < 2; ++rb) {
        const int tr = t0 + wave * 32 + rb * 16;
        bf16x8 a[2];
#pragma unroll
        for (int s = 0; s < 2; ++s) a[s] = *(const bf16x8*)(U + (size_t)(tr + l15) * NU + C_Q + h * 64 + s * 32 + quad * 8);
        f32x4 acc[16];
#pragma unroll
        for (int j = 0; j < 16; ++j) { acc[j] = (f32x4){0.f, 0.f, 0.f, 0.f};
#pragma unroll
            for (int s = 0; s < 2; ++s) acc[j] = MFMA16(a[s], ld_frag(Ks, XA_KLD, j * 16, s * 32, lane), acc[j]); }
        float mx[4], sm[4];
#pragma unroll
        for (int r = 0; r < 4; ++r) { float m_ = -3.0e38f;
#pragma unroll
            for (int j = 0; j < 16; ++j) { acc[j][r] *= 0.125f; m_ = fmaxf(m_, acc[j][r]); }
#pragma unroll
            for (int o = 1; o < 16; o <<= 1) m_ = fmaxf(m_, __shfl_xor(m_, o));
            mx[r] = m_; float s_ = 0.f;
#pragma unroll
            for (int j = 0; j < 16; ++j) { const float p = __expf(acc[j][r] - m_); s_ += p; Pw[(quad * 4 + r) * XA_PLD + j * 16 + l15] = (bf16)f2bf(p); }
#pragma unroll
            for (int o = 1; o < 16; o <<= 1) s_ += __shfl_xor(s_, o);
            sm[r] = s_; }
        __syncthreads();
        f32x4 o4[4];
#pragma unroll
        for (int jd = 0; jd < 4; ++jd) o4[jd] = (f32x4){0.f, 0.f, 0.f, 0.f};
#pragma unroll
        for (int ks = 0; ks < 8; ++ks) { const bf16x8 pa = ld_frag(Pw, XA_PLD, 0, ks * 32, lane);
#pragma unroll
            for (int jd = 0; jd < 4; ++jd) o4[jd] = MFMA16(pa, ld_frag(VT, XA_VLD, jd * 16, ks * 32, lane), o4[jd]); }
#pragma unroll
        for (int jd = 0; jd < 4; ++jd)
#pragma unroll
            for (int r = 0; r < 4; ++r) { const int t = tr + quad * 4 + r, d = jd * 16 + l15;
                const float g = bf2f(U[(size_t)t * NU + C_GX + h * 64 + d]);
                Y[(size_t)t * D + 768 + h * 64 + d] = (bf16)f2bf(o4[jd][r] / sm[r] * silu_f(g)); }
        __syncthreads();
    }
}

__device__ __forceinline__ void ssd_dt(const Params& P, int l, int c, int g, LAS float* dtS, LAS float* acS) {
    const int tid = otid();
    if (tid < 256) { const int hh = tid >> 6, q = tid & 63, h = g * 4 + hh;
        const bf16* U = (const bf16*)(P.ws + WS_U);
        const float raw = bf2f(U[(size_t)(c * 64 + q) * NU + C_DT + h]);
        const float dt = softplus_f(raw + PBP(P, PB_DTB)[l * 8 + h]);
        const float A = -__expf(PBP(P, PB_ALOG)[l * 8 + h]);
        float v = dt * A;
#pragma unroll
        for (int o = 1; o < 64; o <<= 1) { const float t = __shfl_up(v, o); if (q >= o) v += t; }
        dtS[hh * 64 + q] = dt; acS[hh * 64 + q] = v; }
}
__device__ __forceinline__ void conv8x8(const bf16* U, int ts, int col, const float* cw, const float* cb, float (&o)[8][8]) {
    bf16x8 rows[11];
#pragma unroll
    for (int i = 0; i < 11; ++i) { const int tt = ts - 3 + i; rows[i] = (bf16x8){0, 0, 0, 0, 0, 0, 0, 0}; if (tt >= 0) rows[i] = *(const bf16x8*)(U + (size_t)tt * NU + col); }
    float w[4][8], b[8];
#pragma unroll
    for (int k = 0; k < 8; ++k) { b[k] = cb[col + k];
#pragma unroll
        for (int j = 0; j < 4; ++j) w[j][k] = cw[j * 1024 + col + k]; }
#pragma unroll
    for (int tok = 0; tok < 8; ++tok)
#pragma unroll
        for (int k = 0; k < 8; ++k) {
            const float a = b[k] + w[0][k] * us2f(rows[tok][k]) + w[1][k] * us2f(rows[tok + 1][k]) + w[2][k] * us2f(rows[tok + 2][k]) + w[3][k] * us2f(rows[tok + 3][k]);
            o[tok][k] = silu_f(a); }
}
constexpr int S1_LDS = 2048 + (4 * 64 * 72 + 128 * 72) * 2;
__device__ __forceinline__ void stage_ssd_s1(const Params& P, int l, LAS unsigned char* lds, int item) {
    const int tid = otid(), lane = tid & 63, wave = tid >> 6, quad = lane >> 4, l15 = lane & 15;
    const int c = item >> 1, g = item & 1, t0 = c * 64;
    LAS float* dtS = (LAS float*)lds; LAS float* acS = dtS + 256; LAS bf16* XT = (LAS bf16*)(lds + 2048); LAS bf16* BT = XT + 4 * 64 * 72;
    const bf16* U = (const bf16*)(P.ws + WS_U);
    ssd_dt(P, l, c, g, dtS, acS);
    __syncthreads();
    if (tid < 384) {
        const int tseg = tid & 7, cg = tid >> 3; const bool isx = cg < 32;
        const int j0 = isx ? cg * 8 : (cg - 32) * 8, col = isx ? C_XS + g * 256 + j0 : C_B + g * 128 + j0;
        float o[8][8];
        conv8x8(U, t0 + tseg * 8, col, PBP(P, PB_CONVW) + (size_t)l * 4 * 1024, PBP(P, PB_CONVB) + l * 1024, o);
        const int hh = j0 >> 6, p0 = j0 & 63;
        float sc[8];
#pragma unroll
        for (int tok = 0; tok < 8; ++tok) { const int q = tseg * 8 + tok; sc[tok] = isx ? dtS[hh * 64 + q] * __expf(acS[hh * 64 + 63] - acS[hh * 64 + q]) : 1.f; }
        LAS bf16* dst = isx ? XT + (hh * 64 + p0) * 72 + tseg * 8 : BT + j0 * 72 + tseg * 8;
#pragma unroll
        for (int k = 0; k < 8; ++k) { bf16x8 v;
#pragma unroll
            for (int tok = 0; tok < 8; ++tok) v[tok] = (short)f2bf(o[tok][k] * sc[tok]);
            *(LAS bf16x8*)(dst + k * 72) = v; }
    }
    __syncthreads();
    { const int hh = wave >> 1, nh = wave & 1, h = g * 4 + hh;
        bf16* ST = (bf16*)(P.ws + WS_ST) + ((size_t)(c * 8 + h) * 64) * 128;
#pragma unroll
        for (int pb = 0; pb < 4; ++pb)
#pragma unroll
            for (int nb = 0; nb < 4; ++nb) { f32x4 acc = (f32x4){0.f, 0.f, 0.f, 0.f};
#pragma unroll
                for (int ks = 0; ks < 2; ++ks) acc = MFMA16(ld_frag(XT + hh * 64 * 72, 72, pb * 16, ks * 32, lane), ld_frag(BT, 72, nh * 64 + nb * 16, ks * 32, lane), acc);
#pragma unroll
                for (int r = 0; r < 4; ++r) ST[(size_t)(pb * 16 + quad * 4 + r) * 128 + nh * 64 + nb * 16 + l15] = (bf16)f2bf(acc[r]); }
        if (tid < 4) ((float*)(P.ws + WS_CD))[c * 8 + g * 4 + tid] = __expf(acS[tid * 64 + 63]);
    }
    __syncthreads();
}
__device__ __forceinline__ void stage_ssd_scan(const Params& P, LAS unsigned char* lds, int blk) {
    const int tid = otid(), pi = tid & 63, seg = tid >> 6;
    LAS float* cdS = (LAS float*)lds; LAS float* segL = cdS + 256; LAS float* segD = segL + 8 * 128;
    bf16* ST = (bf16*)(P.ws + WS_ST); const float* CD = (const float*)(P.ws + WS_CD);
    const int e0 = blk * 128 + pi * 2, h = (blk * 128) >> 13;
    if (tid < 256) cdS[tid] = CD[tid * 8 + h];
    unsigned v[32];
#pragma unroll
    for (int k = 0; k < 32; ++k) v[k] = *(const unsigned*)(ST + (size_t)(seg * 32 + k) * 65536 + e0);
    __syncthreads();
    float L0 = 0.f, L1 = 0.f, Dt = 1.f;
#pragma unroll
    for (int k = 0; k < 32; ++k) { const float d = cdS[seg * 32 + k]; L0 = L0 * d + bf2f(v[k] & 0xffffu); L1 = L1 * d + bf2f(v[k] >> 16); Dt *= d; }
    segL[seg * 128 + pi * 2] = L0; segL[seg * 128 + pi * 2 + 1] = L1; if (pi == 0) segD[seg] = Dt;
    __syncthreads();
    float c0 = 0.f, c1 = 0.f;
    for (int s2 = 0; s2 < seg; ++s2) { const float d = segD[s2]; c0 = c0 * d + segL[s2 * 128 + pi * 2]; c1 = c1 * d + segL[s2 * 128 + pi * 2 + 1]; }
#pragma unroll
    for (int k = 0; k < 32; ++k) { const float d = cdS[seg * 32 + k]; const unsigned o = f2bf(c0) | (f2bf(c1) << 16);
        c0 = c0 * d + bf2f(v[k] & 0xffffu); c1 = c1 * d + bf2f(v[k] >> 16);
        *(unsigned*)(ST + (size_t)(seg * 32 + k) * 65536 + e0) = o; }
    __syncthreads();
}
constexpr int S3_LDS = 3072 + (2 * 64 * 136 + 4 * 64 * 72 + 8 * 32 * 72) * 2;
__device__ __forceinline__ void stage_ssd_s3(const Params& P, int l, LAS unsigned char* lds, int item) {
    const int tid = otid(), lane = tid & 63, wave = tid >> 6, quad = lane >> 4, l15 = lane & 15;
    const int c = item >> 1, g = item & 1, t0 = c * 64;
    LAS float* dtS = (LAS float*)lds; LAS float* acS = dtS + 256; LAS float* red = acS + 256;
    LAS bf16* Cn = (LAS bf16*)(lds + 3072); LAS bf16* Bn = Cn + 64 * 136; LAS bf16* XT = Bn + 64 * 136; LAS bf16* SCw = XT + 4 * 64 * 72 + wave * 32 * 72;
    const bf16* U = (const bf16*)(P.ws + WS_U); bf16* Y = (bf16*)(P.ws + WS_H);
    ssd_dt(P, l, c, g, dtS, acS);
    __syncthreads();
    {
        const int tseg = tid & 7, cg = tid >> 3; const int kind = cg < 32 ? 0 : (cg < 48 ? 1 : 2);
        const int j0 = kind == 0 ? cg * 8 : (kind == 1 ? (cg - 32) * 8 : (cg - 48) * 8);
        const int col = kind == 0 ? C_XS + g * 256 + j0 : (kind == 1 ? C_B + g * 128 + j0 : C_C + g * 128 + j0);
        float o[8][8];
        conv8x8(U, t0 + tseg * 8, col, PBP(P, PB_CONVW) + (size_t)l * 4 * 1024, PBP(P, PB_CONVB) + l * 1024, o);
        if (kind == 0) { const int hh2 = j0 >> 6, p0 = j0 & 63;
#pragma unroll
            for (int k = 0; k < 8; ++k) { bf16x8 v;
#pragma unroll
                for (int tok = 0; tok < 8; ++tok) v[tok] = (short)f2bf(o[tok][k] * dtS[hh2 * 64 + tseg * 8 + tok]);
                *(LAS bf16x8*)(XT + (hh2 * 64 + p0 + k) * 72 + tseg * 8) = v; }
        } else { LAS bf16* dst = (kind == 1 ? Bn : Cn) + (tseg * 8) * 136 + j0;
#pragma unroll
            for (int tok = 0; tok < 8; ++tok) { bf16x8 v;
#pragma unroll
                for (int k = 0; k < 8; ++k) v[k] = (short)f2bf(o[tok][k]);
                *(LAS bf16x8*)(dst + tok * 136) = v; } }
    }
    __syncthreads();
    const int hh = wave >> 1, qh = wave & 1, h = g * 4 + hh;
#pragma unroll
    for (int qb = 0; qb < 2; ++qb)
#pragma unroll
        for (int sb = 0; sb < 4; ++sb) { f32x4 acc = (f32x4){0.f, 0.f, 0.f, 0.f};
#pragma unroll
            for (int ks = 0; ks < 4; ++ks) acc = MFMA16(ld_frag(Cn, 136, qh * 32 + qb * 16, ks * 32, lane), ld_frag(Bn, 136, sb * 16, ks * 32, lane), acc);
#pragma unroll
            for (int r = 0; r < 4; ++r) { const int q = qh * 32 + qb * 16 + quad * 4 + r, s = sb * 16 + l15;
                const float v = (s <= q) ? acc[r] * __expf(acS[hh * 64 + q] - acS[hh * 64 + s]) : 0.f;
                SCw[(qb * 16 + quad * 4 + r) * 72 + s] = (bf16)f2bf(v); } }
    __syncthreads();
    f32x4 y[2][4];
    const bf16* ST = (const bf16*)(P.ws + WS_ST) + ((size_t)(c * 8 + h) * 64) * 128;
#pragma unroll
    for (int qb = 0; qb < 2; ++qb)
#pragma unroll
        for (int pb = 0; pb < 4; ++pb) { f32x4 yd = (f32x4){0.f, 0.f, 0.f, 0.f}, yo = (f32x4){0.f, 0.f, 0.f, 0.f};
#pragma unroll
            for (int ks = 0; ks < 2; ++ks) yd = MFMA16(ld_frag(SCw, 72, qb * 16, ks * 32, lane), ld_frag(XT + hh * 64 * 72, 72, pb * 16, ks * 32, lane), yd);
#pragma unroll
            for (int ks = 0; ks < 4; ++ks) yo = MFMA16(ld_frag(Cn, 136, qh * 32 + qb * 16, ks * 32, lane), *(const bf16x8*)(ST + (size_t)(pb * 16 + l15) * 128 + ks * 32 + quad * 8), yo);
#pragma unroll
            for (int r = 0; r < 4; ++r) { const int q = qh * 32 + qb * 16 + quad * 4 + r, p = pb * 16 + l15;
                const float xs = bf2f(XT[(hh * 64 + p) * 72 + q]) / dtS[hh * 64 + q];
                float v = yd[r] + __expf(acS[hh * 64 + q]) * yo[r] + PBP(P, PB_DSKIP)[l * 8 + h] * xs;
                const float z = bf2f(U[(size_t)(t0 + q) * NU + C_Z + h * 64 + p]);
                y[qb][pb][r] = v * silu_f(z); } }
#pragma unroll
    for (int qb = 0; qb < 2; ++qb)
#pragma unroll
        for (int r = 0; r < 4; ++r) { float s = 0.f;
#pragma unroll
            for (int pb = 0; pb < 4; ++pb) s += y[qb][pb][r] * y[qb][pb][r];
#pragma unroll
            for (int o = 1; o < 16; o <<= 1) s += __shfl_xor(s, o);
            if (l15 == 0) red[hh * 64 + qh * 32 + qb * 16 + quad * 4 + r] = s; }
    __syncthreads();
#pragma unroll
    for (int qb = 0; qb < 2; ++qb)
#pragma unroll
        for (int r = 0; r < 4; ++r) { const int q = qh * 32 + qb * 16 + quad * 4 + r;
            const float tot = red[q] + red[64 + q] + red[128 + q] + red[192 + q]; const float rstd = rsqrtf(tot * (1.f / 256.f) + NORM_EPS);
#pragma unroll
            for (int pb = 0; pb < 4; ++pb) { const int p = pb * 16 + l15;
                Y[(size_t)(t0 + q) * D + h * 64 + p] = (bf16)f2bf(y[qb][pb][r] * rstd * PBP(P, PB_SSMNW)[l * 512 + h * 64 + p]); } }
    __syncthreads();
}

constexpr int RW_AT = 0, RW_RT = 9216, RW_KT = 18432, RW_BT = 27648, RW_VT = 36864, RW_KHT = 46080, RW_BHT = 55296, RW_X1T = 64512, RW_X2T = 73728,
              RW_MAK = 82944, RW_MRK = 92160, RW_MRB = 101376, RW_MAB = 110592, RW_TOT = 128000, RW_WC = 130048, RW_AAF = 130304, RW_END = 146688;
constexpr int RW_RHS2 = RW_KT;
constexpr int RW_LATW = RW_X1T, RW_LATA = RW_X2T, RW_W2T = RW_MAK, RW_A2T = RW_MRK, RW_AWF = RW_MAB;
constexpr int RW_MOFF = RW_AAF, RW_TB = RW_AAF + 9216, RW_RPT = RW_MAK;
__device__ __forceinline__ float tanh_f(float x) { return 1.f - 2.f / (1.f + __expf(2.f * x)); }
typedef unsigned u32x2 __attribute__((ext_vector_type(2)));
typedef unsigned u32x4v __attribute__((ext_vector_type(4)));
__device__ __forceinline__ u32x2 pack4(float a, float b, float c, float d) { u32x2 o; o.x = f2bf(a) | (f2bf(b) << 16); o.y = f2bf(c) | (f2bf(d) << 16); return o; }

__device__ __forceinline__ void stage_rwkv_p1(const Params& P, int l, LAS unsigned char* lds, int pi) {
    const int tid = otid(), lane = tid & 63, wave = __builtin_amdgcn_readfirstlane(tid >> 6), quad = lane >> 4, l15 = lane & 15;
    const int c = pi >> 2, h = pi & 3, t0 = c * 64;
    LAS bf16* At = (LAS bf16*)(lds + RW_AT); LAS bf16* Rt = (LAS bf16*)(lds + RW_RT); LAS bf16* Kt = (LAS bf16*)(lds + RW_KT); LAS bf16* Bt = (LAS bf16*)(lds + RW_BT);
    LAS bf16* VT = (LAS bf16*)(lds + RW_VT); LAS bf16* KhT = (LAS bf16*)(lds + RW_KHT); LAS bf16* BhT = (LAS bf16*)(lds + RW_BHT);
    LAS bf16* X1T = (LAS bf16*)(lds + RW_X1T); LAS bf16* X2T = (LAS bf16*)(lds + RW_X2T);
    LAS bf16* Mak = (LAS bf16*)(lds + RW_MAK); LAS bf16* Mrk = (LAS bf16*)(lds + RW_MRK); LAS bf16* Mrb = (LAS bf16*)(lds + RW_MRB);
    LAS float* Mab = (LAS float*)(lds + RW_MAB); LAS float* RHS2 = (LAS float*)(lds + RW_RHS2);
    LAS float* tot = (LAS float*)(lds + RW_TOT); LAS float* wCs = (LAS float*)(lds + RW_WC); LAS float* aaF = (LAS float*)(lds + RW_AAF); LAS float* awF = (LAS float*)(lds + RW_AWF);
    LAS bf16* latw = (LAS bf16*)(lds + RW_LATW); LAS bf16* lata = (LAS bf16*)(lds + RW_LATA); LAS bf16* w2T = (LAS bf16*)(lds + RW_W2T); LAS bf16* a2T = (LAS bf16*)(lds + RW_A2T);
    LAS bf16* Moff = (LAS bf16*)(lds + RW_MOFF); LAS bf16* Tb = (LAS bf16*)(lds + RW_TB);
    const bf16* U = (const bf16*)(P.ws + WS_U);
    const float* mu = PBP(P, PB_MU) + (size_t)l * 1152;
    {   const int t = tid >> 3, jg = tid & 7, tg = t0 + t;
        const bf16* uc = U + (size_t)tg * NU + C_WL + jg * 8;
        const bf16x8 cw = *(const bf16x8*)uc, ca = *(const bf16x8*)(uc + 64);
        bf16x8 pw = (bf16x8){0, 0, 0, 0, 0, 0, 0, 0}, pa = pw;
        if (tg > 0) { pw = *(const bf16x8*)(uc - NU); pa = *(const bf16x8*)(uc - NU + 64); }
        bf16x8 ow, oa, w2v, a2v;
#pragma unroll
        for (int jj = 0; jj < 8; ++jj) { const int j = jg * 8 + jj;
            const float cv = us2f(cw[jj]), pv = us2f(pw[jj]); ow[jj] = (short)f2bf(tanh_f(cv + (pv - cv) * mu[1024 + j]));
            const float cv2 = us2f(ca[jj]), pv2 = us2f(pa[jj]); oa[jj] = (short)f2bf(cv2 + (pv2 - cv2) * mu[1088 + j]);
            w2v[jj] = (short)f2bf(PBP(P, PB_W2)[((size_t)l * 64 + j) * 256 + h * 64 + t]); a2v[jj] = (short)f2bf(PBP(P, PB_A2)[((size_t)l * 64 + j) * 256 + h * 64 + t]); }
        *(LAS bf16x8*)(latw + t * 72 + jg * 8) = ow; *(LAS bf16x8*)(lata + t * 72 + jg * 8) = oa;
        *(LAS bf16x8*)(w2T + t * 72 + jg * 8) = w2v; *(LAS bf16x8*)(a2T + t * 72 + jg * 8) = a2v;
    }
    __syncthreads();
    {   const int tb = wave & 3; const bool isA = wave >= 4;
        const LAS bf16* Am = isA ? lata : latw; const LAS bf16* Bm = isA ? a2T : w2T; LAS float* Of = isA ? aaF : awF; const int ofs = isA ? 64 : 68;
#pragma unroll
        for (int cb = 0; cb < 4; ++cb) { f32x4 acc = (f32x4){0.f, 0.f, 0.f, 0.f};
#pragma unroll
            for (int ks = 0; ks < 2; ++ks) acc = MFMA16(ld_frag(Am, 72, tb * 16, ks * 32, lane), ld_frag(Bm, 72, cb * 16, ks * 32, lane), acc);
#pragma unroll
            for (int r = 0; r < 4; ++r) Of[(tb * 16 + quad * 4 + r) * ofs + cb * 16 + l15] = acc[r]; }
    }
    __syncthreads();
    {   const int t = tid >> 3, cg = tid & 7, tg = t0 + t, ch0 = cg * 8, gch = h * 64 + ch0;
        const bf16* uc = U + (size_t)tg * NU + gch;
        const bf16x8 cr = *(const bf16x8*)(uc + C_R), ck = *(const bf16x8*)(uc + C_K), cv = *(const bf16x8*)(uc + C_V);
        bf16x8 pr = (bf16x8){0, 0, 0, 0, 0, 0, 0, 0}, pk = pr, pv = pr;
        if (tg > 0) { pr = *(const bf16x8*)(uc - NU + C_R); pk = *(const bf16x8*)(uc - NU + C_K); pv = *(const bf16x8*)(uc - NU + C_V); }
        float rr[8], k2[8], vv[8], kkn[8], aS[8], lw[8], Lc[8];
        float ss = 0.f, bsum = 0.f;
#pragma unroll
        for (int jj = 0; jj < 8; ++jj) { const int gc = gch + jj, pc = l * 256 + gc;
            float a_ = us2f(cr[jj]), b_ = us2f(pr[jj]); const float r = a_ + (b_ - a_) * mu[gc];
            a_ = us2f(ck[jj]); b_ = us2f(pk[jj]); const float k = a_ + (b_ - a_) * mu[256 + gc];
            a_ = us2f(cv[jj]); b_ = us2f(pv[jj]); const float v = a_ + (b_ - a_) * mu[512 + gc];
            const float aw = awF[t * 68 + ch0 + jj] + PBP(P, PB_W0)[pc], aa = aaF[t * 64 + ch0 + jj] + PBP(P, PB_A0)[pc];
            lw[jj] = -0.60653066f * sigmoid_f(aw); const float a = sigmoid_f(aa);
            const float kr = k * PBP(P, PB_KK)[pc]; ss += kr * kr; kkn[jj] = kr;
            k2[jj] = k * (1.f + (a - 1.f) * PBP(P, PB_KA)[pc]); aS[jj] = a; rr[jj] = r; vv[jj] = v;
            bsum += r * k2[jj] * PBP(P, PB_RK)[pc]; Lc[jj] = lw[jj]; }
#pragma unroll
        for (int o = 1; o < 8; o <<= 1) { ss += __shfl_xor(ss, o); bsum += __shfl_xor(bsum, o); }
        const float inv = 1.f / fmaxf(sqrtf(ss), 1e-12f);
        if (cg == 0) ((float*)(P.ws + WS_BS))[(size_t)tg * 4 + h] = bsum;
#pragma unroll
        for (int o = 8; o < 64; o <<= 1)
#pragma unroll
            for (int jj = 0; jj < 8; ++jj) { const float tmp = __shfl_up(Lc[jj], o); if (lane >= o) Lc[jj] += tmp; }
        if ((lane >> 3) == 7) {
#pragma unroll
            for (int jj = 0; jj < 8; ++jj) tot[wave * 64 + ch0 + jj] = Lc[jj]; }
        __syncthreads();
        bf16x8 oA, oR, oK, oB;
#pragma unroll
        for (int jj = 0; jj < 8; ++jj) { float base = 0.f, LC = 0.f;
#pragma unroll
            for (int w2 = 0; w2 < 8; ++w2) { const float tv = tot[w2 * 64 + ch0 + jj]; base += w2 < wave ? tv : 0.f; LC += tv; }
            const float L = Lc[jj] + base; const float kk = kkn[jj] * inv, b = kk * aS[jj];
            const float eL = __expf(L), eiL = __expf(-L), eh = __expf(LC - L);
            oA[jj] = (short)f2bf(-kk * __expf(L - lw[jj])); oR[jj] = (short)f2bf(rr[jj] * eL); oK[jj] = (short)f2bf(k2[jj] * eiL); oB[jj] = (short)f2bf(b * eiL);
            VT[(ch0 + jj) * 72 + t] = (bf16)f2bf(vv[jj]); KhT[(ch0 + jj) * 72 + t] = (bf16)f2bf(k2[jj] * eh); BhT[(ch0 + jj) * 72 + t] = (bf16)f2bf(b * eh);
            if (t == 63) wCs[ch0 + jj] = __expf(LC); }
        *(LAS bf16x8*)(At + t * 72 + ch0) = oA; *(LAS bf16x8*)(Rt + t * 72 + ch0) = oR; *(LAS bf16x8*)(Kt + t * 72 + ch0) = oK; *(LAS bf16x8*)(Bt + t * 72 + ch0) = oB;
    }
    __syncthreads();
    {   const int mat = wave >> 1, half = wave & 1;
        const LAS bf16* Am = mat < 2 ? At : Rt; const LAS bf16* Bm = (mat == 0 || mat == 3) ? Bt : Kt;
        LAS bf16* Ob = mat == 1 ? Mak : (mat == 2 ? Mrk : Mrb);
#pragma unroll
        for (int tbi = 0; tbi < 2; ++tbi)
#pragma unroll
            for (int sb = 0; sb < 4; ++sb) { const int tb = half * 2 + tbi; f32x4 acc = (f32x4){0.f, 0.f, 0.f, 0.f};
                if (sb <= tb) {
#pragma unroll
                    for (int ks = 0; ks < 2; ++ks) acc = MFMA16(ld_frag(Am, 72, tb * 16, ks * 32, lane), ld_frag(Bm, 72, sb * 16, ks * 32, lane), acc); }
#pragma unroll
                for (int r = 0; r < 4; ++r) { const int t = tb * 16 + quad * 4 + r, s_ = sb * 16 + l15;
                    const bool keep = mat < 2 ? (s_ < t) : (s_ <= t); const float val = keep ? acc[r] : 0.f;
                    if (mat == 0) { Mab[t * 68 + s_] = val; Moff[t * 72 + s_] = (bf16)(sb < tb ? f2bf(val) : 0u); } else Ob[t * 72 + s_] = (bf16)f2bf(val); } }
    }
    __syncthreads();
    if (wave == 0) {
        for (int e = lane; e < 320; e += 64) *(LAS u32x4v*)(Tb + e * 8) = (u32x4v){0u, 0u, 0u, 0u};
        const int b = quad, cc = l15;
        unsigned ma = (unsigned)(uintptr_t)(Mab + (16 * b) * 68 + 16 * b); asm volatile("" : "+v"(ma)); const LAS float* Mv = (const LAS float*)(uintptr_t)ma;
        float x[16];
#pragma unroll
        for (int t = 0; t < 16; ++t) { float a = t == cc ? 1.f : 0.f;
#pragma unroll
            for (int s_ = 0; s_ < t; ++s_) a += Mv[t * 68 + s_] * x[s_];
            asm volatile("" : "+v"(a) :: "memory");
            x[t] = a; }
#pragma unroll
        for (int t = 0; t < 16; ++t) Tb[(b * 16 + t) * 40 + cc] = (bf16)f2bf(x[t]);
    } else {
        for (int tile = wave - 1; tile < 16; tile += 7) { const int tb = tile >> 2, ib = tile & 3; f32x4 acc = (f32x4){0.f, 0.f, 0.f, 0.f};
#pragma unroll
            for (int ks = 0; ks < 2; ++ks) acc = MFMA16(ld_frag(Mak, 72, tb * 16, ks * 32, lane), ld_frag(VT, 72, ib * 16, ks * 32, lane), acc);
#pragma unroll
            for (int r = 0; r < 4; ++r) RHS2[(tb * 16 + quad * 4 + r) * 68 + ib * 16 + l15] = acc[r]; }
    }
    __syncthreads();
    {   LAS bf16* XTw = (wave < 4 ? X1T : X2T) + (wave & 3) * 16 * 72; LAS bf16* Rp = (LAS bf16*)(lds + RW_RPT) + wave * 512;
        for (int e = lane; e < 144; e += 64) *(LAS u32x4v*)(XTw + e * 8) = (u32x4v){0u, 0u, 0u, 0u};
        *(LAS u32x4v*)(Rp + lane * 8) = (u32x4v){0u, 0u, 0u, 0u};
#pragma unroll
        for (int b = 0; b < 4; ++b) {
            f32x4 acc;
#pragma unroll
            for (int r = 0; r < 4; ++r) { const int t = 16 * b + quad * 4 + r; acc[r] = wave < 4 ? bf2f(At[t * 72 + wave * 16 + l15]) : RHS2[t * 68 + (wave - 4) * 16 + l15]; }
            asm volatile("s_waitcnt lgkmcnt(0)" ::: "memory");
            if (b >= 1) acc = MFMA16(ld_frag(Moff, 72, 16 * b, 0, lane), ld_frag(XTw, 72, 0, 0, lane), acc);
            if (b == 3) acc = MFMA16(ld_frag(Moff, 72, 48, 32, lane), ld_frag(XTw, 72, 0, 32, lane), acc);
            *(LAS u32x2*)(Rp + l15 * 32 + quad * 4) = pack4(acc[0], acc[1], acc[2], acc[3]);
            asm volatile("s_waitcnt lgkmcnt(0)" ::: "memory");
            const f32x4 xb = MFMA16(ld_frag(Tb + b * 640, 40, 0, 0, lane), ld_frag(Rp, 32, 0, 0, lane), ((f32x4){0.f, 0.f, 0.f, 0.f}));
            *(LAS u32x2*)(XTw + l15 * 72 + 16 * b + quad * 4) = pack4(xb[0], xb[1], xb[2], xb[3]);
            asm volatile("s_waitcnt lgkmcnt(0)" ::: "memory");
        }
    }
    __syncthreads();
    {   const int mat = wave >> 1, half = wave & 1;
        bf16* Q1g = (bf16*)(P.ws + WS_Q1) + (size_t)pi * 4096; bf16* Y0g = (bf16*)(P.ws + WS_Y0) + (size_t)pi * 4096;
        bf16* PcTg = (bf16*)(P.ws + WS_PCT) + (size_t)pi * 4096; bf16* Gcg = (bf16*)(P.ws + WS_GC) + (size_t)pi * 4096;
        const LAS bf16* A1 = (mat == 0 || mat == 2) ? X1T : (mat == 1 ? VT : KhT);
        const LAS bf16* B1 = mat == 0 ? Mrb : (mat == 1 ? Mrk : (mat == 2 ? BhT : VT));
        const LAS bf16* A2 = mat == 1 ? X2T : BhT; const LAS bf16* B2 = mat == 1 ? Mrb : X2T;
#pragma unroll
        for (int rbi = 0; rbi < 2; ++rbi)
#pragma unroll
            for (int cb = 0; cb < 4; ++cb) { const int rb = half * 2 + rbi; f32x4 acc = (f32x4){0.f, 0.f, 0.f, 0.f};
#pragma unroll
                for (int ks = 0; ks < 2; ++ks) acc = MFMA16(ld_frag(A1, 72, rb * 16, ks * 32, lane), ld_frag(B1, 72, cb * 16, ks * 32, lane), acc);
                if (mat == 1 || mat == 3) {
#pragma unroll
                    for (int ks = 0; ks < 2; ++ks) acc = MFMA16(ld_frag(A2, 72, rb * 16, ks * 32, lane), ld_frag(B2, 72, cb * 16, ks * 32, lane), acc); }
                const int r0 = rb * 16 + quad * 4, cl = cb * 16 + l15;
                if (mat == 0) { const u32x2 rt = *(const LAS u32x2*)(Rt + cl * 72 + r0);
                    *(u32x2*)(Q1g + cl * 64 + r0) = pack4(acc[0] + bf2f(rt.x & 0xffffu), acc[1] + bf2f(rt.x >> 16), acc[2] + bf2f(rt.y & 0xffffu), acc[3] + bf2f(rt.y >> 16)); }
                else if (mat == 1) *(u32x2*)(Y0g + cl * 64 + r0) = pack4(acc[0], acc[1], acc[2], acc[3]);
                else if (mat == 2) { const float wc = wCs[cl];
                    *(u32x2*)(PcTg + cl * 64 + r0) = pack4(acc[0] + (r0 == cl ? wc : 0.f), acc[1] + (r0 + 1 == cl ? wc : 0.f), acc[2] + (r0 + 2 == cl ? wc : 0.f), acc[3] + (r0 + 3 == cl ? wc : 0.f)); }
                else *(u32x2*)(Gcg + ((cb * 64 + lane) * 4 + rb) * 4) = pack4(acc[0], acc[1], acc[2], acc[3]); }
    }
    __syncthreads();
}

constexpr int CH_PT = 0, CH_SB = 8 * 9216, CH_END = CH_SB + 8 * 2304;
__device__ __forceinline__ void chain_step(f32x4 (&acc)[4], const LAS bf16* PTs, LAS bf16* Sb, const u32x4v (&gf)[2], bool withG, int lane) {
    const int quad = lane >> 4, l15 = lane & 15;
#pragma unroll
    for (int jb = 0; jb < 4; ++jb) *(LAS u32x2*)(Sb + l15 * 72 + jb * 16 + quad * 4) = pack4(acc[jb][0], acc[jb][1], acc[jb][2], acc[jb][3]);
    asm volatile("s_waitcnt lgkmcnt(0)" ::: "memory");
    const bf16x8 b0 = ld_frag(Sb, 72, 0, 0, lane), b1 = ld_frag(Sb, 72, 0, 32, lane);
#pragma unroll
    for (int jb = 0; jb < 4; ++jb) { f32x4 n = (f32x4){0.f, 0.f, 0.f, 0.f};
        if (withG) { const unsigned g0 = gf[jb >> 1][(jb & 1) * 2], g1 = gf[jb >> 1][(jb & 1) * 2 + 1]; n = (f32x4){bf2f(g0 & 0xffffu), bf2f(g0 >> 16), bf2f(g1 & 0xffffu), bf2f(g1 >> 16)}; }
        n = MFMA16(ld_frag(PTs, 72, jb * 16, 0, lane), b0, n); n = MFMA16(ld_frag(PTs, 72, jb * 16, 32, lane), b1, n);
        acc[jb] = n; }
    asm volatile("s_waitcnt lgkmcnt(0)" ::: "memory");
}

__device__ __forceinline__ void stage_rwkv_compose(const Params& P, LAS unsigned char* lds, int task) {
    const int tid = otid(), lane = tid & 63, wave = __builtin_amdgcn_readfirstlane(tid >> 6), quad = lane >> 4, l15 = lane & 15;
    const int gI = task >> 2, h = task & 3, kind = wave >> 2, rb = wave & 3;
    LAS bf16* PTs = (LAS bf16*)(lds + CH_PT); LAS bf16* Sb = (LAS bf16*)(lds + CH_SB) + wave * 16 * 72;
    f32x4 acc[4];
#pragma unroll
    for (int jb = 0; jb < 4; ++jb)
#pragma unroll
        for (int r = 0; r < 4; ++r) acc[jb][r] = (kind == 0 && (jb * 16 + quad * 4 + r) == (rb * 16 + l15)) ? 1.f : 0.f;
    for (int bt = 0; bt < 2; ++bt) {
        const size_t pi0 = (size_t)((gI * 16 + bt * 8) * 4 + h);
        u32x4v pt[8], gf[8][2];
#pragma unroll
        for (int s_ = 0; s_ < 8; ++s_) { pt[s_] = *(const u32x4v*)((const bf16*)(P.ws + WS_PCT) + (pi0 + 4 * s_) * 4096 + tid * 8);
            gf[s_][0] = (u32x4v){0u, 0u, 0u, 0u}; gf[s_][1] = gf[s_][0];
            if (kind == 1) { const bf16* gp = (const bf16*)(P.ws + WS_GC) + (pi0 + 4 * s_) * 4096 + (rb * 64 + lane) * 16; gf[s_][0] = *(const u32x4v*)gp; gf[s_][1] = *(const u32x4v*)(gp + 8); } }
        __syncthreads();
#pragma unroll
        for (int s_ = 0; s_ < 8; ++s_) *(LAS u32x4v*)(PTs + s_ * 4608 + (tid >> 3) * 72 + (tid & 7) * 8) = pt[s_];
        __syncthreads();
#pragma unroll
        for (int s_ = 0; s_ < 8; ++s_) chain_step(acc, PTs + s_ * 4608, Sb, gf[s_], kind == 1, lane);
    }
    if (kind == 0) { bf16* PgTg = (bf16*)(P.ws + WS_PGT) + (size_t)task * 4096;
#pragma unroll
        for (int jb = 0; jb < 4; ++jb)
#pragma unroll
            for (int r = 0; r < 4; ++r) PgTg[(jb * 16 + quad * 4 + r) * 64 + rb * 16 + l15] = (bf16)f2bf(acc[jb][r]);
    } else { bf16* Ggg = (bf16*)(P.ws + WS_GG) + (size_t)task * 4096;
#pragma unroll
        for (int jb = 0; jb < 4; ++jb) *(u32x2*)(Ggg + ((rb * 64 + lane) * 4 + jb) * 4) = pack4(acc[jb][0], acc[jb][1], acc[jb][2], acc[jb][3]); }
    __syncthreads();
}

__device__ __forceinline__ void stage_rwkv_chain(const Params& P, LAS unsigned char* lds, int task) {
    const int tid = otid(), lane = tid & 63, wave = __builtin_amdgcn_readfirstlane(tid >> 6);
    const int gI = task >> 2, h = task & 3, rb = wave & 3, nsteps = gI + 16;
    LAS bf16* PTs = (LAS bf16*)(lds + CH_PT); LAS bf16* Sb = (LAS bf16*)(lds + CH_SB) + wave * 16 * 72;
    f32x4 acc[4];
#pragma unroll
    for (int jb = 0; jb < 4; ++jb) acc[jb] = (f32x4){0.f, 0.f, 0.f, 0.f};
    for (int s0 = 0; s0 < nsteps; s0 += 8) {
        u32x4v pt[8], gf[8][2];
#pragma unroll
        for (int s_ = 0; s_ < 8; ++s_) { const int sg = s0 + s_;
            pt[s_] = (u32x4v){0u, 0u, 0u, 0u}; gf[s_][0] = pt[s_]; gf[s_][1] = pt[s_];
            if (sg < nsteps) {
                const bool grp = sg < gI; const size_t idx = grp ? (size_t)(sg * 4 + h) : (size_t)((gI * 16 + sg - gI) * 4 + h);
                const bf16* ptp = (const bf16*)(P.ws + (grp ? WS_PGT : WS_PCT)) + idx * 4096; const bf16* gp = (const bf16*)(P.ws + (grp ? WS_GG : WS_GC)) + idx * 4096 + (rb * 64 + lane) * 16;
                pt[s_] = *(const u32x4v*)(ptp + tid * 8);
                if (wave < 4) { gf[s_][0] = *(const u32x4v*)gp; gf[s_][1] = *(const u32x4v*)(gp + 8); } } }
        __syncthreads();
#pragma unroll
        for (int s_ = 0; s_ < 8; ++s_) *(LAS u32x4v*)(PTs + s_ * 4608 + (tid >> 3) * 72 + (tid & 7) * 8) = pt[s_];
        __syncthreads();
        if (wave < 4) {
#pragma unroll
            for (int s_ = 0; s_ < 8; ++s_) { const int sg = s0 + s_;
                if (sg < nsteps) {
                    if (sg >= gI) {
                        const int quad = lane >> 4, l15 = lane & 15;
#pragma unroll
                        for (int jb = 0; jb < 4; ++jb) *(LAS u32x2*)(Sb + l15 * 72 + jb * 16 + quad * 4) = pack4(acc[jb][0], acc[jb][1], acc[jb][2], acc[jb][3]);
                        asm volatile("s_waitcnt lgkmcnt(0)" ::: "memory");
                        bf16* S0g = (bf16*)(P.ws + WS_S0) + (size_t)((gI * 16 + sg - gI) * 4 + h) * 4096 + (rb * 16 + (lane >> 2)) * 64 + (lane & 3) * 16;
                        const LAS bf16* sp = Sb + (lane >> 2) * 72 + (lane & 3) * 16;
                        *(u32x4v*)S0g = *(const LAS u32x4v*)sp; *(u32x4v*)(S0g + 8) = *(const LAS u32x4v*)(sp + 8);
                        asm volatile("s_waitcnt lgkmcnt(0)" ::: "memory"); }
                    chain_step(acc, PTs + s_ * 4608, Sb, gf[s_], true, lane); } }
        }
    }
    __syncthreads();
}

__device__ __forceinline__ void stage_rwkv_y(const Params& P, int l, int wt, int lane) {
    const int pi = wt >> 2, tb = wt & 3, c = pi >> 2, h = pi & 3, quad = lane >> 4, l15 = lane & 15;
    const bf16* S0g = (const bf16*)(P.ws + WS_S0) + (size_t)pi * 4096; const bf16* Q1g = (const bf16*)(P.ws + WS_Q1) + (size_t)pi * 4096; const bf16* Y0g = (const bf16*)(P.ws + WS_Y0) + (size_t)pi * 4096;
    const bf16* U = (const bf16*)(P.ws + WS_U); bf16* Y = (bf16*)(P.ws + WS_H);
    const int tl = tb * 16 + l15, tg = c * 64 + tl;
    const bf16* qp = Q1g + tl * 64 + quad * 8;
    const bf16x8 q0 = *(const bf16x8*)qp, q1 = *(const bf16x8*)(qp + 32);
    f32x4 y[4];
    u32x2 vc[4], vp[4], gc[4], gp[4];
    const bf16* uc = U + (size_t)tg * NU + h * 64 + quad * 4;
#pragma unroll
    for (int ib = 0; ib < 4; ++ib) {
        const u32x2 y0 = *(const u32x2*)(Y0g + tl * 64 + ib * 16 + quad * 4);
        y[ib] = (f32x4){bf2f(y0.x & 0xffffu), bf2f(y0.x >> 16), bf2f(y0.y & 0xffffu), bf2f(y0.y >> 16)};
        vc[ib] = *(const u32x2*)(uc + C_V + ib * 16); gc[ib] = *(const u32x2*)(uc + C_G + ib * 16);
        vp[ib] = (u32x2){0u, 0u}; gp[ib] = (u32x2){0u, 0u};
        if (tg > 0) { vp[ib] = *(const u32x2*)(uc - NU + C_V + ib * 16); gp[ib] = *(const u32x2*)(uc - NU + C_G + ib * 16); } }
    const float bs = ((const float*)(P.ws + WS_BS))[(size_t)tg * 4 + h];
#pragma unroll
    for (int ib = 0; ib < 4; ++ib) { const bf16* sp = S0g + (ib * 16 + l15) * 64 + quad * 8;
        y[ib] = MFMA16(*(const bf16x8*)sp, q0, y[ib]); y[ib] = MFMA16(*(const bf16x8*)(sp + 32), q1, y[ib]); }
    float s = 0.f;
#pragma unroll
    for (int ib = 0; ib < 4; ++ib) s += (y[ib][0] + y[ib][1]) + (y[ib][2] + y[ib][3]);
    s += __shfl_xor(s, 16); s += __shfl_xor(s, 32);
    const float mean = s * (1.f / 64.f);
    float q = 0.f;
#pragma unroll
    for (int ib = 0; ib < 4; ++ib)
#pragma unroll
        for (int r = 0; r < 4; ++r) { const float d = y[ib][r] - mean; q += d * d; }
    q += __shfl_xor(q, 16); q += __shfl_xor(q, 32);
    const float rstd = rsqrtf(q * (1.f / 64.f) + LNX_EPS);
    const float* mu = PBP(P, PB_MU) + (size_t)l * 1152;
#pragma unroll
    for (int ib = 0; ib < 4; ++ib) { const int chn = h * 64 + ib * 16 + quad * 4, pc = l * 256 + chn;
        float o[4];
#pragma unroll
        for (int r = 0; r < 4; ++r) {
            const unsigned wv = r < 2 ? vc[ib].x : vc[ib].y, wvp = r < 2 ? vp[ib].x : vp[ib].y, wg = r < 2 ? gc[ib].x : gc[ib].y, wgp = r < 2 ? gp[ib].x : gp[ib].y;
            const float cv = bf2f((r & 1) ? (wv >> 16) : (wv & 0xffffu)), pv = bf2f((r & 1) ? (wvp >> 16) : (wvp & 0xffffu));
            const float cg = bf2f((r & 1) ? (wg >> 16) : (wg & 0xffffu)), pg = bf2f((r & 1) ? (wgp >> 16) : (wgp & 0xffffu));
            const float v = cv + (pv - cv) * mu[512 + chn + r], g = cg + (pg - cg) * mu[768 + chn + r];
            const float yn = (y[ib][r] - mean) * rstd * PBP(P, PB_LNW)[pc + r] + PBP(P, PB_LNB)[pc + r];
            o[r] = (yn + bs * v) * silu_f(g); }
        *(u32x2*)(Y + (size_t)tg * D + 512 + chn) = pack4(o[0], o[1], o[2], o[3]); }
}

constexpr int NT = 512;
constexpr int DUP_SUB = -1;
constexpr int REP_XA = 1, REP_S1 = 1, REP_P1 = 1, REP_OUT = 1, REP_SS3 = 1, REP_CMP = 1, REP_Y = 1;
constexpr int LDS_BYTES = 147456, MISC_OFF = LDS_BYTES - 256;
constexpr int CW_BAR = 4096;
static_assert(XA_LDS <= MISC_OFF && S3_LDS <= MISC_OFF && RW_END <= MISC_OFF && CH_END <= MISC_OFF && pg8::STAGE_BYTES <= MISC_OFF, "LDS map");

__global__ void __launch_bounds__(NT, 2) mega_fwd(Params P) {
    extern __shared__ __attribute__((aligned(16))) unsigned char lds_raw[];
    LAS unsigned char* lds_base = (LAS unsigned char*)lds_raw;
    volatile LAS unsigned* MISC = (volatile LAS unsigned*)(lds_base + MISC_OFF);
    const int tid = otid(), wave = __builtin_amdgcn_readfirstlane(tid >> 6), G = gridDim.x, bx = blockIdx.x;
    if (tid < 64) MISC[tid] = 0u;
    __syncthreads();
    XcdBarrier bar = xcd_barrier_post((unsigned*)(P.ws + WS_CTL) + CW_BAR, MISC + 8);
    {
        LAS unsigned char* lds = lds_base; const int gw = bx * 8 + wave, NGW = G * 8;
        stage_blob(P, bx * NT + tid, G * NT);
        for (int it = bx; it < N_PREP_ITEMS; it += G) stage_prep_weights(P, lds, it);
        for (int m = bx; m < MEM_LEN; m += G) stage_memkv(P, lds, m);
        for (int m = gw; m < M; m += NGW) prenorm_row(P.x + (size_t)m * D, P.pre_norm_w, (bf16*)(P.ws + WS_H) + (size_t)m * D, tid & 63);
        xcd_barrier(bar);
    }
    constexpr int PER = 7 + (DUP_SUB >= 0 ? 1 : 0), NPH = 1 + DEPTH * PER;
#pragma unroll 1
    for (int ph = 1; ph < NPH; ++ph) {
        Params Q; Q.ws = P.ws; Q.out = P.out; Q.x = P.x;
        asm volatile("" : "+s"(Q.ws), "+s"(Q.out), "+s"(Q.x));
        unsigned lds_a = (unsigned)(uintptr_t)lds_base; asm volatile("" : "+s"(lds_a)); LAS unsigned char* lds = (LAS unsigned char*)(uintptr_t)lds_a;
        int bx = blockIdx.x, G = gridDim.x; asm volatile("" : "+s"(bx), "+s"(G));
        const int tid = otid(), wave = __builtin_amdgcn_readfirstlane(tid >> 6), gw = bx * 8 + wave, NGW = G * 8;
        const int l = (ph - 1) / PER, s_ = (ph - 1) % PER, sub = (DUP_SUB >= 0 && s_ > DUP_SUB) ? s_ - 1 : s_;
        if (sub == 0) {
            pg8::Gemm g{(const bf16*)(Q.ws + WS_H), (const bf16*)(Q.ws + WS_WIN) + (size_t)l * NU * D, M, NU, D};
            pg8::StaticOrder S; S.init(M, NU, G, bx);
            pg8::EpiBf16 E{(bf16*)(Q.ws + WS_U), NU};
            pg8::gemm_phase<pg8::EpiBf16, pg8::StaticOrder, true, true>(lds, g, S, E);
        } else if (sub == 1) {
            for (int r_ = 0; r_ < REP_XA; ++r_) for (int it = bx; it < (M / 256) * 4; it += G) stage_xattn(Q, lds, it);
            for (int r_ = 0; r_ < REP_S1; ++r_) for (int it = bx; it < NCHUNK * 2; it += G) stage_ssd_s1(Q, l, lds, it);
            for (int r_ = 0; r_ < REP_P1; ++r_) for (int it = bx; it < NCHUNK * 4; it += G) stage_rwkv_p1(Q, l, lds, it);
        } else if (sub == 2) {
            if (bx < 64) for (int r_ = 0; r_ < REP_CMP; ++r_) stage_rwkv_compose(Q, lds, bx);
            else for (int it = bx - 64; it < 512; it += G - 64) stage_ssd_scan(Q, lds, it);
        } else if (sub == 3) {
            if (bx < 64) for (int r_ = 0; r_ < REP_OUT; ++r_) stage_rwkv_chain(Q, lds, bx);
            else for (int r_ = 0; r_ < REP_SS3; ++r_) for (int it = bx - 64; it < NCHUNK * 2; it += G - 64) stage_ssd_s3(Q, l, lds, it);
        } else if (sub == 4) {
            for (int r_ = 0; r_ < REP_Y; ++r_) for (int wt = gw; wt < NCHUNK * 4 * 4; wt += NGW) stage_rwkv_y(Q, l, wt, tid & 63);
        } else if (sub == 5) {
            pg8::Gemm g{(const bf16*)(Q.ws + WS_H), (const bf16*)(Q.ws + WS_WOUT) + (size_t)l * D * D, M, D, D};
            pg8::StaticOrder S; S.init(M, D, G, bx);
            pg8::EpiF32 E{(float*)(Q.ws + WS_U), D};
            pg8::gemm_phase<pg8::EpiF32, pg8::StaticOrder, true, true>(lds, g, S, E);
        } else {
            const float* xin = l == 0 ? Q.x : Q.out;
            for (int m = gw; m < M; m += NGW)
                post_row((const float*)(Q.ws + WS_U) + (size_t)m * D, xin + (size_t)m * D, PBP(Q, PB_POSTNW) + l * D, Q.out + (size_t)m * D,
                         l + 1 < DEPTH ? PBP(Q, PB_PRENW) + (l + 1) * D : nullptr, l + 1 < DEPTH ? (bf16*)(Q.ws + WS_H) + (size_t)m * D : nullptr, tid & 63);
        }
        if (ph + 1 < NPH) { XcdBarrier b2 = bar; asm volatile("" : "+s"(b2.x), "+s"(b2.bar)); xcd_barrier(b2); }
    }
}

extern "C" void kernel_launch(void* const* d_in, const int* in_sizes, int n_in, void* d_out, int out_size, void* d_ws, size_t ws_size, hipStream_t stream) {
    static int grid = 0;
    if (grid == 0) {
        if (n_in != 24 || in_sizes[0] != M * D || out_size != M * D || ws_size < WS_END) { fprintf(stderr, "kernel_launch: unexpected shapes n_in %d in0 %d out %d ws %zu\n", n_in, n_in > 0 ? in_sizes[0] : -1, out_size, ws_size); grid = -1; return; }
        int dev = 0, cus = 0, per_cu = 0;
        if (hipGetDevice(&dev) != hipSuccess || hipDeviceGetAttribute(&cus, hipDeviceAttributeMultiprocessorCount, dev) != hipSuccess) { grid = -1; return; }
        if (hipFuncSetAttribute((const void*)mega_fwd, hipFuncAttributeMaxDynamicSharedMemorySize, LDS_BYTES) != hipSuccess) { fprintf(stderr, "kernel_launch: hipFuncSetAttribute failed\n"); grid = -1; return; }
        if (hipOccupancyMaxActiveBlocksPerMultiprocessor(&per_cu, (const void*)mega_fwd, NT, LDS_BYTES) != hipSuccess || per_cu < 1) fprintf(stderr, "kernel_launch: occupancy query says %d\n", per_cu);
        (void)hipGetLastError();
        grid = cus;
    }
    if (grid < 0) return;
    if (hipMemsetAsync((char*)d_ws + WS_CTL, 0, 1 * MiB, stream) != hipSuccess) return;
    Params P{};
    const float** pp = (const float**)&P;
    for (int i = 0; i < 24; ++i) pp[i] = (const float*)d_in[i];
    P.out = (float*)d_out; P.ws = (unsigned char*)d_ws;
    hipLaunchKernelGGL(mega_fwd, dim3(grid), dim3(NT), LDS_BYTES, stream, P);
}
```

```cpp
#include <hip/hip_runtime.h>
#include <cstdio>
#include <cstdint>

__device__ __forceinline__ int otid() { int t = threadIdx.x; asm volatile("" : "+v"(t)); return t; }
namespace pg8 {
#define PG8_LAS __attribute__((address_space(3)))
typedef unsigned short bf16_t;
typedef short bf16x8 __attribute__((ext_vector_type(8)));
typedef float f32x4 __attribute__((ext_vector_type(4)));
typedef unsigned u32x4 __attribute__((ext_vector_type(4)));
constexpr int BM = 256, BK = 64, HALF = 128, HTB = HALF * BK * 2  , STAGE_BYTES = 8 * HTB, NXCD = 8, WGM = 8;

__host__ __device__ __forceinline__ int lds_byte(int r, int c) { const int st = (r >> 4) * 2 + (c >> 5), rr = r & 15, cc = c & 31, ob = rr * 64 + cc * 2; return st * 1024 + (ob ^ (((ob >> 9) & 1) << 5)); }
__host__ __device__ __forceinline__ void stage_rc(int b, int& R, int& C) { const int st = b / 1024, sb = b % 1024, swz = sb ^ (((sb >> 9) & 1) << 5); R = (st >> 1) * 16 + swz / 64; C = (st & 1) * 32 + (swz % 64) / 2; }
__host__ __device__ __forceinline__ int perm32(int rho) { const int n = rho >> 4, i = rho & 15; return 8 * (i >> 2) + 4 * n + (i & 3); }

struct Unit { int pm, pn; };
struct Gemm { const bf16_t* A; const bf16_t* Bt; int M, N, K; };

struct StaticOrder {
    int nM, nN, nwg, G, c;
    __host__ __device__ void init(int M, int N, int G_, int c_) { nM = M / BM; nN = N / BM; nwg = nM * nN; G = G_; c = c_; }
    __host__ __device__ bool next(int i, Unit& u) const {
        const long L = (long)i * G + c; if (L >= nwg) return false;
        int wgid = (int)L; { const int q = nwg / NXCD, r = nwg % NXCD, xcd = wgid % NXCD, off = wgid / NXCD; wgid = (xcd < r ? xcd * (q + 1) : r * (q + 1) + (xcd - r) * q) + off; }
        const int nig = WGM * nN, gid = wgid / nig, fm = gid * WGM, gsz = (nM - fm) < WGM ? (nM - fm) : WGM;
        u.pm = fm + ((wgid % nig) % gsz); u.pn = (wgid % nig) / gsz; return true;
    }
    __device__ __forceinline__ void a_ready(const Unit&) const {}
    __device__ __forceinline__ void done(const Unit&) const {}
};


__device__ __forceinline__ unsigned cvt_pk_bf16(float lo, float hi) { unsigned r; asm volatile("v_cvt_pk_bf16_f32 %0, %1, %2" : "=v"(r) : "v"(lo), "v"(hi)); return r; }
struct EpiBf16 {
    static constexpr bool PERM = true, AFTER_DRAIN = false;
    bf16_t* O; int ldc;
    __device__ __forceinline__ void operator()(const f32x4 (&acc)[2][2][4][2], const Unit& u, int wr, int wc, int fr, int fq) const {
        const int row0 = u.pm * BM + wr * 64 + fr; const int col0 = u.pn * BM + wc * 32 + 8 * fq;
#pragma unroll
        for (int ai = 0; ai < 2; ++ai)
#pragma unroll
            for (int m = 0; m < 4; ++m) { bf16_t* rowp = O + (size_t)(row0 + ai * HALF + m * 16) * ldc + col0;
#pragma unroll
                for (int bj = 0; bj < 2; ++bj) { const f32x4 v0 = acc[ai][bj][m][0], v1 = acc[ai][bj][m][1];
                    u32x4 w; w.x = cvt_pk_bf16(v0[0], v0[1]); w.y = cvt_pk_bf16(v0[2], v0[3]); w.z = cvt_pk_bf16(v1[0], v1[1]); w.w = cvt_pk_bf16(v1[2], v1[3]);
                    *(u32x4*)(rowp + bj * HALF) = w; } }
    }
};
struct EpiF32 {
    static constexpr bool PERM = false, AFTER_DRAIN = false;
    float* C; int ldc;
    __device__ __forceinline__ void operator()(const f32x4 (&acc)[2][2][4][2], const Unit& u, int wr, int wc, int fr, int fq) const {
        const int row0 = u.pm * BM + wr * 64 + fr, col0 = u.pn * BM + wc * 32 + 4 * fq;
#pragma unroll
        for (int ai = 0; ai < 2; ++ai)
#pragma unroll
            for (int m = 0; m < 4; ++m) { float* rowp = C + (size_t)(row0 + ai * HALF + m * 16) * ldc + col0;
#pragma unroll
                for (int bj = 0; bj < 2; ++bj)
#pragma unroll
                    for (int n = 0; n < 2; ++n) *(f32x4*)(rowp + bj * HALF + n * 16) = acc[ai][bj][m][n]; }
    }
};

template <class Epi, class Sched, bool ALIGN_EPI = false, bool SP2 = false>
__device__ __forceinline__ void gemm_phase(PG8_LAS unsigned char* lds, const Gemm g, const Sched& S, const Epi& E) {
    const int tid = otid(), wid = __builtin_amdgcn_readfirstlane(tid >> 6), lane = tid & 63, wr = wid >> 2, wc = wid & 3, fr = lane & 15, fq = lane >> 4;
    const int K = g.K, nt = K / BK;
    unsigned voffA[2], voffB[2];
#pragma unroll
    for (int i = 0; i < 2; ++i) { int R, C; stage_rc(tid * 16 + i * 8192, R, C); const int Rb = Epi::PERM ? ((R & ~31) + perm32(R & 31)) : R;
        voffA[i] = (unsigned)(R * K + C) * 2u; voffB[i] = (unsigned)(Rb * K + C) * 2u; }
    const size_t kstep = (size_t)(BK * 2);
    const size_t hstep = (size_t)HALF * K * 2;
    const size_t tstep = 2 * hstep;
    const unsigned ldsw = (unsigned)wid * 1024u;
    const int aoff = lds_byte(wr * 64 + fr, fq * 8), boff = lds_byte(wc * 32 + fr, fq * 8);
#define PG8_SA(b, h) (((b) * 2 + (h)) * HTB)
#define PG8_SB(b, h) ((4 + (b) * 2 + (h)) * HTB)
#define PG8_STAGE(bufoff, gbase, voff) do { _Pragma("unroll") for (int _i = 0; _i < 2; ++_i) \
        __builtin_amdgcn_global_load_lds((const unsigned*)((const char*)(gbase) + (voff)[_i]), (PG8_LAS unsigned*)(lds + (bufoff) + ldsw + _i * 8192), 16, 0, 0); } while (0)
#define PG8_LDA(dst, b, h) do { _Pragma("unroll") for (int m = 0; m < 4; ++m) _Pragma("unroll") for (int k = 0; k < 2; ++k) dst[m][k] = *(const PG8_LAS bf16x8*)(lds + PG8_SA(b, h) + aoff + m * 2048 + k * 1024); } while (0)
#define PG8_LDB(dst, b, h) do { _Pragma("unroll") for (int n = 0; n < 2; ++n) _Pragma("unroll") for (int k = 0; k < 2; ++k) dst[n][k] = *(const PG8_LAS bf16x8*)(lds + PG8_SB(b, h) + boff + n * 2048 + k * 1024); } while (0)
#define PG8_MMA(ai, bj, At, Bt) do { __builtin_amdgcn_s_setprio(1); _Pragma("unroll") for (int m = 0; m < 4; ++m) _Pragma("unroll") for (int n = 0; n < 2; ++n) _Pragma("unroll") for (int k = 0; k < 2; ++k) \
        acc[ai][bj][m][n] = __builtin_amdgcn_mfma_f32_16x16x32_bf16(Bt[n][k], At[m][k], acc[ai][bj][m][n], 0, 0, 0); __builtin_amdgcn_s_setprio(0); } while (0)
#define PG8_WAIT_V(n) asm volatile("s_waitcnt vmcnt(" #n ")" ::: "memory")
#define PG8_WAIT_L(n) asm volatile("s_waitcnt lgkmcnt(" #n ")" ::: "memory")
#define PG8_BAR __builtin_amdgcn_s_barrier()
#define PG8_SCHED __builtin_amdgcn_sched_barrier(0)
    Unit cur, nxt; int ui = 0;
    if (!S.next(0, cur)) return;
    f32x4 acc[2][2][4][2];
#pragma unroll
    for (int a = 0; a < 2; ++a)
#pragma unroll
        for (int b = 0; b < 2; ++b)
#pragma unroll
            for (int m = 0; m < 4; ++m)
#pragma unroll
                for (int n = 0; n < 2; ++n) acc[a][b][m][n] = (f32x4){0.f, 0.f, 0.f, 0.f};
    bf16x8 At[4][2], B0[2][2], B1[2][2];
    const char* cA = (const char*)g.A + (size_t)cur.pm * tstep; const char* cB = (const char*)g.Bt + (size_t)cur.pn * tstep;
    S.a_ready(cur);
    if constexpr (SP2) {
        PG8_STAGE(PG8_SB(0, 0), cB, voffB); PG8_STAGE(PG8_SB(0, 1), cB + hstep, voffB); PG8_STAGE(PG8_SA(0, 0), cA, voffA); PG8_STAGE(PG8_SA(0, 1), cA + hstep, voffA);
        if (wr == 1) PG8_BAR;
        PG8_WAIT_V(2); PG8_BAR;
        PG8_STAGE(PG8_SB(1, 0), cB + kstep, voffB); PG8_STAGE(PG8_SA(1, 0), cA + kstep, voffA); PG8_STAGE(PG8_SB(1, 1), cB + hstep + kstep, voffB);
        PG8_WAIT_V(6); PG8_BAR;
    } else {
        PG8_STAGE(PG8_SB(0, 0), cB, voffB); PG8_STAGE(PG8_SA(0, 0), cA, voffA); PG8_STAGE(PG8_SB(0, 1), cB + hstep, voffB); PG8_STAGE(PG8_SA(0, 1), cA + hstep, voffA);
        if (wr == 1) PG8_BAR;
        PG8_WAIT_V(4); PG8_BAR;
        PG8_STAGE(PG8_SB(1, 0), cB + kstep, voffB); PG8_STAGE(PG8_SA(1, 0), cA + kstep, voffA); PG8_STAGE(PG8_SB(1, 1), cB + hstep + kstep, voffB);
        PG8_WAIT_V(6); PG8_BAR;
    }
    for (;;) {
        const bool has_next = S.next(ui + 1, nxt);
        const char* nA = has_next ? (const char*)g.A + (size_t)nxt.pm * tstep : cA; const char* nB = has_next ? (const char*)g.Bt + (size_t)nxt.pn * tstep : cB;
        for (int t = 0; t < nt; t += 2) {
            const bool last = (t == nt - 2);
            const char* a1 = cA + (size_t)(t + 1) * kstep;
            const char* a2 = last ? nA : cA + (size_t)(t + 2) * kstep; const char* b2 = last ? nB : cB + (size_t)(t + 2) * kstep;
            const char* a3 = a2 + kstep; const char* b3 = b2 + kstep;
            if (last && has_next) S.a_ready(nxt);
            if constexpr (SP2) {
            PG8_LDB(B0, 0, 0); PG8_LDB(B1, 0, 1); PG8_SCHED; PG8_LDA(At, 0, 0); PG8_STAGE(PG8_SA(1, 1), a1 + hstep, voffA);
            PG8_WAIT_V(8); PG8_WAIT_L(0); PG8_BAR; PG8_MMA(0, 0, At, B0); PG8_MMA(0, 1, At, B1); PG8_BAR; PG8_SCHED;
            PG8_LDA(At, 0, 1); PG8_STAGE(PG8_SB(0, 0), b2, voffB); PG8_STAGE(PG8_SB(0, 1), b2 + hstep, voffB); PG8_STAGE(PG8_SA(0, 0), a2, voffA);
            PG8_WAIT_V(8); PG8_WAIT_L(0); PG8_BAR; PG8_MMA(1, 0, At, B0); PG8_MMA(1, 1, At, B1); PG8_BAR; PG8_SCHED;
            PG8_LDB(B0, 1, 0); PG8_LDB(B1, 1, 1); PG8_SCHED; PG8_LDA(At, 1, 0); PG8_STAGE(PG8_SA(0, 1), a2 + hstep, voffA);
            PG8_WAIT_V(8); PG8_WAIT_L(0); PG8_BAR; PG8_MMA(0, 0, At, B0); PG8_MMA(0, 1, At, B1); PG8_BAR; PG8_SCHED;
            PG8_LDA(At, 1, 1); PG8_STAGE(PG8_SB(1, 0), b3, voffB); PG8_STAGE(PG8_SB(1, 1), b3 + hstep, voffB); PG8_STAGE(PG8_SA(1, 0), a3, voffA);
            PG8_WAIT_V(8); PG8_WAIT_L(0); PG8_BAR; PG8_MMA(1, 0, At, B0); PG8_MMA(1, 1, At, B1); PG8_BAR; PG8_SCHED;
            } else {
            PG8_LDB(B0, 0, 0); PG8_SCHED; PG8_LDA(At, 0, 0); PG8_STAGE(PG8_SA(1, 1), a1 + hstep, voffA);
            PG8_WAIT_L(8); PG8_BAR; PG8_WAIT_L(0); PG8_MMA(0, 0, At, B0); PG8_BAR; PG8_SCHED;
            PG8_LDB(B1, 0, 1); PG8_STAGE(PG8_SB(0, 0), b2, voffB);
            PG8_BAR; PG8_WAIT_L(0); PG8_MMA(0, 1, At, B1); PG8_BAR;
            PG8_LDA(At, 0, 1); PG8_STAGE(PG8_SA(0, 0), a2, voffA);
            PG8_BAR; PG8_WAIT_L(0); PG8_MMA(1, 0, At, B0); PG8_BAR; PG8_SCHED;
            PG8_STAGE(PG8_SB(0, 1), b2 + hstep, voffB);
            PG8_WAIT_V(6); PG8_BAR; PG8_MMA(1, 1, At, B1); PG8_BAR;
            PG8_LDB(B0, 1, 0); PG8_SCHED; PG8_LDA(At, 1, 0); PG8_STAGE(PG8_SA(0, 1), a2 + hstep, voffA);
            PG8_WAIT_L(8); PG8_BAR; PG8_WAIT_L(0); PG8_MMA(0, 0, At, B0); PG8_BAR; PG8_SCHED;
            PG8_LDB(B1, 1, 1); PG8_STAGE(PG8_SB(1, 0), b3, voffB);
            PG8_BAR; PG8_WAIT_L(0); PG8_MMA(0, 1, At, B1); PG8_BAR;
            PG8_LDA(At, 1, 1); PG8_STAGE(PG8_SA(1, 0), a3, voffA);
            PG8_BAR; PG8_WAIT_L(0); PG8_MMA(1, 0, At, B0); PG8_BAR; PG8_SCHED;
            PG8_STAGE(PG8_SB(1, 1), b3 + hstep, voffB);
            PG8_WAIT_V(6); PG8_BAR; PG8_MMA(1, 1, At, B1); PG8_BAR;
            }
        }
        if constexpr (ALIGN_EPI) { if (wr == 0) PG8_BAR; }
        if constexpr (!Epi::AFTER_DRAIN) { E(acc, cur, wr, wc, fr, fq); S.done(cur); }
        if (!has_next) break;
#pragma unroll
        for (int a = 0; a < 2; ++a)
#pragma unroll
            for (int b = 0; b < 2; ++b)
#pragma unroll
                for (int m = 0; m < 4; ++m)
#pragma unroll
                    for (int n = 0; n < 2; ++n) acc[a][b][m][n] = (f32x4){0.f, 0.f, 0.f, 0.f};
        cur = nxt; cA = nA; cB = nB; ++ui;
        if constexpr (ALIGN_EPI) { if (wr == 1) PG8_BAR; }
    }
    PG8_WAIT_V(0);
    if constexpr (!ALIGN_EPI) { if (wr == 0) PG8_BAR; }
    PG8_BAR;
    if constexpr (Epi::AFTER_DRAIN) { E.fused(acc, cur, wr, wc, fr, fq, lds, wid, lane); S.done(cur); }
#undef PG8_SA
#undef PG8_SB
#undef PG8_STAGE
#undef PG8_LDA
#undef PG8_LDB
#undef PG8_MMA
#undef PG8_WAIT_V
#undef PG8_WAIT_L
#undef PG8_BAR
#undef PG8_SCHED
}
}

constexpr int M = 16384, D = 1024, DEPTH = 4, NU = 3328, NWIN = 3208, NCHUNK = 256;
constexpr int MEM_LEN = 256;
constexpr int C_XS = 0, C_B = 512, C_C = 768, C_Z = 1024, C_R = 1536, C_K = 1792, C_V = 2048, C_G = 2304, C_WL = 2560, C_AL = 2624, C_DT = 2688, C_Q = 2816, C_GX = 3072;
constexpr float NORM_EPS = 1e-6f, LNX_EPS = 64e-5f;

#define LAS __attribute__((address_space(3)))
typedef unsigned short bf16;
typedef short bf16x8 __attribute__((ext_vector_type(8)));
typedef float f32x4 __attribute__((ext_vector_type(4)));

__device__ __forceinline__ unsigned f2bf(float f) { unsigned u = __float_as_uint(f); return (u + 0x7fffu + ((u >> 16) & 1u)) >> 16; }
__device__ __forceinline__ float bf2f(unsigned b) { return __uint_as_float(b << 16); }
__device__ __forceinline__ float us2f(short s) { return bf2f((unsigned)(unsigned short)s); }
typedef unsigned u32x2 __attribute__((ext_vector_type(2)));
typedef unsigned u32x4v __attribute__((ext_vector_type(4)));
__device__ __forceinline__ u32x2 pack4(float a, float b, float c, float d) { u32x2 o; o.x = f2bf(a) | (f2bf(b) << 16); o.y = f2bf(c) | (f2bf(d) << 16); return o; }
__device__ __forceinline__ float wave_sum(float v) {
#pragma unroll
    for (int o = 1; o < 64; o <<= 1) v += __shfl_xor(v, o);
    return v;
}
__device__ __forceinline__ float silu_f(float x) { return x / (1.f + __expf(-x)); }
__device__ __forceinline__ float softplus_f(float x) { return fmaxf(x, 0.f) + log1pf(__expf(-fabsf(x))); }
__device__ __forceinline__ float sigmoid_f(float x) { return 1.f / (1.f + __expf(-x)); }

__device__ __forceinline__ bf16x8 ld_frag(const LAS bf16* base, int ld, int row0, int k0, int lane) {
    return *(const LAS bf16x8*)(base + (row0 + (lane & 15)) * ld + k0 + (lane >> 4) * 8);
}
#define MFMA16(a, b, c) __builtin_amdgcn_mfma_f32_16x16x32_bf16((a), (b), (c), 0, 0, 0)

#define XB_TMO      128
#define XB_XCNT(j)  (256  + 64 * (j))
#define XB_XSUB(j)  (1280 + 64 * (j))
#define XB_XGEN(j)  (2304 + 64 * (j))
#define XB_TOP      3328
#define XB_TOPGEN   3392
#define XCD_BAR_WORDS 3456
#define XB_SPIN_CAP (1u << 22)

__device__ __forceinline__ unsigned xb_ld(unsigned* p)              { return __hip_atomic_load(p, __ATOMIC_RELAXED, __HIP_MEMORY_SCOPE_AGENT); }
__device__ __forceinline__ unsigned xb_add(unsigned* p, unsigned v) { return __hip_atomic_fetch_add(p, v, __ATOMIC_RELAXED, __HIP_MEMORY_SCOPE_AGENT); }
__device__ __forceinline__ unsigned xb_xcc_id() { return (unsigned)__builtin_amdgcn_s_getreg((3 << 11) | 20) & 0xFu; }
#define XB_SPIN(cond, bar) do { unsigned _sp = 0; while (cond) { __builtin_amdgcn_s_sleep(1); \
    if ((++_sp & 255u) == 0u) { if (xb_ld(&(bar)[XB_TMO])) break; if (_sp > XB_SPIN_CAP) { atomicAdd(&(bar)[XB_TMO], 1u); break; } } } } while (0)

struct XcdBarrier {
    unsigned* bar; unsigned x;
    volatile LAS unsigned* st;
};

__device__ __forceinline__ XcdBarrier xcd_barrier_post(unsigned* bar, volatile LAS unsigned* st) {
    XcdBarrier b; b.bar = bar; b.x = xb_xcc_id(); b.st = st;
    if (otid() == 0) (void)xb_add(&bar[XB_XCNT(b.x)], 1u);
    return b;
}
__device__ __forceinline__ void xcd_barrier_complete(unsigned* bar, unsigned x, unsigned& nloc, unsigned& nx) {
    const unsigned G = gridDim.x * gridDim.y * gridDim.z;
    unsigned sum, cnt, mine, sp = 0u;
    for (;;) {
        sum = 0u; cnt = 0u; mine = 0u;
#pragma unroll
        for (unsigned j = 0; j < 16; ++j) { const unsigned c = xb_ld(&bar[XB_XCNT(j)]); sum += c; cnt += (c > 0u) ? 1u : 0u; }
        mine = xb_ld(&bar[XB_XCNT(x)]);
        if (sum == G) break;
        __builtin_amdgcn_s_sleep(1);
        if ((++sp & 255u) == 0u) { if (xb_ld(&bar[XB_TMO])) break; if (sp > XB_SPIN_CAP) { atomicAdd(&bar[XB_TMO], 1u); break; } }
    }
    nloc = mine > 0u ? mine : 1u; nx = cnt > 0u ? cnt : 1u;
}

__device__ __forceinline__ void xcd_barrier(const XcdBarrier& b) {
    asm volatile("s_waitcnt vmcnt(0)" ::: "memory");
    __syncthreads();
    if (otid() == 0) {
        unsigned* bar = b.bar;
        __builtin_amdgcn_s_waitcnt(0);
        unsigned nloc = b.st[0], nx = b.st[1];
        if (nloc == 0u) { xcd_barrier_complete(bar, b.x, nloc, nx); b.st[0] = nloc; b.st[1] = nx; }
        const unsigned old = xb_add(&bar[XB_XSUB(b.x)], 1u);
        const unsigned gen = old / nloc;
        if (old + 1u == (gen + 1u) * nloc) {
            __builtin_amdgcn_fence(__ATOMIC_RELEASE, "agent");
            asm volatile("s_waitcnt vmcnt(0)" ::: "memory");
            const unsigned og = xb_add(&bar[XB_TOP], 1u);
            const unsigned tg = og / nx;
            if (og + 1u == (tg + 1u) * nx) xb_add(&bar[XB_TOPGEN], 1u);
            else XB_SPIN(xb_ld(&bar[XB_TOPGEN]) == tg, bar);
            __builtin_amdgcn_fence(__ATOMIC_ACQUIRE, "agent");
            xb_add(&bar[XB_XGEN(b.x)], 1u);
            asm volatile("s_waitcnt vmcnt(0)" ::: "memory");
        } else {
            XB_SPIN(xb_ld(&bar[XB_XGEN(b.x)]) == gen, bar);
            __builtin_amdgcn_fence(__ATOMIC_ACQUIRE, "agent");
            asm volatile("s_waitcnt vmcnt(0)" ::: "memory");
        }
    }
    __syncthreads();
}


struct Params {
    const float *x, *mem, *mem_norm_w, *w_mem_kv, *pre_norm_w, *w_in, *conv_w, *conv_b, *dt_bias, *a_log, *d_skip, *ssm_norm_w,
                *shift_mu, *w0, *w2, *a0, *a2, *k_k, *k_a, *r_k, *lnx_w, *lnx_b, *w_out, *post_norm_w;
    float* out;
    unsigned char* ws;
};
constexpr size_t MiB = 1u << 20;
constexpr size_t WS_CTL = 0, WS_WIN = 1 * MiB, WS_WOUT = 27 * MiB, WS_KV = 35 * MiB, WS_H = 36 * MiB, WS_U = 68 * MiB, WS_R = 172 * MiB, WS_END = 256 * MiB;
constexpr size_t WS_ST = WS_R, WS_CD = WS_R + 32 * MiB, WS_BS = WS_CD + 65536;
constexpr size_t WS_Q1 = WS_R + 34 * MiB, WS_Y0 = WS_R + 42 * MiB, WS_PCT = WS_R + 50 * MiB, WS_GC = WS_R + 58 * MiB, WS_S0 = WS_R + 66 * MiB, WS_PGT = WS_R + 74 * MiB, WS_GG = WS_R + 75 * MiB;
static_assert(WS_GG + 64 * 8192 <= WS_END && WS_BS + (size_t)16384 * 16 <= WS_Q1, "ws map");


constexpr size_t WS_PB = 128 * 1024;
constexpr int PB_PRENW = 1024, PB_CONVW = 5120, PB_CONVB = 21504, PB_DTB = 25600, PB_ALOG = 25632, PB_DSKIP = 25664, PB_SSMNW = 25728, PB_MU = 27776, PB_W0 = 32384, PB_W2 = 33408,
              PB_A0 = 98944, PB_A2 = 99968, PB_KK = 165504, PB_KA = 166528, PB_RK = 167552, PB_LNW = 168576, PB_LNB = 169600, PB_POSTNW = 170624, PB_END = 174720;
static_assert(WS_PB + (size_t)PB_END * 4 <= 1 * MiB, "blob inside the control MiB");
#define PBP(P, off) ((const float*)((P).ws + WS_PB) + (off))
__device__ __forceinline__ int win_src_col(int n) {
    if (n < 1536) return n;
    if (n < 2560) return n + 8;
    if (n < 2816) { const int j = n - 2560; if (j < 64) return 2568 + j; if (j < 128) return 2632 + (j - 64); if (j < 136) return 1536 + (j - 128); return -1; }
    return n - 120;
}
template <bool WIN>
__device__ __forceinline__ void transpose_tile(const float* src, int src_ld, bf16* dst, int K, int n0, int k0, LAS float* scr) {
    const int tx = otid() & 63, ty = otid() >> 6;
    const int sc = WIN ? win_src_col(n0 + tx) : (n0 + tx);
#pragma unroll
    for (int kk = ty; kk < 64; kk += 8) scr[kk * 65 + tx] = sc >= 0 ? src[(size_t)(k0 + kk) * src_ld + sc] : 0.f;
    __syncthreads();
#pragma unroll
    for (int nn = ty; nn < 64; nn += 8) dst[(size_t)(n0 + nn) * K + k0 + tx] = (bf16)f2bf(scr[tx * 65 + nn]);
    __syncthreads();
}
__device__ __forceinline__ void stage_prep_weights(const Params& P, LAS unsigned char* lds, int item) {
    LAS float* scr = (LAS float*)lds;
    constexpr int T_IN = (NU / 64) * (D / 64);
    constexpr int T_OUT = (D / 64) * (D / 64);
    if (item < DEPTH * T_IN) { const int l = item / T_IN, r = item % T_IN, nb = r / 16, kb = r % 16;
        transpose_tile<true>(P.w_in + (size_t)l * D * NWIN, NWIN, (bf16*)(P.ws + WS_WIN) + (size_t)l * NU * D, D, nb * 64, kb * 64, scr); }
    else { const int it = item - DEPTH * T_IN; const int l = it / T_OUT, r = it % T_OUT, nb = r / 16, kb = r % 16;
        transpose_tile<false>(P.w_out + (size_t)l * D * D, D, (bf16*)(P.ws + WS_WOUT) + (size_t)l * D * D, D, nb * 64, kb * 64, scr); }
}
constexpr int N_PREP_ITEMS = DEPTH * ((NU / 64) * (D / 64) + (D / 64) * (D / 64));


__device__ __forceinline__ void stage_blob(const Params& P, int gtid, int gthreads) {
    float* pb = (float*)(P.ws + WS_PB);
#define CPY(src, off, n) for (int i = gtid; i < (n); i += gthreads) pb[(off) + i] = (src)[i];
    CPY(P.mem_norm_w, 0, 1024) CPY(P.pre_norm_w, PB_PRENW, 4096) CPY(P.conv_w, PB_CONVW, 16384) CPY(P.conv_b, PB_CONVB, 4096) CPY(P.dt_bias, PB_DTB, 32) CPY(P.a_log, PB_ALOG, 32) CPY(P.d_skip, PB_DSKIP, 32)
    CPY(P.ssm_norm_w, PB_SSMNW, 2048) CPY(P.shift_mu, PB_MU, 4608) CPY(P.w0, PB_W0, 1024) CPY(P.w2, PB_W2, 65536) CPY(P.a0, PB_A0, 1024) CPY(P.a2, PB_A2, 65536) CPY(P.k_k, PB_KK, 1024) CPY(P.k_a, PB_KA, 1024)
    CPY(P.r_k, PB_RK, 1024) CPY(P.lnx_w, PB_LNW, 1024) CPY(P.lnx_b, PB_LNB, 1024) CPY(P.post_norm_w, PB_POSTNW, 4096)
#undef CPY
}
__device__ __forceinline__ void stage_memkv(const Params& P, LAS unsigned char* lds, int m) {
    LAS float* xs = (LAS float*)lds; LAS float* red = xs + 1024;
    const int tid = otid();
    const float v0 = P.mem[(size_t)m * D + tid], v1 = P.mem[(size_t)m * D + 512 + tid];
    float s = wave_sum(v0 * v0 + v1 * v1);
    if ((tid & 63) == 0) red[tid >> 6] = s;
    __syncthreads();
    float tot = 0.f;
#pragma unroll
    for (int w = 0; w < 8; ++w) tot += red[w];
    const float rstd = rsqrtf(tot * (1.f / D) + NORM_EPS);
    xs[tid] = v0 * rstd * P.mem_norm_w[tid]; xs[512 + tid] = v1 * rstd * P.mem_norm_w[512 + tid];
    __syncthreads();
    float acc = 0.f;
#pragma unroll 8
    for (int k = 0; k < D; ++k) acc += xs[k] * P.w_mem_kv[(size_t)k * 512 + tid];
    {   const int hh = (tid >> 6) & 3, d = tid & 63;
        if (tid < 256) ((bf16*)(P.ws + WS_KV))[(size_t)(hh * 256 + m) * 64 + d] = (bf16)f2bf(acc);
        else ((bf16*)(P.ws + WS_KV) + 65536)[(size_t)(hh * 64 + d) * 256 + m] = (bf16)f2bf(acc); }
    __syncthreads();
}

__device__ __forceinline__ void prenorm_row(const float* xrow, const float* w, bf16* orow, int lane) {
    const f32x4* xr = (const f32x4*)xrow + lane; const f32x4* wr = (const f32x4*)w + lane;
    f32x4 v[4]; float s = 0.f;
#pragma unroll
    for (int j = 0; j < 4; ++j) { v[j] = xr[64 * j]; s += (v[j].x * v[j].x + v[j].y * v[j].y) + (v[j].z * v[j].z + v[j].w * v[j].w); }
    const float rstd = rsqrtf(wave_sum(s) * (1.f / D) + NORM_EPS);
    unsigned long long* o8 = (unsigned long long*)orow + lane;
#pragma unroll
    for (int j = 0; j < 4; ++j) { const f32x4 ww = wr[64 * j];
        const unsigned lo = f2bf(v[j].x * rstd * ww.x) | (f2bf(v[j].y * rstd * ww.y) << 16), hi = f2bf(v[j].z * rstd * ww.z) | (f2bf(v[j].w * rstd * ww.w) << 16);
        o8[64 * j] = (unsigned long long)lo | ((unsigned long long)hi << 32); }
}
__device__ __forceinline__ void post_row(const float* orow, const float* xin, const float* pw, float* xout, const float* nw, bf16* hrow, int lane) {
    const f32x4* orr = (const f32x4*)orow + lane; const f32x4* xr = (const f32x4*)xin + lane; const f32x4* pr = (const f32x4*)pw + lane;
    f32x4 v[4]; float s = 0.f;
#pragma unroll
    for (int j = 0; j < 4; ++j) { v[j] = orr[64 * j]; s += (v[j].x * v[j].x + v[j].y * v[j].y) + (v[j].z * v[j].z + v[j].w * v[j].w); }
    const float rstd = rsqrtf(wave_sum(s) * (1.f / D) + NORM_EPS);
    float s2 = 0.f;
#pragma unroll
    for (int j = 0; j < 4; ++j) { const f32x4 xx = xr[64 * j], pp = pr[64 * j]; v[j] = xx + v[j] * rstd * pp; s2 += (v[j].x * v[j].x + v[j].y * v[j].y) + (v[j].z * v[j].z + v[j].w * v[j].w);
        ((f32x4*)xout + lane)[64 * j] = v[j]; }
    if (hrow) {
        const float rstd2 = rsqrtf(wave_sum(s2) * (1.f / D) + NORM_EPS);
        const f32x4* wr = (const f32x4*)nw + lane; unsigned long long* o8 = (unsigned long long*)hrow + lane;
#pragma unroll
        for (int j = 0; j < 4; ++j) { const f32x4 ww = wr[64 * j];
            const unsigned lo = f2bf(v[j].x * rstd2 * ww.x) | (f2bf(v[j].y * rstd2 * ww.y) << 16), hi = f2bf(v[j].z * rstd2 * ww.z) | (f2bf(v[j].w * rstd2 * ww.w) << 16);
            o8[64 * j] = (unsigned long long)lo | ((unsigned long long)hi << 32); }
    }
}

constexpr int XA_KLD = 72, XA_VLD = 264;
constexpr int XA_LDS = (256 * XA_KLD + 64 * XA_VLD) * 2;
__device__ __forceinline__ void stage_xattn(const Params& P, LAS unsigned char* lds, int item) {
    const int tid = otid(), lane = tid & 63, wave = tid >> 6, quad = lane >> 4, l15 = lane & 15;
    const int tile = item >> 2, h = item & 3, t0 = tile * 256;
    LAS bf16* Ks = (LAS bf16*)lds; LAS bf16* VT = Ks + 256 * XA_KLD;
    const bf16* KB = (const bf16*)(P.ws + WS_KV) + (size_t)h * 256 * 64; const bf16* VB = (const bf16*)(P.ws + WS_KV) + 65536 + (size_t)h * 64 * 256;
    const bf16* U = (const bf16*)(P.ws + WS_U); bf16* Y = (bf16*)(P.ws + WS_H);
    u32x4v kp[4], vp[4];
#pragma unroll
    for (int i = 0; i < 4; ++i) { const int e = tid + i * 512; kp[i] = *(const u32x4v*)(KB + e * 8); vp[i] = *(const u32x4v*)(VB + e * 8); }
    bf16x8 qf[2][2]; u32x2 gx[2][4];
#pragma unroll
    for (int rb = 0; rb < 2; ++rb) { const bf16* up = U + (size_t)(t0 + wave * 32 + rb * 16 + l15) * NU + h * 64;
#pragma unroll
        for (int s_ = 0; s_ < 2; ++s_) qf[rb][s_] = *(const bf16x8*)(up + C_Q + s_ * 32 + quad * 8);
#pragma unroll
        for (int db = 0; db < 4; ++db) gx[rb][db] = *(const u32x2*)(up + C_GX + db * 16 + quad * 4); }
#pragma unroll
    for (int i = 0; i < 4; ++i) { const int e = tid + i * 512;
        *(LAS u32x4v*)(Ks + (e >> 3) * XA_KLD + (e & 7) * 8) = kp[i]; *(LAS u32x4v*)(VT + (e >> 5) * XA_VLD + (e & 31) * 8) = vp[i]; }
    __syncthreads();
#pragma unroll
    for (int rb = 0; rb < 2; ++rb) {
        f32x4 acc[16];
#pragma unroll
        for (int mb = 0; mb < 16; ++mb) { acc[mb] = (f32x4){0.f, 0.f, 0.f, 0.f};
#pragma unroll
            for (int s_ = 0; s_ < 2; ++s_) acc[mb] = MFMA16(ld_frag(Ks, XA_KLD, mb * 16, s_ * 32, lane), qf[rb][s_], acc[mb]); }
        float m_ = -3.0e38f;
#pragma unroll
        for (int mb = 0; mb < 16; ++mb)
#pragma unroll
            for (int r = 0; r < 4; ++r) { acc[mb][r] *= 0.125f; m_ = fmaxf(m_, acc[mb][r]); }
        m_ = fmaxf(m_, __shfl_xor(m_, 16)); m_ = fmaxf(m_, __shfl_xor(m_, 32));
        float sm = 0.f; u32x2 pk[16];
#pragma unroll
        for (int mb = 0; mb < 16; ++mb) { float p[4];
#pragma unroll
            for (int r = 0; r < 4; ++r) { p[r] = __expf(acc[mb][r] - m_); sm += p[r]; }
            pk[mb] = pack4(p[0], p[1], p[2], p[3]); }
        sm += __shfl_xor(sm, 16); sm += __shfl_xor(sm, 32);
        f32x4 o4[4];
#pragma unroll
        for (int db = 0; db < 4; ++db) o4[db] = (f32x4){0.f, 0.f, 0.f, 0.f};
#pragma unroll
        for (int ks = 0; ks < 8; ++ks) {
            bf16x8 pb; { const u32x4v t4 = (u32x4v){pk[2 * ks].x, pk[2 * ks].y, pk[2 * ks + 1].x, pk[2 * ks + 1].y}; pb = __builtin_bit_cast(bf16x8, t4); }
#pragma unroll
            for (int db = 0; db < 4; ++db) { const LAS bf16* vpn = VT + (db * 16 + l15) * XA_VLD + ks * 32 + quad * 4;
                const u32x2 v0 = *(const LAS u32x2*)vpn, v1 = *(const LAS u32x2*)(vpn + 16);
                const u32x4v t4 = (u32x4v){v0.x, v0.y, v1.x, v1.y};
                o4[db] = MFMA16(__builtin_bit_cast(bf16x8, t4), pb, o4[db]); } }
        const float inv = 1.f / sm; const int t = t0 + wave * 32 + rb * 16 + l15;
#pragma unroll
        for (int db = 0; db < 4; ++db) { const u32x2 g = gx[rb][db];
            *(u32x2*)(Y + (size_t)t * D + 768 + h * 64 + db * 16 + quad * 4) = pack4(o4[db][0] * inv * silu_f(bf2f(g.x & 0xffffu)), o4[db][1] * inv * silu_f(bf2f(g.x >> 16)),
                                                                                   o4[db][2] * inv * silu_f(bf2f(g.y & 0xffffu)), o4[db][3] * inv * silu_f(bf2f(g.y >> 16))); }
    }
    __syncthreads();
}

__device__ __forceinline__ void conv8x8(const bf16* U, int ts, int col, const float* cw, const float* cb, float (&o)[8][8]) {
    bf16x8 rows[11];
#pragma unroll
    for (int i = 0; i < 11; ++i) { const int tt = ts - 3 + i; rows[i] = (bf16x8){0, 0, 0, 0, 0, 0, 0, 0}; if (tt >= 0) rows[i] = *(const bf16x8*)(U + (size_t)tt * NU + col); }
    float w[4][8], b[8];
#pragma unroll
    for (int k = 0; k < 8; ++k) { b[k] = cb[col + k];
#pragma unroll
        for (int j = 0; j < 4; ++j) w[j][k] = cw[j * 1024 + col + k]; }
#pragma unroll
    for (int tok = 0; tok < 8; ++tok)
#pragma unroll
        for (int k = 0; k < 8; ++k) {
            const float a = b[k] + w[0][k] * us2f(rows[tok][k]) + w[1][k] * us2f(rows[tok + 1][k]) + w[2][k] * us2f(rows[tok + 2][k]) + w[3][k] * us2f(rows[tok + 3][k]);
            o[tok][k] = silu_f(a); }
}
__device__ __forceinline__ void ssd_dt(const Params& P, int l, int g, float raw, LAS float* dtS, LAS float* acS, int tid) {
    if (tid < 256) { const int hh = tid >> 6, q = tid & 63, h = g * 4 + hh;
        const float dt = softplus_f(raw + PBP(P, PB_DTB)[l * 8 + h]);
        const float A = -__expf(PBP(P, PB_ALOG)[l * 8 + h]);
        float v = dt * A;
#pragma unroll
        for (int o = 1; o < 64; o <<= 1) { const float t = __shfl_up(v, o); if (q >= o) v += t; }
        dtS[hh * 64 + q] = dt; acS[hh * 64 + q] = v; }
}
constexpr int S1_LDS = 2048 + (4 * 64 * 72 + 128 * 72) * 2;
__device__ __forceinline__ void stage_ssd_s1(const Params& P, int l, LAS unsigned char* lds, int item) {
    const int tid = otid(), lane = tid & 63, wave = tid >> 6, quad = lane >> 4, l15 = lane & 15;
    const int c = item >> 1, g = item & 1, t0 = c * 64;
    LAS float* dtS = (LAS float*)lds; LAS float* acS = dtS + 256; LAS bf16* XT = (LAS bf16*)(lds + 2048); LAS bf16* BT = XT + 4 * 64 * 72;
    const bf16* U = (const bf16*)(P.ws + WS_U);
    const float raw = tid < 256 ? bf2f(U[(size_t)(t0 + (tid & 63)) * NU + C_DT + g * 4 + (tid >> 6)]) : 0.f;
    const int tseg = tid & 7, cg = tid >> 3; const bool isx = cg < 32;
    const int j0 = isx ? cg * 8 : (cg - 32) * 8, col = isx ? C_XS + g * 256 + j0 : C_B + g * 128 + j0;
    float o[8][8];
    if (tid < 384) conv8x8(U, t0 + tseg * 8, col, PBP(P, PB_CONVW) + (size_t)l * 4 * 1024, PBP(P, PB_CONVB) + l * 1024, o);
    ssd_dt(P, l, g, raw, dtS, acS, tid);
    __syncthreads();
    if (tid < 384) {
        const int hh = j0 >> 6, p0 = j0 & 63;
        float sc[8];
#pragma unroll
        for (int tok = 0; tok < 8; ++tok) { const int q = tseg * 8 + tok; sc[tok] = isx ? dtS[hh * 64 + q] * __expf(acS[hh * 64 + 63] - acS[hh * 64 + q]) : 1.f; }
        LAS bf16* dst = isx ? XT + (hh * 64 + p0) * 72 + tseg * 8 : BT + j0 * 72 + tseg * 8;
#pragma unroll
        for (int k = 0; k < 8; ++k) { bf16x8 v;
#pragma unroll
            for (int tok = 0; tok < 8; ++tok) v[tok] = (short)f2bf(o[tok][k] * sc[tok]);
            *(LAS bf16x8*)(dst + k * 72) = v; }
    }
    __syncthreads();
    { const int hh = wave >> 1, nh = wave & 1, h = g * 4 + hh;
        bf16* ST = (bf16*)(P.ws + WS_ST) + ((size_t)(c * 8 + h) * 64) * 128;
#pragma unroll
        for (int pb = 0; pb < 4; ++pb)
#pragma unroll
            for (int nb = 0; nb < 4; ++nb) { f32x4 acc = (f32x4){0.f, 0.f, 0.f, 0.f};
#pragma unroll
                for (int ks = 0; ks < 2; ++ks) acc = MFMA16(ld_frag(BT, 72, nh * 64 + nb * 16, ks * 32, lane), ld_frag(XT + hh * 64 * 72, 72, pb * 16, ks * 32, lane), acc);
                *(u32x2*)(ST + (size_t)(pb * 16 + l15) * 128 + nh * 64 + nb * 16 + quad * 4) = pack4(acc[0], acc[1], acc[2], acc[3]); }
        if (tid < 4) ((float*)(P.ws + WS_CD))[c * 8 + g * 4 + tid] = __expf(acS[tid * 64 + 63]);
    }
    __syncthreads();
}
__device__ __forceinline__ void stage_ssd_scan(const Params& P, LAS unsigned char* lds, int blk) {
    const int tid = otid(), pi = tid & 63, seg = tid >> 6;
    LAS float* cdS = (LAS float*)lds; LAS float* segL = cdS + 256; LAS float* segD = segL + 8 * 128;
    bf16* ST = (bf16*)(P.ws + WS_ST); const float* CD = (const float*)(P.ws + WS_CD);
    const int e0 = blk * 128 + pi * 2, h = (blk * 128) >> 13;
    if (tid < 256) cdS[tid] = CD[tid * 8 + h];
    unsigned v[32];
#pragma unroll
    for (int k = 0; k < 32; ++k) v[k] = *(const unsigned*)(ST + (size_t)(seg * 32 + k) * 65536 + e0);
    __syncthreads();
    float L0 = 0.f, L1 = 0.f, Dt = 1.f;
#pragma unroll
    for (int k = 0; k < 32; ++k) { const float d = cdS[seg * 32 + k]; L0 = L0 * d + bf2f(v[k] & 0xffffu); L1 = L1 * d + bf2f(v[k] >> 16); Dt *= d; }
    segL[seg * 128 + pi * 2] = L0; segL[seg * 128 + pi * 2 + 1] = L1; if (pi == 0) segD[seg] = Dt;
    __syncthreads();
    float c0 = 0.f, c1 = 0.f;
    for (int s2 = 0; s2 < seg; ++s2) { const float d = segD[s2]; c0 = c0 * d + segL[s2 * 128 + pi * 2]; c1 = c1 * d + segL[s2 * 128 + pi * 2 + 1]; }
#pragma unroll
    for (int k = 0; k < 32; ++k) { const float d = cdS[seg * 32 + k]; const unsigned o = f2bf(c0) | (f2bf(c1) << 16);
        c0 = c0 * d + bf2f(v[k] & 0xffffu); c1 = c1 * d + bf2f(v[k] >> 16);
        *(unsigned*)(ST + (size_t)(seg * 32 + k) * 65536 + e0) = o; }
    __syncthreads();
}
constexpr int S3_LDS = 3072 + (2 * 64 * 136 + 4 * 64 * 72 + 8 * 32 * 72) * 2;
__device__ __forceinline__ void stage_ssd_s3(const Params& P, int l, LAS unsigned char* lds, int item) {
    const int tid = otid(), lane = tid & 63, wave = tid >> 6, quad = lane >> 4, l15 = lane & 15;
    const int c = item >> 1, g = item & 1, t0 = c * 64;
    LAS float* dtS = (LAS float*)lds; LAS float* acS = dtS + 256; LAS float* red = acS + 256;
    LAS bf16* Cn = (LAS bf16*)(lds + 3072); LAS bf16* Bn = Cn + 64 * 136; LAS bf16* XT = Bn + 64 * 136; LAS bf16* SCw = XT + 4 * 64 * 72 + wave * 32 * 72;
    const bf16* U = (const bf16*)(P.ws + WS_U); bf16* Y = (bf16*)(P.ws + WS_H);
    const int hh = wave >> 1, qh = wave & 1, h = g * 4 + hh;
    const float raw = tid < 256 ? bf2f(U[(size_t)(t0 + (tid & 63)) * NU + C_DT + g * 4 + (tid >> 6)]) : 0.f;
    u32x2 zz[2][4];
#pragma unroll
    for (int qb = 0; qb < 2; ++qb)
#pragma unroll
        for (int pb = 0; pb < 4; ++pb) zz[qb][pb] = *(const u32x2*)(U + (size_t)(t0 + qh * 32 + qb * 16 + l15) * NU + C_Z + h * 64 + pb * 16 + quad * 4);
    {
        const int tseg = tid & 7, cg = tid >> 3; const int kind = cg < 32 ? 0 : (cg < 48 ? 1 : 2);
        const int j0 = kind == 0 ? cg * 8 : (kind == 1 ? (cg - 32) * 8 : (cg - 48) * 8);
        const int col = kind == 0 ? C_XS + g * 256 + j0 : (kind == 1 ? C_B + g * 128 + j0 : C_C + g * 128 + j0);
        float o[8][8];
        conv8x8(U, t0 + tseg * 8, col, PBP(P, PB_CONVW) + (size_t)l * 4 * 1024, PBP(P, PB_CONVB) + l * 1024, o);
        ssd_dt(P, l, g, raw, dtS, acS, tid);
        __syncthreads();
        if (kind == 0) { const int hh2 = j0 >> 6, p0 = j0 & 63;
#pragma unroll
            for (int k = 0; k < 8; ++k) { bf16x8 v;
#pragma unroll
                for (int tok = 0; tok < 8; ++tok) v[tok] = (short)f2bf(o[tok][k] * dtS[hh2 * 64 + tseg * 8 + tok]);
                *(LAS bf16x8*)(XT + (hh2 * 64 + p0 + k) * 72 + tseg * 8) = v; }
        } else { LAS bf16* dst = (kind == 1 ? Bn : Cn) + (tseg * 8) * 136 + j0;
#pragma unroll
            for (int tok = 0; tok < 8; ++tok) { bf16x8 v;
#pragma unroll
                for (int k = 0; k < 8; ++k) v[k] = (short)f2bf(o[tok][k]);
                *(LAS bf16x8*)(dst + tok * 136) = v; } }
    }
    const bf16* ST = (const bf16*)(P.ws + WS_ST) + ((size_t)(c * 8 + h) * 64) * 128;
    bf16x8 pf[4][4];
#pragma unroll
    for (int pb = 0; pb < 4; ++pb)
#pragma unroll
        for (int ks = 0; ks < 4; ++ks) pf[pb][ks] = *(const bf16x8*)(ST + (size_t)(pb * 16 + l15) * 128 + ks * 32 + quad * 8);
    __syncthreads();
#pragma unroll
    for (int qb = 0; qb < 2; ++qb)
#pragma unroll
        for (int sb = 0; sb < 4; ++sb) { f32x4 acc = (f32x4){0.f, 0.f, 0.f, 0.f};
#pragma unroll
            for (int ks = 0; ks < 4; ++ks) acc = MFMA16(ld_frag(Bn, 136, sb * 16, ks * 32, lane), ld_frag(Cn, 136, qh * 32 + qb * 16, ks * 32, lane), acc);
            const int q = qh * 32 + qb * 16 + l15; const float aq = acS[hh * 64 + q]; float v[4];
#pragma unroll
            for (int r = 0; r < 4; ++r) { const int s_ = sb * 16 + quad * 4 + r; v[r] = (s_ <= q) ? acc[r] * __expf(aq - acS[hh * 64 + s_]) : 0.f; }
            *(LAS u32x2*)(SCw + (qb * 16 + l15) * 72 + sb * 16 + quad * 4) = pack4(v[0], v[1], v[2], v[3]); }
    asm volatile("s_waitcnt lgkmcnt(0)" ::: "memory");
    f32x4 y[2][4];
    float ssq[2] = {0.f, 0.f};
#pragma unroll
    for (int qb = 0; qb < 2; ++qb)
#pragma unroll
        for (int pb = 0; pb < 4; ++pb) { f32x4 yd = (f32x4){0.f, 0.f, 0.f, 0.f}, yo = (f32x4){0.f, 0.f, 0.f, 0.f};
#pragma unroll
            for (int ks = 0; ks < 2; ++ks) yd = MFMA16(ld_frag(XT + hh * 64 * 72, 72, pb * 16, ks * 32, lane), ld_frag(SCw, 72, qb * 16, ks * 32, lane), yd);
#pragma unroll
            for (int ks = 0; ks < 4; ++ks) yo = MFMA16(pf[pb][ks], ld_frag(Cn, 136, qh * 32 + qb * 16, ks * 32, lane), yo);
            const int q = qh * 32 + qb * 16 + l15; const float eq = __expf(acS[hh * 64 + q]), idt = 1.f / dtS[hh * 64 + q], dsk = PBP(P, PB_DSKIP)[l * 8 + h];
            const u32x2 z2 = zz[qb][pb];
#pragma unroll
            for (int r = 0; r < 4; ++r) { const int p = pb * 16 + quad * 4 + r;
                const float xs = bf2f(XT[(hh * 64 + p) * 72 + q]) * idt;
                const unsigned zw = r < 2 ? z2.x : z2.y; const float z = bf2f((r & 1) ? (zw >> 16) : (zw & 0xffffu));
                const float v = (yd[r] + eq * yo[r] + dsk * xs) * silu_f(z);
                y[qb][pb][r] = v; ssq[qb] += v * v; } }
#pragma unroll
    for (int qb = 0; qb < 2; ++qb) { float s_ = ssq[qb]; s_ += __shfl_xor(s_, 16); s_ += __shfl_xor(s_, 32);
        if (quad == 0) red[hh * 64 + qh * 32 + qb * 16 + l15] = s_; }
    __syncthreads();
#pragma unroll
    for (int qb = 0; qb < 2; ++qb) { const int q = qh * 32 + qb * 16 + l15;
        const float tot = red[q] + red[64 + q] + red[128 + q] + red[192 + q]; const float rstd = rsqrtf(tot * (1.f / 256.f) + NORM_EPS);
#pragma unroll
        for (int pb = 0; pb < 4; ++pb) { const int p = pb * 16 + quad * 4; const f32x4 nw = *(const f32x4*)(PBP(P, PB_SSMNW) + l * 512 + h * 64 + p);
            *(u32x2*)(Y + (size_t)(t0 + q) * D + h * 64 + p) = pack4(y[qb][pb][0] * rstd * nw[0], y[qb][pb][1] * rstd * nw[1], y[qb][pb][2] * rstd * nw[2], y[qb][pb][3] * rstd * nw[3]); } }
    __syncthreads();
}

constexpr int RW_AT = 0, RW_RT = 9216, RW_KT = 18432, RW_BT = 27648, RW_VT = 36864, RW_KHT = 46080, RW_BHT = 55296, RW_X1T = 64512, RW_X2T = 73728,
              RW_MAK = 82944, RW_MRK = 92160, RW_MRB = 101376, RW_MAB = 110592, RW_TOT = 128000, RW_WC = 130048, RW_AAF = 130304, RW_END = 146688;
constexpr int RW_RHS2 = RW_KT;
constexpr int RW_LATW = RW_X1T, RW_LATA = RW_X2T, RW_W2T = RW_MAK, RW_A2T = RW_MRK, RW_AWF = RW_MAB;
constexpr int RW_MOFF = RW_AAF, RW_TB = RW_AAF + 9216, RW_RPT = RW_MAK;
__device__ __forceinline__ float tanh_f(float x) { return 1.f - 2.f / (1.f + __expf(2.f * x)); }

__device__ __forceinline__ void stage_rwkv_p1(const Params& P, int l, LAS unsigned char* lds, int pi) {
    const int tid = otid(), lane = tid & 63, wave = __builtin_amdgcn_readfirstlane(tid >> 6), quad = lane >> 4, l15 = lane & 15;
    const int c = pi >> 2, h = pi & 3, t0 = c * 64;
    LAS bf16* At = (LAS bf16*)(lds + RW_AT); LAS bf16* Rt = (LAS bf16*)(lds + RW_RT); LAS bf16* Kt = (LAS bf16*)(lds + RW_KT); LAS bf16* Bt = (LAS bf16*)(lds + RW_BT);
    LAS bf16* VT = (LAS bf16*)(lds + RW_VT); LAS bf16* KhT = (LAS bf16*)(lds + RW_KHT); LAS bf16* BhT = (LAS bf16*)(lds + RW_BHT);
    LAS bf16* X1T = (LAS bf16*)(lds + RW_X1T); LAS bf16* X2T = (LAS bf16*)(lds + RW_X2T);
    LAS bf16* Mak = (LAS bf16*)(lds + RW_MAK); LAS bf16* Mrk = (LAS bf16*)(lds + RW_MRK); LAS bf16* Mrb = (LAS bf16*)(lds + RW_MRB);
    LAS float* Mab = (LAS float*)(lds + RW_MAB); LAS float* RHS2 = (LAS float*)(lds + RW_RHS2);
    LAS float* tot = (LAS float*)(lds + RW_TOT); LAS float* wCs = (LAS float*)(lds + RW_WC); LAS float* aaF = (LAS float*)(lds + RW_AAF); LAS float* awF = (LAS float*)(lds + RW_AWF);
    LAS bf16* latw = (LAS bf16*)(lds + RW_LATW); LAS bf16* lata = (LAS bf16*)(lds + RW_LATA); LAS bf16* w2T = (LAS bf16*)(lds + RW_W2T); LAS bf16* a2T = (LAS bf16*)(lds + RW_A2T);
    LAS bf16* Moff = (LAS bf16*)(lds + RW_MOFF); LAS bf16* Tb = (LAS bf16*)(lds + RW_TB);
    const bf16* U = (const bf16*)(P.ws + WS_U);
    const float* mu = PBP(P, PB_MU) + (size_t)l * 1152;
    const bf16* ucr = U + (size_t)(t0 + (tid >> 3)) * NU + h * 64 + (tid & 7) * 8;
    const bf16x8 cr = *(const bf16x8*)(ucr + C_R), ck = *(const bf16x8*)(ucr + C_K), cv = *(const bf16x8*)(ucr + C_V);
    bf16x8 pr = (bf16x8){0, 0, 0, 0, 0, 0, 0, 0}, pk = pr, pv = pr;
    if (t0 + (tid >> 3) > 0) { pr = *(const bf16x8*)(ucr - NU + C_R); pk = *(const bf16x8*)(ucr - NU + C_K); pv = *(const bf16x8*)(ucr - NU + C_V); }
    {   const int t = tid >> 3, jg = tid & 7, tg = t0 + t;
        const bf16* uc = U + (size_t)tg * NU + C_WL + jg * 8;
        const bf16x8 cw = *(const bf16x8*)uc, ca = *(const bf16x8*)(uc + 64);
        bf16x8 pw = (bf16x8){0, 0, 0, 0, 0, 0, 0, 0}, pa = pw;
        if (tg > 0) { pw = *(const bf16x8*)(uc - NU); pa = *(const bf16x8*)(uc - NU + 64); }
        bf16x8 ow, oa, w2v, a2v;
#pragma unroll
        for (int jj = 0; jj < 8; ++jj) { const int j = jg * 8 + jj;
            const float cv = us2f(cw[jj]), pv = us2f(pw[jj]); ow[jj] = (short)f2bf(tanh_f(cv + (pv - cv) * mu[1024 + j]));
            const float cv2 = us2f(ca[jj]), pv2 = us2f(pa[jj]); oa[jj] = (short)f2bf(cv2 + (pv2 - cv2) * mu[1088 + j]);
            w2v[jj] = (short)f2bf(PBP(P, PB_W2)[((size_t)l * 64 + j) * 256 + h * 64 + t]); a2v[jj] = (short)f2bf(PBP(P, PB_A2)[((size_t)l * 64 + j) * 256 + h * 64 + t]); }
        *(LAS bf16x8*)(latw + t * 72 + jg * 8) = ow; *(LAS bf16x8*)(lata + t * 72 + jg * 8) = oa;
        *(LAS bf16x8*)(w2T + t * 72 + jg * 8) = w2v; *(LAS bf16x8*)(a2T + t * 72 + jg * 8) = a2v;
    }
    __syncthreads();
    {   const int tb = wave & 3; const bool isA = wave >= 4;
        const LAS bf16* Am = isA ? lata : latw; const LAS bf16* Bm = isA ? a2T : w2T; LAS float* Of = isA ? aaF : awF; const int ofs = isA ? 64 : 68;
#pragma unroll
        for (int cb = 0; cb < 4; ++cb) { f32x4 acc = (f32x4){0.f, 0.f, 0.f, 0.f};
#pragma unroll
            for (int ks = 0; ks < 2; ++ks) acc = MFMA16(ld_frag(Am, 72, tb * 16, ks * 32, lane), ld_frag(Bm, 72, cb * 16, ks * 32, lane), acc);
#pragma unroll
            for (int r = 0; r < 4; ++r) Of[(tb * 16 + quad * 4 + r) * ofs + cb * 16 + l15] = acc[r]; }
    }
    __syncthreads();
    {   const int t = tid >> 3, cg = tid & 7, tg = t0 + t, ch0 = cg * 8, gch = h * 64 + ch0;
        float rr[8], k2[8], vv[8], kkn[8], aS[8], lw[8], Lc[8];
        float ss = 0.f, bsum = 0.f;
#pragma unroll
        for (int jj = 0; jj < 8; ++jj) { const int gc = gch + jj, pc = l * 256 + gc;
            float a_ = us2f(cr[jj]), b_ = us2f(pr[jj]); const float r = a_ + (b_ - a_) * mu[gc];
            a_ = us2f(ck[jj]); b_ = us2f(pk[jj]); const float k = a_ + (b_ - a_) * mu[256 + gc];
            a_ = us2f(cv[jj]); b_ = us2f(pv[jj]); const float v = a_ + (b_ - a_) * mu[512 + gc];
            const float aw = awF[t * 68 + ch0 + jj] + PBP(P, PB_W0)[pc], aa = aaF[t * 64 + ch0 + jj] + PBP(P, PB_A0)[pc];
            lw[jj] = -0.60653066f * sigmoid_f(aw); const float a = sigmoid_f(aa);
            const float kr = k * PBP(P, PB_KK)[pc]; ss += kr * kr; kkn[jj] = kr;
            k2[jj] = k * (1.f + (a - 1.f) * PBP(P, PB_KA)[pc]); aS[jj] = a; rr[jj] = r; vv[jj] = v;
            bsum += r * k2[jj] * PBP(P, PB_RK)[pc]; Lc[jj] = lw[jj]; }
#pragma unroll
        for (int o = 1; o < 8; o <<= 1) { ss += __shfl_xor(ss, o); bsum += __shfl_xor(bsum, o); }
        const float inv = 1.f / fmaxf(sqrtf(ss), 1e-12f);
        if (cg == 0) ((float*)(P.ws + WS_BS))[(size_t)tg * 4 + h] = bsum;
#pragma unroll
        for (int o = 8; o < 64; o <<= 1)
#pragma unroll
            for (int jj = 0; jj < 8; ++jj) { const float tmp = __shfl_up(Lc[jj], o); if (lane >= o) Lc[jj] += tmp; }
        if ((lane >> 3) == 7) {
#pragma unroll
            for (int jj = 0; jj < 8; ++jj) tot[wave * 64 + ch0 + jj] = Lc[jj]; }
        __syncthreads();
        bf16x8 oA, oR, oK, oB;
#pragma unroll
        for (int jj = 0; jj < 8; ++jj) { float base = 0.f, LC = 0.f;
#pragma unroll
            for (int w2 = 0; w2 < 8; ++w2) { const float tv = tot[w2 * 64 + ch0 + jj]; base += w2 < wave ? tv : 0.f; LC += tv; }
            const float L = Lc[jj] + base; const float kk = kkn[jj] * inv, b = kk * aS[jj];
            const float eL = __expf(L), eiL = __expf(-L), eh = __expf(LC - L);
            oA[jj] = (short)f2bf(-kk * __expf(L - lw[jj])); oR[jj] = (short)f2bf(rr[jj] * eL); oK[jj] = (short)f2bf(k2[jj] * eiL); oB[jj] = (short)f2bf(b * eiL);
            VT[(ch0 + jj) * 72 + t] = (bf16)f2bf(vv[jj]); KhT[(ch0 + jj) * 72 + t] = (bf16)f2bf(k2[jj] * eh); BhT[(ch0 + jj) * 72 + t] = (bf16)f2bf(b * eh);
            if (t == 63) wCs[ch0 + jj] = __expf(LC); }
        *(LAS bf16x8*)(At + t * 72 + ch0) = oA; *(LAS bf16x8*)(Rt + t * 72 + ch0) = oR; *(LAS bf16x8*)(Kt + t * 72 + ch0) = oK; *(LAS bf16x8*)(Bt + t * 72 + ch0) = oB;
    }
    __syncthreads();
    {   const int mat = wave >> 1, half = wave & 1;
        const LAS bf16* Am = mat < 2 ? At : Rt; const LAS bf16* Bm = (mat == 0 || mat == 3) ? Bt : Kt;
        LAS bf16* Ob = mat == 1 ? Mak : (mat == 2 ? Mrk : Mrb);
#pragma unroll
        for (int tbi = 0; tbi < 2; ++tbi)
#pragma unroll
            for (int sb = 0; sb < 4; ++sb) { const int tb = half * 2 + tbi; f32x4 acc = (f32x4){0.f, 0.f, 0.f, 0.f};
                if (sb <= tb) {
#pragma unroll
                    for (int ks = 0; ks < 2; ++ks) acc = MFMA16(ld_frag(Am, 72, tb * 16, ks * 32, lane), ld_frag(Bm, 72, sb * 16, ks * 32, lane), acc); }
#pragma unroll
                for (int r = 0; r < 4; ++r) { const int t = tb * 16 + quad * 4 + r, s_ = sb * 16 + l15;
                    const bool keep = mat < 2 ? (s_ < t) : (s_ <= t); const float val = keep ? acc[r] : 0.f;
                    if (mat == 0) { Mab[t * 68 + s_] = val; Moff[t * 72 + s_] = (bf16)(sb < tb ? f2bf(val) : 0u); } else Ob[t * 72 + s_] = (bf16)f2bf(val); } }
    }
    __syncthreads();
    if (wave == 0) {
        for (int e = lane; e < 320; e += 64) *(LAS u32x4v*)(Tb + e * 8) = (u32x4v){0u, 0u, 0u, 0u};
        const int b = quad, cc = l15;
        unsigned ma = (unsigned)(uintptr_t)(Mab + (16 * b) * 68 + 16 * b); asm volatile("" : "+v"(ma)); const LAS float* Mv = (const LAS float*)(uintptr_t)ma;
        float x[16];
#pragma unroll
        for (int t = 0; t < 16; ++t) { float a = t == cc ? 1.f : 0.f;
#pragma unroll
            for (int s_ = 0; s_ < t; ++s_) a += Mv[t * 68 + s_] * x[s_];
            asm volatile("" : "+v"(a) :: "memory");
            x[t] = a; }
#pragma unroll
        for (int t = 0; t < 16; ++t) Tb[(b * 16 + t) * 40 + cc] = (bf16)f2bf(x[t]);
    } else {
        for (int tile = wave - 1; tile < 16; tile += 7) { const int tb = tile >> 2, ib = tile & 3; f32x4 acc = (f32x4){0.f, 0.f, 0.f, 0.f};
#pragma unroll
            for (int ks = 0; ks < 2; ++ks) acc = MFMA16(ld_frag(Mak, 72, tb * 16, ks * 32, lane), ld_frag(VT, 72, ib * 16, ks * 32, lane), acc);
#pragma unroll
            for (int r = 0; r < 4; ++r) RHS2[(tb * 16 + quad * 4 + r) * 68 + ib * 16 + l15] = acc[r]; }
    }
    __syncthreads();
    {   LAS bf16* XTw = (wave < 4 ? X1T : X2T) + (wave & 3) * 16 * 72; LAS bf16* Rp = (LAS bf16*)(lds + RW_RPT) + wave * 512;
        for (int e = lane; e < 144; e += 64) *(LAS u32x4v*)(XTw + e * 8) = (u32x4v){0u, 0u, 0u, 0u};
        *(LAS u32x4v*)(Rp + lane * 8) = (u32x4v){0u, 0u, 0u, 0u};
#pragma unroll
        for (int b = 0; b < 4; ++b) {
            f32x4 acc;
#pragma unroll
            for (int r = 0; r < 4; ++r) { const int t = 16 * b + quad * 4 + r; acc[r] = wave < 4 ? bf2f(At[t * 72 + wave * 16 + l15]) : RHS2[t * 68 + (wave - 4) * 16 + l15]; }
            asm volatile("s_waitcnt lgkmcnt(0)" ::: "memory");
            if (b >= 1) acc = MFMA16(ld_frag(Moff, 72, 16 * b, 0, lane), ld_frag(XTw, 72, 0, 0, lane), acc);
            if (b == 3) acc = MFMA16(ld_frag(Moff, 72, 48, 32, lane), ld_frag(XTw, 72, 0, 32, lane), acc);
            *(LAS u32x2*)(Rp + l15 * 32 + quad * 4) = pack4(acc[0], acc[1], acc[2], acc[3]);
            asm volatile("s_waitcnt lgkmcnt(0)" ::: "memory");
            const f32x4 xb = MFMA16(ld_frag(Tb + b * 640, 40, 0, 0, lane), ld_frag(Rp, 32, 0, 0, lane), ((f32x4){0.f, 0.f, 0.f, 0.f}));
            *(LAS u32x2*)(XTw + l15 * 72 + 16 * b + quad * 4) = pack4(xb[0], xb[1], xb[2], xb[3]);
            asm volatile("s_waitcnt lgkmcnt(0)" ::: "memory");
        }
    }
    __syncthreads();
    {   const int mat = wave >> 1, half = wave & 1;
        bf16* Q1g = (bf16*)(P.ws + WS_Q1) + (size_t)pi * 4096; bf16* Y0g = (bf16*)(P.ws + WS_Y0) + (size_t)pi * 4096;
        bf16* PcTg = (bf16*)(P.ws + WS_PCT) + (size_t)pi * 4096; bf16* Gcg = (bf16*)(P.ws + WS_GC) + (size_t)pi * 4096;
        const LAS bf16* A1 = (mat == 0 || mat == 2) ? X1T : (mat == 1 ? VT : KhT);
        const LAS bf16* B1 = mat == 0 ? Mrb : (mat == 1 ? Mrk : (mat == 2 ? BhT : VT));
        const LAS bf16* A2 = mat == 1 ? X2T : BhT; const LAS bf16* B2 = mat == 1 ? Mrb : X2T;
#pragma unroll
        for (int rbi = 0; rbi < 2; ++rbi)
#pragma unroll
            for (int cb = 0; cb < 4; ++cb) { const int rb = half * 2 + rbi; f32x4 acc = (f32x4){0.f, 0.f, 0.f, 0.f};
#pragma unroll
                for (int ks = 0; ks < 2; ++ks) acc = MFMA16(ld_frag(A1, 72, rb * 16, ks * 32, lane), ld_frag(B1, 72, cb * 16, ks * 32, lane), acc);
                if (mat == 1 || mat == 3) {
#pragma unroll
                    for (int ks = 0; ks < 2; ++ks) acc = MFMA16(ld_frag(A2, 72, rb * 16, ks * 32, lane), ld_frag(B2, 72, cb * 16, ks * 32, lane), acc); }
                const int r0 = rb * 16 + quad * 4, cl = cb * 16 + l15;
                if (mat == 0) { const u32x2 rt = *(const LAS u32x2*)(Rt + cl * 72 + r0);
                    *(u32x2*)(Q1g + cl * 64 + r0) = pack4(acc[0] + bf2f(rt.x & 0xffffu), acc[1] + bf2f(rt.x >> 16), acc[2] + bf2f(rt.y & 0xffffu), acc[3] + bf2f(rt.y >> 16)); }
                else if (mat == 1) *(u32x2*)(Y0g + cl * 64 + r0) = pack4(acc[0], acc[1], acc[2], acc[3]);
                else if (mat == 2) { const float wc = wCs[cl];
                    *(u32x2*)(PcTg + cl * 64 + r0) = pack4(acc[0] + (r0 == cl ? wc : 0.f), acc[1] + (r0 + 1 == cl ? wc : 0.f), acc[2] + (r0 + 2 == cl ? wc : 0.f), acc[3] + (r0 + 3 == cl ? wc : 0.f)); }
                else *(u32x2*)(Gcg + ((cb * 64 + lane) * 4 + rb) * 4) = pack4(acc[0], acc[1], acc[2], acc[3]); }
    }
    __syncthreads();
}

constexpr int CH_PT = 0, CH_SB = 8 * 9216, CH_END = CH_SB + 8 * 2304;
__device__ __forceinline__ void chain_step(f32x4 (&acc)[4], const LAS bf16* PTs, LAS bf16* Sb, const u32x4v (&gf)[2], bool withG, int lane) {
    const int quad = lane >> 4, l15 = lane & 15;
#pragma unroll
    for (int jb = 0; jb < 4; ++jb) *(LAS u32x2*)(Sb + l15 * 72 + jb * 16 + quad * 4) = pack4(acc[jb][0], acc[jb][1], acc[jb][2], acc[jb][3]);
    asm volatile("s_waitcnt lgkmcnt(0)" ::: "memory");
    const bf16x8 b0 = ld_frag(Sb, 72, 0, 0, lane), b1 = ld_frag(Sb, 72, 0, 32, lane);
#pragma unroll
    for (int jb = 0; jb < 4; ++jb) { f32x4 n = (f32x4){0.f, 0.f, 0.f, 0.f};
        if (withG) { const unsigned g0 = gf[jb >> 1][(jb & 1) * 2], g1 = gf[jb >> 1][(jb & 1) * 2 + 1]; n = (f32x4){bf2f(g0 & 0xffffu), bf2f(g0 >> 16), bf2f(g1 & 0xffffu), bf2f(g1 >> 16)}; }
        n = MFMA16(ld_frag(PTs, 72, jb * 16, 0, lane), b0, n); n = MFMA16(ld_frag(PTs, 72, jb * 16, 32, lane), b1, n);
        acc[jb] = n; }
    asm volatile("s_waitcnt lgkmcnt(0)" ::: "memory");
}

__device__ __forceinline__ void stage_rwkv_compose(const Params& P, LAS unsigned char* lds, int task) {
    const int tid = otid(), lane = tid & 63, wave = __builtin_amdgcn_readfirstlane(tid >> 6), quad = lane >> 4, l15 = lane & 15;
    const int gI = task >> 2, h = task & 3, kind = wave >> 2, rb = wave & 3;
    LAS bf16* PTs = (LAS bf16*)(lds + CH_PT); LAS bf16* Sb = (LAS bf16*)(lds + CH_SB) + wave * 16 * 72;
    f32x4 acc[4];
#pragma unroll
    for (int jb = 0; jb < 4; ++jb)
#pragma unroll
        for (int r = 0; r < 4; ++r) acc[jb][r] = (kind == 0 && (jb * 16 + quad * 4 + r) == (rb * 16 + l15)) ? 1.f : 0.f;
    for (int bt = 0; bt < 2; ++bt) {
        const size_t pi0 = (size_t)((gI * 16 + bt * 8) * 4 + h);
        u32x4v pt[8], gf[8][2];
#pragma unroll
        for (int s_ = 0; s_ < 8; ++s_) { pt[s_] = *(const u32x4v*)((const bf16*)(P.ws + WS_PCT) + (pi0 + 4 * s_) * 4096 + tid * 8);
            gf[s_][0] = (u32x4v){0u, 0u, 0u, 0u}; gf[s_][1] = gf[s_][0];
            if (kind == 1) { const bf16* gp = (const bf16*)(P.ws + WS_GC) + (pi0 + 4 * s_) * 4096 + (rb * 64 + lane) * 16; gf[s_][0] = *(const u32x4v*)gp; gf[s_][1] = *(const u32x4v*)(gp + 8); } }
        __syncthreads();
#pragma unroll
        for (int s_ = 0; s_ < 8; ++s_) *(LAS u32x4v*)(PTs + s_ * 4608 + (tid >> 3) * 72 + (tid & 7) * 8) = pt[s_];
        __syncthreads();
#pragma unroll
        for (int s_ = 0; s_ < 8; ++s_) chain_step(acc, PTs + s_ * 4608, Sb, gf[s_], kind == 1, lane);
    }
    if (kind == 0) { bf16* PgTg = (bf16*)(P.ws + WS_PGT) + (size_t)task * 4096;
#pragma unroll
        for (int jb = 0; jb < 4; ++jb)
#pragma unroll
            for (int r = 0; r < 4; ++r) PgTg[(jb * 16 + quad * 4 + r) * 64 + rb * 16 + l15] = (bf16)f2bf(acc[jb][r]);
    } else { bf16* Ggg = (bf16*)(P.ws + WS_GG) + (size_t)task * 4096;
#pragma unroll
        for (int jb = 0; jb < 4; ++jb) *(u32x2*)(Ggg + ((rb * 64 + lane) * 4 + jb) * 4) = pack4(acc[jb][0], acc[jb][1], acc[jb][2], acc[jb][3]); }
    __syncthreads();
}

__device__ __forceinline__ void stage_rwkv_chain(const Params& P, LAS unsigned char* lds, int task) {
    const int tid = otid(), lane = tid & 63, wave = __builtin_amdgcn_readfirstlane(tid >> 6);
    const int gI = task >> 2, h = task & 3, rb = wave & 3, nsteps = gI + 16;
    LAS bf16* PTs = (LAS bf16*)(lds + CH_PT); LAS bf16* Sb = (LAS bf16*)(lds + CH_SB) + wave * 16 * 72;
    f32x4 acc[4];
#pragma unroll
    for (int jb = 0; jb < 4; ++jb) acc[jb] = (f32x4){0.f, 0.f, 0.f, 0.f};
    for (int s0 = 0; s0 < nsteps; s0 += 8) {
        u32x4v pt[8], gf[8][2];
#pragma unroll
        for (int s_ = 0; s_ < 8; ++s_) { const int sg = s0 + s_;
            pt[s_] = (u32x4v){0u, 0u, 0u, 0u}; gf[s_][0] = pt[s_]; gf[s_][1] = pt[s_];
            if (sg < nsteps) {
                const bool grp = sg < gI; const size_t idx = grp ? (size_t)(sg * 4 + h) : (size_t)((gI * 16 + sg - gI) * 4 + h);
                const bf16* ptp = (const bf16*)(P.ws + (grp ? WS_PGT : WS_PCT)) + idx * 4096; const bf16* gp = (const bf16*)(P.ws + (grp ? WS_GG : WS_GC)) + idx * 4096 + (rb * 64 + lane) * 16;
                pt[s_] = *(const u32x4v*)(ptp + tid * 8);
                if (wave < 4) { gf[s_][0] = *(const u32x4v*)gp; gf[s_][1] = *(const u32x4v*)(gp + 8); } } }
        __syncthreads();
#pragma unroll
        for (int s_ = 0; s_ < 8; ++s_) *(LAS u32x4v*)(PTs + s_ * 4608 + (tid >> 3) * 72 + (tid & 7) * 8) = pt[s_];
        __syncthreads();
        if (wave < 4) {
#pragma unroll
            for (int s_ = 0; s_ < 8; ++s_) { const int sg = s0 + s_;
                if (sg < nsteps) {
                    if (sg >= gI) {
                        const int quad = lane >> 4, l15 = lane & 15;
#pragma unroll
                        for (int jb = 0; jb < 4; ++jb) *(LAS u32x2*)(Sb + l15 * 72 + jb * 16 + quad * 4) = pack4(acc[jb][0], acc[jb][1], acc[jb][2], acc[jb][3]);
                        asm volatile("s_waitcnt lgkmcnt(0)" ::: "memory");
                        bf16* S0g = (bf16*)(P.ws + WS_S0) + (size_t)((gI * 16 + sg - gI) * 4 + h) * 4096 + (rb * 16 + (lane >> 2)) * 64 + (lane & 3) * 16;
                        const LAS bf16* sp = Sb + (lane >> 2) * 72 + (lane & 3) * 16;
                        *(u32x4v*)S0g = *(const LAS u32x4v*)sp; *(u32x4v*)(S0g + 8) = *(const LAS u32x4v*)(sp + 8);
                        asm volatile("s_waitcnt lgkmcnt(0)" ::: "memory"); }
                    chain_step(acc, PTs + s_ * 4608, Sb, gf[s_], true, lane); } }
        }
    }
    __syncthreads();
}

__device__ __forceinline__ void stage_rwkv_y(const Params& P, int l, int wt, int lane) {
    const int pi = wt >> 2, tb = wt & 3, c = pi >> 2, h = pi & 3, quad = lane >> 4, l15 = lane & 15;
    const bf16* S0g = (const bf16*)(P.ws + WS_S0) + (size_t)pi * 4096; const bf16* Q1g = (const bf16*)(P.ws + WS_Q1) + (size_t)pi * 4096; const bf16* Y0g = (const bf16*)(P.ws + WS_Y0) + (size_t)pi * 4096;
    const bf16* U = (const bf16*)(P.ws + WS_U); bf16* Y = (bf16*)(P.ws + WS_H);
    const int tl = tb * 16 + l15, tg = c * 64 + tl;
    const bf16* qp = Q1g + tl * 64 + quad * 8;
    const bf16x8 q0 = *(const bf16x8*)qp, q1 = *(const bf16x8*)(qp + 32);
    f32x4 y[4];
    u32x2 vc[4], vp[4], gc[4], gp[4];
    const bf16* uc = U + (size_t)tg * NU + h * 64 + quad * 4;
#pragma unroll
    for (int ib = 0; ib < 4; ++ib) {
        const u32x2 y0 = *(const u32x2*)(Y0g + tl * 64 + ib * 16 + quad * 4);
        y[ib] = (f32x4){bf2f(y0.x & 0xffffu), bf2f(y0.x >> 16), bf2f(y0.y & 0xffffu), bf2f(y0.y >> 16)};
        vc[ib] = *(const u32x2*)(uc + C_V + ib * 16); gc[ib] = *(const u32x2*)(uc + C_G + ib * 16);
        vp[ib] = (u32x2){0u, 0u}; gp[ib] = (u32x2){0u, 0u};
        if (tg > 0) { vp[ib] = *(const u32x2*)(uc - NU + C_V + ib * 16); gp[ib] = *(const u32x2*)(uc - NU + C_G + ib * 16); } }
    const float bs = ((const float*)(P.ws + WS_BS))[(size_t)tg * 4 + h];
#pragma unroll
    for (int ib = 0; ib < 4; ++ib) { const bf16* sp = S0g + (ib * 16 + l15) * 64 + quad * 8;
        y[ib] = MFMA16(*(const bf16x8*)sp, q0, y[ib]); y[ib] = MFMA16(*(const bf16x8*)(sp + 32), q1, y[ib]); }
    float s = 0.f;
#pragma unroll
    for (int ib = 0; ib < 4; ++ib) s += (y[ib][0] + y[ib][1]) + (y[ib][2] + y[ib][3]);
    s += __shfl_xor(s, 16); s += __shfl_xor(s, 32);
    const float mean = s * (1.f / 64.f);
    float q = 0.f;
#pragma unroll
    for (int ib = 0; ib < 4; ++ib)
#pragma unroll
        for (int r = 0; r < 4; ++r) { const float d = y[ib][r] - mean; q += d * d; }
    q += __shfl_xor(q, 16); q += __shfl_xor(q, 32);
    const float rstd = rsqrtf(q * (1.f / 64.f) + LNX_EPS);
    const float* mu = PBP(P, PB_MU) + (size_t)l * 1152;
#pragma unroll
    for (int ib = 0; ib < 4; ++ib) { const int chn = h * 64 + ib * 16 + quad * 4, pc = l * 256 + chn;
        float o[4];
#pragma unroll
        for (int r = 0; r < 4; ++r) {
            const unsigned wv = r < 2 ? vc[ib].x : vc[ib].y, wvp = r < 2 ? vp[ib].x : vp[ib].y, wg = r < 2 ? gc[ib].x : gc[ib].y, wgp = r < 2 ? gp[ib].x : gp[ib].y;
            const float cv = bf2f((r & 1) ? (wv >> 16) : (wv & 0xffffu)), pv = bf2f((r & 1) ? (wvp >> 16) : (wvp & 0xffffu));
            const float cg = bf2f((r & 1) ? (wg >> 16) : (wg & 0xffffu)), pg = bf2f((r & 1) ? (wgp >> 16) : (wgp & 0xffffu));
            const float v = cv + (pv - cv) * mu[512 + chn + r], g = cg + (pg - cg) * mu[768 + chn + r];
            const float yn = (y[ib][r] - mean) * rstd * PBP(P, PB_LNW)[pc + r] + PBP(P, PB_LNB)[pc + r];
            o[r] = (yn + bs * v) * silu_f(g); }
        *(u32x2*)(Y + (size_t)tg * D + 512 + chn) = pack4(o[0], o[1], o[2], o[3]); }
}

constexpr int NT = 512;
constexpr int DUP_SUB = -1;
constexpr int REP_XA = 1, REP_S1 = 1, REP_P1 = 1, REP_OUT = 1, REP_SS3 = 1, REP_CMP = 1, REP_Y = 1;
constexpr int LDS_BYTES = 147456, MISC_OFF = LDS_BYTES - 256;
constexpr int CW_BAR = 4096;
static_assert(XA_LDS <= MISC_OFF && S3_LDS <= MISC_OFF && RW_END <= MISC_OFF && CH_END <= MISC_OFF && pg8::STAGE_BYTES <= MISC_OFF, "LDS map");

__global__ void __launch_bounds__(NT, 2) mega_fwd(Params P) {
    extern __shared__ __attribute__((aligned(16))) unsigned char lds_raw[];
    LAS unsigned char* lds_base = (LAS unsigned char*)lds_raw;
    volatile LAS unsigned* MISC = (volatile LAS unsigned*)(lds_base + MISC_OFF);
    const int tid = otid(), wave = __builtin_amdgcn_readfirstlane(tid >> 6), G = gridDim.x, bx = blockIdx.x;
    if (tid < 64) MISC[tid] = 0u;
    __syncthreads();
    XcdBarrier bar = xcd_barrier_post((unsigned*)(P.ws + WS_CTL) + CW_BAR, MISC + 8);
    {
        LAS unsigned char* lds = lds_base; const int gw = bx * 8 + wave, NGW = G * 8;
        stage_blob(P, bx * NT + tid, G * NT);
        for (int it = bx; it < N_PREP_ITEMS; it += G) stage_prep_weights(P, lds, it);
        for (int m = bx; m < MEM_LEN; m += G) stage_memkv(P, lds, m);
        for (int m = gw; m < M; m += NGW) prenorm_row(P.x + (size_t)m * D, P.pre_norm_w, (bf16*)(P.ws + WS_H) + (size_t)m * D, tid & 63);
        xcd_barrier(bar);
    }
    constexpr int PER = 7 + (DUP_SUB >= 0 ? 1 : 0), NPH = 1 + DEPTH * PER;
#pragma unroll 1
    for (int ph = 1; ph < NPH; ++ph) {
        Params Q; Q.ws = P.ws; Q.out = P.out; Q.x = P.x;
        asm volatile("" : "+s"(Q.ws), "+s"(Q.out), "+s"(Q.x));
        unsigned lds_a = (unsigned)(uintptr_t)lds_base; asm volatile("" : "+s"(lds_a)); LAS unsigned char* lds = (LAS unsigned char*)(uintptr_t)lds_a;
        int bx = blockIdx.x, G = gridDim.x; asm volatile("" : "+s"(bx), "+s"(G));
        const int tid = otid(), wave = __builtin_amdgcn_readfirstlane(tid >> 6), gw = bx * 8 + wave, NGW = G * 8;
        const int l = (ph - 1) / PER, s_ = (ph - 1) % PER, sub = (DUP_SUB >= 0 && s_ > DUP_SUB) ? s_ - 1 : s_;
        if (sub == 0) {
            pg8::Gemm g{(const bf16*)(Q.ws + WS_H), (const bf16*)(Q.ws + WS_WIN) + (size_t)l * NU * D, M, NU, D};
            pg8::StaticOrder S; S.init(M, NU, G, bx);
            pg8::EpiBf16 E{(bf16*)(Q.ws + WS_U), NU};
            pg8::gemm_phase<pg8::EpiBf16, pg8::StaticOrder, true, true>(lds, g, S, E);
        } else if (sub == 1) {
            for (int r_ = 0; r_ < REP_XA; ++r_) for (int it = bx; it < (M / 256) * 4; it += G) stage_xattn(Q, lds, it);
            for (int r_ = 0; r_ < REP_S1; ++r_) for (int it = bx; it < NCHUNK * 2; it += G) stage_ssd_s1(Q, l, lds, it);
            for (int r_ = 0; r_ < REP_P1; ++r_) for (int it = bx; it < NCHUNK * 4; it += G) stage_rwkv_p1(Q, l, lds, it);
        } else if (sub == 2) {
            if (bx < 64) for (int r_ = 0; r_ < REP_CMP; ++r_) stage_rwkv_compose(Q, lds, bx);
            else for (int it = bx - 64; it < 512; it += G - 64) stage_ssd_scan(Q, lds, it);
        } else if (sub == 3) {
            if (bx < 64) for (int r_ = 0; r_ < REP_OUT; ++r_) stage_rwkv_chain(Q, lds, bx);
            else for (int r_ = 0; r_ < REP_SS3; ++r_) for (int it = bx - 64; it < NCHUNK * 2; it += G - 64) stage_ssd_s3(Q, l, lds, it);
        } else if (sub == 4) {
            for (int r_ = 0; r_ < REP_Y; ++r_) for (int wt = gw; wt < NCHUNK * 4 * 4; wt += NGW) stage_rwkv_y(Q, l, wt, tid & 63);
        } else if (sub == 5) {
            pg8::Gemm g{(const bf16*)(Q.ws + WS_H), (const bf16*)(Q.ws + WS_WOUT) + (size_t)l * D * D, M, D, D};
            pg8::StaticOrder S; S.init(M, D, G, bx);
            pg8::EpiF32 E{(float*)(Q.ws + WS_U), D};
            pg8::gemm_phase<pg8::EpiF32, pg8::StaticOrder, true, true>(lds, g, S, E);
        } else {
            const float* xin = l == 0 ? Q.x : Q.out;
            for (int m = gw; m < M; m += NGW)
                post_row((const float*)(Q.ws + WS_U) + (size_t)m * D, xin + (size_t)m * D, PBP(Q, PB_POSTNW) + l * D, Q.out + (size_t)m * D,
                         l + 1 < DEPTH ? PBP(Q, PB_PRENW) + (l + 1) * D : nullptr, l + 1 < DEPTH ? (bf16*)(Q.ws + WS_H) + (size_t)m * D : nullptr, tid & 63);
        }
        if (ph + 1 < NPH) { XcdBarrier b2 = bar; asm volatile("" : "+s"(b2.x), "+s"(b2.bar)); xcd_barrier(b2); }
    }
}

extern "C" void kernel_launch(void* const* d_in, const int* in_sizes, int n_in, void* d_out, int out_size, void* d_ws, size_t ws_size, hipStream_t stream) {
    static int grid = 0;
    if (grid == 0) {
        if (n_in != 24 || in_sizes[0] != M * D || out_size != M * D || ws_size < WS_END) { fprintf(stderr, "kernel_launch: unexpected shapes n_in %d in0 %d out %d ws %zu\n", n_in, n_in > 0 ? in_sizes[0] : -1, out_size, ws_size); grid = -1; return; }
        int dev = 0, cus = 0, per_cu = 0;
        if (hipGetDevice(&dev) != hipSuccess || hipDeviceGetAttribute(&cus, hipDeviceAttributeMultiprocessorCount, dev) != hipSuccess) { grid = -1; return; }
        if (hipFuncSetAttribute((const void*)mega_fwd, hipFuncAttributeMaxDynamicSharedMemorySize, LDS_BYTES) != hipSuccess) { fprintf(stderr, "kernel_launch: hipFuncSetAttribute failed\n"); grid = -1; return; }
        if (hipOccupancyMaxActiveBlocksPerMultiprocessor(&per_cu, (const void*)mega_fwd, NT, LDS_BYTES) != hipSuccess || per_cu < 1) fprintf(stderr, "kernel_launch: occupancy query says %d\n", per_cu);
        (void)hipGetLastError();
        grid = cus;
    }
    if (grid < 0) return;
    if (hipMemsetAsync((char*)d_ws + WS_CTL, 0, 1 * MiB, stream) != hipSuccess) return;
    Params P{};
    const float** pp = (const float**)&P;
    for (int i = 0; i < 24; ++i) pp[i] = (const float*)d_in[i];
    P.out = (float*)d_out; P.ws = (unsigned char*)d_ws;
    hipLaunchKernelGGL(mega_fwd, dim3(grid), dim3(NT), LDS_BYTES, stream, P);
}
```

```cpp
#include <hip/hip_runtime.h>
#include <cstdio>
#include <cstdint>

__device__ __forceinline__ int otid() { int t = threadIdx.x; asm volatile("" : "+v"(t)); return t; }
namespace pg8 {
#define PG8_LAS __attribute__((address_space(3)))
typedef unsigned short bf16_t;
typedef short bf16x8 __attribute__((ext_vector_type(8)));
typedef float f32x4 __attribute__((ext_vector_type(4)));
typedef unsigned u32x4 __attribute__((ext_vector_type(4)));
constexpr int BM = 256, BK = 64, HALF = 128, HTB = HALF * BK * 2  , STAGE_BYTES = 8 * HTB, NXCD = 8, WGM = 8;

__host__ __device__ __forceinline__ int lds_byte(int r, int c) { const int st = (r >> 4) * 2 + (c >> 5), rr = r & 15, cc = c & 31, ob = rr * 64 + cc * 2; return st * 1024 + (ob ^ (((ob >> 9) & 1) << 5)); }
__host__ __device__ __forceinline__ void stage_rc(int b, int& R, int& C) { const int st = b / 1024, sb = b % 1024, swz = sb ^ (((sb >> 9) & 1) << 5); R = (st >> 1) * 16 + swz / 64; C = (st & 1) * 32 + (swz % 64) / 2; }
__host__ __device__ __forceinline__ int perm32(int rho) { const int n = rho >> 4, i = rho & 15; return 8 * (i >> 2) + 4 * n + (i & 3); }

struct Unit { int pm, pn; };
struct Gemm { const bf16_t* A; const bf16_t* Bt; int M, N, K; };

struct StaticOrder {
    int nM, nN, nwg, G, c;
    __host__ __device__ void init(int M, int N, int G_, int c_) { nM = M / BM; nN = N / BM; nwg = nM * nN; G = G_; c = c_; }
    __host__ __device__ bool next(int i, Unit& u) const {
        const long L = (long)i * G + c; if (L >= nwg) return false;
        int wgid = (int)L; { const int q = nwg / NXCD, r = nwg % NXCD, xcd = wgid % NXCD, off = wgid / NXCD; wgid = (xcd < r ? xcd * (q + 1) : r * (q + 1) + (xcd - r) * q) + off; }
        const int nig = WGM * nN, gid = wgid / nig, fm = gid * WGM, gsz = (nM - fm) < WGM ? (nM - fm) : WGM;
        u.pm = fm + ((wgid % nig) % gsz); u.pn = (wgid % nig) / gsz; return true;
    }
    __device__ __forceinline__ void a_ready(const Unit&) const {}
    __device__ __forceinline__ void done(const Unit&) const {}
};


__device__ __forceinline__ unsigned cvt_pk_bf16(float lo, float hi) { unsigned r; asm volatile("v_cvt_pk_bf16_f32 %0, %1, %2" : "=v"(r) : "v"(lo), "v"(hi)); return r; }
struct EpiBf16 {
    static constexpr bool PERM = true, AFTER_DRAIN = false;
    bf16_t* O; int ldc;
    __device__ __forceinline__ void operator()(const f32x4 (&acc)[2][2][4][2], const Unit& u, int wr, int wc, int fr, int fq) const {
        const int row0 = u.pm * BM + wr * 64 + fr; const int col0 = u.pn * BM + wc * 32 + 8 * fq;
#pragma unroll
        for (int ai = 0; ai < 2; ++ai)
#pragma unroll
            for (int m = 0; m < 4; ++m) { bf16_t* rowp = O + (size_t)(row0 + ai * HALF + m * 16) * ldc + col0;
#pragma unroll
                for (int bj = 0; bj < 2; ++bj) { const f32x4 v0 = acc[ai][bj][m][0], v1 = acc[ai][bj][m][1];
                    u32x4 w; w.x = cvt_pk_bf16(v0[0], v0[1]); w.y = cvt_pk_bf16(v0[2], v0[3]); w.z = cvt_pk_bf16(v1[0], v1[1]); w.w = cvt_pk_bf16(v1[2], v1[3]);
                    *(u32x4*)(rowp + bj * HALF) = w; } }
    }
};
struct EpiF32 {
    static constexpr bool PERM = false, AFTER_DRAIN = false;
    float* C; int ldc;
    __device__ __forceinline__ void operator()(const f32x4 (&acc)[2][2][4][2], const Unit& u, int wr, int wc, int fr, int fq) const {
        const int row0 = u.pm * BM + wr * 64 + fr, col0 = u.pn * BM + wc * 32 + 4 * fq;
#pragma unroll
        for (int ai = 0; ai < 2; ++ai)
#pragma unroll
            for (int m = 0; m < 4; ++m) { float* rowp = C + (size_t)(row0 + ai * HALF + m * 16) * ldc + col0;
#pragma unroll
                for (int bj = 0; bj < 2; ++bj)
#pragma unroll
                    for (int n = 0; n < 2; ++n) *(f32x4*)(rowp + bj * HALF + n * 16) = acc[ai][bj][m][n]; }
    }
};

template <class Epi, class Sched, bool ALIGN_EPI = false, bool SP2 = false>
__device__ __forceinline__ void gemm_phase(PG8_LAS unsigned char* lds, const Gemm g, const Sched& S, const Epi& E) {
    const int tid = otid(), wid = __builtin_amdgcn_readfirstlane(tid >> 6), lane = tid & 63, wr = wid >> 2, wc = wid & 3, fr = lane & 15, fq = lane >> 4;
    const int K = g.K, nt = K / BK;
    unsigned voffA[2], voffB[2];
#pragma unroll
    for (int i = 0; i < 2; ++i) { int R, C; stage_rc(tid * 16 + i * 8192, R, C); const int Rb = Epi::PERM ? ((R & ~31) + perm32(R & 31)) : R;
        voffA[i] = (unsigned)(R * K + C) * 2u; voffB[i] = (unsigned)(Rb * K + C) * 2u; }
    const size_t kstep = (size_t)(BK * 2);
    const size_t hstep = (size_t)HALF * K * 2;
    const size_t tstep = 2 * hstep;
    const unsigned ldsw = (unsigned)wid * 1024u;
    const int aoff = lds_byte(wr * 64 + fr, fq * 8), boff = lds_byte(wc * 32 + fr, fq * 8);
#define PG8_SA(b, h) (((b) * 2 + (h)) * HTB)
#define PG8_SB(b, h) ((4 + (b) * 2 + (h)) * HTB)
#define PG8_STAGE(bufoff, gbase, voff) do { _Pragma("unroll") for (int _i = 0; _i < 2; ++_i) \
        __builtin_amdgcn_global_load_lds((const unsigned*)((const char*)(gbase) + (voff)[_i]), (PG8_LAS unsigned*)(lds + (bufoff) + ldsw + _i * 8192), 16, 0, 0); } while (0)
#define PG8_LDA(dst, b, h) do { _Pragma("unroll") for (int m = 0; m < 4; ++m) _Pragma("unroll") for (int k = 0; k < 2; ++k) dst[m][k] = *(const PG8_LAS bf16x8*)(lds + PG8_SA(b, h) + aoff + m * 2048 + k * 1024); } while (0)
#define PG8_LDB(dst, b, h) do { _Pragma("unroll") for (int n = 0; n < 2; ++n) _Pragma("unroll") for (int k = 0; k < 2; ++k) dst[n][k] = *(const PG8_LAS bf16x8*)(lds + PG8_SB(b, h) + boff + n * 2048 + k * 1024); } while (0)
#define PG8_MMA(ai, bj, At, Bt) do { __builtin_amdgcn_s_setprio(1); _Pragma("unroll") for (int m = 0; m < 4; ++m) _Pragma("unroll") for (int n = 0; n < 2; ++n) _Pragma("unroll") for (int k = 0; k < 2; ++k) \
        acc[ai][bj][m][n] = __builtin_amdgcn_mfma_f32_16x16x32_bf16(Bt[n][k], At[m][k], acc[ai][bj][m][n], 0, 0, 0); __builtin_amdgcn_s_setprio(0); } while (0)
#define PG8_WAIT_V(n) asm volatile("s_waitcnt vmcnt(" #n ")" ::: "memory")
#define PG8_WAIT_L(n) asm volatile("s_waitcnt lgkmcnt(" #n ")" ::: "memory")
#define PG8_BAR __builtin_amdgcn_s_barrier()
#define PG8_SCHED __builtin_amdgcn_sched_barrier(0)
    Unit cur, nxt; int ui = 0;
    if (!S.next(0, cur)) return;
    f32x4 acc[2][2][4][2];
#pragma unroll
    for (int a = 0; a < 2; ++a)
#pragma unroll
        for (int b = 0; b < 2; ++b)
#pragma unroll
            for (int m = 0; m < 4; ++m)
#pragma unroll
                for (int n = 0; n < 2; ++n) acc[a][b][m][n] = (f32x4){0.f, 0.f, 0.f, 0.f};
    bf16x8 At[4][2], B0[2][2], B1[2][2];
    const char* cA = (const char*)g.A + (size_t)cur.pm * tstep; const char* cB = (const char*)g.Bt + (size_t)cur.pn * tstep;
    S.a_ready(cur);
    if constexpr (SP2) {
        PG8_STAGE(PG8_SB(0, 0), cB, voffB); PG8_STAGE(PG8_SB(0, 1), cB + hstep, voffB); PG8_STAGE(PG8_SA(0, 0), cA, voffA); PG8_STAGE(PG8_SA(0, 1), cA + hstep, voffA);
        if (wr == 1) PG8_BAR;
        PG8_WAIT_V(2); PG8_BAR;
        PG8_STAGE(PG8_SB(1, 0), cB + kstep, voffB); PG8_STAGE(PG8_SA(1, 0), cA + kstep, voffA); PG8_STAGE(PG8_SB(1, 1), cB + hstep + kstep, voffB);
        PG8_WAIT_V(6); PG8_BAR;
    } else {
        PG8_STAGE(PG8_SB(0, 0), cB, voffB); PG8_STAGE(PG8_SA(0, 0), cA, voffA); PG8_STAGE(PG8_SB(0, 1), cB + hstep, voffB); PG8_STAGE(PG8_SA(0, 1), cA + hstep, voffA);
        if (wr == 1) PG8_BAR;
        PG8_WAIT_V(4); PG8_BAR;
        PG8_STAGE(PG8_SB(1, 0), cB + kstep, voffB); PG8_STAGE(PG8_SA(1, 0), cA + kstep, voffA); PG8_STAGE(PG8_SB(1, 1), cB + hstep + kstep, voffB);
        PG8_WAIT_V(6); PG8_BAR;
    }
    for (;;) {
        const bool has_next = S.next(ui + 1, nxt);
        const char* nA = has_next ? (const char*)g.A + (size_t)nxt.pm * tstep : cA; const char* nB = has_next ? (const char*)g.Bt + (size_t)nxt.pn * tstep : cB;
        for (int t = 0; t < nt; t += 2) {
            const bool last = (t == nt - 2);
            const char* a1 = cA + (size_t)(t + 1) * kstep;
            const char* a2 = last ? nA : cA + (size_t)(t + 2) * kstep; const char* b2 = last ? nB : cB + (size_t)(t + 2) * kstep;
            const char* a3 = a2 + kstep; const char* b3 = b2 + kstep;
            if (last && has_next) S.a_ready(nxt);
            if constexpr (SP2) {
            PG8_LDB(B0, 0, 0); PG8_LDB(B1, 0, 1); PG8_SCHED; PG8_LDA(At, 0, 0); PG8_STAGE(PG8_SA(1, 1), a1 + hstep, voffA);
            PG8_WAIT_V(8); PG8_WAIT_L(0); PG8_BAR; PG8_MMA(0, 0, At, B0); PG8_MMA(0, 1, At, B1); PG8_BAR; PG8_SCHED;
            PG8_LDA(At, 0, 1); PG8_STAGE(PG8_SB(0, 0), b2, voffB); PG8_STAGE(PG8_SB(0, 1), b2 + hstep, voffB); PG8_STAGE(PG8_SA(0, 0), a2, voffA);
            PG8_WAIT_V(8); PG8_WAIT_L(0); PG8_BAR; PG8_MMA(1, 0, At, B0); PG8_MMA(1, 1, At, B1); PG8_BAR; PG8_SCHED;
            PG8_LDB(B0, 1, 0); PG8_LDB(B1, 1, 1); PG8_SCHED; PG8_LDA(At, 1, 0); PG8_STAGE(PG8_SA(0, 1), a2 + hstep, voffA);
            PG8_WAIT_V(8); PG8_WAIT_L(0); PG8_BAR; PG8_MMA(0, 0, At, B0); PG8_MMA(0, 1, At, B1); PG8_BAR; PG8_SCHED;
            PG8_LDA(At, 1, 1); PG8_STAGE(PG8_SB(1, 0), b3, voffB); PG8_STAGE(PG8_SB(1, 1), b3 + hstep, voffB); PG8_STAGE(PG8_SA(1, 0), a3, voffA);
            PG8_WAIT_V(8); PG8_WAIT_L(0); PG8_BAR; PG8_MMA(1, 0, At, B0); PG8_MMA(1, 1, At, B1); PG8_BAR; PG8_SCHED;
            } else {
            PG8_LDB(B0, 0, 0); PG8_SCHED; PG8_LDA(At, 0, 0); PG8_STAGE(PG8_SA(1, 1), a1 + hstep, voffA);
            PG8_WAIT_L(8); PG8_BAR; PG8_WAIT_L(0); PG8_MMA(0, 0, At, B0); PG8_BAR; PG8_SCHED;
            PG8_LDB(B1, 0, 1); PG8_STAGE(PG8_SB(0, 0), b2, voffB);
            PG8_BAR; PG8_WAIT_L(0); PG8_MMA(0, 1, At, B1); PG8_BAR;
            PG8_LDA(At, 0, 1); PG8_STAGE(PG8_SA(0, 0), a2, voffA);
            PG8_BAR; PG8_WAIT_L(0); PG8_MMA(1, 0, At, B0); PG8_BAR; PG8_SCHED;
            PG8_STAGE(PG8_SB(0, 1), b2 + hstep, voffB);
            PG8_WAIT_V(6); PG8_BAR; PG8_MMA(1, 1, At, B1); PG8_BAR;
            PG8_LDB(B0, 1, 0); PG8_SCHED; PG8_LDA(At, 1, 0); PG8_STAGE(PG8_SA(0, 1), a2 + hstep, voffA);
            PG8_WAIT_L(8); PG8_BAR; PG8_WAIT_L(0); PG8_MMA(0, 0, At, B0); PG8_BAR; PG8_SCHED;
            PG8_LDB(B1, 1, 1); PG8_STAGE(PG8_SB(1, 0), b3, voffB);
            PG8_BAR; PG8_WAIT_L(0); PG8_MMA(0, 1, At, B1); PG8_BAR;
            PG8_LDA(At, 1, 1); PG8_STAGE(PG8_SA(1, 0), a3, voffA);
            PG8_BAR; PG8_WAIT_L(0); PG8_MMA(1, 0, At, B0); PG8_BAR; PG8_SCHED;
            PG8_STAGE(PG8_SB(1, 1), b3 + hstep, voffB);
            PG8_WAIT_V(6); PG8_BAR; PG8_MMA(1, 1, At, B1); PG8_BAR;
            }
        }
        if constexpr (ALIGN_EPI) { if (wr == 0) PG8_BAR; }
        if constexpr (!Epi::AFTER_DRAIN) { E(acc, cur, wr, wc, fr, fq); S.done(cur); }
        if (!has_next) break;
#pragma unroll
        for (int a = 0; a < 2; ++a)
#pragma unroll
            for (int b = 0; b < 2; ++b)
#pragma unroll
                for (int m = 0; m < 4; ++m)
#pragma unroll
                    for (int n = 0; n < 2; ++n) acc[a][b][m][n] = (f32x4){0.f, 0.f, 0.f, 0.f};
        cur = nxt; cA = nA; cB = nB; ++ui;
        if constexpr (ALIGN_EPI) { if (wr == 1) PG8_BAR; }
    }
    PG8_WAIT_V(0);
    if constexpr (!ALIGN_EPI) { if (wr == 0) PG8_BAR; }
    PG8_BAR;
    if constexpr (Epi::AFTER_DRAIN) { E.fused(acc, cur, wr, wc, fr, fq, lds, wid, lane); S.done(cur); }
#undef PG8_SA
#undef PG8_SB
#undef PG8_STAGE
#undef PG8_LDA
#undef PG8_LDB
#undef PG8_MMA
#undef PG8_WAIT_V
#undef PG8_WAIT_L
#undef PG8_BAR
#undef PG8_SCHED
}
}

constexpr int M = 16384, D = 1024, DEPTH = 4, NU = 3328, NWIN = 3208, NCHUNK = 256;
constexpr int MEM_LEN = 256;
constexpr int C_XS = 0, C_B = 512, C_C = 768, C_Z = 1024, C_R = 1536, C_K = 1792, C_V = 2048, C_G = 2304, C_WL = 2560, C_AL = 2624, C_DT = 2688, C_Q = 2816, C_GX = 3072;
constexpr float NORM_EPS = 1e-6f, LNX_EPS = 64e-5f;

#define LAS __attribute__((address_space(3)))
#define GAS __attribute__((address_space(1)))
typedef unsigned short bf16;
typedef short bf16x8 __attribute__((ext_vector_type(8)));
typedef float f32x4 __attribute__((ext_vector_type(4)));

typedef __bf16 bf16v2_t __attribute__((ext_vector_type(2)));
__device__ __forceinline__ unsigned cvt2bf(float lo, float hi) { bf16v2_t v; v[0] = (__bf16)lo; v[1] = (__bf16)hi; return __builtin_bit_cast(unsigned, v); }
__device__ __forceinline__ unsigned f2bf(float f) { return cvt2bf(f, 0.f) & 0xffffu; }
__device__ __forceinline__ float bf2f(unsigned b) { return __uint_as_float(b << 16); }
__device__ __forceinline__ float us2f(short s) { return bf2f((unsigned)(unsigned short)s); }
typedef unsigned u32x2 __attribute__((ext_vector_type(2)));
typedef unsigned u32x4v __attribute__((ext_vector_type(4)));
__device__ __forceinline__ u32x2 pack4(float a, float b, float c, float d) { u32x2 o; o.x = cvt2bf(a, b); o.y = cvt2bf(c, d); return o; }
__device__ __forceinline__ bf16x8 pack8(const float (&v)[8]) { const u32x4v t = (u32x4v){cvt2bf(v[0], v[1]), cvt2bf(v[2], v[3]), cvt2bf(v[4], v[5]), cvt2bf(v[6], v[7])}; return __builtin_bit_cast(bf16x8, t); }
__device__ __forceinline__ float wave_sum(float v) {
#pragma unroll
    for (int o = 1; o < 64; o <<= 1) v += __shfl_xor(v, o);
    return v;
}
__device__ __forceinline__ float silu_f(float x) { return x * __builtin_amdgcn_rcpf(1.f + __expf(-x)); }
__device__ __forceinline__ float softplus_f(float x) { return fmaxf(x, 0.f) + __logf(1.f + __expf(-fabsf(x))); }
__device__ __forceinline__ float sigmoid_f(float x) { return __builtin_amdgcn_rcpf(1.f + __expf(-x)); }

__device__ __forceinline__ bf16x8 ld_frag(const LAS bf16* base, int ld, int row0, int k0, int lane) {
    return *(const LAS bf16x8*)(base + (row0 + (lane & 15)) * ld + k0 + (lane >> 4) * 8);
}
#define MFMA16(a, b, c) __builtin_amdgcn_mfma_f32_16x16x32_bf16((a), (b), (c), 0, 0, 0)

#define XB_TMO      128
#define XB_XCNT(j)  (256  + 64 * (j))
#define XB_XSUB(j)  (1280 + 64 * (j))
#define XB_XGEN(j)  (2304 + 64 * (j))
#define XB_TOP      3328
#define XB_TOPGEN   3392
#define XCD_BAR_WORDS 3456
#define XB_SPIN_CAP (1u << 22)

__device__ __forceinline__ unsigned xb_ld(unsigned* p)              { return __hip_atomic_load(p, __ATOMIC_RELAXED, __HIP_MEMORY_SCOPE_AGENT); }
__device__ __forceinline__ unsigned xb_add(unsigned* p, unsigned v) { return __hip_atomic_fetch_add(p, v, __ATOMIC_RELAXED, __HIP_MEMORY_SCOPE_AGENT); }
__device__ __forceinline__ unsigned xb_xcc_id() { return (unsigned)__builtin_amdgcn_s_getreg((3 << 11) | 20) & 0xFu; }
#define XB_SPIN(cond, bar) do { unsigned _sp = 0; while (cond) { __builtin_amdgcn_s_sleep(1); \
    if ((++_sp & 255u) == 0u) { if (xb_ld(&(bar)[XB_TMO])) break; if (_sp > XB_SPIN_CAP) { atomicAdd(&(bar)[XB_TMO], 1u); break; } } } } while (0)

struct XcdBarrier {
    unsigned* bar; unsigned x;
    volatile LAS unsigned* st;
};

__device__ __forceinline__ XcdBarrier xcd_barrier_post(unsigned* bar, volatile LAS unsigned* st) {
    XcdBarrier b; b.bar = bar; b.x = xb_xcc_id(); b.st = st;
    if (otid() == 0) (void)xb_add(&bar[XB_XCNT(b.x)], 1u);
    return b;
}
__device__ __forceinline__ void xcd_barrier_complete(unsigned* bar, unsigned x, unsigned& nloc, unsigned& nx) {
    const unsigned G = gridDim.x * gridDim.y * gridDim.z;
    unsigned sum, cnt, mine, sp = 0u;
    for (;;) {
        sum = 0u; cnt = 0u; mine = 0u;
#pragma unroll
        for (unsigned j = 0; j < 16; ++j) { const unsigned c = xb_ld(&bar[XB_XCNT(j)]); sum += c; cnt += (c > 0u) ? 1u : 0u; }
        mine = xb_ld(&bar[XB_XCNT(x)]);
        if (sum == G) break;
        __builtin_amdgcn_s_sleep(1);
        if ((++sp & 255u) == 0u) { if (xb_ld(&bar[XB_TMO])) break; if (sp > XB_SPIN_CAP) { atomicAdd(&bar[XB_TMO], 1u); break; } }
    }
    nloc = mine > 0u ? mine : 1u; nx = cnt > 0u ? cnt : 1u;
}

__device__ __forceinline__ void xcd_barrier(const XcdBarrier& b) {
    asm volatile("s_waitcnt vmcnt(0)" ::: "memory");
    __syncthreads();
    if (otid() == 0) {
        unsigned* bar = b.bar;
        __builtin_amdgcn_s_waitcnt(0);
        unsigned nloc = b.st[0], nx = b.st[1];
        if (nloc == 0u) { xcd_barrier_complete(bar, b.x, nloc, nx); b.st[0] = nloc; b.st[1] = nx; }
        const unsigned old = xb_add(&bar[XB_XSUB(b.x)], 1u);
        const unsigned gen = old / nloc;
        if (old + 1u == (gen + 1u) * nloc) {
            __builtin_amdgcn_fence(__ATOMIC_RELEASE, "agent");
            asm volatile("s_waitcnt vmcnt(0)" ::: "memory");
            const unsigned og = xb_add(&bar[XB_TOP], 1u);
            const unsigned tg = og / nx;
            if (og + 1u == (tg + 1u) * nx) xb_add(&bar[XB_TOPGEN], 1u);
            else XB_SPIN(xb_ld(&bar[XB_TOPGEN]) == tg, bar);
            __builtin_amdgcn_fence(__ATOMIC_ACQUIRE, "agent");
            xb_add(&bar[XB_XGEN(b.x)], 1u);
            asm volatile("s_waitcnt vmcnt(0)" ::: "memory");
        } else {
            XB_SPIN(xb_ld(&bar[XB_XGEN(b.x)]) == gen, bar);
            __builtin_amdgcn_fence(__ATOMIC_ACQUIRE, "agent");
            asm volatile("s_waitcnt vmcnt(0)" ::: "memory");
        }
    }
    __syncthreads();
}


struct Params {
    const float *x, *mem, *mem_norm_w, *w_mem_kv, *pre_norm_w, *w_in, *conv_w, *conv_b, *dt_bias, *a_log, *d_skip, *ssm_norm_w,
                *shift_mu, *w0, *w2, *a0, *a2, *k_k, *k_a, *r_k, *lnx_w, *lnx_b, *w_out, *post_norm_w;
    float* out;
    unsigned char* ws;
};
constexpr size_t MiB = 1u << 20;
constexpr size_t WS_CTL = 0, WS_WIN = 1 * MiB, WS_WOUT = 27 * MiB, WS_KV = 35 * MiB, WS_H = 36 * MiB, WS_U = 68 * MiB, WS_R = 172 * MiB, WS_END = 256 * MiB;
constexpr size_t WS_W2T = WS_KV + 256 * 1024;
constexpr size_t WS_ST = WS_R, WS_CD = WS_R + 32 * MiB, WS_BS = WS_CD + 65536;
constexpr size_t WS_Q1 = WS_R + 34 * MiB, WS_Y0 = WS_R + 42 * MiB, WS_PCT = WS_R + 50 * MiB, WS_GC = WS_R + 58 * MiB, WS_S0 = WS_R + 66 * MiB, WS_PGT = WS_R + 74 * MiB, WS_GG = WS_R + 75 * MiB;
static_assert(WS_GG + 64 * 8192 <= WS_END && WS_BS + (size_t)16384 * 16 <= WS_Q1, "ws map");


constexpr size_t WS_PB = 128 * 1024;
constexpr int PB_PRENW = 1024, PB_CONVW = 5120, PB_CONVB = 21504, PB_DTB = 25600, PB_ALOG = 25632, PB_DSKIP = 25664, PB_SSMNW = 25728, PB_MU = 27776, PB_W0 = 32384, PB_W2 = 33408,
              PB_A0 = 98944, PB_A2 = 99968, PB_KK = 165504, PB_KA = 166528, PB_RK = 167552, PB_LNW = 168576, PB_LNB = 169600, PB_POSTNW = 170624, PB_END = 174720;
static_assert(WS_PB + (size_t)PB_END * 4 <= 1 * MiB, "blob inside the control MiB");
#define PBP(P, off) ((const float*)((P).ws + WS_PB) + (off))
__device__ __forceinline__ int win_src_col(int n) {
    if (n < 1536) return n;
    if (n < 2560) return n + 8;
    if (n < 2816) { const int j = n - 2560; if (j < 64) return 2568 + j; if (j < 128) return 2632 + (j - 64); if (j < 136) return 1536 + (j - 128); return -1; }
    return n - 120;
}
template <bool WIN>
__device__ __forceinline__ void transpose_tile(const float* src, int src_ld, bf16* dst, int K, int n0, int k0, LAS float* scr) {
    const int tx = otid() & 63, ty = otid() >> 6;
    const int sc = WIN ? win_src_col(n0 + tx) : (n0 + tx);
#pragma unroll
    for (int kk = ty; kk < 64; kk += 8) scr[kk * 65 + tx] = sc >= 0 ? src[(size_t)(k0 + kk) * src_ld + sc] : 0.f;
    __syncthreads();
#pragma unroll
    for (int nn = ty; nn < 64; nn += 8) dst[(size_t)(n0 + nn) * K + k0 + tx] = (bf16)f2bf(scr[tx * 65 + nn]);
    __syncthreads();
}
__device__ __forceinline__ void stage_prep_weights(const Params& P, LAS unsigned char* lds, int item) {
    LAS float* scr = (LAS float*)lds;
    constexpr int T_IN = (NU / 64) * (D / 64);
    constexpr int T_OUT = (D / 64) * (D / 64);
    if (item < DEPTH * T_IN) { const int l = item / T_IN, r = item % T_IN, nb = r / 16, kb = r % 16;
        transpose_tile<true>(P.w_in + (size_t)l * D * NWIN, NWIN, (bf16*)(P.ws + WS_WIN) + (size_t)l * NU * D, D, nb * 64, kb * 64, scr); }
    else { const int it = item - DEPTH * T_IN; const int l = it / T_OUT, r = it % T_OUT, nb = r / 16, kb = r % 16;
        transpose_tile<false>(P.w_out + (size_t)l * D * D, D, (bf16*)(P.ws + WS_WOUT) + (size_t)l * D * D, D, nb * 64, kb * 64, scr); }
}
constexpr int N_PREP_ITEMS = DEPTH * ((NU / 64) * (D / 64) + (D / 64) * (D / 64));


__device__ __forceinline__ void stage_blob(const Params& P, int gtid, int gthreads) {
    float* pb = (float*)(P.ws + WS_PB);
#define CPY(src, off, n) for (int i = gtid; i < (n); i += gthreads) pb[(off) + i] = (src)[i];
    CPY(P.mem_norm_w, 0, 1024) CPY(P.pre_norm_w, PB_PRENW, 4096) CPY(P.conv_w, PB_CONVW, 16384) CPY(P.conv_b, PB_CONVB, 4096) CPY(P.dt_bias, PB_DTB, 32) CPY(P.a_log, PB_ALOG, 32) CPY(P.d_skip, PB_DSKIP, 32)
    CPY(P.ssm_norm_w, PB_SSMNW, 2048) CPY(P.shift_mu, PB_MU, 4608) CPY(P.w0, PB_W0, 1024) CPY(P.w2, PB_W2, 65536) CPY(P.a0, PB_A0, 1024) CPY(P.a2, PB_A2, 65536) CPY(P.k_k, PB_KK, 1024) CPY(P.k_a, PB_KA, 1024)
    CPY(P.r_k, PB_RK, 1024) CPY(P.lnx_w, PB_LNW, 1024) CPY(P.lnx_b, PB_LNB, 1024) CPY(P.post_norm_w, PB_POSTNW, 4096)
#undef CPY
    bf16* wi = (bf16*)(P.ws + WS_W2T);
    for (int i = gtid; i < 65536; i += gthreads) { const int j = i & 63, ch = (i >> 6) & 63, h = (i >> 12) & 3, l = i >> 14;
        wi[i] = (bf16)f2bf(P.w2[((size_t)l * 64 + j) * 256 + h * 64 + ch]); wi[65536 + i] = (bf16)f2bf(P.a2[((size_t)l * 64 + j) * 256 + h * 64 + ch]); }
}
__device__ __forceinline__ void stage_memkv(const Params& P, LAS unsigned char* lds, int m) {
    LAS float* xs = (LAS float*)lds; LAS float* red = xs + 1024;
    const int tid = otid();
    const float v0 = P.mem[(size_t)m * D + tid], v1 = P.mem[(size_t)m * D + 512 + tid];
    float s = wave_sum(v0 * v0 + v1 * v1);
    if ((tid & 63) == 0) red[tid >> 6] = s;
    __syncthreads();
    float tot = 0.f;
#pragma unroll
    for (int w = 0; w < 8; ++w) tot += red[w];
    const float rstd = rsqrtf(tot * (1.f / D) + NORM_EPS);
    xs[tid] = v0 * rstd * P.mem_norm_w[tid]; xs[512 + tid] = v1 * rstd * P.mem_norm_w[512 + tid];
    __syncthreads();
    float acc = 0.f;
#pragma unroll 8
    for (int k = 0; k < D; ++k) acc += xs[k] * P.w_mem_kv[(size_t)k * 512 + tid];
    {   const int hh = (tid >> 6) & 3, d = tid & 63;
        if (tid < 256) ((bf16*)(P.ws + WS_KV))[(size_t)(hh * 256 + m) * 64 + d] = (bf16)f2bf(acc);
        else ((bf16*)(P.ws + WS_KV) + 65536)[(size_t)(hh * 64 + d) * 256 + m] = (bf16)f2bf(acc); }
    __syncthreads();
}

__device__ __forceinline__ void prenorm_row(const float* xrow, const float* w, bf16* orow, int lane) {
    const f32x4* xr = (const f32x4*)xrow + lane; const f32x4* wr = (const f32x4*)w + lane;
    f32x4 v[4]; float s = 0.f;
#pragma unroll
    for (int j = 0; j < 4; ++j) { v[j] = xr[64 * j]; s += (v[j].x * v[j].x + v[j].y * v[j].y) + (v[j].z * v[j].z + v[j].w * v[j].w); }
    const float rstd = rsqrtf(wave_sum(s) * (1.f / D) + NORM_EPS);
    unsigned long long* o8 = (unsigned long long*)orow + lane;
#pragma unroll
    for (int j = 0; j < 4; ++j) { const f32x4 ww = wr[64 * j];
        const unsigned lo = f2bf(v[j].x * rstd * ww.x) | (f2bf(v[j].y * rstd * ww.y) << 16), hi = f2bf(v[j].z * rstd * ww.z) | (f2bf(v[j].w * rstd * ww.w) << 16);
        o8[64 * j] = (unsigned long long)lo | ((unsigned long long)hi << 32); }
}
__device__ __forceinline__ void post_row(const float* orow, const float* xin, const float* pw, float* xout, const float* nw, bf16* hrow, int lane) {
    const f32x4* orr = (const f32x4*)orow + lane; const f32x4* xr = (const f32x4*)xin + lane; const f32x4* pr = (const f32x4*)pw + lane;
    f32x4 v[4]; float s = 0.f;
#pragma unroll
    for (int j = 0; j < 4; ++j) { v[j] = orr[64 * j]; s += (v[j].x * v[j].x + v[j].y * v[j].y) + (v[j].z * v[j].z + v[j].w * v[j].w); }
    const float rstd = rsqrtf(wave_sum(s) * (1.f / D) + NORM_EPS);
    float s2 = 0.f;
#pragma unroll
    for (int j = 0; j < 4; ++j) { const f32x4 xx = xr[64 * j], pp = pr[64 * j]; v[j] = xx + v[j] * rstd * pp; s2 += (v[j].x * v[j].x + v[j].y * v[j].y) + (v[j].z * v[j].z + v[j].w * v[j].w);
        ((f32x4*)xout + lane)[64 * j] = v[j]; }
    if (hrow) {
        const float rstd2 = rsqrtf(wave_sum(s2) * (1.f / D) + NORM_EPS);
        const f32x4* wr = (const f32x4*)nw + lane; unsigned long long* o8 = (unsigned long long*)hrow + lane;
#pragma unroll
        for (int j = 0; j < 4; ++j) { const f32x4 ww = wr[64 * j];
            const unsigned lo = f2bf(v[j].x * rstd2 * ww.x) | (f2bf(v[j].y * rstd2 * ww.y) << 16), hi = f2bf(v[j].z * rstd2 * ww.z) | (f2bf(v[j].w * rstd2 * ww.w) << 16);
            o8[64 * j] = (unsigned long long)lo | ((unsigned long long)hi << 32); }
    }
}

constexpr int XA_KLD = 72, XA_VLD = 264;
constexpr int XA_LDS = (256 * XA_KLD + 64 * XA_VLD) * 2;
__device__ __forceinline__ void stage_xattn(const Params& P, LAS unsigned char* lds, int item) {
    const int tid = otid(), lane = tid & 63, wave = tid >> 6, quad = lane >> 4, l15 = lane & 15;
    const int tile = item >> 2, h = item & 3, t0 = tile * 256;
    LAS bf16* Ks = (LAS bf16*)lds; LAS bf16* VT = Ks + 256 * XA_KLD;
    const bf16* KB = (const bf16*)(P.ws + WS_KV) + (size_t)h * 256 * 64; const bf16* VB = (const bf16*)(P.ws + WS_KV) + 65536 + (size_t)h * 64 * 256;
    const bf16* U = (const bf16*)(P.ws + WS_U); bf16* Y = (bf16*)(P.ws + WS_H);
    u32x4v kp[4], vp[4];
#pragma unroll
    for (int i = 0; i < 4; ++i) { const int e = tid + i * 512; kp[i] = *(const u32x4v*)(KB + e * 8); vp[i] = *(const u32x4v*)(VB + e * 8); }
    bf16x8 qf[2][2]; u32x2 gx[2][4];
#pragma unroll
    for (int rb = 0; rb < 2; ++rb) { const bf16* up = U + (size_t)(t0 + wave * 32 + rb * 16 + l15) * NU + h * 64;
#pragma unroll
        for (int s_ = 0; s_ < 2; ++s_) qf[rb][s_] = *(const bf16x8*)(up + C_Q + s_ * 32 + quad * 8);
#pragma unroll
        for (int db = 0; db < 4; ++db) gx[rb][db] = *(const u32x2*)(up + C_GX + db * 16 + quad * 4); }
#pragma unroll
    for (int i = 0; i < 4; ++i) { const int e = tid + i * 512;
        *(LAS u32x4v*)(Ks + (e >> 3) * XA_KLD + (e & 7) * 8) = kp[i]; *(LAS u32x4v*)(VT + (e >> 5) * XA_VLD + (e & 31) * 8) = vp[i]; }
    __syncthreads();
#pragma unroll
    for (int rb = 0; rb < 2; ++rb) {
        f32x4 acc[16];
#pragma unroll
        for (int mb = 0; mb < 16; ++mb) { acc[mb] = (f32x4){0.f, 0.f, 0.f, 0.f};
#pragma unroll
            for (int s_ = 0; s_ < 2; ++s_) acc[mb] = MFMA16(ld_frag(Ks, XA_KLD, mb * 16, s_ * 32, lane), qf[rb][s_], acc[mb]); }
        float m_ = -3.0e38f;
#pragma unroll
        for (int mb = 0; mb < 16; ++mb)
#pragma unroll
            for (int r = 0; r < 4; ++r) { acc[mb][r] *= 0.125f; m_ = fmaxf(m_, acc[mb][r]); }
        m_ = fmaxf(m_, __shfl_xor(m_, 16)); m_ = fmaxf(m_, __shfl_xor(m_, 32));
        float sm = 0.f; u32x2 pk[16];
#pragma unroll
        for (int mb = 0; mb < 16; ++mb) { float p[4];
#pragma unroll
            for (int r = 0; r < 4; ++r) { p[r] = __expf(acc[mb][r] - m_); sm += p[r]; }
            pk[mb] = pack4(p[0], p[1], p[2], p[3]); }
        sm += __shfl_xor(sm, 16); sm += __shfl_xor(sm, 32);
        f32x4 o4[4];
#pragma unroll
        for (int db = 0; db < 4; ++db) o4[db] = (f32x4){0.f, 0.f, 0.f, 0.f};
#pragma unroll
        for (int ks = 0; ks < 8; ++ks) {
            bf16x8 pb; { const u32x4v t4 = (u32x4v){pk[2 * ks].x, pk[2 * ks].y, pk[2 * ks + 1].x, pk[2 * ks + 1].y}; pb = __builtin_bit_cast(bf16x8, t4); }
#pragma unroll
            for (int db = 0; db < 4; ++db) { const LAS bf16* vpn = VT + (db * 16 + l15) * XA_VLD + ks * 32 + quad * 4;
                const u32x2 v0 = *(const LAS u32x2*)vpn, v1 = *(const LAS u32x2*)(vpn + 16);
                const u32x4v t4 = (u32x4v){v0.x, v0.y, v1.x, v1.y};
                o4[db] = MFMA16(__builtin_bit_cast(bf16x8, t4), pb, o4[db]); } }
        const float inv = 1.f / sm; const int t = t0 + wave * 32 + rb * 16 + l15;
#pragma unroll
        for (int db = 0; db < 4; ++db) { const u32x2 g = gx[rb][db];
            *(u32x2*)(Y + (size_t)t * D + 768 + h * 64 + db * 16 + quad * 4) = pack4(o4[db][0] * inv * silu_f(bf2f(g.x & 0xffffu)), o4[db][1] * inv * silu_f(bf2f(g.x >> 16)),
                                                                                   o4[db][2] * inv * silu_f(bf2f(g.y & 0xffffu)), o4[db][3] * inv * silu_f(bf2f(g.y >> 16))); }
        __builtin_amdgcn_sched_barrier(0);
    }
    __syncthreads();
}

__device__ __forceinline__ void conv8x8(const bf16* U, int ts, int col, const float* cw, const float* cb, float (&o)[8][8]) {
    bf16x8 rows[11];
#pragma unroll
    for (int i = 0; i < 11; ++i) { const int tt = ts - 3 + i; rows[i] = (bf16x8){0, 0, 0, 0, 0, 0, 0, 0}; if (tt >= 0) rows[i] = *(const bf16x8*)(U + (size_t)tt * NU + col); }
    float w[4][8], b[8];
#pragma unroll
    for (int k = 0; k < 8; ++k) { b[k] = cb[col + k];
#pragma unroll
        for (int j = 0; j < 4; ++j) w[j][k] = cw[j * 1024 + col + k]; }
#pragma unroll
    for (int tok = 0; tok < 8; ++tok)
#pragma unroll
        for (int k = 0; k < 8; ++k) {
            const float a = b[k] + w[0][k] * us2f(rows[tok][k]) + w[1][k] * us2f(rows[tok + 1][k]) + w[2][k] * us2f(rows[tok + 2][k]) + w[3][k] * us2f(rows[tok + 3][k]);
            o[tok][k] = silu_f(a); }
}
__device__ __forceinline__ void ssd_dt(const Params& P, int l, int g, float raw, LAS float* dtS, LAS float* acS, int tid) {
    if (tid < 256) { const int hh = tid >> 6, q = tid & 63, h = g * 4 + hh;
        const float dt = softplus_f(raw + PBP(P, PB_DTB)[l * 8 + h]);
        const float A = -__expf(PBP(P, PB_ALOG)[l * 8 + h]);
        float v = dt * A;
#pragma unroll
        for (int o = 1; o < 64; o <<= 1) { const float t = __shfl_up(v, o); if (q >= o) v += t; }
        dtS[hh * 64 + q] = dt; acS[hh * 64 + q] = v; }
}
constexpr int S1_LDS = 2048 + (4 * 64 * 72 + 128 * 72) * 2;
__device__ __forceinline__ void stage_ssd_s1(const Params& P, int l, LAS unsigned char* lds, int item) {
    const int tid = otid(), lane = tid & 63, wave = tid >> 6, quad = lane >> 4, l15 = lane & 15;
    const int c = item >> 1, g = item & 1, t0 = c * 64;
    LAS float* dtS = (LAS float*)lds; LAS float* acS = dtS + 256; LAS bf16* XT = (LAS bf16*)(lds + 2048); LAS bf16* BT = XT + 4 * 64 * 72;
    const bf16* U = (const bf16*)(P.ws + WS_U);
    const float raw = tid < 256 ? bf2f(U[(size_t)(t0 + (tid & 63)) * NU + C_DT + g * 4 + (tid >> 6)]) : 0.f;
    const int tseg = tid & 7, cg = tid >> 3; const bool isx = cg < 32;
    const int j0 = isx ? cg * 8 : (cg - 32) * 8, col = isx ? C_XS + g * 256 + j0 : C_B + g * 128 + j0;
    float o[8][8];
    if (tid < 384) conv8x8(U, t0 + tseg * 8, col, PBP(P, PB_CONVW) + (size_t)l * 4 * 1024, PBP(P, PB_CONVB) + l * 1024, o);
    ssd_dt(P, l, g, raw, dtS, acS, tid);
    __syncthreads();
    if (tid < 384) {
        const int hh = j0 >> 6, p0 = j0 & 63;
        float sc[8];
#pragma unroll
        for (int tok = 0; tok < 8; ++tok) { const int q = tseg * 8 + tok; sc[tok] = isx ? dtS[hh * 64 + q] * __expf(acS[hh * 64 + 63] - acS[hh * 64 + q]) : 1.f; }
        LAS bf16* dst = isx ? XT + (hh * 64 + p0) * 72 + tseg * 8 : BT + j0 * 72 + tseg * 8;
#pragma unroll
        for (int k = 0; k < 8; ++k) { float v[8];
#pragma unroll
            for (int tok = 0; tok < 8; ++tok) v[tok] = o[tok][k] * sc[tok];
            *(LAS bf16x8*)(dst + k * 72) = pack8(v); }
    }
    __syncthreads();
    { const int hh = wave >> 1, nh = wave & 1, h = g * 4 + hh;
        bf16* ST = (bf16*)(P.ws + WS_ST) + ((size_t)(c * 8 + h) * 64) * 128;
#pragma unroll
        for (int pb = 0; pb < 4; ++pb)
#pragma unroll
            for (int nb = 0; nb < 4; ++nb) { f32x4 acc = (f32x4){0.f, 0.f, 0.f, 0.f};
#pragma unroll
                for (int ks = 0; ks < 2; ++ks) acc = MFMA16(ld_frag(BT, 72, nh * 64 + nb * 16, ks * 32, lane), ld_frag(XT + hh * 64 * 72, 72, pb * 16, ks * 32, lane), acc);
                *(u32x2*)(ST + (size_t)(pb * 16 + l15) * 128 + nh * 64 + nb * 16 + quad * 4) = pack4(acc[0], acc[1], acc[2], acc[3]); }
        if (tid < 4) ((float*)(P.ws + WS_CD))[c * 8 + g * 4 + tid] = __expf(acS[tid * 64 + 63]);
    }
    __syncthreads();
}
__device__ __forceinline__ void stage_ssd_scan(const Params& P, LAS unsigned char* lds, int blk) {
    const int tid = otid(), pi = tid & 63, seg = tid >> 6;
    LAS float* cdS = (LAS float*)lds; LAS float* segL = cdS + 256; LAS float* segD = segL + 8 * 128;
    bf16* ST = (bf16*)(P.ws + WS_ST); const float* CD = (const float*)(P.ws + WS_CD);
    const int e0 = blk * 128 + pi * 2, h = (blk * 128) >> 13;
    if (tid < 256) cdS[tid] = CD[tid * 8 + h];
    unsigned v[32];
#pragma unroll
    for (int k = 0; k < 32; ++k) v[k] = *(const unsigned*)(ST + (size_t)(seg * 32 + k) * 65536 + e0);
    __syncthreads();
    float L0 = 0.f, L1 = 0.f, Dt = 1.f;
#pragma unroll
    for (int k = 0; k < 32; ++k) { const float d = cdS[seg * 32 + k]; L0 = L0 * d + bf2f(v[k] & 0xffffu); L1 = L1 * d + bf2f(v[k] >> 16); Dt *= d; }
    segL[seg * 128 + pi * 2] = L0; segL[seg * 128 + pi * 2 + 1] = L1; if (pi == 0) segD[seg] = Dt;
    __syncthreads();
    float c0 = 0.f, c1 = 0.f;
    for (int s2 = 0; s2 < seg; ++s2) { const float d = segD[s2]; c0 = c0 * d + segL[s2 * 128 + pi * 2]; c1 = c1 * d + segL[s2 * 128 + pi * 2 + 1]; }
#pragma unroll
    for (int k = 0; k < 32; ++k) { const float d = cdS[seg * 32 + k]; const unsigned o = f2bf(c0) | (f2bf(c1) << 16);
        c0 = c0 * d + bf2f(v[k] & 0xffffu); c1 = c1 * d + bf2f(v[k] >> 16);
        *(unsigned*)(ST + (size_t)(seg * 32 + k) * 65536 + e0) = o; }
    __syncthreads();
}
constexpr int S3_LDS = 3072 + (2 * 64 * 136 + 4 * 64 * 72 + 8 * 32 * 72) * 2;
__device__ __forceinline__ void stage_ssd_s3(const Params& P, int l, LAS unsigned char* lds, int item) {
    const int tid = otid(), lane = tid & 63, wave = tid >> 6, quad = lane >> 4, l15 = lane & 15;
    const int c = item >> 1, g = item & 1, t0 = c * 64;
    LAS float* dtS = (LAS float*)lds; LAS float* acS = dtS + 256; LAS float* red = acS + 256;
    LAS bf16* Cn = (LAS bf16*)(lds + 3072); LAS bf16* Bn = Cn + 64 * 136; LAS bf16* XT = Bn + 64 * 136; LAS bf16* SCw = XT + 4 * 64 * 72 + wave * 32 * 72;
    const bf16* U = (const bf16*)(P.ws + WS_U); bf16* Y = (bf16*)(P.ws + WS_H);
    const int hh = wave >> 1, qh = wave & 1, h = g * 4 + hh;
    const float raw = tid < 256 ? bf2f(U[(size_t)(t0 + (tid & 63)) * NU + C_DT + g * 4 + (tid >> 6)]) : 0.f;
    u32x2 zz[2][4];
#pragma unroll
    for (int qb = 0; qb < 2; ++qb)
#pragma unroll
        for (int pb = 0; pb < 4; ++pb) zz[qb][pb] = *(const u32x2*)(U + (size_t)(t0 + qh * 32 + qb * 16 + l15) * NU + C_Z + h * 64 + pb * 16 + quad * 4);
    {
        const int tseg = tid & 7, cg = tid >> 3; const int kind = cg < 32 ? 0 : (cg < 48 ? 1 : 2);
        const int j0 = kind == 0 ? cg * 8 : (kind == 1 ? (cg - 32) * 8 : (cg - 48) * 8);
        const int col = kind == 0 ? C_XS + g * 256 + j0 : (kind == 1 ? C_B + g * 128 + j0 : C_C + g * 128 + j0);
        float o[8][8];
        conv8x8(U, t0 + tseg * 8, col, PBP(P, PB_CONVW) + (size_t)l * 4 * 1024, PBP(P, PB_CONVB) + l * 1024, o);
        ssd_dt(P, l, g, raw, dtS, acS, tid);
        __syncthreads();
        if (kind == 0) { const int hh2 = j0 >> 6, p0 = j0 & 63;
#pragma unroll
            for (int k = 0; k < 8; ++k) { float v[8];
#pragma unroll
                for (int tok = 0; tok < 8; ++tok) v[tok] = o[tok][k] * dtS[hh2 * 64 + tseg * 8 + tok];
                *(LAS bf16x8*)(XT + (hh2 * 64 + p0 + k) * 72 + tseg * 8) = pack8(v); }
        } else { LAS bf16* dst = (kind == 1 ? Bn : Cn) + (tseg * 8) * 136 + j0;
#pragma unroll
            for (int tok = 0; tok < 8; ++tok) *(LAS bf16x8*)(dst + tok * 136) = pack8(o[tok]); }
    }
    const bf16* ST = (const bf16*)(P.ws + WS_ST) + ((size_t)(c * 8 + h) * 64) * 128;
    bf16x8 pf[4][4];
#pragma unroll
    for (int pb = 0; pb < 4; ++pb)
#pragma unroll
        for (int ks = 0; ks < 4; ++ks) pf[pb][ks] = *(const bf16x8*)(ST + (size_t)(pb * 16 + l15) * 128 + ks * 32 + quad * 8);
    __syncthreads();
#pragma unroll
    for (int qb = 0; qb < 2; ++qb)
#pragma unroll
        for (int sb = 0; sb < 4; ++sb) { f32x4 acc = (f32x4){0.f, 0.f, 0.f, 0.f};
#pragma unroll
            for (int ks = 0; ks < 4; ++ks) acc = MFMA16(ld_frag(Bn, 136, sb * 16, ks * 32, lane), ld_frag(Cn, 136, qh * 32 + qb * 16, ks * 32, lane), acc);
            const int q = qh * 32 + qb * 16 + l15; const float aq = acS[hh * 64 + q]; float v[4];
#pragma unroll
            for (int r = 0; r < 4; ++r) { const int s_ = sb * 16 + quad * 4 + r; v[r] = (s_ <= q) ? acc[r] * __expf(aq - acS[hh * 64 + s_]) : 0.f; }
            *(LAS u32x2*)(SCw + (qb * 16 + l15) * 72 + sb * 16 + quad * 4) = pack4(v[0], v[1], v[2], v[3]); }
    asm volatile("s_waitcnt lgkmcnt(0)" ::: "memory");
    f32x4 y[2][4];
    float ssq[2] = {0.f, 0.f};
#pragma unroll
    for (int qb = 0; qb < 2; ++qb)
#pragma unroll
        for (int pb = 0; pb < 4; ++pb) { f32x4 yd = (f32x4){0.f, 0.f, 0.f, 0.f}, yo = (f32x4){0.f, 0.f, 0.f, 0.f};
#pragma unroll
            for (int ks = 0; ks < 2; ++ks) yd = MFMA16(ld_frag(XT + hh * 64 * 72, 72, pb * 16, ks * 32, lane), ld_frag(SCw, 72, qb * 16, ks * 32, lane), yd);
#pragma unroll
            for (int ks = 0; ks < 4; ++ks) yo = MFMA16(pf[pb][ks], ld_frag(Cn, 136, qh * 32 + qb * 16, ks * 32, lane), yo);
            const int q = qh * 32 + qb * 16 + l15; const float eq = __expf(acS[hh * 64 + q]), idt = 1.f / dtS[hh * 64 + q], dsk = PBP(P, PB_DSKIP)[l * 8 + h];
            const u32x2 z2 = zz[qb][pb];
#pragma unroll
            for (int r = 0; r < 4; ++r) { const int p = pb * 16 + quad * 4 + r;
                const float xs = bf2f(XT[(hh * 64 + p) * 72 + q]) * idt;
                const unsigned zw = r < 2 ? z2.x : z2.y; const float z = bf2f((r & 1) ? (zw >> 16) : (zw & 0xffffu));
                const float v = (yd[r] + eq * yo[r] + dsk * xs) * silu_f(z);
                y[qb][pb][r] = v; ssq[qb] += v * v; } }
#pragma unroll
    for (int qb = 0; qb < 2; ++qb) { float s_ = ssq[qb]; s_ += __shfl_xor(s_, 16); s_ += __shfl_xor(s_, 32);
        if (quad == 0) red[hh * 64 + qh * 32 + qb * 16 + l15] = s_; }
    __syncthreads();
#pragma unroll
    for (int qb = 0; qb < 2; ++qb) { const int q = qh * 32 + qb * 16 + l15;
        const float tot = red[q] + red[64 + q] + red[128 + q] + red[192 + q]; const float rstd = rsqrtf(tot * (1.f / 256.f) + NORM_EPS);
#pragma unroll
        for (int pb = 0; pb < 4; ++pb) { const int p = pb * 16 + quad * 4; const f32x4 nw = *(const f32x4*)(PBP(P, PB_SSMNW) + l * 512 + h * 64 + p);
            *(u32x2*)(Y + (size_t)(t0 + q) * D + h * 64 + p) = pack4(y[qb][pb][0] * rstd * nw[0], y[qb][pb][1] * rstd * nw[1], y[qb][pb][2] * rstd * nw[2], y[qb][pb][3] * rstd * nw[3]); } }
    __syncthreads();
}

constexpr int RW_AT = 0, RW_RT = 9216, RW_KT = 18432, RW_BT = 27648, RW_VT = 36864, RW_KHT = 46080, RW_BHT = 55296, RW_X1T = 64512, RW_X2T = 73728,
              RW_MAK = 82944, RW_MRK = 92160, RW_MRB = 101376, RW_MAB = 110592, RW_TOT = 128000, RW_WC = 130048, RW_AAF = 130304, RW_END = 146688;
constexpr int RW_RHS2 = RW_KT;
constexpr int RW_LATW = RW_X1T, RW_LATA = RW_X2T, RW_W2T = RW_MAK, RW_A2T = RW_MRK, RW_AWF = RW_MAB;
constexpr int RW_MOFF = RW_AAF, RW_TB = RW_AAF + 9216, RW_RPT = RW_MAK;
__device__ __forceinline__ float tanh_f(float x) { return 1.f - 2.f * __builtin_amdgcn_rcpf(1.f + __expf(2.f * x)); }

__device__ __forceinline__ void stage_rwkv_p1(const Params& P, int l, LAS unsigned char* lds, int pi) {
    const int tid = otid(), lane = tid & 63, wave = __builtin_amdgcn_readfirstlane(tid >> 6), quad = lane >> 4, l15 = lane & 15;
    const int c = pi >> 2, h = pi & 3, t0 = c * 64;
    LAS bf16* At = (LAS bf16*)(lds + RW_AT); LAS bf16* Rt = (LAS bf16*)(lds + RW_RT); LAS bf16* Kt = (LAS bf16*)(lds + RW_KT); LAS bf16* Bt = (LAS bf16*)(lds + RW_BT);
    LAS bf16* VT = (LAS bf16*)(lds + RW_VT); LAS bf16* KhT = (LAS bf16*)(lds + RW_KHT); LAS bf16* BhT = (LAS bf16*)(lds + RW_BHT);
    LAS bf16* X1T = (LAS bf16*)(lds + RW_X1T); LAS bf16* X2T = (LAS bf16*)(lds + RW_X2T);
    LAS bf16* Mak = (LAS bf16*)(lds + RW_MAK); LAS bf16* Mrk = (LAS bf16*)(lds + RW_MRK); LAS bf16* Mrb = (LAS bf16*)(lds + RW_MRB);
    LAS float* Mab = (LAS float*)(lds + RW_MAB); LAS float* RHS2 = (LAS float*)(lds + RW_RHS2);
    LAS float* tot = (LAS float*)(lds + RW_TOT); LAS float* wCs = (LAS float*)(lds + RW_WC); LAS float* aaF = (LAS float*)(lds + RW_AAF); LAS float* awF = (LAS float*)(lds + RW_AWF);
    LAS bf16* latw = (LAS bf16*)(lds + RW_LATW); LAS bf16* lata = (LAS bf16*)(lds + RW_LATA); LAS bf16* w2T = (LAS bf16*)(lds + RW_W2T); LAS bf16* a2T = (LAS bf16*)(lds + RW_A2T);
    LAS bf16* Moff = (LAS bf16*)(lds + RW_MOFF); LAS bf16* Tb = (LAS bf16*)(lds + RW_TB);
    const bf16* U = (const bf16*)(P.ws + WS_U);
    const float* mu = PBP(P, PB_MU) + (size_t)l * 1152;
    const bf16* ucr = U + (size_t)(t0 + (tid >> 3)) * NU + h * 64 + (tid & 7) * 8;
    const bf16x8 cr = *(const bf16x8*)(ucr + C_R), ck = *(const bf16x8*)(ucr + C_K), cv = *(const bf16x8*)(ucr + C_V);
    bf16x8 pr = (bf16x8){0, 0, 0, 0, 0, 0, 0, 0}, pk = pr, pv = pr;
    if (t0 + (tid >> 3) > 0) { pr = *(const bf16x8*)(ucr - NU + C_R); pk = *(const bf16x8*)(ucr - NU + C_K); pv = *(const bf16x8*)(ucr - NU + C_V); }
    {   const int t = tid >> 3, jg = tid & 7, tg = t0 + t;
        const bf16* uc = U + (size_t)tg * NU + C_WL + jg * 8;
        const bf16x8 cw = *(const bf16x8*)uc, ca = *(const bf16x8*)(uc + 64);
        bf16x8 pw = (bf16x8){0, 0, 0, 0, 0, 0, 0, 0}, pa = pw;
        if (tg > 0) { pw = *(const bf16x8*)(uc - NU); pa = *(const bf16x8*)(uc - NU + 64); }
        float ow[8], oa[8];
#pragma unroll
        for (int jj = 0; jj < 8; ++jj) { const int j = jg * 8 + jj;
            const float cv = us2f(cw[jj]), pv = us2f(pw[jj]); ow[jj] = tanh_f(cv + (pv - cv) * mu[1024 + j]);
            const float cv2 = us2f(ca[jj]), pv2 = us2f(pa[jj]); oa[jj] = cv2 + (pv2 - cv2) * mu[1088 + j]; }
        *(LAS bf16x8*)(latw + t * 72 + jg * 8) = pack8(ow); *(LAS bf16x8*)(lata + t * 72 + jg * 8) = pack8(oa);
        const bf16* wt = (const bf16*)(P.ws + WS_W2T) + (size_t)((l * 4 + h) * 64 + t) * 64 + jg * 8;
        *(LAS bf16x8*)(w2T + t * 72 + jg * 8) = *(const bf16x8*)wt; *(LAS bf16x8*)(a2T + t * 72 + jg * 8) = *(const bf16x8*)(wt + 65536);
    }
    __syncthreads();
    {   const int tb = wave & 3; const bool isA = wave >= 4;
        const LAS bf16* Am = isA ? lata : latw; const LAS bf16* Bm = isA ? a2T : w2T; LAS float* Of = isA ? aaF : awF; const int ofs = isA ? 64 : 68;
#pragma unroll
        for (int cb = 0; cb < 4; ++cb) { f32x4 acc = (f32x4){0.f, 0.f, 0.f, 0.f};
#pragma unroll
            for (int ks = 0; ks < 2; ++ks) acc = MFMA16(ld_frag(Am, 72, tb * 16, ks * 32, lane), ld_frag(Bm, 72, cb * 16, ks * 32, lane), acc);
#pragma unroll
            for (int r = 0; r < 4; ++r) Of[(tb * 16 + quad * 4 + r) * ofs + cb * 16 + l15] = acc[r]; }
    }
    __syncthreads();
    {   const int t = tid >> 3, cg = tid & 7, tg = t0 + t, ch0 = cg * 8, gch = h * 64 + ch0;
        float rr[8], k2[8], vv[8], kkn[8], aS[8], lw[8], Lc[8];
        float ss = 0.f, bsum = 0.f;
        float cmr[8], cmk[8], cmv[8], cw0[8], ca0[8], ckk[8], cka[8], crk[8];
#pragma unroll
        for (int q4 = 0; q4 < 2; ++q4) { const int pc4 = l * 256 + gch + q4 * 4;
            const f32x4 m0 = *(const f32x4*)(mu + gch + q4 * 4), m1 = *(const f32x4*)(mu + 256 + gch + q4 * 4), m2 = *(const f32x4*)(mu + 512 + gch + q4 * 4);
            const f32x4 c0 = *(const f32x4*)(PBP(P, PB_W0) + pc4), c1 = *(const f32x4*)(PBP(P, PB_A0) + pc4), c2 = *(const f32x4*)(PBP(P, PB_KK) + pc4), c3 = *(const f32x4*)(PBP(P, PB_KA) + pc4), c4 = *(const f32x4*)(PBP(P, PB_RK) + pc4);
#pragma unroll
            for (int e = 0; e < 4; ++e) { cmr[q4 * 4 + e] = m0[e]; cmk[q4 * 4 + e] = m1[e]; cmv[q4 * 4 + e] = m2[e]; cw0[q4 * 4 + e] = c0[e]; ca0[q4 * 4 + e] = c1[e]; ckk[q4 * 4 + e] = c2[e]; cka[q4 * 4 + e] = c3[e]; crk[q4 * 4 + e] = c4[e]; } }
#pragma unroll
        for (int jj = 0; jj < 8; ++jj) {
            float a_ = us2f(cr[jj]), b_ = us2f(pr[jj]); const float r = a_ + (b_ - a_) * cmr[jj];
            a_ = us2f(ck[jj]); b_ = us2f(pk[jj]); const float k = a_ + (b_ - a_) * cmk[jj];
            a_ = us2f(cv[jj]); b_ = us2f(pv[jj]); const float v = a_ + (b_ - a_) * cmv[jj];
            const float aw = awF[t * 68 + ch0 + jj] + cw0[jj], aa = aaF[t * 64 + ch0 + jj] + ca0[jj];
            lw[jj] = -0.60653066f * sigmoid_f(aw); const float a = sigmoid_f(aa);
            const float kr = k * ckk[jj]; ss += kr * kr; kkn[jj] = kr;
            k2[jj] = k * (1.f + (a - 1.f) * cka[jj]); aS[jj] = a; rr[jj] = r; vv[jj] = v;
            bsum += r * k2[jj] * crk[jj]; Lc[jj] = lw[jj]; }
#pragma unroll
        for (int o = 1; o < 8; o <<= 1) { ss += __shfl_xor(ss, o); bsum += __shfl_xor(bsum, o); }
        const float inv = 1.f / fmaxf(sqrtf(ss), 1e-12f);
        if (cg == 0) ((float*)(P.ws + WS_BS))[(size_t)tg * 4 + h] = bsum;
#pragma unroll
        for (int o = 8; o < 64; o <<= 1)
#pragma unroll
            for (int jj = 0; jj < 8; ++jj) { const float tmp = __shfl_up(Lc[jj], o); if (lane >= o) Lc[jj] += tmp; }
        if ((lane >> 3) == 7) {
#pragma unroll
            for (int jj = 0; jj < 8; ++jj) tot[wave * 64 + ch0 + jj] = Lc[jj]; }
        __syncthreads();
        float oA[8], oR[8], oK[8], oB[8];
#pragma unroll
        for (int jj = 0; jj < 8; ++jj) { float base = 0.f, LC = 0.f;
#pragma unroll
            for (int w2 = 0; w2 < 8; ++w2) { const float tv = tot[w2 * 64 + ch0 + jj]; base += w2 < wave ? tv : 0.f; LC += tv; }
            const float L = Lc[jj] + base; const float kk = kkn[jj] * inv, b = kk * aS[jj];
            const float eL = __expf(L), eiL = __expf(-L), eh = __expf(LC - L);
            oA[jj] = -kk * __expf(L - lw[jj]); oR[jj] = rr[jj] * eL; oK[jj] = k2[jj] * eiL; oB[jj] = b * eiL;
            VT[(ch0 + jj) * 72 + t] = (bf16)f2bf(vv[jj]); KhT[(ch0 + jj) * 72 + t] = (bf16)f2bf(k2[jj] * eh); BhT[(ch0 + jj) * 72 + t] = (bf16)f2bf(b * eh);
            if (t == 63) wCs[ch0 + jj] = __expf(LC); }
        *(LAS bf16x8*)(At + t * 72 + ch0) = pack8(oA); *(LAS bf16x8*)(Rt + t * 72 + ch0) = pack8(oR); *(LAS bf16x8*)(Kt + t * 72 + ch0) = pack8(oK); *(LAS bf16x8*)(Bt + t * 72 + ch0) = pack8(oB);
    }
    __syncthreads();
    {   const int mat = wave >> 1, half = wave & 1;
        const LAS bf16* Am = mat < 2 ? At : Rt; const LAS bf16* Bm = (mat == 0 || mat == 3) ? Bt : Kt;
        LAS bf16* Ob = mat == 1 ? Mak : (mat == 2 ? Mrk : Mrb);
#pragma unroll
        for (int tbi = 0; tbi < 2; ++tbi)
#pragma unroll
            for (int sb = 0; sb < 4; ++sb) { const int tb = half * 2 + tbi; f32x4 acc = (f32x4){0.f, 0.f, 0.f, 0.f};
                if (sb <= tb) {
#pragma unroll
                    for (int ks = 0; ks < 2; ++ks) acc = MFMA16(ld_frag(Am, 72, tb * 16, ks * 32, lane), ld_frag(Bm, 72, sb * 16, ks * 32, lane), acc); }
#pragma unroll
                for (int r = 0; r < 4; ++r) { const int t = tb * 16 + quad * 4 + r, s_ = sb * 16 + l15;
                    const bool keep = mat < 2 ? (s_ < t) : (s_ <= t); const float val = keep ? acc[r] : 0.f;
                    if (mat == 0) { Mab[t * 68 + s_] = val; Moff[t * 72 + s_] = (bf16)(sb < tb ? f2bf(val) : 0u); } else Ob[t * 72 + s_] = (bf16)f2bf(val); } }
    }
    __syncthreads();
    if (wave == 0) {
        for (int e = lane; e < 320; e += 64) *(LAS u32x4v*)(Tb + e * 8) = (u32x4v){0u, 0u, 0u, 0u};
        const int b = quad, cc = l15;
        unsigned ma = (unsigned)(uintptr_t)(Mab + (16 * b) * 68 + 16 * b); asm volatile("" : "+v"(ma)); const LAS float* Mv = (const LAS float*)(uintptr_t)ma;
        float x[16];
#pragma unroll
        for (int t = 0; t < 16; ++t) { float a = t == cc ? 1.f : 0.f;
#pragma unroll
            for (int s_ = 0; s_ < t; ++s_) a += Mv[t * 68 + s_] * x[s_];
            asm volatile("" : "+v"(a) :: "memory");
            x[t] = a; }
#pragma unroll
        for (int t = 0; t < 16; ++t) Tb[(b * 16 + t) * 40 + cc] = (bf16)f2bf(x[t]);
    } else {
        for (int tile = wave - 1; tile < 16; tile += 7) { const int tb = tile >> 2, ib = tile & 3; f32x4 acc = (f32x4){0.f, 0.f, 0.f, 0.f};
#pragma unroll
            for (int ks = 0; ks < 2; ++ks) acc = MFMA16(ld_frag(Mak, 72, tb * 16, ks * 32, lane), ld_frag(VT, 72, ib * 16, ks * 32, lane), acc);
#pragma unroll
            for (int r = 0; r < 4; ++r) RHS2[(tb * 16 + quad * 4 + r) * 68 + ib * 16 + l15] = acc[r]; }
    }
    __syncthreads();
    {   LAS bf16* XTw = (wave < 4 ? X1T : X2T) + (wave & 3) * 16 * 72; LAS bf16* Rp = (LAS bf16*)(lds + RW_RPT) + wave * 512;
        for (int e = lane; e < 144; e += 64) *(LAS u32x4v*)(XTw + e * 8) = (u32x4v){0u, 0u, 0u, 0u};
        *(LAS u32x4v*)(Rp + lane * 8) = (u32x4v){0u, 0u, 0u, 0u};
#pragma unroll
        for (int b = 0; b < 4; ++b) {
            f32x4 acc;
#pragma unroll
            for (int r = 0; r < 4; ++r) { const int t = 16 * b + quad * 4 + r; acc[r] = wave < 4 ? bf2f(At[t * 72 + wave * 16 + l15]) : RHS2[t * 68 + (wave - 4) * 16 + l15]; }
            asm volatile("s_waitcnt lgkmcnt(0)" ::: "memory");
            if (b >= 1) acc = MFMA16(ld_frag(Moff, 72, 16 * b, 0, lane), ld_frag(XTw, 72, 0, 0, lane), acc);
            if (b == 3) acc = MFMA16(ld_frag(Moff, 72, 48, 32, lane), ld_frag(XTw, 72, 0, 32, lane), acc);
            *(LAS u32x2*)(Rp + l15 * 32 + quad * 4) = pack4(acc[0], acc[1], acc[2], acc[3]);
            asm volatile("s_waitcnt lgkmcnt(0)" ::: "memory");
            const f32x4 xb = MFMA16(ld_frag(Tb + b * 640, 40, 0, 0, lane), ld_frag(Rp, 32, 0, 0, lane), ((f32x4){0.f, 0.f, 0.f, 0.f}));
            *(LAS u32x2*)(XTw + l15 * 72 + 16 * b + quad * 4) = pack4(xb[0], xb[1], xb[2], xb[3]);
            asm volatile("s_waitcnt lgkmcnt(0)" ::: "memory");
        }
    }
    __syncthreads();
    {   const int mat = wave >> 1, half = wave & 1;
        bf16* Q1g = (bf16*)(P.ws + WS_Q1) + (size_t)pi * 4096; bf16* Y0g = (bf16*)(P.ws + WS_Y0) + (size_t)pi * 4096;
        bf16* PcTg = (bf16*)(P.ws + WS_PCT) + (size_t)pi * 4096; bf16* Gcg = (bf16*)(P.ws + WS_GC) + (size_t)pi * 4096;
        const LAS bf16* A1 = (mat == 0 || mat == 2) ? X1T : (mat == 1 ? VT : KhT);
        const LAS bf16* B1 = mat == 0 ? Mrb : (mat == 1 ? Mrk : (mat == 2 ? BhT : VT));
        const LAS bf16* A2 = mat == 1 ? X2T : BhT; const LAS bf16* B2 = mat == 1 ? Mrb : X2T;
#pragma unroll
        for (int rbi = 0; rbi < 2; ++rbi)
#pragma unroll
            for (int cb = 0; cb < 4; ++cb) { const int rb = half * 2 + rbi; f32x4 acc = (f32x4){0.f, 0.f, 0.f, 0.f};
#pragma unroll
                for (int ks = 0; ks < 2; ++ks) acc = MFMA16(ld_frag(A1, 72, rb * 16, ks * 32, lane), ld_frag(B1, 72, cb * 16, ks * 32, lane), acc);
                if (mat == 1 || mat == 3) {
#pragma unroll
                    for (int ks = 0; ks < 2; ++ks) acc = MFMA16(ld_frag(A2, 72, rb * 16, ks * 32, lane), ld_frag(B2, 72, cb * 16, ks * 32, lane), acc); }
                const int r0 = rb * 16 + quad * 4, cl = cb * 16 + l15;
                if (mat == 0) { const u32x2 rt = *(const LAS u32x2*)(Rt + cl * 72 + r0);
                    *(u32x2*)(Q1g + cl * 64 + r0) = pack4(acc[0] + bf2f(rt.x & 0xffffu), acc[1] + bf2f(rt.x >> 16), acc[2] + bf2f(rt.y & 0xffffu), acc[3] + bf2f(rt.y >> 16)); }
                else if (mat == 1) *(u32x2*)(Y0g + cl * 64 + r0) = pack4(acc[0], acc[1], acc[2], acc[3]);
                else if (mat == 2) { const float wc = wCs[cl];
                    *(u32x2*)(PcTg + cl * 64 + r0) = pack4(acc[0] + (r0 == cl ? wc : 0.f), acc[1] + (r0 + 1 == cl ? wc : 0.f), acc[2] + (r0 + 2 == cl ? wc : 0.f), acc[3] + (r0 + 3 == cl ? wc : 0.f)); }
                else *(u32x2*)(Gcg + ((cb * 64 + lane) * 4 + rb) * 4) = pack4(acc[0], acc[1], acc[2], acc[3]); }
    }
    __syncthreads();
}

constexpr int CH_PT = 0, CH_SB = 8 * 9216, CH_END = CH_SB + 8 * 2304;
__device__ __forceinline__ void chain_step(f32x4 (&acc)[4], const LAS bf16* PTs, LAS bf16* Sb, const u32x4v (&gf)[2], bool withG, int lane) {
    const int quad = lane >> 4, l15 = lane & 15;
#pragma unroll
    for (int jb = 0; jb < 4; ++jb) *(LAS u32x2*)(Sb + l15 * 72 + jb * 16 + quad * 4) = pack4(acc[jb][0], acc[jb][1], acc[jb][2], acc[jb][3]);
    asm volatile("s_waitcnt lgkmcnt(0)" ::: "memory");
    const bf16x8 b0 = ld_frag(Sb, 72, 0, 0, lane), b1 = ld_frag(Sb, 72, 0, 32, lane);
#pragma unroll
    for (int jb = 0; jb < 4; ++jb) { f32x4 n = (f32x4){0.f, 0.f, 0.f, 0.f};
        if (withG) { const unsigned g0 = gf[jb >> 1][(jb & 1) * 2], g1 = gf[jb >> 1][(jb & 1) * 2 + 1]; n = (f32x4){bf2f(g0 & 0xffffu), bf2f(g0 >> 16), bf2f(g1 & 0xffffu), bf2f(g1 >> 16)}; }
        n = MFMA16(ld_frag(PTs, 72, jb * 16, 0, lane), b0, n); n = MFMA16(ld_frag(PTs, 72, jb * 16, 32, lane), b1, n);
        acc[jb] = n; }
    asm volatile("s_waitcnt lgkmcnt(0)" ::: "memory");
}

__device__ __forceinline__ void stage_rwkv_compose(const Params& P, LAS unsigned char* lds, int task) {
    const int tid = otid(), lane = tid & 63, wave = __builtin_amdgcn_readfirstlane(tid >> 6), quad = lane >> 4, l15 = lane & 15;
    const int gI = task >> 2, h = task & 3, kind = wave >> 2, rb = wave & 3;
    LAS bf16* PTs = (LAS bf16*)(lds + CH_PT); LAS bf16* Sb = (LAS bf16*)(lds + CH_SB) + wave * 16 * 72;
    f32x4 acc[4];
#pragma unroll
    for (int jb = 0; jb < 4; ++jb)
#pragma unroll
        for (int r = 0; r < 4; ++r) acc[jb][r] = (kind == 0 && (jb * 16 + quad * 4 + r) == (rb * 16 + l15)) ? 1.f : 0.f;
    for (int bt = 0; bt < 2; ++bt) {
        const size_t pi0 = (size_t)((gI * 16 + bt * 8) * 4 + h);
        u32x4v pt[8], gf[8][2];
#pragma unroll
        for (int s_ = 0; s_ < 8; ++s_) { pt[s_] = *(const u32x4v*)((const bf16*)(P.ws + WS_PCT) + (pi0 + 4 * s_) * 4096 + tid * 8);
            gf[s_][0] = (u32x4v){0u, 0u, 0u, 0u}; gf[s_][1] = gf[s_][0];
            if (kind == 1) { const bf16* gp = (const bf16*)(P.ws + WS_GC) + (pi0 + 4 * s_) * 4096 + (rb * 64 + lane) * 16; gf[s_][0] = *(const u32x4v*)gp; gf[s_][1] = *(const u32x4v*)(gp + 8); } }
        __syncthreads();
#pragma unroll
        for (int s_ = 0; s_ < 8; ++s_) *(LAS u32x4v*)(PTs + s_ * 4608 + (tid >> 3) * 72 + (tid & 7) * 8) = pt[s_];
        __syncthreads();
#pragma unroll
        for (int s_ = 0; s_ < 8; ++s_) chain_step(acc, PTs + s_ * 4608, Sb, gf[s_], kind == 1, lane);
    }
    if (kind == 0) { bf16* PgTg = (bf16*)(P.ws + WS_PGT) + (size_t)task * 4096;
#pragma unroll
        for (int jb = 0; jb < 4; ++jb)
#pragma unroll
            for (int r = 0; r < 4; ++r) PgTg[(jb * 16 + quad * 4 + r) * 64 + rb * 16 + l15] = (bf16)f2bf(acc[jb][r]);
    } else { bf16* Ggg = (bf16*)(P.ws + WS_GG) + (size_t)task * 4096;
#pragma unroll
        for (int jb = 0; jb < 4; ++jb) *(u32x2*)(Ggg + ((rb * 64 + lane) * 4 + jb) * 4) = pack4(acc[jb][0], acc[jb][1], acc[jb][2], acc[jb][3]); }
    __syncthreads();
}

__device__ __forceinline__ void stage_rwkv_chain(const Params& P, LAS unsigned char* lds, int task) {
    const int tid = otid(), lane = tid & 63, wave = __builtin_amdgcn_readfirstlane(tid >> 6);
    const int gI = task >> 2, h = task & 3, rb = wave & 3, nsteps = gI + 16;
    LAS bf16* PTs = (LAS bf16*)(lds + CH_PT); LAS bf16* Sb = (LAS bf16*)(lds + CH_SB) + wave * 16 * 72;
    f32x4 acc[4];
#pragma unroll
    for (int jb = 0; jb < 4; ++jb) acc[jb] = (f32x4){0.f, 0.f, 0.f, 0.f};
    for (int s0 = 0; s0 < nsteps; s0 += 8) {
        u32x4v pt[8], gf[8][2];
#pragma unroll
        for (int s_ = 0; s_ < 8; ++s_) { const int sg = s0 + s_;
            pt[s_] = (u32x4v){0u, 0u, 0u, 0u}; gf[s_][0] = pt[s_]; gf[s_][1] = pt[s_];
            if (sg < nsteps) {
                const bool grp = sg < gI; const size_t idx = grp ? (size_t)(sg * 4 + h) : (size_t)((gI * 16 + sg - gI) * 4 + h);
                const bf16* ptp = (const bf16*)(P.ws + (grp ? WS_PGT : WS_PCT)) + idx * 4096; const bf16* gp = (const bf16*)(P.ws + (grp ? WS_GG : WS_GC)) + idx * 4096 + (rb * 64 + lane) * 16;
                pt[s_] = *(const u32x4v*)(ptp + tid * 8);
                if (wave < 4) { gf[s_][0] = *(const u32x4v*)gp; gf[s_][1] = *(const u32x4v*)(gp + 8); } } }
        __syncthreads();
#pragma unroll
        for (int s_ = 0; s_ < 8; ++s_) *(LAS u32x4v*)(PTs + s_ * 4608 + (tid >> 3) * 72 + (tid & 7) * 8) = pt[s_];
        __syncthreads();
        if (wave < 4) {
#pragma unroll
            for (int s_ = 0; s_ < 8; ++s_) { const int sg = s0 + s_;
                if (sg < nsteps) {
                    if (sg >= gI) {
                        const int quad = lane >> 4, l15 = lane & 15;
#pragma unroll
                        for (int jb = 0; jb < 4; ++jb) *(LAS u32x2*)(Sb + l15 * 72 + jb * 16 + quad * 4) = pack4(acc[jb][0], acc[jb][1], acc[jb][2], acc[jb][3]);
                        asm volatile("s_waitcnt lgkmcnt(0)" ::: "memory");
                        bf16* S0g = (bf16*)(P.ws + WS_S0) + (size_t)((gI * 16 + sg - gI) * 4 + h) * 4096 + (rb * 16 + (lane >> 2)) * 64 + (lane & 3) * 16;
                        const LAS bf16* sp = Sb + (lane >> 2) * 72 + (lane & 3) * 16;
                        *(u32x4v*)S0g = *(const LAS u32x4v*)sp; *(u32x4v*)(S0g + 8) = *(const LAS u32x4v*)(sp + 8);
                        asm volatile("s_waitcnt lgkmcnt(0)" ::: "memory"); }
                    chain_step(acc, PTs + s_ * 4608, Sb, gf[s_], true, lane); } }
        }
    }
    __syncthreads();
}

__device__ __forceinline__ void stage_rwkv_y(const Params& P, int l, int wt, int lane) {
    const int pi = wt >> 2, tb = wt & 3, c = pi >> 2, h = pi & 3, quad = lane >> 4, l15 = lane & 15;
    const bf16* S0g = (const bf16*)(P.ws + WS_S0) + (size_t)pi * 4096; const bf16* Q1g = (const bf16*)(P.ws + WS_Q1) + (size_t)pi * 4096; const bf16* Y0g = (const bf16*)(P.ws + WS_Y0) + (size_t)pi * 4096;
    const bf16* U = (const bf16*)(P.ws + WS_U); bf16* Y = (bf16*)(P.ws + WS_H);
    const int tl = tb * 16 + l15, tg = c * 64 + tl;
    const bf16* qp = Q1g + tl * 64 + quad * 8;
    const bf16x8 q0 = *(const bf16x8*)qp, q1 = *(const bf16x8*)(qp + 32);
    f32x4 y[4];
    u32x2 vc[4], vp[4], gc[4], gp[4];
    const bf16* uc = U + (size_t)tg * NU + h * 64 + quad * 4;
#pragma unroll
    for (int ib = 0; ib < 4; ++ib) {
        const u32x2 y0 = *(const u32x2*)(Y0g + tl * 64 + ib * 16 + quad * 4);
        y[ib] = (f32x4){bf2f(y0.x & 0xffffu), bf2f(y0.x >> 16), bf2f(y0.y & 0xffffu), bf2f(y0.y >> 16)};
        vc[ib] = *(const u32x2*)(uc + C_V + ib * 16); gc[ib] = *(const u32x2*)(uc + C_G + ib * 16);
        vp[ib] = (u32x2){0u, 0u}; gp[ib] = (u32x2){0u, 0u};
        if (tg > 0) { vp[ib] = *(const u32x2*)(uc - NU + C_V + ib * 16); gp[ib] = *(const u32x2*)(uc - NU + C_G + ib * 16); } }
    const float bs = ((const float*)(P.ws + WS_BS))[(size_t)tg * 4 + h];
#pragma unroll
    for (int ib = 0; ib < 4; ++ib) { const bf16* sp = S0g + (ib * 16 + l15) * 64 + quad * 8;
        y[ib] = MFMA16(*(const bf16x8*)sp, q0, y[ib]); y[ib] = MFMA16(*(const bf16x8*)(sp + 32), q1, y[ib]); }
    float s = 0.f;
#pragma unroll
    for (int ib = 0; ib < 4; ++ib) s += (y[ib][0] + y[ib][1]) + (y[ib][2] + y[ib][3]);
    s += __shfl_xor(s, 16); s += __shfl_xor(s, 32);
    const float mean = s * (1.f / 64.f);
    float q = 0.f;
#pragma unroll
    for (int ib = 0; ib < 4; ++ib)
#pragma unroll
        for (int r = 0; r < 4; ++r) { const float d = y[ib][r] - mean; q += d * d; }
    q += __shfl_xor(q, 16); q += __shfl_xor(q, 32);
    const float rstd = rsqrtf(q * (1.f / 64.f) + LNX_EPS);
    const float* mu = PBP(P, PB_MU) + (size_t)l * 1152;
#pragma unroll
    for (int ib = 0; ib < 4; ++ib) { const int chn = h * 64 + ib * 16 + quad * 4, pc = l * 256 + chn;
        float o[4];
#pragma unroll
        for (int r = 0; r < 4; ++r) {
            const unsigned wv = r < 2 ? vc[ib].x : vc[ib].y, wvp = r < 2 ? vp[ib].x : vp[ib].y, wg = r < 2 ? gc[ib].x : gc[ib].y, wgp = r < 2 ? gp[ib].x : gp[ib].y;
            const float cv = bf2f((r & 1) ? (wv >> 16) : (wv & 0xffffu)), pv = bf2f((r & 1) ? (wvp >> 16) : (wvp & 0xffffu));
            const float cg = bf2f((r & 1) ? (wg >> 16) : (wg & 0xffffu)), pg = bf2f((r & 1) ? (wgp >> 16) : (wgp & 0xffffu));
            const float v = cv + (pv - cv) * mu[512 + chn + r], g = cg + (pg - cg) * mu[768 + chn + r];
            const float yn = (y[ib][r] - mean) * rstd * PBP(P, PB_LNW)[pc + r] + PBP(P, PB_LNB)[pc + r];
            o[r] = (yn + bs * v) * silu_f(g); }
        *(u32x2*)(Y + (size_t)tg * D + 512 + chn) = pack4(o[0], o[1], o[2], o[3]); }
}

constexpr int NT = 512;
constexpr int DUP_SUB = -1;
constexpr int REP_XA = 1, REP_S1 = 1, REP_P1 = 1, REP_OUT = 1, REP_SS3 = 1, REP_CMP = 1, REP_Y = 1;
constexpr int LDS_BYTES = 147456, MISC_OFF = LDS_BYTES - 256;
constexpr int CW_BAR = 4096;
static_assert(XA_LDS <= MISC_OFF && S3_LDS <= MISC_OFF && RW_END <= MISC_OFF && CH_END <= MISC_OFF && pg8::STAGE_BYTES <= MISC_OFF, "LDS map");

__global__ void __launch_bounds__(NT, 2) mega_fwd(Params P) {
    extern __shared__ __attribute__((aligned(16))) unsigned char lds_raw[];
    LAS unsigned char* lds_base = (LAS unsigned char*)lds_raw;
    volatile LAS unsigned* MISC = (volatile LAS unsigned*)(lds_base + MISC_OFF);
    const int tid = otid(), wave = __builtin_amdgcn_readfirstlane(tid >> 6), G = gridDim.x, bx = blockIdx.x;
    if (tid < 64) MISC[tid] = 0u;
    __syncthreads();
    XcdBarrier bar = xcd_barrier_post((unsigned*)(P.ws + WS_CTL) + CW_BAR, MISC + 8);
    {
        LAS unsigned char* lds = lds_base; const int gw = bx * 8 + wave, NGW = G * 8;
        stage_blob(P, bx * NT + tid, G * NT);
        for (int it = bx; it < N_PREP_ITEMS; it += G) stage_prep_weights(P, lds, it);
        for (int m = bx; m < MEM_LEN; m += G) stage_memkv(P, lds, m);
        for (int m = gw; m < M; m += NGW) prenorm_row(P.x + (size_t)m * D, P.pre_norm_w, (bf16*)(P.ws + WS_H) + (size_t)m * D, tid & 63);
        xcd_barrier(bar);
    }
    constexpr int PER = 7 + (DUP_SUB >= 0 ? 1 : 0), NPH = 1 + DEPTH * PER;
#pragma unroll 1
    for (int ph = 1; ph < NPH; ++ph) {
        Params Q;
        {   uintptr_t w_ = (uintptr_t)P.ws, o_ = (uintptr_t)P.out, x_ = (uintptr_t)P.x;
            asm volatile("" : "+s"(w_), "+s"(o_), "+s"(x_));
            Q.ws = (unsigned char*)(GAS unsigned char*)w_; Q.out = (float*)(GAS float*)o_; Q.x = (const float*)(GAS const float*)x_; }
        unsigned lds_a = (unsigned)(uintptr_t)lds_base; asm volatile("" : "+s"(lds_a)); LAS unsigned char* lds = (LAS unsigned char*)(uintptr_t)lds_a;
        int bx = blockIdx.x, G = gridDim.x; asm volatile("" : "+s"(bx), "+s"(G));
        const int tid = otid(), wave = __builtin_amdgcn_readfirstlane(tid >> 6), gw = bx * 8 + wave, NGW = G * 8;
        const int l = (ph - 1) / PER, s_ = (ph - 1) % PER, sub = (DUP_SUB >= 0 && s_ > DUP_SUB) ? s_ - 1 : s_;
        if (sub == 0) {
            pg8::Gemm g{(const bf16*)(Q.ws + WS_H), (const bf16*)(Q.ws + WS_WIN) + (size_t)l * NU * D, M, NU, D};
            pg8::StaticOrder S; S.init(M, NU, G, bx);
            pg8::EpiBf16 E{(bf16*)(Q.ws + WS_U), NU};
            pg8::gemm_phase<pg8::EpiBf16, pg8::StaticOrder, true, true>(lds, g, S, E);
        } else if (sub == 1) {
            for (int r_ = 0; r_ < REP_XA; ++r_) for (int it = bx; it < (M / 256) * 4; it += G) stage_xattn(Q, lds, it);
            for (int r_ = 0; r_ < REP_S1; ++r_) for (int it = bx; it < NCHUNK * 2; it += G) stage_ssd_s1(Q, l, lds, it);
            for (int r_ = 0; r_ < REP_P1; ++r_) for (int it = bx; it < NCHUNK * 4; it += G) stage_rwkv_p1(Q, l, lds, it);
        } else if (sub == 2) {
            if (bx < 64) for (int r_ = 0; r_ < REP_CMP; ++r_) stage_rwkv_compose(Q, lds, bx);
            else for (int it = bx - 64; it < 512; it += G - 64) stage_ssd_scan(Q, lds, it);
        } else if (sub == 3) {
            if (bx < 64) for (int r_ = 0; r_ < REP_OUT; ++r_) stage_rwkv_chain(Q, lds, bx);
            else for (int r_ = 0; r_ < REP_SS3; ++r_) for (int it = bx - 64; it < NCHUNK * 2; it += G - 64) stage_ssd_s3(Q, l, lds, it);
        } else if (sub == 4) {
            for (int r_ = 0; r_ < REP_Y; ++r_) for (int wt = gw; wt < NCHUNK * 4 * 4; wt += NGW) stage_rwkv_y(Q, l, wt, tid & 63);
        } else if (sub == 5) {
            pg8::Gemm g{(const bf16*)(Q.ws + WS_H), (const bf16*)(Q.ws + WS_WOUT) + (size_t)l * D * D, M, D, D};
            pg8::StaticOrder S; S.init(M, D, G, bx);
            pg8::EpiF32 E{(float*)(Q.ws + WS_U), D};
            pg8::gemm_phase<pg8::EpiF32, pg8::StaticOrder, true, true>(lds, g, S, E);
        } else {
            const float* xin = l == 0 ? Q.x : Q.out;
            for (int m = gw; m < M; m += NGW)
                post_row((const float*)(Q.ws + WS_U) + (size_t)m * D, xin + (size_t)m * D, PBP(Q, PB_POSTNW) + l * D, Q.out + (size_t)m * D,
                         l + 1 < DEPTH ? PBP(Q, PB_PRENW) + (l + 1) * D : nullptr, l + 1 < DEPTH ? (bf16*)(Q.ws + WS_H) + (size_t)m * D : nullptr, tid & 63);
        }
        if (ph + 1 < NPH) { XcdBarrier b2 = bar; asm volatile("" : "+s"(b2.x), "+s"(b2.bar)); xcd_barrier(b2); }
    }
}

extern "C" void kernel_launch(void* const* d_in, const int* in_sizes, int n_in, void* d_out, int out_size, void* d_ws, size_t ws_size, hipStream_t stream) {
    static int grid = 0;
    if (grid == 0) {
        if (n_in != 24 || in_sizes[0] != M * D || out_size != M * D || ws_size < WS_END) { fprintf(stderr, "kernel_launch: unexpected shapes n_in %d in0 %d out %d ws %zu\n", n_in, n_in > 0 ? in_sizes[0] : -1, out_size, ws_size); grid = -1; return; }
        int dev = 0, cus = 0, per_cu = 0;
        if (hipGetDevice(&dev) != hipSuccess || hipDeviceGetAttribute(&cus, hipDeviceAttributeMultiprocessorCount, dev) != hipSuccess) { grid = -1; return; }
        if (hipFuncSetAttribute((const void*)mega_fwd, hipFuncAttributeMaxDynamicSharedMemorySize, LDS_BYTES) != hipSuccess) { fprintf(stderr, "kernel_launch: hipFuncSetAttribute failed\n"); grid = -1; return; }
        if (hipOccupancyMaxActiveBlocksPerMultiprocessor(&per_cu, (const void*)mega_fwd, NT, LDS_BYTES) != hipSuccess || per_cu < 1) fprintf(stderr, "kernel_launch: occupancy query says %d\n", per_cu);
        (void)hipGetLastError();
        grid = cus;
    }
    if (grid < 0) return;
    if (hipMemsetAsync((char*)d_ws + WS_CTL, 0, 1 * MiB, stream) != hipSuccess) return;
    Params P{};
    const float** pp = (const float**)&P;
    for (int i = 0; i < 24; ++i) pp[i] = (const float*)d_in[i];
    P.out = (float*)d_out; P.ws = (unsigned char*)d_ws;
    hipLaunchKernelGGL(mega_fwd, dim3(grid), dim3(NT), LDS_BYTES, stream, P);
}
```

```cpp
#include <hip/hip_runtime.h>
#include <cstdio>
#include <cstdint>

__device__ __forceinline__ int otid() { int t = threadIdx.x; asm volatile("" : "+v"(t)); return t; }
namespace pg8 {
#define PG8_LAS __attribute__((address_space(3)))
typedef unsigned short bf16_t;
typedef short bf16x8 __attribute__((ext_vector_type(8)));
typedef float f32x4 __attribute__((ext_vector_type(4)));
typedef unsigned u32x4 __attribute__((ext_vector_type(4)));
constexpr int BM = 256, BK = 64, HALF = 128, HTB = HALF * BK * 2  , STAGE_BYTES = 8 * HTB, NXCD = 8, WGM = 8;

__host__ __device__ __forceinline__ int lds_byte(int r, int c) { const int st = (r >> 4) * 2 + (c >> 5), rr = r & 15, cc = c & 31, ob = rr * 64 + cc * 2; return st * 1024 + (ob ^ (((ob >> 9) & 1) << 5)); }
__host__ __device__ __forceinline__ void stage_rc(int b, int& R, int& C) { const int st = b / 1024, sb = b % 1024, swz = sb ^ (((sb >> 9) & 1) << 5); R = (st >> 1) * 16 + swz / 64; C = (st & 1) * 32 + (swz % 64) / 2; }
__host__ __device__ __forceinline__ int perm32(int rho) { const int n = rho >> 4, i = rho & 15; return 8 * (i >> 2) + 4 * n + (i & 3); }

struct Unit { int pm, pn; };
struct Gemm { const bf16_t* A; const bf16_t* Bt; int M, N, K; };

struct StaticOrder {
    int nM, nN, nwg, G, c;
    __host__ __device__ void init(int M, int N, int G_, int c_) { nM = M / BM; nN = N / BM; nwg = nM * nN; G = G_; c = c_; }
    __host__ __device__ bool next(int i, Unit& u) const {
        const long L = (long)i * G + c; if (L >= nwg) return false;
        int wgid = (int)L; { const int q = nwg / NXCD, r = nwg % NXCD, xcd = wgid % NXCD, off = wgid / NXCD; wgid = (xcd < r ? xcd * (q + 1) : r * (q + 1) + (xcd - r) * q) + off; }
        const int nig = WGM * nN, gid = wgid / nig, fm = gid * WGM, gsz = (nM - fm) < WGM ? (nM - fm) : WGM;
        u.pm = fm + ((wgid % nig) % gsz); u.pn = (wgid % nig) / gsz; return true;
    }
    __device__ __forceinline__ void a_ready(const Unit&) const {}
    __device__ __forceinline__ void done(const Unit&) const {}
};


__device__ __forceinline__ unsigned cvt_pk_bf16(float lo, float hi) { unsigned r; asm volatile("v_cvt_pk_bf16_f32 %0, %1, %2" : "=v"(r) : "v"(lo), "v"(hi)); return r; }
struct EpiBf16 {
    static constexpr bool PERM = true, AFTER_DRAIN = false;
    bf16_t* O; int ldc;
    __device__ __forceinline__ void operator()(const f32x4 (&acc)[2][2][4][2], const Unit& u, int wr, int wc, int fr, int fq) const {
        const int row0 = u.pm * BM + wr * 64 + fr; const int col0 = u.pn * BM + wc * 32 + 8 * fq;
#pragma unroll
        for (int ai = 0; ai < 2; ++ai)
#pragma unroll
            for (int m = 0; m < 4; ++m) { bf16_t* rowp = O + (size_t)(row0 + ai * HALF + m * 16) * ldc + col0;
#pragma unroll
                for (int bj = 0; bj < 2; ++bj) { const f32x4 v0 = acc[ai][bj][m][0], v1 = acc[ai][bj][m][1];
                    u32x4 w; w.x = cvt_pk_bf16(v0[0], v0[1]); w.y = cvt_pk_bf16(v0[2], v0[3]); w.z = cvt_pk_bf16(v1[0], v1[1]); w.w = cvt_pk_bf16(v1[2], v1[3]);
                    *(u32x4*)(rowp + bj * HALF) = w; } }
    }
};
struct EpiF32 {
    static constexpr bool PERM = false, AFTER_DRAIN = false;
    float* C; int ldc;
    __device__ __forceinline__ void operator()(const f32x4 (&acc)[2][2][4][2], const Unit& u, int wr, int wc, int fr, int fq) const {
        const int row0 = u.pm * BM + wr * 64 + fr, col0 = u.pn * BM + wc * 32 + 4 * fq;
#pragma unroll
        for (int ai = 0; ai < 2; ++ai)
#pragma unroll
            for (int m = 0; m < 4; ++m) { float* rowp = C + (size_t)(row0 + ai * HALF + m * 16) * ldc + col0;
#pragma unroll
                for (int bj = 0; bj < 2; ++bj)
#pragma unroll
                    for (int n = 0; n < 2; ++n) *(f32x4*)(rowp + bj * HALF + n * 16) = acc[ai][bj][m][n]; }
    }
};

template <class Epi, class Sched, bool ALIGN_EPI = false, bool SP2 = false>
__device__ __forceinline__ void gemm_phase(PG8_LAS unsigned char* lds, const Gemm g, const Sched& S, const Epi& E) {
    const int tid = otid(), wid = __builtin_amdgcn_readfirstlane(tid >> 6), lane = tid & 63, wr = wid >> 2, wc = wid & 3, fr = lane & 15, fq = lane >> 4;
    const int K = g.K, nt = K / BK;
    unsigned voffA[2], voffB[2];
#pragma unroll
    for (int i = 0; i < 2; ++i) { int R, C; stage_rc(tid * 16 + i * 8192, R, C); const int Rb = Epi::PERM ? ((R & ~31) + perm32(R & 31)) : R;
        voffA[i] = (unsigned)(R * K + C) * 2u; voffB[i] = (unsigned)(Rb * K + C) * 2u; }
    const size_t kstep = (size_t)(BK * 2);
    const size_t hstep = (size_t)HALF * K * 2;
    const size_t tstep = 2 * hstep;
    const unsigned ldsw = (unsigned)wid * 1024u;
    const int aoff = lds_byte(wr * 64 + fr, fq * 8), boff = lds_byte(wc * 32 + fr, fq * 8);
#define PG8_SA(b, h) (((b) * 2 + (h)) * HTB)
#define PG8_SB(b, h) ((4 + (b) * 2 + (h)) * HTB)
#define PG8_STAGE(bufoff, gbase, voff) do { _Pragma("unroll") for (int _i = 0; _i < 2; ++_i) \
        __builtin_amdgcn_global_load_lds((const unsigned*)((const char*)(gbase) + (voff)[_i]), (PG8_LAS unsigned*)(lds + (bufoff) + ldsw + _i * 8192), 16, 0, 0); } while (0)
#define PG8_LDA(dst, b, h) do { _Pragma("unroll") for (int m = 0; m < 4; ++m) _Pragma("unroll") for (int k = 0; k < 2; ++k) dst[m][k] = *(const PG8_LAS bf16x8*)(lds + PG8_SA(b, h) + aoff + m * 2048 + k * 1024); } while (0)
#define PG8_LDB(dst, b, h) do { _Pragma("unroll") for (int n = 0; n < 2; ++n) _Pragma("unroll") for (int k = 0; k < 2; ++k) dst[n][k] = *(const PG8_LAS bf16x8*)(lds + PG8_SB(b, h) + boff + n * 2048 + k * 1024); } while (0)
#define PG8_MMA(ai, bj, At, Bt) do { __builtin_amdgcn_s_setprio(1); _Pragma("unroll") for (int m = 0; m < 4; ++m) _Pragma("unroll") for (int n = 0; n < 2; ++n) _Pragma("unroll") for (int k = 0; k < 2; ++k) \
        acc[ai][bj][m][n] = __builtin_amdgcn_mfma_f32_16x16x32_bf16(Bt[n][k], At[m][k], acc[ai][bj][m][n], 0, 0, 0); __builtin_amdgcn_s_setprio(0); } while (0)
#define PG8_WAIT_V(n) asm volatile("s_waitcnt vmcnt(" #n ")" ::: "memory")
#define PG8_WAIT_L(n) asm volatile("s_waitcnt lgkmcnt(" #n ")" ::: "memory")
#define PG8_BAR __builtin_amdgcn_s_barrier()
#define PG8_SCHED __builtin_amdgcn_sched_barrier(0)
    Unit cur, nxt; int ui = 0;
    if (!S.next(0, cur)) return;
    f32x4 acc[2][2][4][2];
#pragma unroll
    for (int a = 0; a < 2; ++a)
#pragma unroll
        for (int b = 0; b < 2; ++b)
#pragma unroll
            for (int m = 0; m < 4; ++m)
#pragma unroll
                for (int n = 0; n < 2; ++n) acc[a][b][m][n] = (f32x4){0.f, 0.f, 0.f, 0.f};
    bf16x8 At[4][2], B0[2][2], B1[2][2];
    const char* cA = (const char*)g.A + (size_t)cur.pm * tstep; const char* cB = (const char*)g.Bt + (size_t)cur.pn * tstep;
    S.a_ready(cur);
    if constexpr (SP2) {
        PG8_STAGE(PG8_SB(0, 0), cB, voffB); PG8_STAGE(PG8_SB(0, 1), cB + hstep, voffB); PG8_STAGE(PG8_SA(0, 0), cA, voffA); PG8_STAGE(PG8_SA(0, 1), cA + hstep, voffA);
        if (wr == 1) PG8_BAR;
        PG8_WAIT_V(2); PG8_BAR;
        PG8_STAGE(PG8_SB(1, 0), cB + kstep, voffB); PG8_STAGE(PG8_SA(1, 0), cA + kstep, voffA); PG8_STAGE(PG8_SB(1, 1), cB + hstep + kstep, voffB);
        PG8_WAIT_V(6); PG8_BAR;
    } else {
        PG8_STAGE(PG8_SB(0, 0), cB, voffB); PG8_STAGE(PG8_SA(0, 0), cA, voffA); PG8_STAGE(PG8_SB(0, 1), cB + hstep, voffB); PG8_STAGE(PG8_SA(0, 1), cA + hstep, voffA);
        if (wr == 1) PG8_BAR;
        PG8_WAIT_V(4); PG8_BAR;
        PG8_STAGE(PG8_SB(1, 0), cB + kstep, voffB); PG8_STAGE(PG8_SA(1, 0), cA + kstep, voffA); PG8_STAGE(PG8_SB(1, 1), cB + hstep + kstep, voffB);
        PG8_WAIT_V(6); PG8_BAR;
    }
    for (;;) {
        const bool has_next = S.next(ui + 1, nxt);
        const char* nA = has_next ? (const char*)g.A + (size_t)nxt.pm * tstep : cA; const char* nB = has_next ? (const char*)g.Bt + (size_t)nxt.pn * tstep : cB;
        for (int t = 0; t < nt; t += 2) {
            const bool last = (t == nt - 2);
            const char* a1 = cA + (size_t)(t + 1) * kstep;
            const char* a2 = last ? nA : cA + (size_t)(t + 2) * kstep; const char* b2 = last ? nB : cB + (size_t)(t + 2) * kstep;
            const char* a3 = a2 + kstep; const char* b3 = b2 + kstep;
            if (last && has_next) S.a_ready(nxt);
            if constexpr (SP2) {
            PG8_LDB(B0, 0, 0); PG8_LDB(B1, 0, 1); PG8_SCHED; PG8_LDA(At, 0, 0); PG8_STAGE(PG8_SA(1, 1), a1 + hstep, voffA);
            PG8_WAIT_V(8); PG8_WAIT_L(0); PG8_BAR; PG8_MMA(0, 0, At, B0); PG8_MMA(0, 1, At, B1); PG8_BAR; PG8_SCHED;
            PG8_LDA(At, 0, 1); PG8_STAGE(PG8_SB(0, 0), b2, voffB); PG8_STAGE(PG8_SB(0, 1), b2 + hstep, voffB); PG8_STAGE(PG8_SA(0, 0), a2, voffA);
            PG8_WAIT_V(8); PG8_WAIT_L(0); PG8_BAR; PG8_MMA(1, 0, At, B0); PG8_MMA(1, 1, At, B1); PG8_BAR; PG8_SCHED;
            PG8_LDB(B0, 1, 0); PG8_LDB(B1, 1, 1); PG8_SCHED; PG8_LDA(At, 1, 0); PG8_STAGE(PG8_SA(0, 1), a2 + hstep, voffA);
            PG8_WAIT_V(8); PG8_WAIT_L(0); PG8_BAR; PG8_MMA(0, 0, At, B0); PG8_MMA(0, 1, At, B1); PG8_BAR; PG8_SCHED;
            PG8_LDA(At, 1, 1); PG8_STAGE(PG8_SB(1, 0), b3, voffB); PG8_STAGE(PG8_SB(1, 1), b3 + hstep, voffB); PG8_STAGE(PG8_SA(1, 0), a3, voffA);
            PG8_WAIT_V(8); PG8_WAIT_L(0); PG8_BAR; PG8_MMA(1, 0, At, B0); PG8_MMA(1, 1, At, B1); PG8_BAR; PG8_SCHED;
            } else {
            PG8_LDB(B0, 0, 0); PG8_SCHED; PG8_LDA(At, 0, 0); PG8_STAGE(PG8_SA(1, 1), a1 + hstep, voffA);
            PG8_WAIT_L(8); PG8_BAR; PG8_WAIT_L(0); PG8_MMA(0, 0, At, B0); PG8_BAR; PG8_SCHED;
            PG8_LDB(B1, 0, 1); PG8_STAGE(PG8_SB(0, 0), b2, voffB);
            PG8_BAR; PG8_WAIT_L(0); PG8_MMA(0, 1, At, B1); PG8_BAR;
            PG8_LDA(At, 0, 1); PG8_STAGE(PG8_SA(0, 0), a2, voffA);
            PG8_BAR; PG8_WAIT_L(0); PG8_MMA(1, 0, At, B0); PG8_BAR; PG8_SCHED;
            PG8_STAGE(PG8_SB(0, 1), b2 + hstep, voffB);
            PG8_WAIT_V(6); PG8_BAR; PG8_MMA(1, 1, At, B1); PG8_BAR;
            PG8_LDB(B0, 1, 0); PG8_SCHED; PG8_LDA(At, 1, 0); PG8_STAGE(PG8_SA(0, 1), a2 + hstep, voffA);
            PG8_WAIT_L(8); PG8_BAR; PG8_WAIT_L(0); PG8_MMA(0, 0, At, B0); PG8_BAR; PG8_SCHED;
            PG8_LDB(B1, 1, 1); PG8_STAGE(PG8_SB(1, 0), b3, voffB);
            PG8_BAR; PG8_WAIT_L(0); PG8_MMA(0, 1, At, B1); PG8_BAR;
            PG8_LDA(At, 1, 1); PG8_STAGE(PG8_SA(1, 0), a3, voffA);
            PG8_BAR; PG8_WAIT_L(0); PG8_MMA(1, 0, At, B0); PG8_BAR; PG8_SCHED;
            PG8_STAGE(PG8_SB(1, 1), b3 + hstep, voffB);
            PG8_WAIT_V(6); PG8_BAR; PG8_MMA(1, 1, At, B1); PG8_BAR;
            }
        }
        if constexpr (ALIGN_EPI) { if (wr == 0) PG8_BAR; }
        if constexpr (!Epi::AFTER_DRAIN) { E(acc, cur, wr, wc, fr, fq); S.done(cur); }
        if (!has_next) break;
#pragma unroll
        for (int a = 0; a < 2; ++a)
#pragma unroll
            for (int b = 0; b < 2; ++b)
#pragma unroll
                for (int m = 0; m < 4; ++m)
#pragma unroll
                    for (int n = 0; n < 2; ++n) acc[a][b][m][n] = (f32x4){0.f, 0.f, 0.f, 0.f};
        cur = nxt; cA = nA; cB = nB; ++ui;
        if constexpr (ALIGN_EPI) { if (wr == 1) PG8_BAR; }
    }
    PG8_WAIT_V(0);
    if constexpr (!ALIGN_EPI) { if (wr == 0) PG8_BAR; }
    PG8_BAR;
    if constexpr (Epi::AFTER_DRAIN) { E.fused(acc, cur, wr, wc, fr, fq, lds, wid, lane); S.done(cur); }
#undef PG8_SA
#undef PG8_SB
#undef PG8_STAGE
#undef PG8_LDA
#undef PG8_LDB
#undef PG8_MMA
#undef PG8_WAIT_V
#undef PG8_WAIT_L
#undef PG8_BAR
#undef PG8_SCHED
}
}

constexpr int M = 16384, D = 1024, DEPTH = 4, NU = 3328, NWIN = 3208, NCHUNK = 256;
constexpr int MEM_LEN = 256;
constexpr int C_XS = 0, C_B = 512, C_C = 768, C_Z = 1024, C_R = 1536, C_K = 1792, C_V = 2048, C_G = 2304, C_WL = 2560, C_AL = 2624, C_DT = 2688, C_Q = 2816, C_GX = 3072;
constexpr float NORM_EPS = 1e-6f, LNX_EPS = 64e-5f;

#define LAS __attribute__((address_space(3)))
#define GAS __attribute__((address_space(1)))
typedef unsigned short bf16;
typedef short bf16x8 __attribute__((ext_vector_type(8)));
typedef float f32x4 __attribute__((ext_vector_type(4)));

typedef __bf16 bf16v2_t __attribute__((ext_vector_type(2)));
__device__ __forceinline__ unsigned cvt2bf(float lo, float hi) { bf16v2_t v; v[0] = (__bf16)lo; v[1] = (__bf16)hi; return __builtin_bit_cast(unsigned, v); }
__device__ __forceinline__ unsigned f2bf(float f) { return cvt2bf(f, 0.f) & 0xffffu; }
__device__ __forceinline__ float bf2f(unsigned b) { return __uint_as_float(b << 16); }
__device__ __forceinline__ float us2f(short s) { return bf2f((unsigned)(unsigned short)s); }
typedef unsigned u32x2 __attribute__((ext_vector_type(2)));
typedef unsigned u32x4v __attribute__((ext_vector_type(4)));
__device__ __forceinline__ u32x2 pack4(float a, float b, float c, float d) { u32x2 o; o.x = cvt2bf(a, b); o.y = cvt2bf(c, d); return o; }
__device__ __forceinline__ bf16x8 pack8(const float (&v)[8]) { const u32x4v t = (u32x4v){cvt2bf(v[0], v[1]), cvt2bf(v[2], v[3]), cvt2bf(v[4], v[5]), cvt2bf(v[6], v[7])}; return __builtin_bit_cast(bf16x8, t); }
__device__ __forceinline__ float wave_sum(float v) {
#pragma unroll
    for (int o = 1; o < 64; o <<= 1) v += __shfl_xor(v, o);
    return v;
}
__device__ __forceinline__ float silu_f(float x) { return x * __builtin_amdgcn_rcpf(1.f + __expf(-x)); }
__device__ __forceinline__ float softplus_f(float x) { return fmaxf(x, 0.f) + __logf(1.f + __expf(-fabsf(x))); }
__device__ __forceinline__ float sigmoid_f(float x) { return __builtin_amdgcn_rcpf(1.f + __expf(-x)); }

__device__ __forceinline__ bf16x8 ld_frag(const LAS bf16* base, int ld, int row0, int k0, int lane) {
    return *(const LAS bf16x8*)(base + (row0 + (lane & 15)) * ld + k0 + (lane >> 4) * 8);
}
#define MFMA16(a, b, c) __builtin_amdgcn_mfma_f32_16x16x32_bf16((a), (b), (c), 0, 0, 0)
#define BAR_LDS() do { asm volatile("s_waitcnt lgkmcnt(0)" ::: "memory"); __builtin_amdgcn_s_barrier(); asm volatile("" ::: "memory"); } while (0)

#define XB_TMO      128
#define XB_XCNT(j)  (256  + 64 * (j))
#define XB_XSUB(j)  (1280 + 64 * (j))
#define XB_XGEN(j)  (2304 + 64 * (j))
#define XB_TOP      3328
#define XB_TOPGEN   3392
#define XCD_BAR_WORDS 3456
#define XB_SPIN_CAP (1u << 22)

__device__ __forceinline__ unsigned xb_ld(unsigned* p)              { return __hip_atomic_load(p, __ATOMIC_RELAXED, __HIP_MEMORY_SCOPE_AGENT); }
__device__ __forceinline__ unsigned xb_add(unsigned* p, unsigned v) { return __hip_atomic_fetch_add(p, v, __ATOMIC_RELAXED, __HIP_MEMORY_SCOPE_AGENT); }
__device__ __forceinline__ unsigned xb_xcc_id() { return (unsigned)__builtin_amdgcn_s_getreg((3 << 11) | 20) & 0xFu; }
#define XB_SPIN(cond, bar) do { unsigned _sp = 0; while (cond) { __builtin_amdgcn_s_sleep(1); \
    if ((++_sp & 255u) == 0u) { if (xb_ld(&(bar)[XB_TMO])) break; if (_sp > XB_SPIN_CAP) { atomicAdd(&(bar)[XB_TMO], 1u); break; } } } } while (0)

struct XcdBarrier {
    unsigned* bar; unsigned x;
    volatile LAS unsigned* st;
};

__device__ __forceinline__ XcdBarrier xcd_barrier_post(unsigned* bar, volatile LAS unsigned* st) {
    XcdBarrier b; b.bar = bar; b.x = xb_xcc_id(); b.st = st;
    if (otid() == 0) (void)xb_add(&bar[XB_XCNT(b.x)], 1u);
    return b;
}
__device__ __forceinline__ void xcd_barrier_complete(unsigned* bar, unsigned x, unsigned& nloc, unsigned& nx) {
    const unsigned G = gridDim.x * gridDim.y * gridDim.z;
    unsigned sum, cnt, mine, sp = 0u;
    for (;;) {
        sum = 0u; cnt = 0u; mine = 0u;
#pragma unroll
        for (unsigned j = 0; j < 16; ++j) { const unsigned c = xb_ld(&bar[XB_XCNT(j)]); sum += c; cnt += (c > 0u) ? 1u : 0u; }
        mine = xb_ld(&bar[XB_XCNT(x)]);
        if (sum == G) break;
        __builtin_amdgcn_s_sleep(1);
        if ((++sp & 255u) == 0u) { if (xb_ld(&bar[XB_TMO])) break; if (sp > XB_SPIN_CAP) { atomicAdd(&bar[XB_TMO], 1u); break; } }
    }
    nloc = mine > 0u ? mine : 1u; nx = cnt > 0u ? cnt : 1u;
}

__device__ __forceinline__ void xcd_barrier(const XcdBarrier& b) {
    asm volatile("s_waitcnt vmcnt(0)" ::: "memory");
    __syncthreads();
    if (otid() == 0) {
        unsigned* bar = b.bar;
        __builtin_amdgcn_s_waitcnt(0);
        unsigned nloc = b.st[0], nx = b.st[1];
        if (nloc == 0u) { xcd_barrier_complete(bar, b.x, nloc, nx); b.st[0] = nloc; b.st[1] = nx; }
        const unsigned old = xb_add(&bar[XB_XSUB(b.x)], 1u);
        const unsigned gen = old / nloc;
        if (old + 1u == (gen + 1u) * nloc) {
            __builtin_amdgcn_fence(__ATOMIC_RELEASE, "agent");
            asm volatile("s_waitcnt vmcnt(0)" ::: "memory");
            const unsigned og = xb_add(&bar[XB_TOP], 1u);
            const unsigned tg = og / nx;
            if (og + 1u == (tg + 1u) * nx) xb_add(&bar[XB_TOPGEN], 1u);
            else XB_SPIN(xb_ld(&bar[XB_TOPGEN]) == tg, bar);
            __builtin_amdgcn_fence(__ATOMIC_ACQUIRE, "agent");
            xb_add(&bar[XB_XGEN(b.x)], 1u);
            asm volatile("s_waitcnt vmcnt(0)" ::: "memory");
        } else {
            XB_SPIN(xb_ld(&bar[XB_XGEN(b.x)]) == gen, bar);
            __builtin_amdgcn_fence(__ATOMIC_ACQUIRE, "agent");
            asm volatile("s_waitcnt vmcnt(0)" ::: "memory");
        }
    }
    __syncthreads();
}


struct Params {
    const float *x, *mem, *mem_norm_w, *w_mem_kv, *pre_norm_w, *w_in, *conv_w, *conv_b, *dt_bias, *a_log, *d_skip, *ssm_norm_w,
                *shift_mu, *w0, *w2, *a0, *a2, *k_k, *k_a, *r_k, *lnx_w, *lnx_b, *w_out, *post_norm_w;
    float* out;
    unsigned char* ws;
};
constexpr size_t MiB = 1u << 20;
constexpr size_t WS_CTL = 0, WS_WIN = 1 * MiB, WS_WOUT = 27 * MiB, WS_KV = 35 * MiB, WS_H = 36 * MiB, WS_U = 68 * MiB, WS_R = 172 * MiB, WS_END = 256 * MiB;
constexpr size_t WS_W2T = WS_KV + 256 * 1024;
constexpr size_t WS_ST = WS_R, WS_CD = WS_R + 32 * MiB, WS_BS = WS_CD + 65536;
constexpr size_t WS_Q1 = WS_R + 34 * MiB, WS_Y0 = WS_R + 42 * MiB, WS_PCT = WS_R + 50 * MiB, WS_GC = WS_R + 58 * MiB, WS_S0 = WS_R + 66 * MiB, WS_PGT = WS_R + 74 * MiB, WS_GG = WS_R + 75 * MiB;
static_assert(WS_GG + 64 * 8192 <= WS_END && WS_BS + (size_t)16384 * 16 <= WS_Q1, "ws map");


constexpr size_t WS_PB = 128 * 1024;
constexpr int PB_PRENW = 1024, PB_CONVW = 5120, PB_CONVB = 21504, PB_DTB = 25600, PB_ALOG = 25632, PB_DSKIP = 25664, PB_SSMNW = 25728, PB_MU = 27776, PB_W0 = 32384, PB_W2 = 33408,
              PB_A0 = 98944, PB_A2 = 99968, PB_KK = 165504, PB_KA = 166528, PB_RK = 167552, PB_LNW = 168576, PB_LNB = 169600, PB_POSTNW = 170624, PB_END = 174720;
static_assert(WS_PB + (size_t)PB_END * 4 <= 1 * MiB, "blob inside the control MiB");
#define PBP(P, off) ((const float*)((P).ws + WS_PB) + (off))
__device__ __forceinline__ int win_src_col(int n) {
    if (n < 1536) return n;
    if (n < 2560) return n + 8;
    if (n < 2816) { const int j = n - 2560; if (j < 64) return 2568 + j; if (j < 128) return 2632 + (j - 64); if (j < 136) return 1536 + (j - 128); return -1; }
    return n - 120;
}
template <bool WIN>
__device__ __forceinline__ void transpose_tile(const float* src, int src_ld, bf16* dst, int K, int n0, int k0, LAS float* scr) {
    const int tid = otid(), kk = tid >> 3, ng = tid & 7;
    const int sc = WIN ? win_src_col(n0 + ng * 8) : (n0 + ng * 8);
    f32x4 v0 = (f32x4){0.f, 0.f, 0.f, 0.f}, v1 = v0;
    { const float* sp = src + (size_t)(k0 + kk) * src_ld + (sc >= 0 ? sc : 0); const f32x4 a0 = *(const f32x4*)sp, a1 = *(const f32x4*)(sp + 4); if (sc >= 0) { v0 = a0; v1 = a1; } }
    BAR_LDS();
#pragma unroll
    for (int j = 0; j < 4; ++j) { scr[(ng * 8 + j) * 65 + kk] = v0[j]; scr[(ng * 8 + 4 + j) * 65 + kk] = v1[j]; }
    BAR_LDS();
    const int n = tid >> 3, kg = tid & 7; float o[8];
#pragma unroll
    for (int j = 0; j < 8; ++j) o[j] = scr[n * 65 + kg * 8 + j];
    *(bf16x8*)(dst + (size_t)(n0 + n) * K + k0 + kg * 8) = pack8(o);
}
__device__ __forceinline__ void stage_prep_weights(const Params& P, LAS unsigned char* lds, int item) {
    LAS float* scr = (LAS float*)lds;
    constexpr int T_IN = (NU / 64) * (D / 64);
    constexpr int T_OUT = (D / 64) * (D / 64);
    if (item < DEPTH * T_IN) { const int l = item / T_IN, r = item % T_IN, nb = r / 16, kb = r % 16;
        transpose_tile<true>(P.w_in + (size_t)l * D * NWIN, NWIN, (bf16*)(P.ws + WS_WIN) + (size_t)l * NU * D, D, nb * 64, kb * 64, scr); }
    else { const int it = item - DEPTH * T_IN; const int l = it / T_OUT, r = it % T_OUT, nb = r / 16, kb = r % 16;
        transpose_tile<false>(P.w_out + (size_t)l * D * D, D, (bf16*)(P.ws + WS_WOUT) + (size_t)l * D * D, D, nb * 64, kb * 64, scr); }
}
constexpr int N_PREP_ITEMS = DEPTH * ((NU / 64) * (D / 64) + (D / 64) * (D / 64));


__device__ __forceinline__ void stage_blob(const Params& P, int gtid, int gthreads) {
    float* pb = (float*)(P.ws + WS_PB);
#define CPY(src, off, n) for (int i = gtid; i < (n); i += gthreads) pb[(off) + i] = (src)[i];
    CPY(P.mem_norm_w, 0, 1024) CPY(P.pre_norm_w, PB_PRENW, 4096) CPY(P.conv_w, PB_CONVW, 16384) CPY(P.conv_b, PB_CONVB, 4096) CPY(P.dt_bias, PB_DTB, 32) CPY(P.a_log, PB_ALOG, 32) CPY(P.d_skip, PB_DSKIP, 32)
    CPY(P.ssm_norm_w, PB_SSMNW, 2048) CPY(P.shift_mu, PB_MU, 4608) CPY(P.w0, PB_W0, 1024) CPY(P.w2, PB_W2, 65536) CPY(P.a0, PB_A0, 1024) CPY(P.a2, PB_A2, 65536) CPY(P.k_k, PB_KK, 1024) CPY(P.k_a, PB_KA, 1024)
    CPY(P.r_k, PB_RK, 1024) CPY(P.lnx_w, PB_LNW, 1024) CPY(P.lnx_b, PB_LNB, 1024) CPY(P.post_norm_w, PB_POSTNW, 4096)
#undef CPY
    bf16* wi = (bf16*)(P.ws + WS_W2T);
    for (int i = gtid; i < 65536; i += gthreads) { const int j = i & 63, ch = (i >> 6) & 63, h = (i >> 12) & 3, l = i >> 14;
        wi[i] = (bf16)f2bf(P.w2[((size_t)l * 64 + j) * 256 + h * 64 + ch]); wi[65536 + i] = (bf16)f2bf(P.a2[((size_t)l * 64 + j) * 256 + h * 64 + ch]); }
}
__device__ __forceinline__ void stage_memkv(const Params& P, LAS unsigned char* lds, int m) {
    LAS float* xs = (LAS float*)lds; LAS float* red = xs + 1024;
    const int tid = otid();
    const float v0 = P.mem[(size_t)m * D + tid], v1 = P.mem[(size_t)m * D + 512 + tid];
    float s = wave_sum(v0 * v0 + v1 * v1);
    if ((tid & 63) == 0) red[tid >> 6] = s;
    __syncthreads();
    float tot = 0.f;
#pragma unroll
    for (int w = 0; w < 8; ++w) tot += red[w];
    const float rstd = rsqrtf(tot * (1.f / D) + NORM_EPS);
    xs[tid] = v0 * rstd * P.mem_norm_w[tid]; xs[512 + tid] = v1 * rstd * P.mem_norm_w[512 + tid];
    __syncthreads();
    float acc = 0.f;
#pragma unroll 32
    for (int k = 0; k < D; ++k) acc += xs[k] * P.w_mem_kv[(size_t)k * 512 + tid];
    {   const int hh = (tid >> 6) & 3, d = tid & 63;
        if (tid < 256) ((bf16*)(P.ws + WS_KV))[(size_t)(hh * 256 + m) * 64 + d] = (bf16)f2bf(acc);
        else ((bf16*)(P.ws + WS_KV) + 65536)[(size_t)(hh * 64 + d) * 256 + m] = (bf16)f2bf(acc); }
    __syncthreads();
}

__device__ __forceinline__ void prenorm_row(const float* xrow, const float* w, bf16* orow, int lane) {
    const f32x4* xr = (const f32x4*)xrow + lane; const f32x4* wr = (const f32x4*)w + lane;
    f32x4 v[4]; float s = 0.f;
#pragma unroll
    for (int j = 0; j < 4; ++j) { v[j] = xr[64 * j]; s += (v[j].x * v[j].x + v[j].y * v[j].y) + (v[j].z * v[j].z + v[j].w * v[j].w); }
    const float rstd = rsqrtf(wave_sum(s) * (1.f / D) + NORM_EPS);
    unsigned long long* o8 = (unsigned long long*)orow + lane;
#pragma unroll
    for (int j = 0; j < 4; ++j) { const f32x4 ww = wr[64 * j];
        const unsigned lo = f2bf(v[j].x * rstd * ww.x) | (f2bf(v[j].y * rstd * ww.y) << 16), hi = f2bf(v[j].z * rstd * ww.z) | (f2bf(v[j].w * rstd * ww.w) << 16);
        o8[64 * j] = (unsigned long long)lo | ((unsigned long long)hi << 32); }
}
__device__ __forceinline__ void post_row(const bf16* orow, const float* xin, const float* pw, float* xout, const float* nw, bf16* hrow, int lane) {
    const f32x4* xr = (const f32x4*)xin + lane; const f32x4* pr = (const f32x4*)pw + lane;
    f32x4 v[4]; float s = 0.f;
#pragma unroll
    for (int j = 0; j < 4; ++j) { const u32x2 o2 = *((const u32x2*)orow + 64 * j + lane); v[j] = (f32x4){bf2f(o2.x & 0xffffu), bf2f(o2.x >> 16), bf2f(o2.y & 0xffffu), bf2f(o2.y >> 16)};
        s += (v[j].x * v[j].x + v[j].y * v[j].y) + (v[j].z * v[j].z + v[j].w * v[j].w); }
    const float rstd = rsqrtf(wave_sum(s) * (1.f / D) + NORM_EPS);
    float s2 = 0.f;
#pragma unroll
    for (int j = 0; j < 4; ++j) { const f32x4 xx = xr[64 * j], pp = pr[64 * j]; v[j] = xx + v[j] * rstd * pp; s2 += (v[j].x * v[j].x + v[j].y * v[j].y) + (v[j].z * v[j].z + v[j].w * v[j].w);
        ((f32x4*)xout + lane)[64 * j] = v[j]; }
    if (hrow) {
        const float rstd2 = rsqrtf(wave_sum(s2) * (1.f / D) + NORM_EPS);
        const f32x4* wr = (const f32x4*)nw + lane; unsigned long long* o8 = (unsigned long long*)hrow + lane;
#pragma unroll
        for (int j = 0; j < 4; ++j) { const f32x4 ww = wr[64 * j];
            const unsigned lo = f2bf(v[j].x * rstd2 * ww.x) | (f2bf(v[j].y * rstd2 * ww.y) << 16), hi = f2bf(v[j].z * rstd2 * ww.z) | (f2bf(v[j].w * rstd2 * ww.w) << 16);
            o8[64 * j] = (unsigned long long)lo | ((unsigned long long)hi << 32); }
    }
}

constexpr int XA_KLD = 72, XA_VLD = 264;
constexpr int XA_LDS = (256 * XA_KLD + 64 * XA_VLD) * 2;
__device__ __forceinline__ void stage_xattn(const Params& P, LAS unsigned char* lds, int item) {
    const int tid = otid(), lane = tid & 63, wave = tid >> 6, quad = lane >> 4, l15 = lane & 15;
    const int tile = item >> 2, h = item & 3, t0 = tile * 256;
    LAS bf16* Ks = (LAS bf16*)lds; LAS bf16* VT = Ks + 256 * XA_KLD;
    const bf16* KB = (const bf16*)(P.ws + WS_KV) + (size_t)h * 256 * 64; const bf16* VB = (const bf16*)(P.ws + WS_KV) + 65536 + (size_t)h * 64 * 256;
    const bf16* U = (const bf16*)(P.ws + WS_U); bf16* Y = (bf16*)(P.ws + WS_H);
    u32x4v kp[4], vp[4];
#pragma unroll
    for (int i = 0; i < 4; ++i) { const int e = tid + i * 512; kp[i] = *(const u32x4v*)(KB + e * 8); vp[i] = *(const u32x4v*)(VB + e * 8); }
    bf16x8 qf[2][2]; u32x2 gx[2][4];
#pragma unroll
    for (int rb = 0; rb < 2; ++rb) { const bf16* up = U + (size_t)(t0 + wave * 32 + rb * 16 + l15) * NU + h * 64;
#pragma unroll
        for (int s_ = 0; s_ < 2; ++s_) qf[rb][s_] = *(const bf16x8*)(up + C_Q + s_ * 32 + quad * 8);
#pragma unroll
        for (int db = 0; db < 4; ++db) gx[rb][db] = *(const u32x2*)(up + C_GX + db * 16 + quad * 4); }
#pragma unroll
    for (int i = 0; i < 4; ++i) { const int e = tid + i * 512;
        *(LAS u32x4v*)(Ks + (e >> 3) * XA_KLD + (e & 7) * 8) = kp[i]; *(LAS u32x4v*)(VT + (e >> 5) * XA_VLD + (e & 31) * 8) = vp[i]; }
    BAR_LDS();
#pragma unroll
    for (int rb = 0; rb < 2; ++rb) {
        f32x4 acc[16];
#pragma unroll
        for (int mb = 0; mb < 16; ++mb) { acc[mb] = (f32x4){0.f, 0.f, 0.f, 0.f};
#pragma unroll
            for (int s_ = 0; s_ < 2; ++s_) acc[mb] = MFMA16(ld_frag(Ks, XA_KLD, mb * 16, s_ * 32, lane), qf[rb][s_], acc[mb]); }
        float m_ = -3.0e38f;
#pragma unroll
        for (int mb = 0; mb < 16; ++mb)
#pragma unroll
            for (int r = 0; r < 4; ++r) { acc[mb][r] *= 0.125f; m_ = fmaxf(m_, acc[mb][r]); }
        m_ = fmaxf(m_, __shfl_xor(m_, 16)); m_ = fmaxf(m_, __shfl_xor(m_, 32));
        float sm = 0.f; u32x2 pk[16];
#pragma unroll
        for (int mb = 0; mb < 16; ++mb) { float p[4];
#pragma unroll
            for (int r = 0; r < 4; ++r) { p[r] = __expf(acc[mb][r] - m_); sm += p[r]; }
            pk[mb] = pack4(p[0], p[1], p[2], p[3]); }
        sm += __shfl_xor(sm, 16); sm += __shfl_xor(sm, 32);
        f32x4 o4[4];
#pragma unroll
        for (int db = 0; db < 4; ++db) o4[db] = (f32x4){0.f, 0.f, 0.f, 0.f};
#pragma unroll
        for (int ks = 0; ks < 8; ++ks) {
            bf16x8 pb; { const u32x4v t4 = (u32x4v){pk[2 * ks].x, pk[2 * ks].y, pk[2 * ks + 1].x, pk[2 * ks + 1].y}; pb = __builtin_bit_cast(bf16x8, t4); }
#pragma unroll
            for (int db = 0; db < 4; ++db) { const LAS bf16* vpn = VT + (db * 16 + l15) * XA_VLD + ks * 32 + quad * 4;
                const u32x2 v0 = *(const LAS u32x2*)vpn, v1 = *(const LAS u32x2*)(vpn + 16);
                const u32x4v t4 = (u32x4v){v0.x, v0.y, v1.x, v1.y};
                o4[db] = MFMA16(__builtin_bit_cast(bf16x8, t4), pb, o4[db]); } }
        const float inv = 1.f / sm; const int t = t0 + wave * 32 + rb * 16 + l15;
#pragma unroll
        for (int db = 0; db < 4; ++db) { const u32x2 g = gx[rb][db];
            *(u32x2*)(Y + (size_t)t * D + 768 + h * 64 + db * 16 + quad * 4) = pack4(o4[db][0] * inv * silu_f(bf2f(g.x & 0xffffu)), o4[db][1] * inv * silu_f(bf2f(g.x >> 16)),
                                                                                   o4[db][2] * inv * silu_f(bf2f(g.y & 0xffffu)), o4[db][3] * inv * silu_f(bf2f(g.y >> 16))); }
        __builtin_amdgcn_sched_barrier(0);
    }
    BAR_LDS();
}

__device__ __forceinline__ void conv_issue(const bf16* U, int ts, int col, bf16x8 (&rows)[11]) {
#pragma unroll
    for (int i = 0; i < 11; ++i) { const int tt = ts - 3 + i; rows[i] = *(const bf16x8*)(U + (size_t)(tt < 0 ? 0 : tt) * NU + col); }
}
__device__ __forceinline__ void conv_weights(const float* cw, const float* cb, int col, LAS float* cwS, int tid) {
    const int j = tid & 7, cg = tid >> 3;
    if (j < 5) { const float* src = j < 4 ? cw + j * 1024 + col : cb + col;
        const f32x4 w0 = *(const f32x4*)src, w1 = *(const f32x4*)(src + 4);
        *(LAS f32x4*)(cwS + j * 512 + cg * 8) = w0; *(LAS f32x4*)(cwS + j * 512 + cg * 8 + 4) = w1; }
}
__device__ __forceinline__ void conv_math(bf16x8 (&rows)[11], int ts, const LAS float* cwS, int cg, float (&o)[8][8]) {
    if (ts < 3) {
#pragma unroll
        for (int i = 0; i < 3; ++i) if (ts - 3 + i < 0) rows[i] = (bf16x8){0, 0, 0, 0, 0, 0, 0, 0}; }
    float w[5][8];
#pragma unroll
    for (int j = 0; j < 5; ++j) { const f32x4 w0 = *(const LAS f32x4*)(cwS + j * 512 + cg * 8), w1 = *(const LAS f32x4*)(cwS + j * 512 + cg * 8 + 4);
#pragma unroll
        for (int e = 0; e < 4; ++e) { w[j][e] = w0[e]; w[j][4 + e] = w1[e]; } }
#pragma unroll
    for (int tok = 0; tok < 8; ++tok)
#pragma unroll
        for (int k = 0; k < 8; ++k) {
            const float a = w[4][k] + w[0][k] * us2f(rows[tok][k]) + w[1][k] * us2f(rows[tok + 1][k]) + w[2][k] * us2f(rows[tok + 2][k]) + w[3][k] * us2f(rows[tok + 3][k]);
            o[tok][k] = silu_f(a); }
}
__device__ __forceinline__ void ssd_dt(float dtb, float A, float raw, LAS float* dtS, LAS float* acS, int tid) {
    if (tid < 256) { const int hh = tid >> 6, q = tid & 63;
        const float dt = softplus_f(raw + dtb);
        float v = dt * A;
#pragma unroll
        for (int o = 1; o < 64; o <<= 1) { const float t = __shfl_up(v, o); if (q >= o) v += t; }
        dtS[hh * 64 + q] = dt; acS[hh * 64 + q] = v; }
}
constexpr int S1_LDS = 2048 + (4 * 64 * 72 + 128 * 72) * 2;
__device__ __forceinline__ void stage_ssd_s1(const Params& P, int l, LAS unsigned char* lds, int first, int stride, int end) {
    const int tid = otid(), lane = tid & 63, wave = tid >> 6, quad = lane >> 4, l15 = lane & 15;
    LAS float* dtS = (LAS float*)lds; LAS float* acS = dtS + 256; LAS bf16* XT = (LAS bf16*)(lds + 2048); LAS bf16* BT = XT + 4 * 64 * 72;
    const bf16* U = (const bf16*)(P.ws + WS_U);
    const int tseg = tid & 7, cg = tid < 384 ? tid >> 3 : 0; const bool isx = cg < 32;
    const int j0 = isx ? cg * 8 : (cg - 32) * 8;
#define S1_COL(it) (isx ? C_XS + ((it) & 1) * 256 + j0 : C_B + ((it) & 1) * 128 + j0)
#define S1_RAW(it) (tid < 256 ? bf2f(U[(size_t)(((it) >> 1) * 64 + (tid & 63)) * NU + C_DT + ((it) & 1) * 4 + (tid >> 6)]) : 0.f)
    bf16x8 rows[11]; float raw = S1_RAW(first);
    conv_issue(U, (first >> 1) * 64 + tseg * 8, S1_COL(first), rows);
    LAS float* cwS = (LAS float*)(lds + S1_LDS);
    if (tid < 384) conv_weights(PBP(P, PB_CONVW) + (size_t)l * 4 * 1024, PBP(P, PB_CONVB) + l * 1024, S1_COL(first), cwS, tid);
    BAR_LDS();
    const int hq = l * 8 + (first & 1) * 4 + ((tid >> 6) & 3); const float dtb = PBP(P, PB_DTB)[hq], Aneg = -__expf(PBP(P, PB_ALOG)[hq]);
    for (int item = first; item < end; item += stride) {
    const int c = item >> 1, g = item & 1, t0 = c * 64, col = S1_COL(item);
    float o[8][8];
    conv_math(rows, t0 + tseg * 8, cwS, cg, o);
    ssd_dt(dtb, Aneg, raw, dtS, acS, tid);
    {   const int nx = item + stride < end ? item + stride : item;
        raw = S1_RAW(nx); conv_issue(U, (nx >> 1) * 64 + tseg * 8, S1_COL(nx), rows); }
    BAR_LDS();
    if (tid < 384) {
        const int hh = j0 >> 6, p0 = j0 & 63;
        float sc[8];
#pragma unroll
        for (int tok = 0; tok < 8; ++tok) { const int q = tseg * 8 + tok; sc[tok] = isx ? dtS[hh * 64 + q] * __expf(acS[hh * 64 + 63] - acS[hh * 64 + q]) : 1.f; }
        LAS bf16* dst = isx ? XT + (hh * 64 + p0) * 72 + tseg * 8 : BT + j0 * 72 + tseg * 8;
#pragma unroll
        for (int k = 0; k < 8; ++k) { float v[8];
#pragma unroll
            for (int tok = 0; tok < 8; ++tok) v[tok] = o[tok][k] * sc[tok];
            *(LAS bf16x8*)(dst + k * 72) = pack8(v); }
    }
    BAR_LDS();
    { const int hh = wave >> 1, nh = wave & 1, h = g * 4 + hh;
        bf16* ST = (bf16*)(P.ws + WS_ST) + ((size_t)(c * 8 + h) * 64) * 128;
#pragma unroll
        for (int pb = 0; pb < 4; ++pb)
#pragma unroll
            for (int nb = 0; nb < 4; ++nb) { f32x4 acc = (f32x4){0.f, 0.f, 0.f, 0.f};
#pragma unroll
                for (int ks = 0; ks < 2; ++ks) acc = MFMA16(ld_frag(BT, 72, nh * 64 + nb * 16, ks * 32, lane), ld_frag(XT + hh * 64 * 72, 72, pb * 16, ks * 32, lane), acc);
                *(u32x2*)(ST + (size_t)(pb * 16 + l15) * 128 + nh * 64 + nb * 16 + quad * 4) = pack4(acc[0], acc[1], acc[2], acc[3]); }
        if (tid < 4) ((float*)(P.ws + WS_CD))[c * 8 + g * 4 + tid] = __expf(acS[tid * 64 + 63]);
    }
    BAR_LDS();
    }
#undef S1_COL
#undef S1_RAW
}
__device__ __forceinline__ void stage_ssd_scan(const Params& P, LAS unsigned char* lds, int blk) {
    const int tid = otid(), pi = tid & 63, seg = tid >> 6;
    LAS float* cdS = (LAS float*)lds; LAS float* segL = cdS + 256; LAS float* segD = segL + 8 * 128;
    bf16* ST = (bf16*)(P.ws + WS_ST); const float* CD = (const float*)(P.ws + WS_CD);
    const int e0 = blk * 128 + pi * 2, h = (blk * 128) >> 13;
    if (tid < 256) cdS[tid] = CD[tid * 8 + h];
    unsigned v[32];
#pragma unroll
    for (int k = 0; k < 32; ++k) v[k] = *(const unsigned*)(ST + (size_t)(seg * 32 + k) * 65536 + e0);
    BAR_LDS();
    float L0 = 0.f, L1 = 0.f, Dt = 1.f;
#pragma unroll
    for (int k = 0; k < 32; ++k) { const float d = cdS[seg * 32 + k]; L0 = L0 * d + bf2f(v[k] & 0xffffu); L1 = L1 * d + bf2f(v[k] >> 16); Dt *= d; }
    segL[seg * 128 + pi * 2] = L0; segL[seg * 128 + pi * 2 + 1] = L1; if (pi == 0) segD[seg] = Dt;
    BAR_LDS();
    float c0 = 0.f, c1 = 0.f;
    for (int s2 = 0; s2 < seg; ++s2) { const float d = segD[s2]; c0 = c0 * d + segL[s2 * 128 + pi * 2]; c1 = c1 * d + segL[s2 * 128 + pi * 2 + 1]; }
#pragma unroll
    for (int k = 0; k < 32; ++k) { const float d = cdS[seg * 32 + k]; const unsigned o = f2bf(c0) | (f2bf(c1) << 16);
        c0 = c0 * d + bf2f(v[k] & 0xffffu); c1 = c1 * d + bf2f(v[k] >> 16);
        *(unsigned*)(ST + (size_t)(seg * 32 + k) * 65536 + e0) = o; }
    BAR_LDS();
}
constexpr int S3_LDS = 3072 + (2 * 64 * 136 + 4 * 64 * 72 + 8 * 32 * 72) * 2;
__device__ __forceinline__ void stage_ssd_s3(const Params& P, int l, LAS unsigned char* lds, int first, int stride, int end) {
    const int tid = otid(), lane = tid & 63, wave = tid >> 6, quad = lane >> 4, l15 = lane & 15;
    LAS float* dtS = (LAS float*)lds; LAS float* acS = dtS + 256; LAS float* red = acS + 256;
    LAS bf16* Cn = (LAS bf16*)(lds + 3072); LAS bf16* Bn = Cn + 64 * 136; LAS bf16* XT = Bn + 64 * 136; LAS bf16* SCw = XT + 4 * 64 * 72 + wave * 32 * 72;
    const bf16* U = (const bf16*)(P.ws + WS_U); bf16* Y = (bf16*)(P.ws + WS_H);
    const int hh = wave >> 1, qh = wave & 1;
    const int tseg = tid & 7, cg = tid >> 3; const int kind = cg < 32 ? 0 : (cg < 48 ? 1 : 2);
    const int j0 = kind == 0 ? cg * 8 : (kind == 1 ? (cg - 32) * 8 : (cg - 48) * 8);
#define S3_COL(it) (kind == 0 ? C_XS + ((it) & 1) * 256 + j0 : (kind == 1 ? C_B + ((it) & 1) * 128 + j0 : C_C + ((it) & 1) * 128 + j0))
#define S3_RAW(it) (tid < 256 ? bf2f(U[(size_t)(((it) >> 1) * 64 + (tid & 63)) * NU + C_DT + ((it) & 1) * 4 + (tid >> 6)]) : 0.f)
    bf16x8 rows[11]; float raw = S3_RAW(first);
    conv_issue(U, (first >> 1) * 64 + tseg * 8, S3_COL(first), rows);
    LAS float* cwS = (LAS float*)(lds + S3_LDS);
    conv_weights(PBP(P, PB_CONVW) + (size_t)l * 4 * 1024, PBP(P, PB_CONVB) + l * 1024, S3_COL(first), cwS, tid);
    LAS float* nwS = cwS + 2560; if (tid < 256) nwS[tid] = PBP(P, PB_SSMNW)[l * 512 + (first & 1) * 256 + tid];
    BAR_LDS();
    const int hq = l * 8 + (first & 1) * 4 + ((tid >> 6) & 3); const float dtb = PBP(P, PB_DTB)[hq], Aneg = -__expf(PBP(P, PB_ALOG)[hq]);
    const float dsk = PBP(P, PB_DSKIP)[l * 8 + (first & 1) * 4 + hh];
    for (int item = first; item < end; item += stride) {
    const int c = item >> 1, g = item & 1, t0 = c * 64, h = g * 4 + hh;
    u32x2 zz[2][4];
#pragma unroll
    for (int qb = 0; qb < 2; ++qb)
#pragma unroll
        for (int pb = 0; pb < 4; ++pb) zz[qb][pb] = *(const u32x2*)(U + (size_t)(t0 + qh * 32 + qb * 16 + l15) * NU + C_Z + h * 64 + pb * 16 + quad * 4);
    {   float o[8][8];
        conv_math(rows, t0 + tseg * 8, cwS, cg, o);
        ssd_dt(dtb, Aneg, raw, dtS, acS, tid);
        {   const int nx = item + stride < end ? item + stride : item;
            raw = S3_RAW(nx); conv_issue(U, (nx >> 1) * 64 + tseg * 8, S3_COL(nx), rows); }
        BAR_LDS();
        if (kind == 0) { const int hh2 = j0 >> 6, p0 = j0 & 63;
#pragma unroll
            for (int k = 0; k < 8; ++k) { float v[8];
#pragma unroll
                for (int tok = 0; tok < 8; ++tok) v[tok] = o[tok][k] * dtS[hh2 * 64 + tseg * 8 + tok];
                *(LAS bf16x8*)(XT + (hh2 * 64 + p0 + k) * 72 + tseg * 8) = pack8(v); }
        } else { LAS bf16* dst = (kind == 1 ? Bn : Cn) + (tseg * 8) * 136 + j0;
#pragma unroll
            for (int tok = 0; tok < 8; ++tok) *(LAS bf16x8*)(dst + tok * 136) = pack8(o[tok]); }
    }
    const bf16* ST = (const bf16*)(P.ws + WS_ST) + ((size_t)(c * 8 + h) * 64) * 128;
    bf16x8 pf[4][4];
#pragma unroll
    for (int pb = 0; pb < 4; ++pb)
#pragma unroll
        for (int ks = 0; ks < 4; ++ks) pf[pb][ks] = *(const bf16x8*)(ST + (size_t)(pb * 16 + l15) * 128 + ks * 32 + quad * 8);
    BAR_LDS();
#pragma unroll
    for (int qb = 0; qb < 2; ++qb)
#pragma unroll
        for (int sb = 0; sb < 4; ++sb) { f32x4 acc = (f32x4){0.f, 0.f, 0.f, 0.f};
#pragma unroll
            for (int ks = 0; ks < 4; ++ks) acc = MFMA16(ld_frag(Bn, 136, sb * 16, ks * 32, lane), ld_frag(Cn, 136, qh * 32 + qb * 16, ks * 32, lane), acc);
            const int q = qh * 32 + qb * 16 + l15; const float aq = acS[hh * 64 + q]; float v[4];
#pragma unroll
            for (int r = 0; r < 4; ++r) { const int s_ = sb * 16 + quad * 4 + r; v[r] = (s_ <= q) ? acc[r] * __expf(aq - acS[hh * 64 + s_]) : 0.f; }
            *(LAS u32x2*)(SCw + (qb * 16 + l15) * 72 + sb * 16 + quad * 4) = pack4(v[0], v[1], v[2], v[3]); }
    asm volatile("s_waitcnt lgkmcnt(0)" ::: "memory");
    f32x4 y[2][4];
    float ssq[2] = {0.f, 0.f};
#pragma unroll
    for (int qb = 0; qb < 2; ++qb)
#pragma unroll
        for (int pb = 0; pb < 4; ++pb) { f32x4 yd = (f32x4){0.f, 0.f, 0.f, 0.f}, yo = (f32x4){0.f, 0.f, 0.f, 0.f};
#pragma unroll
            for (int ks = 0; ks < 2; ++ks) yd = MFMA16(ld_frag(XT + hh * 64 * 72, 72, pb * 16, ks * 32, lane), ld_frag(SCw, 72, qb * 16, ks * 32, lane), yd);
#pragma unroll
            for (int ks = 0; ks < 4; ++ks) yo = MFMA16(pf[pb][ks], ld_frag(Cn, 136, qh * 32 + qb * 16, ks * 32, lane), yo);
            const int q = qh * 32 + qb * 16 + l15; const float eq = __expf(acS[hh * 64 + q]), idt = __builtin_amdgcn_rcpf(dtS[hh * 64 + q]);
            const u32x2 z2 = zz[qb][pb];
#pragma unroll
            for (int r = 0; r < 4; ++r) { const int p = pb * 16 + quad * 4 + r;
                const float xs = bf2f(XT[(hh * 64 + p) * 72 + q]) * idt;
                const unsigned zw = r < 2 ? z2.x : z2.y; const float z = bf2f((r & 1) ? (zw >> 16) : (zw & 0xffffu));
                const float v = (yd[r] + eq * yo[r] + dsk * xs) * silu_f(z);
                y[qb][pb][r] = v; ssq[qb] += v * v; } }
#pragma unroll
    for (int qb = 0; qb < 2; ++qb) { float s_ = ssq[qb]; s_ += __shfl_xor(s_, 16); s_ += __shfl_xor(s_, 32);
        if (quad == 0) red[hh * 64 + qh * 32 + qb * 16 + l15] = s_; }
    BAR_LDS();
#pragma unroll
    for (int qb = 0; qb < 2; ++qb) { const int q = qh * 32 + qb * 16 + l15;
        const float tot = red[q] + red[64 + q] + red[128 + q] + red[192 + q]; const float rstd = rsqrtf(tot * (1.f / 256.f) + NORM_EPS);
#pragma unroll
        for (int pb = 0; pb < 4; ++pb) { const int p = pb * 16 + quad * 4; const f32x4 nw = *(const LAS f32x4*)(nwS + hh * 64 + p);
            *(u32x2*)(Y + (size_t)(t0 + q) * D + h * 64 + p) = pack4(y[qb][pb][0] * rstd * nw[0], y[qb][pb][1] * rstd * nw[1], y[qb][pb][2] * rstd * nw[2], y[qb][pb][3] * rstd * nw[3]); } }
    BAR_LDS();
    }
#undef S3_COL
#undef S3_RAW
}

constexpr int RW_AT = 0, RW_RT = 9216, RW_KT = 18432, RW_BT = 27648, RW_VT = 36864, RW_KHT = 46080, RW_BHT = 55296, RW_X1T = 64512, RW_X2T = 73728,
              RW_MAK = 82944, RW_MRK = 92160, RW_MRB = 101376, RW_MAB = 110592, RW_TOT = 128000, RW_WC = 130048, RW_AAF = 130304, RW_END = 146688;
constexpr int RW_RHS2 = RW_KT;
constexpr int RW_LATW = RW_X1T, RW_LATA = RW_X2T, RW_W2T = RW_MAK, RW_A2T = RW_MRK, RW_AWF = RW_MAB;
constexpr int RW_MOFF = RW_AAF, RW_TB = RW_AAF + 9216, RW_RPT = RW_MAK;
__device__ __forceinline__ float tanh_f(float x) { return 1.f - 2.f * __builtin_amdgcn_rcpf(1.f + __expf(2.f * x)); }

__device__ __forceinline__ void stage_rwkv_p1(const Params& P, int l, LAS unsigned char* lds, int pi) {
    const int tid = otid(), lane = tid & 63, wave = __builtin_amdgcn_readfirstlane(tid >> 6), quad = lane >> 4, l15 = lane & 15;
    const int c = pi >> 2, h = pi & 3, t0 = c * 64;
    LAS bf16* At = (LAS bf16*)(lds + RW_AT); LAS bf16* Rt = (LAS bf16*)(lds + RW_RT); LAS bf16* Kt = (LAS bf16*)(lds + RW_KT); LAS bf16* Bt = (LAS bf16*)(lds + RW_BT);
    LAS bf16* VT = (LAS bf16*)(lds + RW_VT); LAS bf16* KhT = (LAS bf16*)(lds + RW_KHT); LAS bf16* BhT = (LAS bf16*)(lds + RW_BHT);
    LAS bf16* X1T = (LAS bf16*)(lds + RW_X1T); LAS bf16* X2T = (LAS bf16*)(lds + RW_X2T);
    LAS bf16* Mak = (LAS bf16*)(lds + RW_MAK); LAS bf16* Mrk = (LAS bf16*)(lds + RW_MRK); LAS bf16* Mrb = (LAS bf16*)(lds + RW_MRB);
    LAS float* Mab = (LAS float*)(lds + RW_MAB); LAS float* RHS2 = (LAS float*)(lds + RW_RHS2);
    LAS float* tot = (LAS float*)(lds + RW_TOT); LAS float* wCs = (LAS float*)(lds + RW_WC); LAS float* aaF = (LAS float*)(lds + RW_AAF); LAS float* awF = (LAS float*)(lds + RW_AWF);
    LAS bf16* latw = (LAS bf16*)(lds + RW_LATW); LAS bf16* lata = (LAS bf16*)(lds + RW_LATA); LAS bf16* w2T = (LAS bf16*)(lds + RW_W2T); LAS bf16* a2T = (LAS bf16*)(lds + RW_A2T);
    LAS bf16* Moff = (LAS bf16*)(lds + RW_MOFF); LAS bf16* Tb = (LAS bf16*)(lds + RW_TB);
    const bf16* U = (const bf16*)(P.ws + WS_U);
    const float* mu = PBP(P, PB_MU) + (size_t)l * 1152;
    const bf16* ucr = U + (size_t)(t0 + (tid >> 3)) * NU + h * 64 + (tid & 7) * 8;
    const bf16x8 cr = *(const bf16x8*)(ucr + C_R), ck = *(const bf16x8*)(ucr + C_K), cv = *(const bf16x8*)(ucr + C_V);
    const bool hasp = t0 + (tid >> 3) > 0; const bf16* upr = hasp ? ucr - NU : ucr;
    bf16x8 pr = *(const bf16x8*)(upr + C_R), pk = *(const bf16x8*)(upr + C_K), pv = *(const bf16x8*)(upr + C_V);
    if (!hasp) { pr = (bf16x8){0, 0, 0, 0, 0, 0, 0, 0}; pk = pr; pv = pr; }
    {   const int t = tid >> 3, jg = tid & 7, tg = t0 + t;
        const bf16* uc = U + (size_t)tg * NU + C_WL + jg * 8;
        const bf16x8 cw = *(const bf16x8*)uc, ca = *(const bf16x8*)(uc + 64);
        const bf16* up_ = tg > 0 ? uc - NU : uc;
        bf16x8 pw = *(const bf16x8*)up_, pa = *(const bf16x8*)(up_ + 64);
        if (tg == 0) { pw = (bf16x8){0, 0, 0, 0, 0, 0, 0, 0}; pa = pw; }
        float ow[8], oa[8];
#pragma unroll
        for (int jj = 0; jj < 8; ++jj) { const int j = jg * 8 + jj;
            const float cv = us2f(cw[jj]), pv = us2f(pw[jj]); ow[jj] = tanh_f(cv + (pv - cv) * mu[1024 + j]);
            const float cv2 = us2f(ca[jj]), pv2 = us2f(pa[jj]); oa[jj] = cv2 + (pv2 - cv2) * mu[1088 + j]; }
        *(LAS bf16x8*)(latw + t * 72 + jg * 8) = pack8(ow); *(LAS bf16x8*)(lata + t * 72 + jg * 8) = pack8(oa);
        const bf16* wt = (const bf16*)(P.ws + WS_W2T) + (size_t)((l * 4 + h) * 64 + t) * 64 + jg * 8;
        *(LAS bf16x8*)(w2T + t * 72 + jg * 8) = *(const bf16x8*)wt; *(LAS bf16x8*)(a2T + t * 72 + jg * 8) = *(const bf16x8*)(wt + 65536);
    }
    BAR_LDS();
    {   const int tb = wave & 3; const bool isA = wave >= 4;
        const LAS bf16* Am = isA ? lata : latw; const LAS bf16* Bm = isA ? a2T : w2T; LAS float* Of = isA ? aaF : awF; const int ofs = isA ? 64 : 68;
#pragma unroll
        for (int cb = 0; cb < 4; ++cb) { f32x4 acc = (f32x4){0.f, 0.f, 0.f, 0.f};
#pragma unroll
            for (int ks = 0; ks < 2; ++ks) acc = MFMA16(ld_frag(Am, 72, tb * 16, ks * 32, lane), ld_frag(Bm, 72, cb * 16, ks * 32, lane), acc);
#pragma unroll
            for (int r = 0; r < 4; ++r) Of[(tb * 16 + quad * 4 + r) * ofs + cb * 16 + l15] = acc[r]; }
    }
    BAR_LDS();
    {   const int t = tid >> 3, cg = tid & 7, tg = t0 + t, ch0 = cg * 8, gch = h * 64 + ch0;
        float rr[8], k2[8], vv[8], kkn[8], aS[8], lw[8], Lc[8];
        float ss = 0.f, bsum = 0.f;
        float cmr[8], cmk[8], cmv[8], cw0[8], ca0[8], ckk[8], cka[8], crk[8];
#pragma unroll
        for (int q4 = 0; q4 < 2; ++q4) { const int pc4 = l * 256 + gch + q4 * 4;
            const f32x4 m0 = *(const f32x4*)(mu + gch + q4 * 4), m1 = *(const f32x4*)(mu + 256 + gch + q4 * 4), m2 = *(const f32x4*)(mu + 512 + gch + q4 * 4);
            const f32x4 c0 = *(const f32x4*)(PBP(P, PB_W0) + pc4), c1 = *(const f32x4*)(PBP(P, PB_A0) + pc4), c2 = *(const f32x4*)(PBP(P, PB_KK) + pc4), c3 = *(const f32x4*)(PBP(P, PB_KA) + pc4), c4 = *(const f32x4*)(PBP(P, PB_RK) + pc4);
#pragma unroll
            for (int e = 0; e < 4; ++e) { cmr[q4 * 4 + e] = m0[e]; cmk[q4 * 4 + e] = m1[e]; cmv[q4 * 4 + e] = m2[e]; cw0[q4 * 4 + e] = c0[e]; ca0[q4 * 4 + e] = c1[e]; ckk[q4 * 4 + e] = c2[e]; cka[q4 * 4 + e] = c3[e]; crk[q4 * 4 + e] = c4[e]; } }
#pragma unroll
        for (int jj = 0; jj < 8; ++jj) {
            float a_ = us2f(cr[jj]), b_ = us2f(pr[jj]); const float r = a_ + (b_ - a_) * cmr[jj];
            a_ = us2f(ck[jj]); b_ = us2f(pk[jj]); const float k = a_ + (b_ - a_) * cmk[jj];
            a_ = us2f(cv[jj]); b_ = us2f(pv[jj]); const float v = a_ + (b_ - a_) * cmv[jj];
            const float aw = awF[t * 68 + ch0 + jj] + cw0[jj], aa = aaF[t * 64 + ch0 + jj] + ca0[jj];
            lw[jj] = -0.60653066f * sigmoid_f(aw); const float a = sigmoid_f(aa);
            const float kr = k * ckk[jj]; ss += kr * kr; kkn[jj] = kr;
            k2[jj] = k * (1.f + (a - 1.f) * cka[jj]); aS[jj] = a; rr[jj] = r; vv[jj] = v;
            bsum += r * k2[jj] * crk[jj]; Lc[jj] = lw[jj]; }
#pragma unroll
        for (int o = 1; o < 8; o <<= 1) { ss += __shfl_xor(ss, o); bsum += __shfl_xor(bsum, o); }
        const float inv = 1.f / fmaxf(sqrtf(ss), 1e-12f);
        if (cg == 0) ((float*)(P.ws + WS_BS))[(size_t)tg * 4 + h] = bsum;
#pragma unroll
        for (int o = 8; o < 64; o <<= 1)
#pragma unroll
            for (int jj = 0; jj < 8; ++jj) { const float tmp = __shfl_up(Lc[jj], o); if (lane >= o) Lc[jj] += tmp; }
        if ((lane >> 3) == 7) {
#pragma unroll
            for (int jj = 0; jj < 8; ++jj) tot[wave * 64 + ch0 + jj] = Lc[jj]; }
        BAR_LDS();
        float oA[8], oR[8], oK[8], oB[8];
#pragma unroll
        for (int jj = 0; jj < 8; ++jj) { float base = 0.f, LC = 0.f;
#pragma unroll
            for (int w2 = 0; w2 < 8; ++w2) { const float tv = tot[w2 * 64 + ch0 + jj]; base += w2 < wave ? tv : 0.f; LC += tv; }
            const float L = Lc[jj] + base; const float kk = kkn[jj] * inv, b = kk * aS[jj];
            const float eL = __expf(L), eiL = __expf(-L), eh = __expf(LC - L);
            oA[jj] = -kk * __expf(L - lw[jj]); oR[jj] = rr[jj] * eL; oK[jj] = k2[jj] * eiL; oB[jj] = b * eiL;
            VT[(ch0 + jj) * 72 + t] = (bf16)f2bf(vv[jj]); KhT[(ch0 + jj) * 72 + t] = (bf16)f2bf(k2[jj] * eh); BhT[(ch0 + jj) * 72 + t] = (bf16)f2bf(b * eh);
            if (t == 63) wCs[ch0 + jj] = __expf(LC); }
        *(LAS bf16x8*)(At + t * 72 + ch0) = pack8(oA); *(LAS bf16x8*)(Rt + t * 72 + ch0) = pack8(oR); *(LAS bf16x8*)(Kt + t * 72 + ch0) = pack8(oK); *(LAS bf16x8*)(Bt + t * 72 + ch0) = pack8(oB);
    }
    BAR_LDS();
    {   const int mat = wave >> 1, half = wave & 1;
        const LAS bf16* Am = mat < 2 ? At : Rt; const LAS bf16* Bm = (mat == 0 || mat == 3) ? Bt : Kt;
        LAS bf16* Ob = mat == 1 ? Mak : (mat == 2 ? Mrk : Mrb);
#pragma unroll
        for (int tbi = 0; tbi < 2; ++tbi)
#pragma unroll
            for (int sb = 0; sb < 4; ++sb) { const int tb = half * 2 + tbi; f32x4 acc = (f32x4){0.f, 0.f, 0.f, 0.f};
                if (sb <= tb) {
#pragma unroll
                    for (int ks = 0; ks < 2; ++ks) acc = MFMA16(ld_frag(Am, 72, tb * 16, ks * 32, lane), ld_frag(Bm, 72, sb * 16, ks * 32, lane), acc); }
#pragma unroll
                for (int r = 0; r < 4; ++r) { const int t = tb * 16 + quad * 4 + r, s_ = sb * 16 + l15;
                    const bool keep = mat < 2 ? (s_ < t) : (s_ <= t); const float val = keep ? acc[r] : 0.f;
                    if (mat == 0) { Mab[t * 68 + s_] = val; Moff[t * 72 + s_] = (bf16)(sb < tb ? f2bf(val) : 0u); } else Ob[t * 72 + s_] = (bf16)f2bf(val); } }
    }
    BAR_LDS();
    if (wave == 0) {
        for (int e = lane; e < 320; e += 64) *(LAS u32x4v*)(Tb + e * 8) = (u32x4v){0u, 0u, 0u, 0u};
        const int b = quad, cc = l15;
        unsigned ma = (unsigned)(uintptr_t)(Mab + (16 * b) * 68 + 16 * b); asm volatile("" : "+v"(ma)); const LAS float* Mv = (const LAS float*)(uintptr_t)ma;
        float x[16];
#pragma unroll
        for (int t = 0; t < 16; ++t) { float a = t == cc ? 1.f : 0.f;
#pragma unroll
            for (int s_ = 0; s_ < t; ++s_) a += Mv[t * 68 + s_] * x[s_];
            asm volatile("" : "+v"(a) :: "memory");
            x[t] = a; }
#pragma unroll
        for (int t = 0; t < 16; ++t) Tb[(b * 16 + t) * 40 + cc] = (bf16)f2bf(x[t]);
    } else {
        for (int tile = wave - 1; tile < 16; tile += 7) { const int tb = tile >> 2, ib = tile & 3; f32x4 acc = (f32x4){0.f, 0.f, 0.f, 0.f};
#pragma unroll
            for (int ks = 0; ks < 2; ++ks) acc = MFMA16(ld_frag(Mak, 72, tb * 16, ks * 32, lane), ld_frag(VT, 72, ib * 16, ks * 32, lane), acc);
#pragma unroll
            for (int r = 0; r < 4; ++r) RHS2[(tb * 16 + quad * 4 + r) * 68 + ib * 16 + l15] = acc[r]; }
    }
    BAR_LDS();
    {   LAS bf16* XTw = (wave < 4 ? X1T : X2T) + (wave & 3) * 16 * 72; LAS bf16* Rp = (LAS bf16*)(lds + RW_RPT) + wave * 512;
        for (int e = lane; e < 144; e += 64) *(LAS u32x4v*)(XTw + e * 8) = (u32x4v){0u, 0u, 0u, 0u};
        *(LAS u32x4v*)(Rp + lane * 8) = (u32x4v){0u, 0u, 0u, 0u};
#pragma unroll
        for (int b = 0; b < 4; ++b) {
            f32x4 acc;
#pragma unroll
            for (int r = 0; r < 4; ++r) { const int t = 16 * b + quad * 4 + r; acc[r] = wave < 4 ? bf2f(At[t * 72 + wave * 16 + l15]) : RHS2[t * 68 + (wave - 4) * 16 + l15]; }
            asm volatile("s_waitcnt lgkmcnt(0)" ::: "memory");
            if (b >= 1) acc = MFMA16(ld_frag(Moff, 72, 16 * b, 0, lane), ld_frag(XTw, 72, 0, 0, lane), acc);
            if (b == 3) acc = MFMA16(ld_frag(Moff, 72, 48, 32, lane), ld_frag(XTw, 72, 0, 32, lane), acc);
            *(LAS u32x2*)(Rp + l15 * 32 + quad * 4) = pack4(acc[0], acc[1], acc[2], acc[3]);
            asm volatile("s_waitcnt lgkmcnt(0)" ::: "memory");
            const f32x4 xb = MFMA16(ld_frag(Tb + b * 640, 40, 0, 0, lane), ld_frag(Rp, 32, 0, 0, lane), ((f32x4){0.f, 0.f, 0.f, 0.f}));
            *(LAS u32x2*)(XTw + l15 * 72 + 16 * b + quad * 4) = pack4(xb[0], xb[1], xb[2], xb[3]);
            asm volatile("s_waitcnt lgkmcnt(0)" ::: "memory");
        }
    }
    BAR_LDS();
    {   const int mat = wave >> 1, half = wave & 1;
        bf16* Q1g = (bf16*)(P.ws + WS_Q1) + (size_t)pi * 4096; bf16* Y0g = (bf16*)(P.ws + WS_Y0) + (size_t)pi * 4096;
        bf16* PcTg = (bf16*)(P.ws + WS_PCT) + (size_t)pi * 4096; bf16* Gcg = (bf16*)(P.ws + WS_GC) + (size_t)pi * 4096;
        const LAS bf16* A1 = (mat == 0 || mat == 2) ? X1T : (mat == 1 ? VT : KhT);
        const LAS bf16* B1 = mat == 0 ? Mrb : (mat == 1 ? Mrk : (mat == 2 ? BhT : VT));
        const LAS bf16* A2 = mat == 1 ? X2T : BhT; const LAS bf16* B2 = mat == 1 ? Mrb : X2T;
#pragma unroll
        for (int rbi = 0; rbi < 2; ++rbi)
#pragma unroll
            for (int cb = 0; cb < 4; ++cb) { const int rb = half * 2 + rbi; f32x4 acc = (f32x4){0.f, 0.f, 0.f, 0.f};
#pragma unroll
                for (int ks = 0; ks < 2; ++ks) acc = MFMA16(ld_frag(A1, 72, rb * 16, ks * 32, lane), ld_frag(B1, 72, cb * 16, ks * 32, lane), acc);
                if (mat == 1 || mat == 3) {
#pragma unroll
                    for (int ks = 0; ks < 2; ++ks) acc = MFMA16(ld_frag(A2, 72, rb * 16, ks * 32, lane), ld_frag(B2, 72, cb * 16, ks * 32, lane), acc); }
                const int r0 = rb * 16 + quad * 4, cl = cb * 16 + l15;
                if (mat == 0) { const u32x2 rt = *(const LAS u32x2*)(Rt + cl * 72 + r0);
                    *(u32x2*)(Q1g + cl * 64 + r0) = pack4(acc[0] + bf2f(rt.x & 0xffffu), acc[1] + bf2f(rt.x >> 16), acc[2] + bf2f(rt.y & 0xffffu), acc[3] + bf2f(rt.y >> 16)); }
                else if (mat == 1) *(u32x2*)(Y0g + cl * 64 + r0) = pack4(acc[0], acc[1], acc[2], acc[3]);
                else if (mat == 2) { const float wc = wCs[cl];
                    *(u32x2*)(PcTg + cl * 64 + r0) = pack4(acc[0] + (r0 == cl ? wc : 0.f), acc[1] + (r0 + 1 == cl ? wc : 0.f), acc[2] + (r0 + 2 == cl ? wc : 0.f), acc[3] + (r0 + 3 == cl ? wc : 0.f)); }
                else *(u32x2*)(Gcg + ((cb * 64 + lane) * 4 + rb) * 4) = pack4(acc[0], acc[1], acc[2], acc[3]); }
    }
    BAR_LDS();
}

constexpr int CH_PT = 0, CH_SB = 8 * 9216, CH_END = CH_SB + 8 * 2304;
__device__ __forceinline__ void chain_step(f32x4 (&acc)[4], const LAS bf16* PTs, LAS bf16* Sb, const u32x4v (&gf)[2], bool withG, int lane) {
    const int quad = lane >> 4, l15 = lane & 15;
#pragma unroll
    for (int jb = 0; jb < 4; ++jb) *(LAS u32x2*)(Sb + l15 * 72 + jb * 16 + quad * 4) = pack4(acc[jb][0], acc[jb][1], acc[jb][2], acc[jb][3]);
    asm volatile("s_waitcnt lgkmcnt(0)" ::: "memory");
    const bf16x8 b0 = ld_frag(Sb, 72, 0, 0, lane), b1 = ld_frag(Sb, 72, 0, 32, lane);
#pragma unroll
    for (int jb = 0; jb < 4; ++jb) { f32x4 n = (f32x4){0.f, 0.f, 0.f, 0.f};
        if (withG) { const unsigned g0 = gf[jb >> 1][(jb & 1) * 2], g1 = gf[jb >> 1][(jb & 1) * 2 + 1]; n = (f32x4){bf2f(g0 & 0xffffu), bf2f(g0 >> 16), bf2f(g1 & 0xffffu), bf2f(g1 >> 16)}; }
        n = MFMA16(ld_frag(PTs, 72, jb * 16, 0, lane), b0, n); n = MFMA16(ld_frag(PTs, 72, jb * 16, 32, lane), b1, n);
        acc[jb] = n; }
    asm volatile("s_waitcnt lgkmcnt(0)" ::: "memory");
}

__device__ __forceinline__ void stage_rwkv_compose(const Params& P, LAS unsigned char* lds, int task) {
    const int tid = otid(), lane = tid & 63, wave = __builtin_amdgcn_readfirstlane(tid >> 6), quad = lane >> 4, l15 = lane & 15;
    const int gI = task >> 2, h = task & 3, kind = wave >> 2, rb = wave & 3;
    LAS bf16* PTs = (LAS bf16*)(lds + CH_PT); LAS bf16* Sb = (LAS bf16*)(lds + CH_SB) + wave * 16 * 72;
    f32x4 acc[4];
#pragma unroll
    for (int jb = 0; jb < 4; ++jb)
#pragma unroll
        for (int r = 0; r < 4; ++r) acc[jb][r] = (kind == 0 && (jb * 16 + quad * 4 + r) == (rb * 16 + l15)) ? 1.f : 0.f;
    for (int bt = 0; bt < 2; ++bt) {
        const size_t pi0 = (size_t)((gI * 16 + bt * 8) * 4 + h);
        u32x4v pt[8], gf[8][2];
#pragma unroll
        for (int s_ = 0; s_ < 8; ++s_) { pt[s_] = *(const u32x4v*)((const bf16*)(P.ws + WS_PCT) + (pi0 + 4 * s_) * 4096 + tid * 8);
            gf[s_][0] = (u32x4v){0u, 0u, 0u, 0u}; gf[s_][1] = gf[s_][0];
            if (kind == 1) { const bf16* gp = (const bf16*)(P.ws + WS_GC) + (pi0 + 4 * s_) * 4096 + (rb * 64 + lane) * 16; gf[s_][0] = *(const u32x4v*)gp; gf[s_][1] = *(const u32x4v*)(gp + 8); } }
        BAR_LDS();
#pragma unroll
        for (int s_ = 0; s_ < 8; ++s_) *(LAS u32x4v*)(PTs + s_ * 4608 + (tid >> 3) * 72 + (tid & 7) * 8) = pt[s_];
        BAR_LDS();
#pragma unroll
        for (int s_ = 0; s_ < 8; ++s_) chain_step(acc, PTs + s_ * 4608, Sb, gf[s_], kind == 1, lane);
    }
    if (kind == 0) { bf16* PgTg = (bf16*)(P.ws + WS_PGT) + (size_t)task * 4096;
#pragma unroll
        for (int jb = 0; jb < 4; ++jb)
#pragma unroll
            for (int r = 0; r < 4; ++r) PgTg[(jb * 16 + quad * 4 + r) * 64 + rb * 16 + l15] = (bf16)f2bf(acc[jb][r]);
    } else { bf16* Ggg = (bf16*)(P.ws + WS_GG) + (size_t)task * 4096;
#pragma unroll
        for (int jb = 0; jb < 4; ++jb) *(u32x2*)(Ggg + ((rb * 64 + lane) * 4 + jb) * 4) = pack4(acc[jb][0], acc[jb][1], acc[jb][2], acc[jb][3]); }
    BAR_LDS();
}

__device__ __forceinline__ void stage_rwkv_chain(const Params& P, LAS unsigned char* lds, int task) {
    const int tid = otid(), lane = tid & 63, wave = __builtin_amdgcn_readfirstlane(tid >> 6);
    const int gI = task >> 2, h = task & 3, rb = wave & 3, nsteps = gI + 16;
    LAS bf16* PTs = (LAS bf16*)(lds + CH_PT); LAS bf16* Sb = (LAS bf16*)(lds + CH_SB) + wave * 16 * 72;
    f32x4 acc[4];
#pragma unroll
    for (int jb = 0; jb < 4; ++jb) acc[jb] = (f32x4){0.f, 0.f, 0.f, 0.f};
    for (int s0 = 0; s0 < nsteps; s0 += 8) {
        u32x4v pt[8], gf[8][2];
#pragma unroll
        for (int s_ = 0; s_ < 8; ++s_) { const int sg = s0 + s_;
            pt[s_] = (u32x4v){0u, 0u, 0u, 0u}; gf[s_][0] = pt[s_]; gf[s_][1] = pt[s_];
            if (sg < nsteps) {
                const bool grp = sg < gI; const size_t idx = grp ? (size_t)(sg * 4 + h) : (size_t)((gI * 16 + sg - gI) * 4 + h);
                const bf16* ptp = (const bf16*)(P.ws + (grp ? WS_PGT : WS_PCT)) + idx * 4096; const bf16* gp = (const bf16*)(P.ws + (grp ? WS_GG : WS_GC)) + idx * 4096 + (rb * 64 + lane) * 16;
                pt[s_] = *(const u32x4v*)(ptp + tid * 8);
                if (wave < 4) { gf[s_][0] = *(const u32x4v*)gp; gf[s_][1] = *(const u32x4v*)(gp + 8); } } }
        BAR_LDS();
#pragma unroll
        for (int s_ = 0; s_ < 8; ++s_) *(LAS u32x4v*)(PTs + s_ * 4608 + (tid >> 3) * 72 + (tid & 7) * 8) = pt[s_];
        BAR_LDS();
        if (wave < 4) {
#pragma unroll
            for (int s_ = 0; s_ < 8; ++s_) { const int sg = s0 + s_;
                if (sg < nsteps) {
                    if (sg >= gI) {
                        const int quad = lane >> 4, l15 = lane & 15;
#pragma unroll
                        for (int jb = 0; jb < 4; ++jb) *(LAS u32x2*)(Sb + l15 * 72 + jb * 16 + quad * 4) = pack4(acc[jb][0], acc[jb][1], acc[jb][2], acc[jb][3]);
                        asm volatile("s_waitcnt lgkmcnt(0)" ::: "memory");
                        bf16* S0g = (bf16*)(P.ws + WS_S0) + (size_t)((gI * 16 + sg - gI) * 4 + h) * 4096 + (rb * 16 + (lane >> 2)) * 64 + (lane & 3) * 16;
                        const LAS bf16* sp = Sb + (lane >> 2) * 72 + (lane & 3) * 16;
                        *(u32x4v*)S0g = *(const LAS u32x4v*)sp; *(u32x4v*)(S0g + 8) = *(const LAS u32x4v*)(sp + 8);
                        asm volatile("s_waitcnt lgkmcnt(0)" ::: "memory"); }
                    chain_step(acc, PTs + s_ * 4608, Sb, gf[s_], true, lane); } }
        }
    }
    BAR_LDS();
}

__device__ __forceinline__ void stage_rwkv_y(const Params& P, int l, int wt, int lane) {
    const int pi = wt >> 2, tb = wt & 3, c = pi >> 2, h = pi & 3, quad = lane >> 4, l15 = lane & 15;
    const bf16* S0g = (const bf16*)(P.ws + WS_S0) + (size_t)pi * 4096; const bf16* Q1g = (const bf16*)(P.ws + WS_Q1) + (size_t)pi * 4096; const bf16* Y0g = (const bf16*)(P.ws + WS_Y0) + (size_t)pi * 4096;
    const bf16* U = (const bf16*)(P.ws + WS_U); bf16* Y = (bf16*)(P.ws + WS_H);
    const int tl = tb * 16 + l15, tg = c * 64 + tl;
    const bf16* qp = Q1g + tl * 64 + quad * 8;
    const bf16x8 q0 = *(const bf16x8*)qp, q1 = *(const bf16x8*)(qp + 32);
    f32x4 y[4];
    u32x2 vc[4], vp[4], gc[4], gp[4];
    const bf16* uc = U + (size_t)tg * NU + h * 64 + quad * 4;
#pragma unroll
    for (int ib = 0; ib < 4; ++ib) {
        const u32x2 y0 = *(const u32x2*)(Y0g + tl * 64 + ib * 16 + quad * 4);
        y[ib] = (f32x4){bf2f(y0.x & 0xffffu), bf2f(y0.x >> 16), bf2f(y0.y & 0xffffu), bf2f(y0.y >> 16)};
        vc[ib] = *(const u32x2*)(uc + C_V + ib * 16); gc[ib] = *(const u32x2*)(uc + C_G + ib * 16);
        const bf16* up_ = tg > 0 ? uc - NU : uc;
        vp[ib] = *(const u32x2*)(up_ + C_V + ib * 16); gp[ib] = *(const u32x2*)(up_ + C_G + ib * 16);
        if (tg == 0) { vp[ib] = (u32x2){0u, 0u}; gp[ib] = (u32x2){0u, 0u}; } }
    const float bs = ((const float*)(P.ws + WS_BS))[(size_t)tg * 4 + h];
#pragma unroll
    for (int ib = 0; ib < 4; ++ib) { const bf16* sp = S0g + (ib * 16 + l15) * 64 + quad * 8;
        y[ib] = MFMA16(*(const bf16x8*)sp, q0, y[ib]); y[ib] = MFMA16(*(const bf16x8*)(sp + 32), q1, y[ib]); }
    float s = 0.f;
#pragma unroll
    for (int ib = 0; ib < 4; ++ib) s += (y[ib][0] + y[ib][1]) + (y[ib][2] + y[ib][3]);
    s += __shfl_xor(s, 16); s += __shfl_xor(s, 32);
    const float mean = s * (1.f / 64.f);
    float q = 0.f;
#pragma unroll
    for (int ib = 0; ib < 4; ++ib)
#pragma unroll
        for (int r = 0; r < 4; ++r) { const float d = y[ib][r] - mean; q += d * d; }
    q += __shfl_xor(q, 16); q += __shfl_xor(q, 32);
    const float rstd = rsqrtf(q * (1.f / 64.f) + LNX_EPS);
    const float* mu = PBP(P, PB_MU) + (size_t)l * 1152;
#pragma unroll
    for (int ib = 0; ib < 4; ++ib) { const int chn = h * 64 + ib * 16 + quad * 4, pc = l * 256 + chn;
        float o[4];
#pragma unroll
        for (int r = 0; r < 4; ++r) {
            const unsigned wv = r < 2 ? vc[ib].x : vc[ib].y, wvp = r < 2 ? vp[ib].x : vp[ib].y, wg = r < 2 ? gc[ib].x : gc[ib].y, wgp = r < 2 ? gp[ib].x : gp[ib].y;
            const float cv = bf2f((r & 1) ? (wv >> 16) : (wv & 0xffffu)), pv = bf2f((r & 1) ? (wvp >> 16) : (wvp & 0xffffu));
            const float cg = bf2f((r & 1) ? (wg >> 16) : (wg & 0xffffu)), pg = bf2f((r & 1) ? (wgp >> 16) : (wgp & 0xffffu));
            const float v = cv + (pv - cv) * mu[512 + chn + r], g = cg + (pg - cg) * mu[768 + chn + r];
            const float yn = (y[ib][r] - mean) * rstd * PBP(P, PB_LNW)[pc + r] + PBP(P, PB_LNB)[pc + r];
            o[r] = (yn + bs * v) * silu_f(g); }
        *(u32x2*)(Y + (size_t)tg * D + 512 + chn) = pack4(o[0], o[1], o[2], o[3]); }
}

constexpr int NT = 512;
constexpr int DUP_SUB = -1;
constexpr int REP_XA = 1, REP_S1 = 1, REP_P1 = 1, REP_OUT = 1, REP_SS3 = 1, REP_CMP = 1, REP_Y = 1;
constexpr int LDS_BYTES = 147456, MISC_OFF = LDS_BYTES - 256;
constexpr int CW_BAR = 4096;
static_assert(XA_LDS <= MISC_OFF && S3_LDS + 11264 <= MISC_OFF && S1_LDS + 10240 <= MISC_OFF && RW_END <= MISC_OFF && CH_END <= MISC_OFF && pg8::STAGE_BYTES <= MISC_OFF, "LDS map");

__global__ void __launch_bounds__(NT, 2) mega_fwd(Params P) {
    extern __shared__ __attribute__((aligned(16))) unsigned char lds_raw[];
    LAS unsigned char* lds_base = (LAS unsigned char*)lds_raw;
    volatile LAS unsigned* MISC = (volatile LAS unsigned*)(lds_base + MISC_OFF);
    const int tid = otid(), wave = __builtin_amdgcn_readfirstlane(tid >> 6), G = gridDim.x, bx = blockIdx.x;
    if (tid < 64) MISC[tid] = 0u;
    __syncthreads();
    XcdBarrier bar = xcd_barrier_post((unsigned*)(P.ws + WS_CTL) + CW_BAR, MISC + 8);
    {
        LAS unsigned char* lds = lds_base; const int gw = bx * 8 + wave, NGW = G * 8;
        stage_blob(P, bx * NT + tid, G * NT);
        for (int it = bx; it < N_PREP_ITEMS; it += G) stage_prep_weights(P, lds, it);
        for (int m = bx; m < MEM_LEN; m += G) stage_memkv(P, lds, m);
        for (int m = gw; m < M; m += NGW) prenorm_row(P.x + (size_t)m * D, P.pre_norm_w, (bf16*)(P.ws + WS_H) + (size_t)m * D, tid & 63);
        xcd_barrier(bar);
    }
    constexpr int PER = 7 + (DUP_SUB >= 0 ? 1 : 0), NPH = 1 + DEPTH * PER;
#pragma unroll 1
    for (int ph = 1; ph < NPH; ++ph) {
        Params Q;
        {   uintptr_t w_ = (uintptr_t)P.ws, o_ = (uintptr_t)P.out, x_ = (uintptr_t)P.x;
            asm volatile("" : "+s"(w_), "+s"(o_), "+s"(x_));
            Q.ws = (unsigned char*)(GAS unsigned char*)w_; Q.out = (float*)(GAS float*)o_; Q.x = (const float*)(GAS const float*)x_; }
        unsigned lds_a = (unsigned)(uintptr_t)lds_base; asm volatile("" : "+s"(lds_a)); LAS unsigned char* lds = (LAS unsigned char*)(uintptr_t)lds_a;
        int bx = blockIdx.x, G = gridDim.x; asm volatile("" : "+s"(bx), "+s"(G));
        const int tid = otid(), wave = __builtin_amdgcn_readfirstlane(tid >> 6), gw = bx * 8 + wave, NGW = G * 8;
        const int l = (ph - 1) / PER, s_ = (ph - 1) % PER, sub = (DUP_SUB >= 0 && s_ > DUP_SUB) ? s_ - 1 : s_;
        if (sub == 0) {
            pg8::Gemm g{(const bf16*)(Q.ws + WS_H), (const bf16*)(Q.ws + WS_WIN) + (size_t)l * NU * D, M, NU, D};
            pg8::StaticOrder S; S.init(M, NU, G, bx);
            pg8::EpiBf16 E{(bf16*)(Q.ws + WS_U), NU};
            pg8::gemm_phase<pg8::EpiBf16, pg8::StaticOrder, true, true>(lds, g, S, E);
        } else if (sub == 1) {
            for (int r_ = 0; r_ < REP_XA; ++r_) for (int it = bx; it < (M / 256) * 4; it += G) stage_xattn(Q, lds, it);
            for (int r_ = 0; r_ < REP_S1; ++r_) stage_ssd_s1(Q, l, lds, bx, G, NCHUNK * 2);
            for (int r_ = 0; r_ < REP_P1; ++r_) for (int it = bx; it < NCHUNK * 4; it += G) stage_rwkv_p1(Q, l, lds, it);
        } else if (sub == 2) {
            if (bx < 64) for (int r_ = 0; r_ < REP_CMP; ++r_) stage_rwkv_compose(Q, lds, bx);
            else for (int it = bx - 64; it < 512; it += G - 64) stage_ssd_scan(Q, lds, it);
        } else if (sub == 3) {
            if (bx < 64) for (int r_ = 0; r_ < REP_OUT; ++r_) stage_rwkv_chain(Q, lds, bx);
            else for (int r_ = 0; r_ < REP_SS3; ++r_) stage_ssd_s3(Q, l, lds, bx - 64, G - 64, NCHUNK * 2);
        } else if (sub == 4) {
            for (int r_ = 0; r_ < REP_Y; ++r_) for (int wt = gw; wt < NCHUNK * 4 * 4; wt += NGW) stage_rwkv_y(Q, l, wt, tid & 63);
        } else if (sub == 5) {
            pg8::Gemm g{(const bf16*)(Q.ws + WS_H), (const bf16*)(Q.ws + WS_WOUT) + (size_t)l * D * D, M, D, D};
            pg8::StaticOrder S; S.init(M, D, G, bx);
            pg8::EpiBf16 E{(bf16*)(Q.ws + WS_U), D};
            pg8::gemm_phase<pg8::EpiBf16, pg8::StaticOrder, true, true>(lds, g, S, E);
        } else {
            const float* xin = l == 0 ? Q.x : Q.out;
            for (int m = gw; m < M; m += NGW)
                post_row((const bf16*)(Q.ws + WS_U) + (size_t)m * D, xin + (size_t)m * D, PBP(Q, PB_POSTNW) + l * D, Q.out + (size_t)m * D,
                         l + 1 < DEPTH ? PBP(Q, PB_PRENW) + (l + 1) * D : nullptr, l + 1 < DEPTH ? (bf16*)(Q.ws + WS_H) + (size_t)m * D : nullptr, tid & 63);
        }
        if (ph + 1 < NPH) { XcdBarrier b2 = bar; asm volatile("" : "+s"(b2.x), "+s"(b2.bar)); xcd_barrier(b2); }
    }
}

extern "C" void kernel_launch(void* const* d_in, const int* in_sizes, int n_in, void* d_out, int out_size, void* d_ws, size_t ws_size, hipStream_t stream) {
    static int grid = 0;
    if (grid == 0) {
        if (n_in != 24 || in_sizes[0] != M * D || out_size != M * D || ws_size < WS_END) { fprintf(stderr, "kernel_launch: unexpected shapes n_in %d in0 %d out %d ws %zu\n", n_in, n_in > 0 ? in_sizes[0] : -1, out_size, ws_size); grid = -1; return; }
        int dev = 0, cus = 0, per_cu = 0;
        if (hipGetDevice(&dev) != hipSuccess || hipDeviceGetAttribute(&cus, hipDeviceAttributeMultiprocessorCount, dev) != hipSuccess) { grid = -1; return; }
        if (hipFuncSetAttribute((const void*)mega_fwd, hipFuncAttributeMaxDynamicSharedMemorySize, LDS_BYTES) != hipSuccess) { fprintf(stderr, "kernel_launch: hipFuncSetAttribute failed\n"); grid = -1; return; }
        if (hipOccupancyMaxActiveBlocksPerMultiprocessor(&per_cu, (const void*)mega_fwd, NT, LDS_BYTES) != hipSuccess || per_cu < 1) fprintf(stderr, "kernel_launch: occupancy query says %d\n", per_cu);
        (void)hipGetLastError();
        grid = cus;
    }
    if (grid < 0) return;
    if (hipMemsetAsync((char*)d_ws + WS_CTL, 0, 1 * MiB, stream) != hipSuccess) return;
    Params P{};
    const float** pp = (const float**)&P;
    for (int i = 0; i < 24; ++i) pp[i] = (const float*)d_in[i];
    P.out = (float*)d_out; P.ws = (unsigned char*)d_ws;
    hipLaunchKernelGGL(mega_fwd, dim3(grid), dim3(NT), LDS_BYTES, stream, P);
}
```

```cpp
#include <hip/hip_runtime.h>
#include <cstdio>
#include <cstdint>

__device__ __forceinline__ int otid() { int t = threadIdx.x; asm volatile("" : "+v"(t)); return t; }
namespace pg8 {
#define PG8_LAS __attribute__((address_space(3)))
typedef unsigned short bf16_t;
typedef short bf16x8 __attribute__((ext_vector_type(8)));
typedef float f32x4 __attribute__((ext_vector_type(4)));
typedef unsigned u32x4 __attribute__((ext_vector_type(4)));
constexpr int BM = 256, BK = 64, HALF = 128, HTB = HALF * BK * 2  , STAGE_BYTES = 8 * HTB, NXCD = 8, WGM = 8;

__host__ __device__ __forceinline__ int lds_byte(int r, int c) { const int st = (r >> 4) * 2 + (c >> 5), rr = r & 15, cc = c & 31, ob = rr * 64 + cc * 2; return st * 1024 + (ob ^ (((ob >> 9) & 1) << 5)); }
__host__ __device__ __forceinline__ void stage_rc(int b, int& R, int& C) { const int st = b / 1024, sb = b % 1024, swz = sb ^ (((sb >> 9) & 1) << 5); R = (st >> 1) * 16 + swz / 64; C = (st & 1) * 32 + (swz % 64) / 2; }
__host__ __device__ __forceinline__ int perm32(int rho) { const int n = rho >> 4, i = rho & 15; return 8 * (i >> 2) + 4 * n + (i & 3); }

struct Unit { int pm, pn; };
struct Gemm { const bf16_t* A; const bf16_t* Bt; int M, N, K; };

struct StaticOrder {
    int nM, nN, nwg, G, c;
    __host__ __device__ void init(int M, int N, int G_, int c_) { nM = M / BM; nN = N / BM; nwg = nM * nN; G = G_; c = c_; }
    __host__ __device__ bool next(int i, Unit& u) const {
        const long L = (long)i * G + c; if (L >= nwg) return false;
        int wgid = (int)L; { const int q = nwg / NXCD, r = nwg % NXCD, xcd = wgid % NXCD, off = wgid / NXCD; wgid = (xcd < r ? xcd * (q + 1) : r * (q + 1) + (xcd - r) * q) + off; }
        const int nig = WGM * nN, gid = wgid / nig, fm = gid * WGM, gsz = (nM - fm) < WGM ? (nM - fm) : WGM;
        u.pm = fm + ((wgid % nig) % gsz); u.pn = (wgid % nig) / gsz; return true;
    }
    __device__ __forceinline__ void a_ready(const Unit&) const {}
    __device__ __forceinline__ void done(const Unit&) const {}
};


__device__ __forceinline__ unsigned cvt_pk_bf16(float lo, float hi) { unsigned r; asm volatile("v_cvt_pk_bf16_f32 %0, %1, %2" : "=v"(r) : "v"(lo), "v"(hi)); return r; }
struct EpiBf16 {
    static constexpr bool PERM = true, AFTER_DRAIN = false;
    bf16_t* O; int ldc;
    __device__ __forceinline__ void operator()(const f32x4 (&acc)[2][2][4][2], const Unit& u, int wr, int wc, int fr, int fq) const {
        const int row0 = u.pm * BM + wr * 64 + fr; const int col0 = u.pn * BM + wc * 32 + 8 * fq;
#pragma unroll
        for (int ai = 0; ai < 2; ++ai)
#pragma unroll
            for (int m = 0; m < 4; ++m) { bf16_t* rowp = O + (size_t)(row0 + ai * HALF + m * 16) * ldc + col0;
#pragma unroll
                for (int bj = 0; bj < 2; ++bj) { const f32x4 v0 = acc[ai][bj][m][0], v1 = acc[ai][bj][m][1];
                    u32x4 w; w.x = cvt_pk_bf16(v0[0], v0[1]); w.y = cvt_pk_bf16(v0[2], v0[3]); w.z = cvt_pk_bf16(v1[0], v1[1]); w.w = cvt_pk_bf16(v1[2], v1[3]);
                    *(u32x4*)(rowp + bj * HALF) = w; } }
    }
};
struct EpiF32 {
    static constexpr bool PERM = false, AFTER_DRAIN = false;
    float* C; int ldc;
    __device__ __forceinline__ void operator()(const f32x4 (&acc)[2][2][4][2], const Unit& u, int wr, int wc, int fr, int fq) const {
        const int row0 = u.pm * BM + wr * 64 + fr, col0 = u.pn * BM + wc * 32 + 4 * fq;
#pragma unroll
        for (int ai = 0; ai < 2; ++ai)
#pragma unroll
            for (int m = 0; m < 4; ++m) { float* rowp = C + (size_t)(row0 + ai * HALF + m * 16) * ldc + col0;
#pragma unroll
                for (int bj = 0; bj < 2; ++bj)
#pragma unroll
                    for (int n = 0; n < 2; ++n) *(f32x4*)(rowp + bj * HALF + n * 16) = acc[ai][bj][m][n]; }
    }
};

template <class Epi, class Sched, bool ALIGN_EPI = false, bool SP2 = false>
__device__ __forceinline__ void gemm_phase(PG8_LAS unsigned char* lds, const Gemm g, const Sched& S, const Epi& E) {
    const int tid = otid(), wid = __builtin_amdgcn_readfirstlane(tid >> 6), lane = tid & 63, wr = wid >> 2, wc = wid & 3, fr = lane & 15, fq = lane >> 4;
    const int K = g.K, nt = K / BK;
    unsigned voffA[2], voffB[2];
#pragma unroll
    for (int i = 0; i < 2; ++i) { int R, C; stage_rc(tid * 16 + i * 8192, R, C); const int Rb = Epi::PERM ? ((R & ~31) + perm32(R & 31)) : R;
        voffA[i] = (unsigned)(R * K + C) * 2u; voffB[i] = (unsigned)(Rb * K + C) * 2u; }
    const size_t kstep = (size_t)(BK * 2);
    const size_t hstep = (size_t)HALF * K * 2;
    const size_t tstep = 2 * hstep;
    const unsigned ldsw = (unsigned)wid * 1024u;
    const int aoff = lds_byte(wr * 64 + fr, fq * 8), boff = lds_byte(wc * 32 + fr, fq * 8);
#define PG8_SA(b, h) (((b) * 2 + (h)) * HTB)
#define PG8_SB(b, h) ((4 + (b) * 2 + (h)) * HTB)
#define PG8_STAGE(bufoff, gbase, voff) do { _Pragma("unroll") for (int _i = 0; _i < 2; ++_i) \
        __builtin_amdgcn_global_load_lds((const unsigned*)((const char*)(gbase) + (voff)[_i]), (PG8_LAS unsigned*)(lds + (bufoff) + ldsw + _i * 8192), 16, 0, 0); } while (0)
#define PG8_LDA(dst, b, h) do { _Pragma("unroll") for (int m = 0; m < 4; ++m) _Pragma("unroll") for (int k = 0; k < 2; ++k) dst[m][k] = *(const PG8_LAS bf16x8*)(lds + PG8_SA(b, h) + aoff + m * 2048 + k * 1024); } while (0)
#define PG8_LDB(dst, b, h) do { _Pragma("unroll") for (int n = 0; n < 2; ++n) _Pragma("unroll") for (int k = 0; k < 2; ++k) dst[n][k] = *(const PG8_LAS bf16x8*)(lds + PG8_SB(b, h) + boff + n * 2048 + k * 1024); } while (0)
#define PG8_MMA(ai, bj, At, Bt) do { __builtin_amdgcn_s_setprio(1); _Pragma("unroll") for (int m = 0; m < 4; ++m) _Pragma("unroll") for (int n = 0; n < 2; ++n) _Pragma("unroll") for (int k = 0; k < 2; ++k) \
        acc[ai][bj][m][n] = __builtin_amdgcn_mfma_f32_16x16x32_bf16(Bt[n][k], At[m][k], acc[ai][bj][m][n], 0, 0, 0); __builtin_amdgcn_s_setprio(0); } while (0)
#define PG8_WAIT_V(n) asm volatile("s_waitcnt vmcnt(" #n ")" ::: "memory")
#define PG8_WAIT_L(n) asm volatile("s_waitcnt lgkmcnt(" #n ")" ::: "memory")
#define PG8_BAR __builtin_amdgcn_s_barrier()
#define PG8_SCHED __builtin_amdgcn_sched_barrier(0)
    Unit cur, nxt; int ui = 0;
    if (!S.next(0, cur)) return;
    f32x4 acc[2][2][4][2];
#pragma unroll
    for (int a = 0; a < 2; ++a)
#pragma unroll
        for (int b = 0; b < 2; ++b)
#pragma unroll
            for (int m = 0; m < 4; ++m)
#pragma unroll
                for (int n = 0; n < 2; ++n) acc[a][b][m][n] = (f32x4){0.f, 0.f, 0.f, 0.f};
    bf16x8 At[4][2], B0[2][2], B1[2][2];
    const char* cA = (const char*)g.A + (size_t)cur.pm * tstep; const char* cB = (const char*)g.Bt + (size_t)cur.pn * tstep;
    S.a_ready(cur);
    if constexpr (SP2) {
        PG8_STAGE(PG8_SB(0, 0), cB, voffB); PG8_STAGE(PG8_SB(0, 1), cB + hstep, voffB); PG8_STAGE(PG8_SA(0, 0), cA, voffA); PG8_STAGE(PG8_SA(0, 1), cA + hstep, voffA);
        if (wr == 1) PG8_BAR;
        PG8_WAIT_V(2); PG8_BAR;
        PG8_STAGE(PG8_SB(1, 0), cB + kstep, voffB); PG8_STAGE(PG8_SA(1, 0), cA + kstep, voffA); PG8_STAGE(PG8_SB(1, 1), cB + hstep + kstep, voffB);
        PG8_WAIT_V(6); PG8_BAR;
    } else {
        PG8_STAGE(PG8_SB(0, 0), cB, voffB); PG8_STAGE(PG8_SA(0, 0), cA, voffA); PG8_STAGE(PG8_SB(0, 1), cB + hstep, voffB); PG8_STAGE(PG8_SA(0, 1), cA + hstep, voffA);
        if (wr == 1) PG8_BAR;
        PG8_WAIT_V(4); PG8_BAR;
        PG8_STAGE(PG8_SB(1, 0), cB + kstep, voffB); PG8_STAGE(PG8_SA(1, 0), cA + kstep, voffA); PG8_STAGE(PG8_SB(1, 1), cB + hstep + kstep, voffB);
        PG8_WAIT_V(6); PG8_BAR;
    }
    for (;;) {
        const bool has_next = S.next(ui + 1, nxt);
        const char* nA = has_next ? (const char*)g.A + (size_t)nxt.pm * tstep : cA; const char* nB = has_next ? (const char*)g.Bt + (size_t)nxt.pn * tstep : cB;
        for (int t = 0; t < nt; t += 2) {
            const bool last = (t == nt - 2);
            const char* a1 = cA + (size_t)(t + 1) * kstep;
            const char* a2 = last ? nA : cA + (size_t)(t + 2) * kstep; const char* b2 = last ? nB : cB + (size_t)(t + 2) * kstep;
            const char* a3 = a2 + kstep; const char* b3 = b2 + kstep;
            if (last && has_next) S.a_ready(nxt);
            if constexpr (SP2) {
            PG8_LDB(B0, 0, 0); PG8_LDB(B1, 0, 1); PG8_SCHED; PG8_LDA(At, 0, 0); PG8_STAGE(PG8_SA(1, 1), a1 + hstep, voffA);
            PG8_WAIT_V(8); PG8_WAIT_L(0); PG8_BAR; PG8_MMA(0, 0, At, B0); PG8_MMA(0, 1, At, B1); PG8_BAR; PG8_SCHED;
            PG8_LDA(At, 0, 1); PG8_STAGE(PG8_SB(0, 0), b2, voffB); PG8_STAGE(PG8_SB(0, 1), b2 + hstep, voffB); PG8_STAGE(PG8_SA(0, 0), a2, voffA);
            PG8_WAIT_V(8); PG8_WAIT_L(0); PG8_BAR; PG8_MMA(1, 0, At, B0); PG8_MMA(1, 1, At, B1); PG8_BAR; PG8_SCHED;
            PG8_LDB(B0, 1, 0); PG8_LDB(B1, 1, 1); PG8_SCHED; PG8_LDA(At, 1, 0); PG8_STAGE(PG8_SA(0, 1), a2 + hstep, voffA);
            PG8_WAIT_V(8); PG8_WAIT_L(0); PG8_BAR; PG8_MMA(0, 0, At, B0); PG8_MMA(0, 1, At, B1); PG8_BAR; PG8_SCHED;
            PG8_LDA(At, 1, 1); PG8_STAGE(PG8_SB(1, 0), b3, voffB); PG8_STAGE(PG8_SB(1, 1), b3 + hstep, voffB); PG8_STAGE(PG8_SA(1, 0), a3, voffA);
            PG8_WAIT_V(8); PG8_WAIT_L(0); PG8_BAR; PG8_MMA(1, 0, At, B0); PG8_MMA(1, 1, At, B1); PG8_BAR; PG8_SCHED;
            } else {
            PG8_LDB(B0, 0, 0); PG8_SCHED; PG8_LDA(At, 0, 0); PG8_STAGE(PG8_SA(1, 1), a1 + hstep, voffA);
            PG8_WAIT_L(8); PG8_BAR; PG8_WAIT_L(0); PG8_MMA(0, 0, At, B0); PG8_BAR; PG8_SCHED;
            PG8_LDB(B1, 0, 1); PG8_STAGE(PG8_SB(0, 0), b2, voffB);
            PG8_BAR; PG8_WAIT_L(0); PG8_MMA(0, 1, At, B1); PG8_BAR;
            PG8_LDA(At, 0, 1); PG8_STAGE(PG8_SA(0, 0), a2, voffA);
            PG8_BAR; PG8_WAIT_L(0); PG8_MMA(1, 0, At, B0); PG8_BAR; PG8_SCHED;
            PG8_STAGE(PG8_SB(0, 1), b2 + hstep, voffB);
            PG8_WAIT_V(6); PG8_BAR; PG8_MMA(1, 1, At, B1); PG8_BAR;
            PG8_LDB(B0, 1, 0); PG8_SCHED; PG8_LDA(At, 1, 0); PG8_STAGE(PG8_SA(0, 1), a2 + hstep, voffA);
            PG8_WAIT_L(8); PG8_BAR; PG8_WAIT_L(0); PG8_MMA(0, 0, At, B0); PG8_BAR; PG8_SCHED;
            PG8_LDB(B1, 1, 1); PG8_STAGE(PG8_SB(1, 0), b3, voffB);
            PG8_BAR; PG8_WAIT_L(0); PG8_MMA(0, 1, At, B1); PG8_BAR;
            PG8_LDA(At, 1, 1); PG8_STAGE(PG8_SA(1, 0), a3, voffA);
            PG8_BAR; PG8_WAIT_L(0); PG8_MMA(1, 0, At, B0); PG8_BAR; PG8_SCHED;
            PG8_STAGE(PG8_SB(1, 1), b3 + hstep, voffB);
            PG8_WAIT_V(6); PG8_BAR; PG8_MMA(1, 1, At, B1); PG8_BAR;
            }
        }
        if constexpr (ALIGN_EPI) { if (wr == 0) PG8_BAR; }
        if constexpr (!Epi::AFTER_DRAIN) { E(acc, cur, wr, wc, fr, fq); S.done(cur); }
        if (!has_next) break;
#pragma unroll
        for (int a = 0; a < 2; ++a)
#pragma unroll
            for (int b = 0; b < 2; ++b)
#pragma unroll
                for (int m = 0; m < 4; ++m)
#pragma unroll
                    for (int n = 0; n < 2; ++n) acc[a][b][m][n] = (f32x4){0.f, 0.f, 0.f, 0.f};
        cur = nxt; cA = nA; cB = nB; ++ui;
        if constexpr (ALIGN_EPI) { if (wr == 1) PG8_BAR; }
    }
    PG8_WAIT_V(0);
    if constexpr (!ALIGN_EPI) { if (wr == 0) PG8_BAR; }
    PG8_BAR;
    if constexpr (Epi::AFTER_DRAIN) { E.fused(acc, cur, wr, wc, fr, fq, lds, wid, lane); S.done(cur); }
#undef PG8_SA
#undef PG8_SB
#undef PG8_STAGE
#undef PG8_LDA
#undef PG8_LDB
#undef PG8_MMA
#undef PG8_WAIT_V
#undef PG8_WAIT_L
#undef PG8_BAR
#undef PG8_SCHED
}
}

constexpr int M = 16384, D = 1024, DEPTH = 4, NU = 3328, NWIN = 3208, NCHUNK = 256;
constexpr int MEM_LEN = 256;
constexpr int C_XS = 0, C_B = 512, C_C = 768, C_Z = 1024, C_R = 1536, C_K = 1792, C_V = 2048, C_G = 2304, C_Q = 2560, C_GX = 2816, C_WL = 3072, C_AL = 3136, C_DT = 3200;
constexpr int NMAIN = 3072, NSK = 144;
constexpr float NORM_EPS = 1e-6f, LNX_EPS = 64e-5f;

#define LAS __attribute__((address_space(3)))
#define GAS __attribute__((address_space(1)))
typedef unsigned short bf16;
typedef short bf16x8 __attribute__((ext_vector_type(8)));
typedef float f32x4 __attribute__((ext_vector_type(4)));

typedef __bf16 bf16v2_t __attribute__((ext_vector_type(2)));
__device__ __forceinline__ unsigned cvt2bf(float lo, float hi) { bf16v2_t v; v[0] = (__bf16)lo; v[1] = (__bf16)hi; return __builtin_bit_cast(unsigned, v); }
__device__ __forceinline__ unsigned f2bf(float f) { return cvt2bf(f, 0.f) & 0xffffu; }
__device__ __forceinline__ float bf2f(unsigned b) { return __uint_as_float(b << 16); }
__device__ __forceinline__ float us2f(short s) { return bf2f((unsigned)(unsigned short)s); }
typedef unsigned u32x2 __attribute__((ext_vector_type(2)));
typedef unsigned u32x4v __attribute__((ext_vector_type(4)));
__device__ __forceinline__ u32x2 pack4(float a, float b, float c, float d) { u32x2 o; o.x = cvt2bf(a, b); o.y = cvt2bf(c, d); return o; }
__device__ __forceinline__ bf16x8 pack8(const float (&v)[8]) { const u32x4v t = (u32x4v){cvt2bf(v[0], v[1]), cvt2bf(v[2], v[3]), cvt2bf(v[4], v[5]), cvt2bf(v[6], v[7])}; return __builtin_bit_cast(bf16x8, t); }
__device__ __forceinline__ float wave_sum(float v) {
#pragma unroll
    for (int o = 1; o < 64; o <<= 1) v += __shfl_xor(v, o);
    return v;
}
__device__ __forceinline__ float silu_f(float x) { return x * __builtin_amdgcn_rcpf(1.f + __expf(-x)); }
__device__ __forceinline__ float softplus_f(float x) { return fmaxf(x, 0.f) + __logf(1.f + __expf(-fabsf(x))); }
__device__ __forceinline__ float sigmoid_f(float x) { return __builtin_amdgcn_rcpf(1.f + __expf(-x)); }

__device__ __forceinline__ bf16x8 ld_frag(const LAS bf16* base, int ld, int row0, int k0, int lane) {
    return *(const LAS bf16x8*)(base + (row0 + (lane & 15)) * ld + k0 + (lane >> 4) * 8);
}
#define MFMA16(a, b, c) __builtin_amdgcn_mfma_f32_16x16x32_bf16((a), (b), (c), 0, 0, 0)
#define BAR_LDS() do { asm volatile("s_waitcnt lgkmcnt(0)" ::: "memory"); __builtin_amdgcn_s_barrier(); asm volatile("" ::: "memory"); } while (0)

#define XB_TMO      128
#define XB_XCNT(j)  (256  + 64 * (j))
#define XB_XSUB(j)  (1280 + 64 * (j))
#define XB_XGEN(j)  (2304 + 64 * (j))
#define XB_TOP      3328
#define XB_TOPGEN   3392
#define XCD_BAR_WORDS 3456
#define XB_SPIN_CAP (1u << 22)

__device__ __forceinline__ unsigned xb_ld(unsigned* p)              { return __hip_atomic_load(p, __ATOMIC_RELAXED, __HIP_MEMORY_SCOPE_AGENT); }
__device__ __forceinline__ unsigned xb_add(unsigned* p, unsigned v) { return __hip_atomic_fetch_add(p, v, __ATOMIC_RELAXED, __HIP_MEMORY_SCOPE_AGENT); }
__device__ __forceinline__ unsigned xb_xcc_id() { return (unsigned)__builtin_amdgcn_s_getreg((3 << 11) | 20) & 0xFu; }
#define XB_SPIN(cond, bar) do { unsigned _sp = 0; while (cond) { __builtin_amdgcn_s_sleep(1); \
    if ((++_sp & 255u) == 0u) { if (xb_ld(&(bar)[XB_TMO])) break; if (_sp > XB_SPIN_CAP) { atomicAdd(&(bar)[XB_TMO], 1u); break; } } } } while (0)

struct XcdBarrier {
    unsigned* bar; unsigned x;
    volatile LAS unsigned* st;
};

__device__ __forceinline__ XcdBarrier xcd_barrier_post(unsigned* bar, volatile LAS unsigned* st) {
    XcdBarrier b; b.bar = bar; b.x = xb_xcc_id(); b.st = st;
    if (otid() == 0) (void)xb_add(&bar[XB_XCNT(b.x)], 1u);
    return b;
}
__device__ __forceinline__ void xcd_barrier_complete(unsigned* bar, unsigned x, unsigned& nloc, unsigned& nx) {
    const unsigned G = gridDim.x * gridDim.y * gridDim.z;
    unsigned sum, cnt, mine, sp = 0u;
    for (;;) {
        sum = 0u; cnt = 0u; mine = 0u;
#pragma unroll
        for (unsigned j = 0; j < 16; ++j) { const unsigned c = xb_ld(&bar[XB_XCNT(j)]); sum += c; cnt += (c > 0u) ? 1u : 0u; }
        mine = xb_ld(&bar[XB_XCNT(x)]);
        if (sum == G) break;
        __builtin_amdgcn_s_sleep(1);
        if ((++sp & 255u) == 0u) { if (xb_ld(&bar[XB_TMO])) break; if (sp > XB_SPIN_CAP) { atomicAdd(&bar[XB_TMO], 1u); break; } }
    }
    nloc = mine > 0u ? mine : 1u; nx = cnt > 0u ? cnt : 1u;
}

__device__ __forceinline__ void xcd_barrier(const XcdBarrier& b) {
    asm volatile("s_waitcnt vmcnt(0)" ::: "memory");
    __syncthreads();
    if (otid() == 0) {
        unsigned* bar = b.bar;
        __builtin_amdgcn_s_waitcnt(0);
        unsigned nloc = b.st[0], nx = b.st[1];
        if (nloc == 0u) { xcd_barrier_complete(bar, b.x, nloc, nx); b.st[0] = nloc; b.st[1] = nx; }
        const unsigned old = xb_add(&bar[XB_XSUB(b.x)], 1u);
        const unsigned gen = old / nloc;
        if (old + 1u == (gen + 1u) * nloc) {
            __builtin_amdgcn_fence(__ATOMIC_RELEASE, "agent");
            asm volatile("s_waitcnt vmcnt(0)" ::: "memory");
            const unsigned og = xb_add(&bar[XB_TOP], 1u);
            const unsigned tg = og / nx;
            if (og + 1u == (tg + 1u) * nx) xb_add(&bar[XB_TOPGEN], 1u);
            else XB_SPIN(xb_ld(&bar[XB_TOPGEN]) == tg, bar);
            __builtin_amdgcn_fence(__ATOMIC_ACQUIRE, "agent");
            xb_add(&bar[XB_XGEN(b.x)], 1u);
            asm volatile("s_waitcnt vmcnt(0)" ::: "memory");
        } else {
            XB_SPIN(xb_ld(&bar[XB_XGEN(b.x)]) == gen, bar);
            __builtin_amdgcn_fence(__ATOMIC_ACQUIRE, "agent");
            asm volatile("s_waitcnt vmcnt(0)" ::: "memory");
        }
    }
    __syncthreads();
}


struct Params {
    const float *x, *mem, *mem_norm_w, *w_mem_kv, *pre_norm_w, *w_in, *conv_w, *conv_b, *dt_bias, *a_log, *d_skip, *ssm_norm_w,
                *shift_mu, *w0, *w2, *a0, *a2, *k_k, *k_a, *r_k, *lnx_w, *lnx_b, *w_out, *post_norm_w;
    float* out;
    unsigned char* ws;
};
constexpr size_t MiB = 1u << 20;
constexpr size_t WS_CTL = 0, WS_WIN = 1 * MiB, WS_WOUT = 27 * MiB, WS_KV = 35 * MiB, WS_H = 36 * MiB, WS_U = 68 * MiB, WS_R = 172 * MiB, WS_END = 256 * MiB;
constexpr size_t WS_W2T = WS_KV + 256 * 1024;
constexpr size_t WS_ST = WS_R, WS_CD = WS_R + 32 * MiB, WS_BS = WS_CD + 65536;
constexpr size_t WS_Q1 = WS_R + 34 * MiB, WS_Y0 = WS_R + 42 * MiB, WS_PCT = WS_R + 50 * MiB, WS_GC = WS_R + 58 * MiB, WS_S0 = WS_R + 66 * MiB, WS_PGT = WS_R + 74 * MiB, WS_GG = WS_R + 75 * MiB;
static_assert(WS_GG + 64 * 8192 <= WS_END && WS_BS + (size_t)16384 * 16 <= WS_Q1, "ws map");


constexpr size_t WS_PB = 128 * 1024;
constexpr int PB_PRENW = 1024, PB_CONVW = 5120, PB_CONVB = 21504, PB_DTB = 25600, PB_ALOG = 25632, PB_DSKIP = 25664, PB_SSMNW = 25728, PB_MU = 27776, PB_W0 = 32384, PB_W2 = 33408,
              PB_A0 = 98944, PB_A2 = 99968, PB_KK = 165504, PB_KA = 166528, PB_RK = 167552, PB_LNW = 168576, PB_LNB = 169600, PB_POSTNW = 170624, PB_END = 174720;
static_assert(WS_PB + (size_t)PB_END * 4 <= 1 * MiB, "blob inside the control MiB");
#define PBP(P, off) ((const float*)((P).ws + WS_PB) + (off))
__device__ __forceinline__ int win_src_col(int n) {
    if (n < 1536) return n;
    if (n < 2560) return n + 8;
    if (n < 3072) return n + 136;
    const int j = n - 3072; if (j < 64) return 2568 + j; if (j < 128) return 2632 + (j - 64); if (j < 136) return 1536 + (j - 128); return -1;
}
template <bool WIN>
__device__ __forceinline__ void transpose_tile(const float* src, int src_ld, bf16* dst, int K, int n0, int k0, LAS float* scr) {
    const int tid = otid(), kk = tid >> 3, ng = tid & 7;
    const int sc = WIN ? win_src_col(n0 + ng * 8) : (n0 + ng * 8);
    f32x4 v0 = (f32x4){0.f, 0.f, 0.f, 0.f}, v1 = v0;
    { const float* sp = src + (size_t)(k0 + kk) * src_ld + (sc >= 0 ? sc : 0); const f32x4 a0 = *(const f32x4*)sp, a1 = *(const f32x4*)(sp + 4); if (sc >= 0) { v0 = a0; v1 = a1; } }
    BAR_LDS();
#pragma unroll
    for (int j = 0; j < 4; ++j) { scr[(ng * 8 + j) * 65 + kk] = v0[j]; scr[(ng * 8 + 4 + j) * 65 + kk] = v1[j]; }
    BAR_LDS();
    const int n = tid >> 3, kg = tid & 7; float o[8];
#pragma unroll
    for (int j = 0; j < 8; ++j) o[j] = scr[n * 65 + kg * 8 + j];
    *(bf16x8*)(dst + (size_t)(n0 + n) * K + k0 + kg * 8) = pack8(o);
}
__device__ __forceinline__ void stage_prep_weights(const Params& P, LAS unsigned char* lds, int item) {
    LAS float* scr = (LAS float*)lds;
    constexpr int T_IN = (NU / 64) * (D / 64);
    constexpr int T_OUT = (D / 64) * (D / 64);
    if (item < DEPTH * T_IN) { const int l = item / T_IN, r = item % T_IN, nb = r / 16, kb = r % 16;
        transpose_tile<true>(P.w_in + (size_t)l * D * NWIN, NWIN, (bf16*)(P.ws + WS_WIN) + (size_t)l * NU * D, D, nb * 64, kb * 64, scr); }
    else { const int it = item - DEPTH * T_IN; const int l = it / T_OUT, r = it % T_OUT, nb = r / 16, kb = r % 16;
        transpose_tile<false>(P.w_out + (size_t)l * D * D, D, (bf16*)(P.ws + WS_WOUT) + (size_t)l * D * D, D, nb * 64, kb * 64, scr); }
}
constexpr int N_PREP_ITEMS = DEPTH * ((NU / 64) * (D / 64) + (D / 64) * (D / 64));


__device__ __forceinline__ void stage_blob(const Params& P, int gtid, int gthreads) {
    float* pb = (float*)(P.ws + WS_PB);
#define CPY(src, off, n) for (int i = gtid; i < (n); i += gthreads) pb[(off) + i] = (src)[i];
    CPY(P.mem_norm_w, 0, 1024) CPY(P.pre_norm_w, PB_PRENW, 4096) CPY(P.conv_w, PB_CONVW, 16384) CPY(P.conv_b, PB_CONVB, 4096) CPY(P.dt_bias, PB_DTB, 32) CPY(P.a_log, PB_ALOG, 32) CPY(P.d_skip, PB_DSKIP, 32)
    CPY(P.ssm_norm_w, PB_SSMNW, 2048) CPY(P.shift_mu, PB_MU, 4608) CPY(P.w0, PB_W0, 1024) CPY(P.w2, PB_W2, 65536) CPY(P.a0, PB_A0, 1024) CPY(P.a2, PB_A2, 65536) CPY(P.k_k, PB_KK, 1024) CPY(P.k_a, PB_KA, 1024)
    CPY(P.r_k, PB_RK, 1024) CPY(P.lnx_w, PB_LNW, 1024) CPY(P.lnx_b, PB_LNB, 1024) CPY(P.post_norm_w, PB_POSTNW, 4096)
#undef CPY
    bf16* wi = (bf16*)(P.ws + WS_W2T);
    for (int i = gtid; i < 65536; i += gthreads) { const int j = i & 63, ch = (i >> 6) & 63, h = (i >> 12) & 3, l = i >> 14;
        wi[i] = (bf16)f2bf(P.w2[((size_t)l * 64 + j) * 256 + h * 64 + ch]); wi[65536 + i] = (bf16)f2bf(P.a2[((size_t)l * 64 + j) * 256 + h * 64 + ch]); }
}
__device__ __forceinline__ void stage_memkv(const Params& P, LAS unsigned char* lds, int m) {
    LAS float* xs = (LAS float*)lds; LAS float* red = xs + 1024;
    const int tid = otid();
    const float v0 = P.mem[(size_t)m * D + tid], v1 = P.mem[(size_t)m * D + 512 + tid];
    float s = wave_sum(v0 * v0 + v1 * v1);
    if ((tid & 63) == 0) red[tid >> 6] = s;
    __syncthreads();
    float tot = 0.f;
#pragma unroll
    for (int w = 0; w < 8; ++w) tot += red[w];
    const float rstd = rsqrtf(tot * (1.f / D) + NORM_EPS);
    xs[tid] = v0 * rstd * P.mem_norm_w[tid]; xs[512 + tid] = v1 * rstd * P.mem_norm_w[512 + tid];
    __syncthreads();
    float acc = 0.f;
#pragma unroll 32
    for (int k = 0; k < D; ++k) acc += xs[k] * P.w_mem_kv[(size_t)k * 512 + tid];
    {   const int hh = (tid >> 6) & 3, d = tid & 63;
        if (tid < 256) ((bf16*)(P.ws + WS_KV))[(size_t)(hh * 256 + m) * 64 + d] = (bf16)f2bf(acc);
        else ((bf16*)(P.ws + WS_KV) + 65536)[(size_t)(hh * 64 + d) * 256 + m] = (bf16)f2bf(acc); }
    __syncthreads();
}

__device__ __forceinline__ void prenorm_row(const float* xrow, const float* w, bf16* orow, int lane) {
    const f32x4* xr = (const f32x4*)xrow + lane; const f32x4* wr = (const f32x4*)w + lane;
    f32x4 v[4]; float s = 0.f;
#pragma unroll
    for (int j = 0; j < 4; ++j) { v[j] = xr[64 * j]; s += (v[j].x * v[j].x + v[j].y * v[j].y) + (v[j].z * v[j].z + v[j].w * v[j].w); }
    const float rstd = rsqrtf(wave_sum(s) * (1.f / D) + NORM_EPS);
    unsigned long long* o8 = (unsigned long long*)orow + lane;
#pragma unroll
    for (int j = 0; j < 4; ++j) { const f32x4 ww = wr[64 * j];
        const unsigned lo = f2bf(v[j].x * rstd * ww.x) | (f2bf(v[j].y * rstd * ww.y) << 16), hi = f2bf(v[j].z * rstd * ww.z) | (f2bf(v[j].w * rstd * ww.w) << 16);
        o8[64 * j] = (unsigned long long)lo | ((unsigned long long)hi << 32); }
}
__device__ __forceinline__ void post_row(const bf16* orow, const float* xin, const float* pw, float* xout, const float* nw, bf16* hrow, int lane) {
    const f32x4* xr = (const f32x4*)xin + lane; const f32x4* pr = (const f32x4*)pw + lane;
    f32x4 v[4]; float s = 0.f;
#pragma unroll
    for (int j = 0; j < 4; ++j) { const u32x2 o2 = *((const u32x2*)orow + 64 * j + lane); v[j] = (f32x4){bf2f(o2.x & 0xffffu), bf2f(o2.x >> 16), bf2f(o2.y & 0xffffu), bf2f(o2.y >> 16)};
        s += (v[j].x * v[j].x + v[j].y * v[j].y) + (v[j].z * v[j].z + v[j].w * v[j].w); }
    const float rstd = rsqrtf(wave_sum(s) * (1.f / D) + NORM_EPS);
    float s2 = 0.f;
#pragma unroll
    for (int j = 0; j < 4; ++j) { const f32x4 xx = xr[64 * j], pp = pr[64 * j]; v[j] = xx + v[j] * rstd * pp; s2 += (v[j].x * v[j].x + v[j].y * v[j].y) + (v[j].z * v[j].z + v[j].w * v[j].w);
        ((f32x4*)xout + lane)[64 * j] = v[j]; }
    if (hrow) {
        const float rstd2 = rsqrtf(wave_sum(s2) * (1.f / D) + NORM_EPS);
        const f32x4* wr = (const f32x4*)nw + lane; unsigned long long* o8 = (unsigned long long*)hrow + lane;
#pragma unroll
        for (int j = 0; j < 4; ++j) { const f32x4 ww = wr[64 * j];
            const unsigned lo = f2bf(v[j].x * rstd2 * ww.x) | (f2bf(v[j].y * rstd2 * ww.y) << 16), hi = f2bf(v[j].z * rstd2 * ww.z) | (f2bf(v[j].w * rstd2 * ww.w) << 16);
            o8[64 * j] = (unsigned long long)lo | ((unsigned long long)hi << 32); }
    }
}

constexpr int XA_KLD = 72, XA_VLD = 264;
constexpr int XA_LDS = (256 * XA_KLD + 64 * XA_VLD) * 2;
__device__ __forceinline__ void stage_xattn(const Params& P, LAS unsigned char* lds, int item) {
    const int tid = otid(), lane = tid & 63, wave = tid >> 6, quad = lane >> 4, l15 = lane & 15;
    const int tile = item >> 2, h = item & 3, t0 = tile * 256;
    LAS bf16* Ks = (LAS bf16*)lds; LAS bf16* VT = Ks + 256 * XA_KLD;
    const bf16* KB = (const bf16*)(P.ws + WS_KV) + (size_t)h * 256 * 64; const bf16* VB = (const bf16*)(P.ws + WS_KV) + 65536 + (size_t)h * 64 * 256;
    const bf16* U = (const bf16*)(P.ws + WS_U); bf16* Y = (bf16*)(P.ws + WS_H);
    u32x4v kp[4], vp[4];
#pragma unroll
    for (int i = 0; i < 4; ++i) { const int e = tid + i * 512; kp[i] = *(const u32x4v*)(KB + e * 8); vp[i] = *(const u32x4v*)(VB + e * 8); }
    bf16x8 qf[2][2]; u32x2 gx[2][4];
#pragma unroll
    for (int rb = 0; rb < 2; ++rb) { const bf16* up = U + (size_t)(t0 + wave * 32 + rb * 16 + l15) * NU + h * 64;
#pragma unroll
        for (int s_ = 0; s_ < 2; ++s_) qf[rb][s_] = *(const bf16x8*)(up + C_Q + s_ * 32 + quad * 8);
#pragma unroll
        for (int db = 0; db < 4; ++db) gx[rb][db] = *(const u32x2*)(up + C_GX + db * 16 + quad * 4); }
#pragma unroll
    for (int i = 0; i < 4; ++i) { const int e = tid + i * 512;
        *(LAS u32x4v*)(Ks + (e >> 3) * XA_KLD + (e & 7) * 8) = kp[i]; *(LAS u32x4v*)(VT + (e >> 5) * XA_VLD + (e & 31) * 8) = vp[i]; }
    BAR_LDS();
#pragma unroll
    for (int rb = 0; rb < 2; ++rb) {
        f32x4 acc[16];
#pragma unroll
        for (int mb = 0; mb < 16; ++mb) { acc[mb] = (f32x4){0.f, 0.f, 0.f, 0.f};
#pragma unroll
            for (int s_ = 0; s_ < 2; ++s_) acc[mb] = MFMA16(ld_frag(Ks, XA_KLD, mb * 16, s_ * 32, lane), qf[rb][s_], acc[mb]); }
        float m_ = -3.0e38f;
#pragma unroll
        for (int mb = 0; mb < 16; ++mb)
#pragma unroll
            for (int r = 0; r < 4; ++r) { acc[mb][r] *= 0.125f; m_ = fmaxf(m_, acc[mb][r]); }
        m_ = fmaxf(m_, __shfl_xor(m_, 16)); m_ = fmaxf(m_, __shfl_xor(m_, 32));
        float sm = 0.f; u32x2 pk[16];
#pragma unroll
        for (int mb = 0; mb < 16; ++mb) { float p[4];
#pragma unroll
            for (int r = 0; r < 4; ++r) { p[r] = __expf(acc[mb][r] - m_); sm += p[r]; }
            pk[mb] = pack4(p[0], p[1], p[2], p[3]); }
        sm += __shfl_xor(sm, 16); sm += __shfl_xor(sm, 32);
        f32x4 o4[4];
#pragma unroll
        for (int db = 0; db < 4; ++db) o4[db] = (f32x4){0.f, 0.f, 0.f, 0.f};
#pragma unroll
        for (int ks = 0; ks < 8; ++ks) {
            bf16x8 pb; { const u32x4v t4 = (u32x4v){pk[2 * ks].x, pk[2 * ks].y, pk[2 * ks + 1].x, pk[2 * ks + 1].y}; pb = __builtin_bit_cast(bf16x8, t4); }
#pragma unroll
            for (int db = 0; db < 4; ++db) { const LAS bf16* vpn = VT + (db * 16 + l15) * XA_VLD + ks * 32 + quad * 4;
                const u32x2 v0 = *(const LAS u32x2*)vpn, v1 = *(const LAS u32x2*)(vpn + 16);
                const u32x4v t4 = (u32x4v){v0.x, v0.y, v1.x, v1.y};
                o4[db] = MFMA16(__builtin_bit_cast(bf16x8, t4), pb, o4[db]); } }
        const float inv = 1.f / sm; const int t = t0 + wave * 32 + rb * 16 + l15;
#pragma unroll
        for (int db = 0; db < 4; ++db) { const u32x2 g = gx[rb][db];
            *(u32x2*)(Y + (size_t)t * D + 768 + h * 64 + db * 16 + quad * 4) = pack4(o4[db][0] * inv * silu_f(bf2f(g.x & 0xffffu)), o4[db][1] * inv * silu_f(bf2f(g.x >> 16)),
                                                                                   o4[db][2] * inv * silu_f(bf2f(g.y & 0xffffu)), o4[db][3] * inv * silu_f(bf2f(g.y >> 16))); }
        __builtin_amdgcn_sched_barrier(0);
    }
    BAR_LDS();
}

__device__ __forceinline__ void conv_issue(const bf16* U, int ts, int col, bf16x8 (&rows)[11]) {
#pragma unroll
    for (int i = 0; i < 11; ++i) { const int tt = ts - 3 + i; rows[i] = *(const bf16x8*)(U + (size_t)(tt < 0 ? 0 : tt) * NU + col); }
}
__device__ __forceinline__ void conv_weights(const float* cw, const float* cb, int col, LAS float* cwS, int tid) {
    const int j = tid & 7, cg = tid >> 3;
    if (j < 5) { const float* src = j < 4 ? cw + j * 1024 + col : cb + col;
        const f32x4 w0 = *(const f32x4*)src, w1 = *(const f32x4*)(src + 4);
        *(LAS f32x4*)(cwS + j * 512 + cg * 8) = w0; *(LAS f32x4*)(cwS + j * 512 + cg * 8 + 4) = w1; }
}
__device__ __forceinline__ void conv_math(bf16x8 (&rows)[11], int ts, const LAS float* cwS, int cg, float (&o)[8][8]) {
    if (ts < 3) {
#pragma unroll
        for (int i = 0; i < 3; ++i) if (ts - 3 + i < 0) rows[i] = (bf16x8){0, 0, 0, 0, 0, 0, 0, 0}; }
    float w[5][8];
#pragma unroll
    for (int j = 0; j < 5; ++j) { const f32x4 w0 = *(const LAS f32x4*)(cwS + j * 512 + cg * 8), w1 = *(const LAS f32x4*)(cwS + j * 512 + cg * 8 + 4);
#pragma unroll
        for (int e = 0; e < 4; ++e) { w[j][e] = w0[e]; w[j][4 + e] = w1[e]; } }
#pragma unroll
    for (int tok = 0; tok < 8; ++tok)
#pragma unroll
        for (int k = 0; k < 8; ++k) {
            const float a = w[4][k] + w[0][k] * us2f(rows[tok][k]) + w[1][k] * us2f(rows[tok + 1][k]) + w[2][k] * us2f(rows[tok + 2][k]) + w[3][k] * us2f(rows[tok + 3][k]);
            o[tok][k] = silu_f(a); }
}
__device__ __forceinline__ void ssd_dt(float dtb, float A, float raw, LAS float* dtS, LAS float* acS, int tid) {
    if (tid < 256) { const int hh = tid >> 6, q = tid & 63;
        const float dt = softplus_f(raw + dtb);
        float v = dt * A;
#pragma unroll
        for (int o = 1; o < 64; o <<= 1) { const float t = __shfl_up(v, o); if (q >= o) v += t; }
        dtS[hh * 64 + q] = dt; acS[hh * 64 + q] = v; }
}
constexpr int S1_LDS = 2048 + (4 * 64 * 72 + 128 * 72) * 2;
__device__ __forceinline__ void stage_ssd_s1(const Params& P, int l, LAS unsigned char* lds, int first, int stride, int end) {
    const int tid = otid(), lane = tid & 63, wave = tid >> 6, quad = lane >> 4, l15 = lane & 15;
    LAS float* dtS = (LAS float*)lds; LAS float* acS = dtS + 256; LAS bf16* XT = (LAS bf16*)(lds + 2048); LAS bf16* BT = XT + 4 * 64 * 72;
    const bf16* U = (const bf16*)(P.ws + WS_U);
    const int tseg = tid & 7, cg = tid < 384 ? tid >> 3 : 0; const bool isx = cg < 32;
    const int j0 = isx ? cg * 8 : (cg - 32) * 8;
#define S1_COL(it) (isx ? C_XS + ((it) & 1) * 256 + j0 : C_B + ((it) & 1) * 128 + j0)
#define S1_RAW(it) (tid < 256 ? bf2f(U[(size_t)(((it) >> 1) * 64 + (tid & 63)) * NU + C_DT + ((it) & 1) * 4 + (tid >> 6)]) : 0.f)
    bf16x8 rows[11]; float raw = S1_RAW(first);
    conv_issue(U, (first >> 1) * 64 + tseg * 8, S1_COL(first), rows);
    LAS float* cwS = (LAS float*)(lds + S1_LDS);
    if (tid < 384) conv_weights(PBP(P, PB_CONVW) + (size_t)l * 4 * 1024, PBP(P, PB_CONVB) + l * 1024, S1_COL(first), cwS, tid);
    BAR_LDS();
    const int hq = l * 8 + (first & 1) * 4 + ((tid >> 6) & 3); const float dtb = PBP(P, PB_DTB)[hq], Aneg = -__expf(PBP(P, PB_ALOG)[hq]);
    for (int item = first; item < end; item += stride) {
    const int c = item >> 1, g = item & 1, t0 = c * 64, col = S1_COL(item);
    float o[8][8];
    conv_math(rows, t0 + tseg * 8, cwS, cg, o);
    ssd_dt(dtb, Aneg, raw, dtS, acS, tid);
    {   const int nx = item + stride < end ? item + stride : item;
        raw = S1_RAW(nx); conv_issue(U, (nx >> 1) * 64 + tseg * 8, S1_COL(nx), rows); }
    BAR_LDS();
    if (tid < 384) {
        const int hh = j0 >> 6, p0 = j0 & 63;
        float sc[8];
#pragma unroll
        for (int tok = 0; tok < 8; ++tok) { const int q = tseg * 8 + tok; sc[tok] = isx ? dtS[hh * 64 + q] * __expf(acS[hh * 64 + 63] - acS[hh * 64 + q]) : 1.f; }
        LAS bf16* dst = isx ? XT + (hh * 64 + p0) * 72 + tseg * 8 : BT + j0 * 72 + tseg * 8;
#pragma unroll
        for (int k = 0; k < 8; ++k) { float v[8];
#pragma unroll
            for (int tok = 0; tok < 8; ++tok) v[tok] = o[tok][k] * sc[tok];
            *(LAS bf16x8*)(dst + k * 72) = pack8(v); }
    }
    BAR_LDS();
    { const int hh = wave >> 1, nh = wave & 1, h = g * 4 + hh;
        bf16* ST = (bf16*)(P.ws + WS_ST) + ((size_t)(c * 8 + h) * 64) * 128;
#pragma unroll
        for (int pb = 0; pb < 4; ++pb)
#pragma unroll
            for (int nb = 0; nb < 4; ++nb) { f32x4 acc = (f32x4){0.f, 0.f, 0.f, 0.f};
#pragma unroll
                for (int ks = 0; ks < 2; ++ks) acc = MFMA16(ld_frag(BT, 72, nh * 64 + nb * 16, ks * 32, lane), ld_frag(XT + hh * 64 * 72, 72, pb * 16, ks * 32, lane), acc);
                *(u32x2*)(ST + (size_t)(pb * 16 + l15) * 128 + nh * 64 + nb * 16 + quad * 4) = pack4(acc[0], acc[1], acc[2], acc[3]); }
        if (tid < 4) ((float*)(P.ws + WS_CD))[c * 8 + g * 4 + tid] = __expf(acS[tid * 64 + 63]);
    }
    BAR_LDS();
    }
#undef S1_COL
#undef S1_RAW
}
__device__ __forceinline__ void stage_ssd_scan(const Params& P, LAS unsigned char* lds, int blk) {
    const int tid = otid(), pi = tid & 63, seg = tid >> 6;
    LAS float* cdS = (LAS float*)lds; LAS float* segL = cdS + 256; LAS float* segD = segL + 8 * 128;
    bf16* ST = (bf16*)(P.ws + WS_ST); const float* CD = (const float*)(P.ws + WS_CD);
    const int e0 = blk * 128 + pi * 2, h = (blk * 128) >> 13;
    if (tid < 256) cdS[tid] = CD[tid * 8 + h];
    unsigned v[32];
#pragma unroll
    for (int k = 0; k < 32; ++k) v[k] = *(const unsigned*)(ST + (size_t)(seg * 32 + k) * 65536 + e0);
    BAR_LDS();
    float L0 = 0.f, L1 = 0.f, Dt = 1.f;
#pragma unroll
    for (int k = 0; k < 32; ++k) { const float d = cdS[seg * 32 + k]; L0 = L0 * d + bf2f(v[k] & 0xffffu); L1 = L1 * d + bf2f(v[k] >> 16); Dt *= d; }
    segL[seg * 128 + pi * 2] = L0; segL[seg * 128 + pi * 2 + 1] = L1; if (pi == 0) segD[seg] = Dt;
    BAR_LDS();
    float c0 = 0.f, c1 = 0.f;
    for (int s2 = 0; s2 < seg; ++s2) { const float d = segD[s2]; c0 = c0 * d + segL[s2 * 128 + pi * 2]; c1 = c1 * d + segL[s2 * 128 + pi * 2 + 1]; }
#pragma unroll
    for (int k = 0; k < 32; ++k) { const float d = cdS[seg * 32 + k]; const unsigned o = f2bf(c0) | (f2bf(c1) << 16);
        c0 = c0 * d + bf2f(v[k] & 0xffffu); c1 = c1 * d + bf2f(v[k] >> 16);
        *(unsigned*)(ST + (size_t)(seg * 32 + k) * 65536 + e0) = o; }
    BAR_LDS();
}
constexpr int S3_LDS = 3072 + (2 * 64 * 136 + 4 * 64 * 72 + 8 * 32 * 72) * 2;
__device__ __forceinline__ void stage_ssd_s3(const Params& P, int l, LAS unsigned char* lds, int first, int stride, int end) {
    const int tid = otid(), lane = tid & 63, wave = tid >> 6, quad = lane >> 4, l15 = lane & 15;
    LAS float* dtS = (LAS float*)lds; LAS float* acS = dtS + 256; LAS float* red = acS + 256;
    LAS bf16* Cn = (LAS bf16*)(lds + 3072); LAS bf16* Bn = Cn + 64 * 136; LAS bf16* XT = Bn + 64 * 136; LAS bf16* SCw = XT + 4 * 64 * 72 + wave * 32 * 72;
    const bf16* U = (const bf16*)(P.ws + WS_U); bf16* Y = (bf16*)(P.ws + WS_H);
    const int hh = wave >> 1, qh = wave & 1;
    const int tseg = tid & 7, cg = tid >> 3; const int kind = cg < 32 ? 0 : (cg < 48 ? 1 : 2);
    const int j0 = kind == 0 ? cg * 8 : (kind == 1 ? (cg - 32) * 8 : (cg - 48) * 8);
#define S3_COL(it) (kind == 0 ? C_XS + ((it) & 1) * 256 + j0 : (kind == 1 ? C_B + ((it) & 1) * 128 + j0 : C_C + ((it) & 1) * 128 + j0))
#define S3_RAW(it) (tid < 256 ? bf2f(U[(size_t)(((it) >> 1) * 64 + (tid & 63)) * NU + C_DT + ((it) & 1) * 4 + (tid >> 6)]) : 0.f)
    bf16x8 rows[11]; float raw = S3_RAW(first);
    conv_issue(U, (first >> 1) * 64 + tseg * 8, S3_COL(first), rows);
    LAS float* cwS = (LAS float*)(lds + S3_LDS);
    conv_weights(PBP(P, PB_CONVW) + (size_t)l * 4 * 1024, PBP(P, PB_CONVB) + l * 1024, S3_COL(first), cwS, tid);
    LAS float* nwS = cwS + 2560; if (tid < 256) nwS[tid] = PBP(P, PB_SSMNW)[l * 512 + (first & 1) * 256 + tid];
    BAR_LDS();
    const int hq = l * 8 + (first & 1) * 4 + ((tid >> 6) & 3); const float dtb = PBP(P, PB_DTB)[hq], Aneg = -__expf(PBP(P, PB_ALOG)[hq]);
    const float dsk = PBP(P, PB_DSKIP)[l * 8 + (first & 1) * 4 + hh];
    for (int item = first; item < end; item += stride) {
    const int c = item >> 1, g = item & 1, t0 = c * 64, h = g * 4 + hh;
    u32x2 zz[2][4];
#pragma unroll
    for (int qb = 0; qb < 2; ++qb)
#pragma unroll
        for (int pb = 0; pb < 4; ++pb) zz[qb][pb] = *(const u32x2*)(U + (size_t)(t0 + qh * 32 + qb * 16 + l15) * NU + C_Z + h * 64 + pb * 16 + quad * 4);
    {   float o[8][8];
        conv_math(rows, t0 + tseg * 8, cwS, cg, o);
        ssd_dt(dtb, Aneg, raw, dtS, acS, tid);
        {   const int nx = item + stride < end ? item + stride : item;
            raw = S3_RAW(nx); conv_issue(U, (nx >> 1) * 64 + tseg * 8, S3_COL(nx), rows); }
        BAR_LDS();
        if (kind == 0) { const int hh2 = j0 >> 6, p0 = j0 & 63;
#pragma unroll
            for (int k = 0; k < 8; ++k) { float v[8];
#pragma unroll
                for (int tok = 0; tok < 8; ++tok) v[tok] = o[tok][k] * dtS[hh2 * 64 + tseg * 8 + tok];
                *(LAS bf16x8*)(XT + (hh2 * 64 + p0 + k) * 72 + tseg * 8) = pack8(v); }
        } else { LAS bf16* dst = (kind == 1 ? Bn : Cn) + (tseg * 8) * 136 + j0;
#pragma unroll
            for (int tok = 0; tok < 8; ++tok) *(LAS bf16x8*)(dst + tok * 136) = pack8(o[tok]); }
    }
    const bf16* ST = (const bf16*)(P.ws + WS_ST) + ((size_t)(c * 8 + h) * 64) * 128;
    bf16x8 pf[4][4];
#pragma unroll
    for (int pb = 0; pb < 4; ++pb)
#pragma unroll
        for (int ks = 0; ks < 4; ++ks) pf[pb][ks] = *(const bf16x8*)(ST + (size_t)(pb * 16 + l15) * 128 + ks * 32 + quad * 8);
    BAR_LDS();
#pragma unroll
    for (int qb = 0; qb < 2; ++qb)
#pragma unroll
        for (int sb = 0; sb < 4; ++sb) { f32x4 acc = (f32x4){0.f, 0.f, 0.f, 0.f};
#pragma unroll
            for (int ks = 0; ks < 4; ++ks) acc = MFMA16(ld_frag(Bn, 136, sb * 16, ks * 32, lane), ld_frag(Cn, 136, qh * 32 + qb * 16, ks * 32, lane), acc);
            const int q = qh * 32 + qb * 16 + l15; const float aq = acS[hh * 64 + q]; float v[4];
#pragma unroll
            for (int r = 0; r < 4; ++r) { const int s_ = sb * 16 + quad * 4 + r; v[r] = (s_ <= q) ? acc[r] * __expf(aq - acS[hh * 64 + s_]) : 0.f; }
            *(LAS u32x2*)(SCw + (qb * 16 + l15) * 72 + sb * 16 + quad * 4) = pack4(v[0], v[1], v[2], v[3]); }
    asm volatile("s_waitcnt lgkmcnt(0)" ::: "memory");
    f32x4 y[2][4];
    float ssq[2] = {0.f, 0.f};
#pragma unroll
    for (int qb = 0; qb < 2; ++qb)
#pragma unroll
        for (int pb = 0; pb < 4; ++pb) { f32x4 yd = (f32x4){0.f, 0.f, 0.f, 0.f}, yo = (f32x4){0.f, 0.f, 0.f, 0.f};
#pragma unroll
            for (int ks = 0; ks < 2; ++ks) yd = MFMA16(ld_frag(XT + hh * 64 * 72, 72, pb * 16, ks * 32, lane), ld_frag(SCw, 72, qb * 16, ks * 32, lane), yd);
#pragma unroll
            for (int ks = 0; ks < 4; ++ks) yo = MFMA16(pf[pb][ks], ld_frag(Cn, 136, qh * 32 + qb * 16, ks * 32, lane), yo);
            const int q = qh * 32 + qb * 16 + l15; const float eq = __expf(acS[hh * 64 + q]), idt = __builtin_amdgcn_rcpf(dtS[hh * 64 + q]);
            const u32x2 z2 = zz[qb][pb];
#pragma unroll
            for (int r = 0; r < 4; ++r) { const int p = pb * 16 + quad * 4 + r;
                const float xs = bf2f(XT[(hh * 64 + p) * 72 + q]) * idt;
                const unsigned zw = r < 2 ? z2.x : z2.y; const float z = bf2f((r & 1) ? (zw >> 16) : (zw & 0xffffu));
                const float v = (yd[r] + eq * yo[r] + dsk * xs) * silu_f(z);
                y[qb][pb][r] = v; ssq[qb] += v * v; } }
#pragma unroll
    for (int qb = 0; qb < 2; ++qb) { float s_ = ssq[qb]; s_ += __shfl_xor(s_, 16); s_ += __shfl_xor(s_, 32);
        if (quad == 0) red[hh * 64 + qh * 32 + qb * 16 + l15] = s_; }
    BAR_LDS();
#pragma unroll
    for (int qb = 0; qb < 2; ++qb) { const int q = qh * 32 + qb * 16 + l15;
        const float tot = red[q] + red[64 + q] + red[128 + q] + red[192 + q]; const float rstd = rsqrtf(tot * (1.f / 256.f) + NORM_EPS);
#pragma unroll
        for (int pb = 0; pb < 4; ++pb) { const int p = pb * 16 + quad * 4; const f32x4 nw = *(const LAS f32x4*)(nwS + hh * 64 + p);
            *(u32x2*)(Y + (size_t)(t0 + q) * D + h * 64 + p) = pack4(y[qb][pb][0] * rstd * nw[0], y[qb][pb][1] * rstd * nw[1], y[qb][pb][2] * rstd * nw[2], y[qb][pb][3] * rstd * nw[3]); } }
    BAR_LDS();
    }
#undef S3_COL
#undef S3_RAW
}

constexpr int RW_AT = 0, RW_RT = 9216, RW_KT = 18432, RW_BT = 27648, RW_VT = 36864, RW_KHT = 46080, RW_BHT = 55296, RW_X1T = 64512, RW_X2T = 73728,
              RW_MAK = 82944, RW_MRK = 92160, RW_MRB = 101376, RW_MAB = 110592, RW_TOT = 128000, RW_WC = 130048, RW_AAF = 130304, RW_END = 146688;
constexpr int RW_RHS2 = RW_KT;
constexpr int RW_LATW = RW_X1T, RW_LATA = RW_X2T, RW_W2T = RW_MAK, RW_A2T = RW_MRK, RW_AWF = RW_MAB;
constexpr int RW_MOFF = RW_AAF, RW_TB = RW_AAF + 9216, RW_RPT = RW_MAK;
__device__ __forceinline__ float tanh_f(float x) { return 1.f - 2.f * __builtin_amdgcn_rcpf(1.f + __expf(2.f * x)); }

__device__ __forceinline__ void stage_rwkv_p1(const Params& P, int l, LAS unsigned char* lds, int first, int stride, int end) {
    const int tid = otid(), lane = tid & 63, wave = __builtin_amdgcn_readfirstlane(tid >> 6), quad = lane >> 4, l15 = lane & 15;
    const int h = first & 3;
    LAS bf16* At = (LAS bf16*)(lds + RW_AT); LAS bf16* Rt = (LAS bf16*)(lds + RW_RT); LAS bf16* Kt = (LAS bf16*)(lds + RW_KT); LAS bf16* Bt = (LAS bf16*)(lds + RW_BT);
    LAS bf16* VT = (LAS bf16*)(lds + RW_VT); LAS bf16* KhT = (LAS bf16*)(lds + RW_KHT); LAS bf16* BhT = (LAS bf16*)(lds + RW_BHT);
    LAS bf16* X1T = (LAS bf16*)(lds + RW_X1T); LAS bf16* X2T = (LAS bf16*)(lds + RW_X2T);
    LAS bf16* Mak = (LAS bf16*)(lds + RW_MAK); LAS bf16* Mrk = (LAS bf16*)(lds + RW_MRK); LAS bf16* Mrb = (LAS bf16*)(lds + RW_MRB);
    LAS float* Mab = (LAS float*)(lds + RW_MAB); LAS float* RHS2 = (LAS float*)(lds + RW_RHS2);
    LAS float* tot = (LAS float*)(lds + RW_TOT); LAS float* wCs = (LAS float*)(lds + RW_WC); LAS float* aaF = (LAS float*)(lds + RW_AAF); LAS float* awF = (LAS float*)(lds + RW_AWF);
    LAS bf16* latw = (LAS bf16*)(lds + RW_LATW); LAS bf16* lata = (LAS bf16*)(lds + RW_LATA); LAS bf16* w2T = (LAS bf16*)(lds + RW_W2T); LAS bf16* a2T = (LAS bf16*)(lds + RW_A2T);
    LAS bf16* Moff = (LAS bf16*)(lds + RW_MOFF); LAS bf16* Tb = (LAS bf16*)(lds + RW_TB);
    const bf16* U = (const bf16*)(P.ws + WS_U);
    const float* mu = PBP(P, PB_MU) + (size_t)l * 1152;
    bf16x8 cr, ck, cv, pr, pk, pv, cw, ca, pw, pa;
#define P1_ISSUE_A(pi_) do { const int tg_ = ((pi_) >> 2) * 64 + (tid >> 3); const bf16* uc_ = U + (size_t)tg_ * NU + C_WL + (tid & 7) * 8; const bf16* up2_ = tg_ > 0 ? uc_ - NU : uc_; \
        cw = *(const bf16x8*)uc_; ca = *(const bf16x8*)(uc_ + 64); pw = *(const bf16x8*)up2_; pa = *(const bf16x8*)(up2_ + 64); } while (0)
#define P1_ISSUE_B(pi_) do { const int tg_ = ((pi_) >> 2) * 64 + (tid >> 3); const bf16* ucr_ = U + (size_t)tg_ * NU + h * 64 + (tid & 7) * 8; const bf16* upr_ = tg_ > 0 ? ucr_ - NU : ucr_; \
        cr = *(const bf16x8*)(ucr_ + C_R); ck = *(const bf16x8*)(ucr_ + C_K); cv = *(const bf16x8*)(ucr_ + C_V); pr = *(const bf16x8*)(upr_ + C_R); pk = *(const bf16x8*)(upr_ + C_K); pv = *(const bf16x8*)(upr_ + C_V); } while (0)
    P1_ISSUE_A(first);
    const bf16* wt = (const bf16*)(P.ws + WS_W2T) + (size_t)((l * 4 + h) * 64 + (tid >> 3)) * 64 + (tid & 7) * 8;
    const bf16x8 w2i = *(const bf16x8*)wt, a2i = *(const bf16x8*)(wt + 65536);
    for (int pi = first; pi < end; pi += stride) {
    const int tid = otid(), lane = tid & 63, quad = lane >> 4, l15 = lane & 15;
    const int c = pi >> 2, t0 = c * 64;
    P1_ISSUE_B(pi);
    f32x4 muw[2], mua[2], kc[8][2];
#pragma unroll
    for (int q4 = 0; q4 < 2; ++q4) { const int gch4 = h * 64 + (tid & 7) * 8 + q4 * 4, pc4 = l * 256 + gch4;
        muw[q4] = *(const f32x4*)(mu + 1024 + (tid & 7) * 8 + q4 * 4); mua[q4] = *(const f32x4*)(mu + 1088 + (tid & 7) * 8 + q4 * 4);
        kc[0][q4] = *(const f32x4*)(mu + gch4); kc[1][q4] = *(const f32x4*)(mu + 256 + gch4); kc[2][q4] = *(const f32x4*)(mu + 512 + gch4);
        kc[3][q4] = *(const f32x4*)(PBP(P, PB_W0) + pc4); kc[4][q4] = *(const f32x4*)(PBP(P, PB_A0) + pc4); kc[5][q4] = *(const f32x4*)(PBP(P, PB_KK) + pc4);
        kc[6][q4] = *(const f32x4*)(PBP(P, PB_KA) + pc4); kc[7][q4] = *(const f32x4*)(PBP(P, PB_RK) + pc4); }
    {   const int t = tid >> 3, jg = tid & 7, tg = t0 + t;
        if (tg == 0) { pw = (bf16x8){0, 0, 0, 0, 0, 0, 0, 0}; pa = pw; pr = pw; pk = pw; pv = pw; }
        float ow[8], oa[8];
#pragma unroll
        for (int jj = 0; jj < 8; ++jj) {
            const float c1 = us2f(cw[jj]), p1 = us2f(pw[jj]); ow[jj] = tanh_f(c1 + (p1 - c1) * muw[jj >> 2][jj & 3]);
            const float c2 = us2f(ca[jj]), p2 = us2f(pa[jj]); oa[jj] = c2 + (p2 - c2) * mua[jj >> 2][jj & 3]; }
        *(LAS bf16x8*)(latw + t * 72 + jg * 8) = pack8(ow); *(LAS bf16x8*)(lata + t * 72 + jg * 8) = pack8(oa);
        *(LAS bf16x8*)(w2T + t * 72 + jg * 8) = w2i; *(LAS bf16x8*)(a2T + t * 72 + jg * 8) = a2i;
    }
    BAR_LDS();
    {   const int tb = wave & 3; const bool isA = wave >= 4;
        const LAS bf16* Am = isA ? lata : latw; const LAS bf16* Bm = isA ? a2T : w2T; LAS float* Of = isA ? aaF : awF; const int ofs = isA ? 64 : 68;
#pragma unroll
        for (int cb = 0; cb < 4; ++cb) { f32x4 acc = (f32x4){0.f, 0.f, 0.f, 0.f};
#pragma unroll
            for (int ks = 0; ks < 2; ++ks) acc = MFMA16(ld_frag(Am, 72, tb * 16, ks * 32, lane), ld_frag(Bm, 72, cb * 16, ks * 32, lane), acc);
#pragma unroll
            for (int r = 0; r < 4; ++r) Of[(tb * 16 + quad * 4 + r) * ofs + cb * 16 + l15] = acc[r]; }
    }
    BAR_LDS();
    {   const int t = tid >> 3, cg = tid & 7, tg = t0 + t, ch0 = cg * 8, gch = h * 64 + ch0;
        float rr[8], k2[8], vv[8], kkn[8], aS[8], lw[8], Lc[8];
        float ss = 0.f, bsum = 0.f;
#pragma unroll
        for (int jj = 0; jj < 8; ++jj) {
            float a_ = us2f(cr[jj]), b_ = us2f(pr[jj]); const float r = a_ + (b_ - a_) * kc[0][jj >> 2][jj & 3];
            a_ = us2f(ck[jj]); b_ = us2f(pk[jj]); const float k = a_ + (b_ - a_) * kc[1][jj >> 2][jj & 3];
            a_ = us2f(cv[jj]); b_ = us2f(pv[jj]); const float v = a_ + (b_ - a_) * kc[2][jj >> 2][jj & 3];
            const float aw = awF[t * 68 + ch0 + jj] + kc[3][jj >> 2][jj & 3], aa = aaF[t * 64 + ch0 + jj] + kc[4][jj >> 2][jj & 3];
            lw[jj] = -0.60653066f * sigmoid_f(aw); const float a = sigmoid_f(aa);
            const float kr = k * kc[5][jj >> 2][jj & 3]; ss += kr * kr; kkn[jj] = kr;
            k2[jj] = k * (1.f + (a - 1.f) * kc[6][jj >> 2][jj & 3]); aS[jj] = a; rr[jj] = r; vv[jj] = v;
            bsum += r * k2[jj] * kc[7][jj >> 2][jj & 3]; Lc[jj] = lw[jj]; }
        { const int nx = pi + stride < end ? pi + stride : pi; P1_ISSUE_A(nx); }
#pragma unroll
        for (int o = 1; o < 8; o <<= 1) { ss += __shfl_xor(ss, o); bsum += __shfl_xor(bsum, o); }
        const float inv = 1.f / fmaxf(sqrtf(ss), 1e-12f);
        if (cg == 0) ((float*)(P.ws + WS_BS))[(size_t)tg * 4 + h] = bsum;
#pragma unroll
        for (int o = 8; o < 64; o <<= 1)
#pragma unroll
            for (int jj = 0; jj < 8; ++jj) { const float tmp = __shfl_up(Lc[jj], o); if (lane >= o) Lc[jj] += tmp; }
        if ((lane >> 3) == 7) {
#pragma unroll
            for (int jj = 0; jj < 8; ++jj) tot[wave * 64 + ch0 + jj] = Lc[jj]; }
        BAR_LDS();
        float oA[8], oR[8], oK[8], oB[8];
#pragma unroll
        for (int jj = 0; jj < 8; ++jj) { float base = 0.f, LC = 0.f;
#pragma unroll
            for (int w2 = 0; w2 < 8; ++w2) { const float tv = tot[w2 * 64 + ch0 + jj]; base += w2 < wave ? tv : 0.f; LC += tv; }
            const float L = Lc[jj] + base; const float kk = kkn[jj] * inv, b = kk * aS[jj];
            const float eL = __expf(L), eiL = __expf(-L), eh = __expf(LC - L);
            oA[jj] = -kk * __expf(L - lw[jj]); oR[jj] = rr[jj] * eL; oK[jj] = k2[jj] * eiL; oB[jj] = b * eiL;
            VT[(ch0 + jj) * 72 + t] = (bf16)f2bf(vv[jj]); KhT[(ch0 + jj) * 72 + t] = (bf16)f2bf(k2[jj] * eh); BhT[(ch0 + jj) * 72 + t] = (bf16)f2bf(b * eh);
            if (t == 63) wCs[ch0 + jj] = __expf(LC); }
        *(LAS bf16x8*)(At + t * 72 + ch0) = pack8(oA); *(LAS bf16x8*)(Rt + t * 72 + ch0) = pack8(oR); *(LAS bf16x8*)(Kt + t * 72 + ch0) = pack8(oK); *(LAS bf16x8*)(Bt + t * 72 + ch0) = pack8(oB);
    }
    BAR_LDS();
    {   const int mat = wave >> 1, half = wave & 1;
        const LAS bf16* Am = mat < 2 ? At : Rt; const LAS bf16* Bm = (mat == 0 || mat == 3) ? Bt : Kt;
        LAS bf16* Ob = mat == 1 ? Mak : (mat == 2 ? Mrk : Mrb);
#pragma unroll
        for (int tbi = 0; tbi < 2; ++tbi)
#pragma unroll
            for (int sb = 0; sb < 4; ++sb) { const int tb = half * 2 + tbi; f32x4 acc = (f32x4){0.f, 0.f, 0.f, 0.f};
                if (sb <= tb) {
#pragma unroll
                    for (int ks = 0; ks < 2; ++ks) acc = MFMA16(ld_frag(Am, 72, tb * 16, ks * 32, lane), ld_frag(Bm, 72, sb * 16, ks * 32, lane), acc); }
#pragma unroll
                for (int r = 0; r < 4; ++r) { const int t = tb * 16 + quad * 4 + r, s_ = sb * 16 + l15;
                    const bool keep = mat < 2 ? (s_ < t) : (s_ <= t); const float val = keep ? acc[r] : 0.f;
                    if (mat == 0) { Mab[t * 68 + s_] = val; Moff[t * 72 + s_] = (bf16)(sb < tb ? f2bf(val) : 0u); } else Ob[t * 72 + s_] = (bf16)f2bf(val); } }
    }
    BAR_LDS();
    if (wave == 0) {
        for (int e = lane; e < 320; e += 64) *(LAS u32x4v*)(Tb + e * 8) = (u32x4v){0u, 0u, 0u, 0u};
        const int b = quad, cc = l15;
        unsigned ma = (unsigned)(uintptr_t)(Mab + (16 * b) * 68 + 16 * b); asm volatile("" : "+v"(ma)); const LAS float* Mv = (const LAS float*)(uintptr_t)ma;
        float x[16];
#pragma unroll
        for (int t = 0; t < 16; ++t) { float a = t == cc ? 1.f : 0.f;
#pragma unroll
            for (int s_ = 0; s_ < t; ++s_) a += Mv[t * 68 + s_] * x[s_];
            asm volatile("" : "+v"(a) :: "memory");
            x[t] = a; }
#pragma unroll
        for (int t = 0; t < 16; ++t) Tb[(b * 16 + t) * 40 + cc] = (bf16)f2bf(x[t]);
    } else {
        for (int tile = wave - 1; tile < 16; tile += 7) { const int tb = tile >> 2, ib = tile & 3; f32x4 acc = (f32x4){0.f, 0.f, 0.f, 0.f};
#pragma unroll
            for (int ks = 0; ks < 2; ++ks) acc = MFMA16(ld_frag(Mak, 72, tb * 16, ks * 32, lane), ld_frag(VT, 72, ib * 16, ks * 32, lane), acc);
#pragma unroll
            for (int r = 0; r < 4; ++r) RHS2[(tb * 16 + quad * 4 + r) * 68 + ib * 16 + l15] = acc[r]; }
    }
    BAR_LDS();
    {   LAS bf16* XTw = (wave < 4 ? X1T : X2T) + (wave & 3) * 16 * 72; LAS bf16* Rp = (LAS bf16*)(lds + RW_RPT) + wave * 512;
        for (int e = lane; e < 144; e += 64) *(LAS u32x4v*)(XTw + e * 8) = (u32x4v){0u, 0u, 0u, 0u};
        *(LAS u32x4v*)(Rp + lane * 8) = (u32x4v){0u, 0u, 0u, 0u};
#pragma unroll
        for (int b = 0; b < 4; ++b) {
            f32x4 acc;
#pragma unroll
            for (int r = 0; r < 4; ++r) { const int t = 16 * b + quad * 4 + r; acc[r] = wave < 4 ? bf2f(At[t * 72 + wave * 16 + l15]) : RHS2[t * 68 + (wave - 4) * 16 + l15]; }
            asm volatile("s_waitcnt lgkmcnt(0)" ::: "memory");
            if (b >= 1) acc = MFMA16(ld_frag(Moff, 72, 16 * b, 0, lane), ld_frag(XTw, 72, 0, 0, lane), acc);
            if (b == 3) acc = MFMA16(ld_frag(Moff, 72, 48, 32, lane), ld_frag(XTw, 72, 0, 32, lane), acc);
            *(LAS u32x2*)(Rp + l15 * 32 + quad * 4) = pack4(acc[0], acc[1], acc[2], acc[3]);
            asm volatile("s_waitcnt lgkmcnt(0)" ::: "memory");
            const f32x4 xb = MFMA16(ld_frag(Tb + b * 640, 40, 0, 0, lane), ld_frag(Rp, 32, 0, 0, lane), ((f32x4){0.f, 0.f, 0.f, 0.f}));
            *(LAS u32x2*)(XTw + l15 * 72 + 16 * b + quad * 4) = pack4(xb[0], xb[1], xb[2], xb[3]);
            asm volatile("s_waitcnt lgkmcnt(0)" ::: "memory");
        }
    }
    BAR_LDS();
    {   const int mat = wave >> 1, half = wave & 1;
        bf16* Q1g = (bf16*)(P.ws + WS_Q1) + (size_t)pi * 4096; bf16* Y0g = (bf16*)(P.ws + WS_Y0) + (size_t)pi * 4096;
        bf16* PcTg = (bf16*)(P.ws + WS_PCT) + (size_t)pi * 4096; bf16* Gcg = (bf16*)(P.ws + WS_GC) + (size_t)pi * 4096;
        const LAS bf16* A1 = (mat == 0 || mat == 2) ? X1T : (mat == 1 ? VT : KhT);
        const LAS bf16* B1 = mat == 0 ? Mrb : (mat == 1 ? Mrk : (mat == 2 ? BhT : VT));
        const LAS bf16* A2 = mat == 1 ? X2T : BhT; const LAS bf16* B2 = mat == 1 ? Mrb : X2T;
#pragma unroll
        for (int rbi = 0; rbi < 2; ++rbi)
#pragma unroll
            for (int cb = 0; cb < 4; ++cb) { const int rb = half * 2 + rbi; f32x4 acc = (f32x4){0.f, 0.f, 0.f, 0.f};
#pragma unroll
                for (int ks = 0; ks < 2; ++ks) acc = MFMA16(ld_frag(A1, 72, rb * 16, ks * 32, lane), ld_frag(B1, 72, cb * 16, ks * 32, lane), acc);
                if (mat == 1 || mat == 3) {
#pragma unroll
                    for (int ks = 0; ks < 2; ++ks) acc = MFMA16(ld_frag(A2, 72, rb * 16, ks * 32, lane), ld_frag(B2, 72, cb * 16, ks * 32, lane), acc); }
                const int r0 = rb * 16 + quad * 4, cl = cb * 16 + l15;
                if (mat == 0) { const u32x2 rt = *(const LAS u32x2*)(Rt + cl * 72 + r0);
                    *(u32x2*)(Q1g + cl * 64 + r0) = pack4(acc[0] + bf2f(rt.x & 0xffffu), acc[1] + bf2f(rt.x >> 16), acc[2] + bf2f(rt.y & 0xffffu), acc[3] + bf2f(rt.y >> 16)); }
                else if (mat == 1) *(u32x2*)(Y0g + cl * 64 + r0) = pack4(acc[0], acc[1], acc[2], acc[3]);
                else if (mat == 2) { const float wc = wCs[cl];
                    *(u32x2*)(PcTg + cl * 64 + r0) = pack4(acc[0] + (r0 == cl ? wc : 0.f), acc[1] + (r0 + 1 == cl ? wc : 0.f), acc[2] + (r0 + 2 == cl ? wc : 0.f), acc[3] + (r0 + 3 == cl ? wc : 0.f)); }
                else *(u32x2*)(Gcg + ((cb * 64 + lane) * 4 + rb) * 4) = pack4(acc[0], acc[1], acc[2], acc[3]); }
    }
    BAR_LDS();
    }
#undef P1_ISSUE_A
#undef P1_ISSUE_B
}

constexpr int CH_PT = 0, CH_SB = 8 * 9216, CH_END = CH_SB + 8 * 2304;
__device__ __forceinline__ void chain_step(f32x4 (&acc)[4], const LAS bf16* PTs, LAS bf16* Sb, const u32x4v (&gf)[2], bool withG, int lane) {
    const int quad = lane >> 4, l15 = lane & 15;
#pragma unroll
    for (int jb = 0; jb < 4; ++jb) *(LAS u32x2*)(Sb + l15 * 72 + jb * 16 + quad * 4) = pack4(acc[jb][0], acc[jb][1], acc[jb][2], acc[jb][3]);
    asm volatile("s_waitcnt lgkmcnt(0)" ::: "memory");
    const bf16x8 b0 = ld_frag(Sb, 72, 0, 0, lane), b1 = ld_frag(Sb, 72, 0, 32, lane);
#pragma unroll
    for (int jb = 0; jb < 4; ++jb) { f32x4 n = (f32x4){0.f, 0.f, 0.f, 0.f};
        if (withG) { const unsigned g0 = gf[jb >> 1][(jb & 1) * 2], g1 = gf[jb >> 1][(jb & 1) * 2 + 1]; n = (f32x4){bf2f(g0 & 0xffffu), bf2f(g0 >> 16), bf2f(g1 & 0xffffu), bf2f(g1 >> 16)}; }
        n = MFMA16(ld_frag(PTs, 72, jb * 16, 0, lane), b0, n); n = MFMA16(ld_frag(PTs, 72, jb * 16, 32, lane), b1, n);
        acc[jb] = n; }
    asm volatile("s_waitcnt lgkmcnt(0)" ::: "memory");
}

__device__ __forceinline__ void stage_rwkv_compose(const Params& P, LAS unsigned char* lds, int task) {
    const int tid = otid(), lane = tid & 63, wave = __builtin_amdgcn_readfirstlane(tid >> 6), quad = lane >> 4, l15 = lane & 15;
    const int gI = task >> 2, h = task & 3, kind = wave >> 2, rb = wave & 3;
    LAS bf16* PTs = (LAS bf16*)(lds + CH_PT); LAS bf16* Sb = (LAS bf16*)(lds + CH_SB) + wave * 16 * 72;
    f32x4 acc[4];
#pragma unroll
    for (int jb = 0; jb < 4; ++jb)
#pragma unroll
        for (int r = 0; r < 4; ++r) acc[jb][r] = (kind == 0 && (jb * 16 + quad * 4 + r) == (rb * 16 + l15)) ? 1.f : 0.f;
    for (int bt = 0; bt < 2; ++bt) {
        const size_t pi0 = (size_t)((gI * 16 + bt * 8) * 4 + h);
        u32x4v pt[8], gf[8][2];
#pragma unroll
        for (int s_ = 0; s_ < 8; ++s_) { pt[s_] = *(const u32x4v*)((const bf16*)(P.ws + WS_PCT) + (pi0 + 4 * s_) * 4096 + tid * 8);
            gf[s_][0] = (u32x4v){0u, 0u, 0u, 0u}; gf[s_][1] = gf[s_][0];
            if (kind == 1) { const bf16* gp = (const bf16*)(P.ws + WS_GC) + (pi0 + 4 * s_) * 4096 + (rb * 64 + lane) * 16; gf[s_][0] = *(const u32x4v*)gp; gf[s_][1] = *(const u32x4v*)(gp + 8); } }
        BAR_LDS();
#pragma unroll
        for (int s_ = 0; s_ < 8; ++s_) *(LAS u32x4v*)(PTs + s_ * 4608 + (tid >> 3) * 72 + (tid & 7) * 8) = pt[s_];
        BAR_LDS();
#pragma unroll
        for (int s_ = 0; s_ < 8; ++s_) chain_step(acc, PTs + s_ * 4608, Sb, gf[s_], kind == 1, lane);
    }
    if (kind == 0) { bf16* PgTg = (bf16*)(P.ws + WS_PGT) + (size_t)task * 4096;
#pragma unroll
        for (int jb = 0; jb < 4; ++jb)
#pragma unroll
            for (int r = 0; r < 4; ++r) PgTg[(jb * 16 + quad * 4 + r) * 64 + rb * 16 + l15] = (bf16)f2bf(acc[jb][r]);
    } else { bf16* Ggg = (bf16*)(P.ws + WS_GG) + (size_t)task * 4096;
#pragma unroll
        for (int jb = 0; jb < 4; ++jb) *(u32x2*)(Ggg + ((rb * 64 + lane) * 4 + jb) * 4) = pack4(acc[jb][0], acc[jb][1], acc[jb][2], acc[jb][3]); }
    BAR_LDS();
}

__device__ __forceinline__ void stage_rwkv_chain(const Params& P, LAS unsigned char* lds, int task) {
    const int tid = otid(), lane = tid & 63, wave = __builtin_amdgcn_readfirstlane(tid >> 6);
    const int gI = task >> 2, h = task & 3, rb = wave & 3, nsteps = gI + 16;
    LAS bf16* PTs = (LAS bf16*)(lds + CH_PT); LAS bf16* Sb = (LAS bf16*)(lds + CH_SB) + wave * 16 * 72;
    f32x4 acc[4];
#pragma unroll
    for (int jb = 0; jb < 4; ++jb) acc[jb] = (f32x4){0.f, 0.f, 0.f, 0.f};
    for (int s0 = 0; s0 < nsteps; s0 += 8) {
        u32x4v pt[8], gf[8][2];
#pragma unroll
        for (int s_ = 0; s_ < 8; ++s_) { const int sg = s0 + s_;
            pt[s_] = (u32x4v){0u, 0u, 0u, 0u}; gf[s_][0] = pt[s_]; gf[s_][1] = pt[s_];
            if (sg < nsteps) {
                const bool grp = sg < gI; const size_t idx = grp ? (size_t)(sg * 4 + h) : (size_t)((gI * 16 + sg - gI) * 4 + h);
                const bf16* ptp = (const bf16*)(P.ws + (grp ? WS_PGT : WS_PCT)) + idx * 4096; const bf16* gp = (const bf16*)(P.ws + (grp ? WS_GG : WS_GC)) + idx * 4096 + (rb * 64 + lane) * 16;
                pt[s_] = *(const u32x4v*)(ptp + tid * 8);
                if (wave < 4) { gf[s_][0] = *(const u32x4v*)gp; gf[s_][1] = *(const u32x4v*)(gp + 8); } } }
        BAR_LDS();
#pragma unroll
        for (int s_ = 0; s_ < 8; ++s_) *(LAS u32x4v*)(PTs + s_ * 4608 + (tid >> 3) * 72 + (tid & 7) * 8) = pt[s_];
        BAR_LDS();
        if (wave < 4) {
#pragma unroll
            for (int s_ = 0; s_ < 8; ++s_) { const int sg = s0 + s_;
                if (sg < nsteps) {
                    if (sg >= gI) {
                        const int quad = lane >> 4, l15 = lane & 15;
#pragma unroll
                        for (int jb = 0; jb < 4; ++jb) *(LAS u32x2*)(Sb + l15 * 72 + jb * 16 + quad * 4) = pack4(acc[jb][0], acc[jb][1], acc[jb][2], acc[jb][3]);
                        asm volatile("s_waitcnt lgkmcnt(0)" ::: "memory");
                        bf16* S0g = (bf16*)(P.ws + WS_S0) + (size_t)((gI * 16 + sg - gI) * 4 + h) * 4096 + (rb * 16 + (lane >> 2)) * 64 + (lane & 3) * 16;
                        const LAS bf16* sp = Sb + (lane >> 2) * 72 + (lane & 3) * 16;
                        *(u32x4v*)S0g = *(const LAS u32x4v*)sp; *(u32x4v*)(S0g + 8) = *(const LAS u32x4v*)(sp + 8);
                        asm volatile("s_waitcnt lgkmcnt(0)" ::: "memory"); }
                    chain_step(acc, PTs + s_ * 4608, Sb, gf[s_], true, lane); } }
        }
    }
    BAR_LDS();
}

__device__ __forceinline__ void stage_rwkv_y(const Params& P, int l, int wt, int lane) {
    const int pi = wt >> 2, tb = wt & 3, c = pi >> 2, h = pi & 3, quad = lane >> 4, l15 = lane & 15;
    const bf16* S0g = (const bf16*)(P.ws + WS_S0) + (size_t)pi * 4096; const bf16* Q1g = (const bf16*)(P.ws + WS_Q1) + (size_t)pi * 4096; const bf16* Y0g = (const bf16*)(P.ws + WS_Y0) + (size_t)pi * 4096;
    const bf16* U = (const bf16*)(P.ws + WS_U); bf16* Y = (bf16*)(P.ws + WS_H);
    const int tl = tb * 16 + l15, tg = c * 64 + tl;
    const bf16* qp = Q1g + tl * 64 + quad * 8;
    const bf16x8 q0 = *(const bf16x8*)qp, q1 = *(const bf16x8*)(qp + 32);
    f32x4 y[4];
    u32x2 vc[4], vp[4], gc[4], gp[4];
    const bf16* uc = U + (size_t)tg * NU + h * 64 + quad * 4;
#pragma unroll
    for (int ib = 0; ib < 4; ++ib) {
        const u32x2 y0 = *(const u32x2*)(Y0g + tl * 64 + ib * 16 + quad * 4);
        y[ib] = (f32x4){bf2f(y0.x & 0xffffu), bf2f(y0.x >> 16), bf2f(y0.y & 0xffffu), bf2f(y0.y >> 16)};
        vc[ib] = *(const u32x2*)(uc + C_V + ib * 16); gc[ib] = *(const u32x2*)(uc + C_G + ib * 16);
        const bf16* up_ = tg > 0 ? uc - NU : uc;
        vp[ib] = *(const u32x2*)(up_ + C_V + ib * 16); gp[ib] = *(const u32x2*)(up_ + C_G + ib * 16);
        if (tg == 0) { vp[ib] = (u32x2){0u, 0u}; gp[ib] = (u32x2){0u, 0u}; } }
    const float bs = ((const float*)(P.ws + WS_BS))[(size_t)tg * 4 + h];
    const float* mu = PBP(P, PB_MU) + (size_t)l * 1152;
    f32x4 muv[4], mug[4], lnw[4], lnb[4];
#pragma unroll
    for (int ib = 0; ib < 4; ++ib) { const int chn = h * 64 + ib * 16 + quad * 4;
        muv[ib] = *(const f32x4*)(mu + 512 + chn); mug[ib] = *(const f32x4*)(mu + 768 + chn); lnw[ib] = *(const f32x4*)(PBP(P, PB_LNW) + l * 256 + chn); lnb[ib] = *(const f32x4*)(PBP(P, PB_LNB) + l * 256 + chn); }
#pragma unroll
    for (int ib = 0; ib < 4; ++ib) { const bf16* sp = S0g + (ib * 16 + l15) * 64 + quad * 8;
        y[ib] = MFMA16(*(const bf16x8*)sp, q0, y[ib]); y[ib] = MFMA16(*(const bf16x8*)(sp + 32), q1, y[ib]); }
    float s = 0.f;
#pragma unroll
    for (int ib = 0; ib < 4; ++ib) s += (y[ib][0] + y[ib][1]) + (y[ib][2] + y[ib][3]);
    s += __shfl_xor(s, 16); s += __shfl_xor(s, 32);
    const float mean = s * (1.f / 64.f);
    float q = 0.f;
#pragma unroll
    for (int ib = 0; ib < 4; ++ib)
#pragma unroll
        for (int r = 0; r < 4; ++r) { const float d = y[ib][r] - mean; q += d * d; }
    q += __shfl_xor(q, 16); q += __shfl_xor(q, 32);
    const float rstd = rsqrtf(q * (1.f / 64.f) + LNX_EPS);
#pragma unroll
    for (int ib = 0; ib < 4; ++ib) { const int chn = h * 64 + ib * 16 + quad * 4;
        float o[4];
#pragma unroll
        for (int r = 0; r < 4; ++r) {
            const unsigned wv = r < 2 ? vc[ib].x : vc[ib].y, wvp = r < 2 ? vp[ib].x : vp[ib].y, wg = r < 2 ? gc[ib].x : gc[ib].y, wgp = r < 2 ? gp[ib].x : gp[ib].y;
            const float cv = bf2f((r & 1) ? (wv >> 16) : (wv & 0xffffu)), pv = bf2f((r & 1) ? (wvp >> 16) : (wvp & 0xffffu));
            const float cg = bf2f((r & 1) ? (wg >> 16) : (wg & 0xffffu)), pg = bf2f((r & 1) ? (wgp >> 16) : (wgp & 0xffffu));
            const float v = cv + (pv - cv) * muv[ib][r], g = cg + (pg - cg) * mug[ib][r];
            const float yn = (y[ib][r] - mean) * rstd * lnw[ib][r] + lnb[ib][r];
            o[r] = (yn + bs * v) * silu_f(g); }
        *(u32x2*)(Y + (size_t)tg * D + 512 + chn) = pack4(o[0], o[1], o[2], o[3]); }
}

constexpr int SK_KS = 128, SK_LD = 136, SK_BUF = NSK * SK_LD;
constexpr int SK_LDS = 2 * SK_BUF * 2;
__device__ __forceinline__ void stage_skinny(const Params& P, int l, LAS unsigned char* lds, int blk) {
    const int tid = otid(), lane = tid & 63, wave = tid >> 6, quad = lane >> 4, l15 = lane & 15;
    LAS bf16* Bs = (LAS bf16*)lds;
    const bf16* H = (const bf16*)(P.ws + WS_H) + (size_t)(blk * 64 + (wave & 3) * 16 + l15) * D + quad * 8;
    const bf16* W = (const bf16*)(P.ws + WS_WIN) + ((size_t)l * NU + NMAIN) * D;
    const int ct0 = (wave >> 2) * 5, nct = (wave >> 2) ? 4 : 5;
    f32x4 acc[5];
#pragma unroll
    for (int i = 0; i < 5; ++i) acc[i] = (f32x4){0.f, 0.f, 0.f, 0.f};
    u32x4v bp[5]; bf16x8 af[4];
#define SK_LOAD(s_) do { _Pragma("unroll") for (int i = 0; i < 5; ++i) { const int e = tid + i * 512; const int e2 = e < 2304 ? e : 2303; bp[i] = *(const u32x4v*)(W + (size_t)(e2 >> 4) * D + (s_) * SK_KS + (e2 & 15) * 8); } \
        _Pragma("unroll") for (int ks = 0; ks < 4; ++ks) af[ks] = *(const bf16x8*)(H + (s_) * SK_KS + ks * 32); } while (0)
#define SK_STORE(b_) do { _Pragma("unroll") for (int i = 0; i < 5; ++i) { const int e = tid + i * 512; if (e < 2304) *(LAS u32x4v*)(Bs + (b_) * SK_BUF + (e >> 4) * SK_LD + (e & 15) * 8) = bp[i]; } } while (0)
    SK_LOAD(0);
    SK_STORE(0);
    bf16x8 ac[4];
#pragma unroll
    for (int ks = 0; ks < 4; ++ks) ac[ks] = af[ks];
    BAR_LDS();
    for (int s_ = 0; s_ < 8; ++s_) {
        const int sn = s_ + 1 < 8 ? s_ + 1 : 7;
        SK_LOAD(sn);
        const LAS bf16* Bb = Bs + (s_ & 1) * SK_BUF;
#pragma unroll
        for (int i = 0; i < 5; ++i) if (i < nct) {
#pragma unroll
            for (int ks = 0; ks < 4; ++ks) acc[i] = MFMA16(ld_frag(Bb, SK_LD, (ct0 + i) * 16, ks * 32, lane), ac[ks], acc[i]); }
        BAR_LDS();
        SK_STORE((s_ + 1) & 1);
#pragma unroll
        for (int ks = 0; ks < 4; ++ks) ac[ks] = af[ks];
        BAR_LDS();
    }
    bf16* Uo = (bf16*)(P.ws + WS_U) + (size_t)(blk * 64 + (wave & 3) * 16 + l15) * NU + NMAIN + quad * 4;
#pragma unroll
    for (int i = 0; i < 5; ++i) if (i < nct) *(u32x2*)(Uo + (ct0 + i) * 16) = pack4(acc[i][0], acc[i][1], acc[i][2], acc[i][3]);
#undef SK_LOAD
#undef SK_STORE
}

constexpr int NT = 512;
constexpr int DUP_SUB = -1;
constexpr int REP_XA = 1, REP_S1 = 1, REP_P1 = 1, REP_OUT = 1, REP_SS3 = 1, REP_CMP = 1, REP_Y = 1;
constexpr int LDS_BYTES = 147456, MISC_OFF = LDS_BYTES - 256;
constexpr int CW_BAR = 4096;
static_assert(XA_LDS <= MISC_OFF && S3_LDS + 11264 <= MISC_OFF && S1_LDS + 10240 <= MISC_OFF && RW_END <= MISC_OFF && CH_END <= MISC_OFF && SK_LDS <= MISC_OFF && pg8::STAGE_BYTES <= MISC_OFF, "LDS map");

__global__ void __launch_bounds__(NT, 2) mega_fwd(Params P) {
    extern __shared__ __attribute__((aligned(16))) unsigned char lds_raw[];
    LAS unsigned char* lds_base = (LAS unsigned char*)lds_raw;
    volatile LAS unsigned* MISC = (volatile LAS unsigned*)(lds_base + MISC_OFF);
    const int tid = otid(), wave = __builtin_amdgcn_readfirstlane(tid >> 6), G = gridDim.x, bx = blockIdx.x;
    if (tid < 64) MISC[tid] = 0u;
    __syncthreads();
    XcdBarrier bar = xcd_barrier_post((unsigned*)(P.ws + WS_CTL) + CW_BAR, MISC + 8);
    {
        LAS unsigned char* lds = lds_base; const int gw = bx * 8 + wave, NGW = G * 8;
        stage_blob(P, bx * NT + tid, G * NT);
        for (int it = bx; it < N_PREP_ITEMS; it += G) stage_prep_weights(P, lds, it);
        for (int m = bx; m < MEM_LEN; m += G) stage_memkv(P, lds, m);
        for (int m = gw; m < M; m += NGW) prenorm_row(P.x + (size_t)m * D, P.pre_norm_w, (bf16*)(P.ws + WS_H) + (size_t)m * D, tid & 63);
        xcd_barrier(bar);
    }
    constexpr int PER = 7 + (DUP_SUB >= 0 ? 1 : 0), NPH = 1 + DEPTH * PER;
#pragma unroll 1
    for (int ph = 1; ph < NPH; ++ph) {
        Params Q;
        {   uintptr_t w_ = (uintptr_t)P.ws, o_ = (uintptr_t)P.out, x_ = (uintptr_t)P.x;
            asm volatile("" : "+s"(w_), "+s"(o_), "+s"(x_));
            Q.ws = (unsigned char*)(GAS unsigned char*)w_; Q.out = (float*)(GAS float*)o_; Q.x = (const float*)(GAS const float*)x_; }
        unsigned lds_a = (unsigned)(uintptr_t)lds_base; asm volatile("" : "+s"(lds_a)); LAS unsigned char* lds = (LAS unsigned char*)(uintptr_t)lds_a;
        int bx = blockIdx.x, G = gridDim.x; asm volatile("" : "+s"(bx), "+s"(G));
        const int tid = otid(), wave = __builtin_amdgcn_readfirstlane(tid >> 6), gw = bx * 8 + wave, NGW = G * 8;
        const int l = (ph - 1) / PER, s_ = (ph - 1) % PER, sub = (DUP_SUB >= 0 && s_ > DUP_SUB) ? s_ - 1 : s_;
        if (sub == 0) {
            pg8::Gemm g{(const bf16*)(Q.ws + WS_H), (const bf16*)(Q.ws + WS_WIN) + (size_t)l * NU * D, M, NMAIN, D};
            pg8::StaticOrder S; S.init(M, NMAIN, G, bx);
            pg8::EpiBf16 E{(bf16*)(Q.ws + WS_U), NU};
            pg8::gemm_phase<pg8::EpiBf16, pg8::StaticOrder, true, true>(lds, g, S, E);
            for (int it = bx; it < M / 64; it += G) stage_skinny(Q, l, lds, it);
        } else if (sub == 1) {
            for (int r_ = 0; r_ < REP_XA; ++r_) for (int it = bx; it < (M / 256) * 4; it += G) stage_xattn(Q, lds, it);
            for (int r_ = 0; r_ < REP_S1; ++r_) stage_ssd_s1(Q, l, lds, bx, G, NCHUNK * 2);
            for (int r_ = 0; r_ < REP_P1; ++r_) stage_rwkv_p1(Q, l, lds, bx, G, NCHUNK * 4);
        } else if (sub == 2) {
            if (bx < 64) for (int r_ = 0; r_ < REP_CMP; ++r_) stage_rwkv_compose(Q, lds, bx);
            else for (int it = bx - 64; it < 512; it += G - 64) stage_ssd_scan(Q, lds, it);
        } else if (sub == 3) {
            if (bx < 64) for (int r_ = 0; r_ < REP_OUT; ++r_) stage_rwkv_chain(Q, lds, bx);
            else for (int r_ = 0; r_ < REP_SS3; ++r_) stage_ssd_s3(Q, l, lds, bx - 64, G - 64, NCHUNK * 2);
        } else if (sub == 4) {
            for (int r_ = 0; r_ < REP_Y; ++r_) for (int wt = gw; wt < NCHUNK * 4 * 4; wt += NGW) stage_rwkv_y(Q, l, wt, tid & 63);
        } else if (sub == 5) {
            pg8::Gemm g{(const bf16*)(Q.ws + WS_H), (const bf16*)(Q.ws + WS_WOUT) + (size_t)l * D * D, M, D, D};
            pg8::StaticOrder S; S.init(M, D, G, bx);
            pg8::EpiBf16 E{(bf16*)(Q.ws + WS_U), D};
            pg8::gemm_phase<pg8::EpiBf16, pg8::StaticOrder, true, true>(lds, g, S, E);
        } else {
            const float* xin = l == 0 ? Q.x : Q.out;
            for (int m = gw; m < M; m += NGW)
                post_row((const bf16*)(Q.ws + WS_U) + (size_t)m * D, xin + (size_t)m * D, PBP(Q, PB_POSTNW) + l * D, Q.out + (size_t)m * D,
                         l + 1 < DEPTH ? PBP(Q, PB_PRENW) + (l + 1) * D : nullptr, l + 1 < DEPTH ? (bf16*)(Q.ws + WS_H) + (size_t)m * D : nullptr, tid & 63);
        }
        if (ph + 1 < NPH) { XcdBarrier b2 = bar; asm volatile("" : "+s"(b2.x), "+s"(b2.bar)); xcd_barrier(b2); }
    }
}

extern "C" void kernel_launch(void* const* d_in, const int* in_sizes, int n_in, void* d_out, int out_size, void* d_ws, size_t ws_size, hipStream_t stream) {
    static int grid = 0;
    if (grid == 0) {
        if (n_in != 24 || in_sizes[0] != M * D || out_size != M * D || ws_size < WS_END) { fprintf(stderr, "kernel_launch: unexpected shapes n_in %d in0 %d out %d ws %zu\n", n_in, n_in > 0 ? in_sizes[0] : -1, out_size, ws_size); grid = -1; return; }
        int dev = 0, cus = 0, per_cu = 0;
        if (hipGetDevice(&dev) != hipSuccess || hipDeviceGetAttribute(&cus, hipDeviceAttributeMultiprocessorCount, dev) != hipSuccess) { grid = -1; return; }
        if (hipFuncSetAttribute((const void*)mega_fwd, hipFuncAttributeMaxDynamicSharedMemorySize, LDS_BYTES) != hipSuccess) { fprintf(stderr, "kernel_launch: hipFuncSetAttribute failed\n"); grid = -1; return; }
        if (hipOccupancyMaxActiveBlocksPerMultiprocessor(&per_cu, (const void*)mega_fwd, NT, LDS_BYTES) != hipSuccess || per_cu < 1) fprintf(stderr, "kernel_launch: occupancy query says %d\n", per_cu);
        (void)hipGetLastError();
        grid = cus;
    }
    if (grid < 0) return;
    if (hipMemsetAsync((char*)d_ws + WS_CTL, 0, 1 * MiB, stream) != hipSuccess) return;
    Params P{};
    const float** pp = (const float**)&P;
    for (int i = 0; i < 24; ++i) pp[i] = (const float*)d_in[i];
    P.out = (float*)d_out; P.ws = (unsigned char*)d_ws;
    hipLaunchKernelGGL(mega_fwd, dim3(grid), dim3(NT), LDS_BYTES, stream, P);
}
```

```cpp
#include <hip/hip_runtime.h>
#include <cstdio>
#include <cstdint>

__device__ __forceinline__ int otid() { int t = threadIdx.x; asm volatile("" : "+v"(t)); return t; }
namespace pg8 {
#define PG8_LAS __attribute__((address_space(3)))
typedef unsigned short bf16_t;
typedef short bf16x8 __attribute__((ext_vector_type(8)));
typedef float f32x4 __attribute__((ext_vector_type(4)));
typedef unsigned u32x4 __attribute__((ext_vector_type(4)));
constexpr int BM = 256, BK = 64, HALF = 128, HTB = HALF * BK * 2  , STAGE_BYTES = 8 * HTB, NXCD = 8, WGM = 8;

__host__ __device__ __forceinline__ int lds_byte(int r, int c) { const int st = (r >> 4) * 2 + (c >> 5), rr = r & 15, cc = c & 31, ob = rr * 64 + cc * 2; return st * 1024 + (ob ^ (((ob >> 9) & 1) << 5)); }
__host__ __device__ __forceinline__ void stage_rc(int b, int& R, int& C) { const int st = b / 1024, sb = b % 1024, swz = sb ^ (((sb >> 9) & 1) << 5); R = (st >> 1) * 16 + swz / 64; C = (st & 1) * 32 + (swz % 64) / 2; }
__host__ __device__ __forceinline__ int perm32(int rho) { const int n = rho >> 4, i = rho & 15; return 8 * (i >> 2) + 4 * n + (i & 3); }

struct Unit { int pm, pn; };
struct Gemm { const bf16_t* A; const bf16_t* Bt; int M, N, K; };

struct StaticOrder {
    int nM, nN, nwg, G, c;
    __host__ __device__ void init(int M, int N, int G_, int c_) { nM = M / BM; nN = N / BM; nwg = nM * nN; G = G_; c = c_; }
    __host__ __device__ bool next(int i, Unit& u) const {
        const long L = (long)i * G + c; if (L >= nwg) return false;
        int wgid = (int)L; { const int q = nwg / NXCD, r = nwg % NXCD, xcd = wgid % NXCD, off = wgid / NXCD; wgid = (xcd < r ? xcd * (q + 1) : r * (q + 1) + (xcd - r) * q) + off; }
        const int nig = WGM * nN, gid = wgid / nig, fm = gid * WGM, gsz = (nM - fm) < WGM ? (nM - fm) : WGM;
        u.pm = fm + ((wgid % nig) % gsz); u.pn = (wgid % nig) / gsz; return true;
    }
    __device__ __forceinline__ void a_ready(const Unit&) const {}
    __device__ __forceinline__ void done(const Unit&) const {}
};


__device__ __forceinline__ unsigned cvt_pk_bf16(float lo, float hi) { unsigned r; asm volatile("v_cvt_pk_bf16_f32 %0, %1, %2" : "=v"(r) : "v"(lo), "v"(hi)); return r; }
struct EpiBf16 {
    static constexpr bool PERM = true, AFTER_DRAIN = false;
    bf16_t* O; int ldc;
    __device__ __forceinline__ void operator()(const f32x4 (&acc)[2][2][4][2], const Unit& u, int wr, int wc, int fr, int fq) const {
        const int row0 = u.pm * BM + wr * 64 + fr; const int col0 = u.pn * BM + wc * 32 + 8 * fq;
#pragma unroll
        for (int ai = 0; ai < 2; ++ai)
#pragma unroll
            for (int m = 0; m < 4; ++m) { bf16_t* rowp = O + (size_t)(row0 + ai * HALF + m * 16) * ldc + col0;
#pragma unroll
                for (int bj = 0; bj < 2; ++bj) { const f32x4 v0 = acc[ai][bj][m][0], v1 = acc[ai][bj][m][1];
                    u32x4 w; w.x = cvt_pk_bf16(v0[0], v0[1]); w.y = cvt_pk_bf16(v0[2], v0[3]); w.z = cvt_pk_bf16(v1[0], v1[1]); w.w = cvt_pk_bf16(v1[2], v1[3]);
                    *(u32x4*)(rowp + bj * HALF) = w; } }
    }
};
struct EpiF32 {
    static constexpr bool PERM = false, AFTER_DRAIN = false;
    float* C; int ldc;
    __device__ __forceinline__ void operator()(const f32x4 (&acc)[2][2][4][2], const Unit& u, int wr, int wc, int fr, int fq) const {
        const int row0 = u.pm * BM + wr * 64 + fr, col0 = u.pn * BM + wc * 32 + 4 * fq;
#pragma unroll
        for (int ai = 0; ai < 2; ++ai)
#pragma unroll
            for (int m = 0; m < 4; ++m) { float* rowp = C + (size_t)(row0 + ai * HALF + m * 16) * ldc + col0;
#pragma unroll
                for (int bj = 0; bj < 2; ++bj)
#pragma unroll
                    for (int n = 0; n < 2; ++n) *(f32x4*)(rowp + bj * HALF + n * 16) = acc[ai][bj][m][n]; }
    }
};

template <class Epi, class Sched, bool ALIGN_EPI = false, bool SP2 = false>
__device__ __forceinline__ void gemm_phase(PG8_LAS unsigned char* lds, const Gemm g, const Sched& S, const Epi& E) {
    const int tid = otid(), wid = __builtin_amdgcn_readfirstlane(tid >> 6), lane = tid & 63, wr = wid >> 2, wc = wid & 3, fr = lane & 15, fq = lane >> 4;
    const int K = g.K, nt = K / BK;
    unsigned voffA[2], voffB[2];
#pragma unroll
    for (int i = 0; i < 2; ++i) { int R, C; stage_rc(tid * 16 + i * 8192, R, C); const int Rb = Epi::PERM ? ((R & ~31) + perm32(R & 31)) : R;
        voffA[i] = (unsigned)(R * K + C) * 2u; voffB[i] = (unsigned)(Rb * K + C) * 2u; }
    const size_t kstep = (size_t)(BK * 2);
    const size_t hstep = (size_t)HALF * K * 2;
    const size_t tstep = 2 * hstep;
    const unsigned ldsw = (unsigned)wid * 1024u;
    const int aoff = lds_byte(wr * 64 + fr, fq * 8), boff = lds_byte(wc * 32 + fr, fq * 8);
#define PG8_SA(b, h) (((b) * 2 + (h)) * HTB)
#define PG8_SB(b, h) ((4 + (b) * 2 + (h)) * HTB)
#define PG8_STAGE(bufoff, gbase, voff) do { _Pragma("unroll") for (int _i = 0; _i < 2; ++_i) \
        __builtin_amdgcn_global_load_lds((const unsigned*)((const char*)(gbase) + (voff)[_i]), (PG8_LAS unsigned*)(lds + (bufoff) + ldsw + _i * 8192), 16, 0, 0); } while (0)
#define PG8_LDA(dst, b, h) do { _Pragma("unroll") for (int m = 0; m < 4; ++m) _Pragma("unroll") for (int k = 0; k < 2; ++k) dst[m][k] = *(const PG8_LAS bf16x8*)(lds + PG8_SA(b, h) + aoff + m * 2048 + k * 1024); } while (0)
#define PG8_LDB(dst, b, h) do { _Pragma("unroll") for (int n = 0; n < 2; ++n) _Pragma("unroll") for (int k = 0; k < 2; ++k) dst[n][k] = *(const PG8_LAS bf16x8*)(lds + PG8_SB(b, h) + boff + n * 2048 + k * 1024); } while (0)
#define PG8_MMA(ai, bj, At, Bt) do { __builtin_amdgcn_s_setprio(1); _Pragma("unroll") for (int m = 0; m < 4; ++m) _Pragma("unroll") for (int n = 0; n < 2; ++n) _Pragma("unroll") for (int k = 0; k < 2; ++k) \
        acc[ai][bj][m][n] = __builtin_amdgcn_mfma_f32_16x16x32_bf16(Bt[n][k], At[m][k], acc[ai][bj][m][n], 0, 0, 0); __builtin_amdgcn_s_setprio(0); } while (0)
#define PG8_WAIT_V(n) asm volatile("s_waitcnt vmcnt(" #n ")" ::: "memory")
#define PG8_WAIT_L(n) asm volatile("s_waitcnt lgkmcnt(" #n ")" ::: "memory")
#define PG8_BAR __builtin_amdgcn_s_barrier()
#define PG8_SCHED __builtin_amdgcn_sched_barrier(0)
    Unit cur, nxt; int ui = 0;
    if (!S.next(0, cur)) return;
    f32x4 acc[2][2][4][2];
#pragma unroll
    for (int a = 0; a < 2; ++a)
#pragma unroll
        for (int b = 0; b < 2; ++b)
#pragma unroll
            for (int m = 0; m < 4; ++m)
#pragma unroll
                for (int n = 0; n < 2; ++n) acc[a][b][m][n] = (f32x4){0.f, 0.f, 0.f, 0.f};
    bf16x8 At[4][2], B0[2][2], B1[2][2];
    const char* cA = (const char*)g.A + (size_t)cur.pm * tstep; const char* cB = (const char*)g.Bt + (size_t)cur.pn * tstep;
    S.a_ready(cur);
    if constexpr (SP2) {
        PG8_STAGE(PG8_SB(0, 0), cB, voffB); PG8_STAGE(PG8_SB(0, 1), cB + hstep, voffB); PG8_STAGE(PG8_SA(0, 0), cA, voffA); PG8_STAGE(PG8_SA(0, 1), cA + hstep, voffA);
        if (wr == 1) PG8_BAR;
        PG8_WAIT_V(2); PG8_BAR;
        PG8_STAGE(PG8_SB(1, 0), cB + kstep, voffB); PG8_STAGE(PG8_SA(1, 0), cA + kstep, voffA); PG8_STAGE(PG8_SB(1, 1), cB + hstep + kstep, voffB);
        PG8_WAIT_V(6); PG8_BAR;
    } else {
        PG8_STAGE(PG8_SB(0, 0), cB, voffB); PG8_STAGE(PG8_SA(0, 0), cA, voffA); PG8_STAGE(PG8_SB(0, 1), cB + hstep, voffB); PG8_STAGE(PG8_SA(0, 1), cA + hstep, voffA);
        if (wr == 1) PG8_BAR;
        PG8_WAIT_V(4); PG8_BAR;
        PG8_STAGE(PG8_SB(1, 0), cB + kstep, voffB); PG8_STAGE(PG8_SA(1, 0), cA + kstep, voffA); PG8_STAGE(PG8_SB(1, 1), cB + hstep + kstep, voffB);
        PG8_WAIT_V(6); PG8_BAR;
    }
    for (;;) {
        const bool has_next = S.next(ui + 1, nxt);
        const char* nA = has_next ? (const char*)g.A + (size_t)nxt.pm * tstep : cA; const char* nB = has_next ? (const char*)g.Bt + (size_t)nxt.pn * tstep : cB;
        for (int t = 0; t < nt; t += 2) {
            const bool last = (t == nt - 2);
            const char* a1 = cA + (size_t)(t + 1) * kstep;
            const char* a2 = last ? nA : cA + (size_t)(t + 2) * kstep; const char* b2 = last ? nB : cB + (size_t)(t + 2) * kstep;
            const char* a3 = a2 + kstep; const char* b3 = b2 + kstep;
            if (last && has_next) S.a_ready(nxt);
            if constexpr (SP2) {
            PG8_LDB(B0, 0, 0); PG8_LDB(B1, 0, 1); PG8_SCHED; PG8_LDA(At, 0, 0); PG8_STAGE(PG8_SA(1, 1), a1 + hstep, voffA);
            PG8_WAIT_V(8); PG8_WAIT_L(0); PG8_BAR; PG8_MMA(0, 0, At, B0); PG8_MMA(0, 1, At, B1); PG8_BAR; PG8_SCHED;
            PG8_LDA(At, 0, 1); PG8_STAGE(PG8_SB(0, 0), b2, voffB); PG8_STAGE(PG8_SB(0, 1), b2 + hstep, voffB); PG8_STAGE(PG8_SA(0, 0), a2, voffA);
            PG8_WAIT_V(8); PG8_WAIT_L(0); PG8_BAR; PG8_MMA(1, 0, At, B0); PG8_MMA(1, 1, At, B1); PG8_BAR; PG8_SCHED;
            PG8_LDB(B0, 1, 0); PG8_LDB(B1, 1, 1); PG8_SCHED; PG8_LDA(At, 1, 0); PG8_STAGE(PG8_SA(0, 1), a2 + hstep, voffA);
            PG8_WAIT_V(8); PG8_WAIT_L(0); PG8_BAR; PG8_MMA(0, 0, At, B0); PG8_MMA(0, 1, At, B1); PG8_BAR; PG8_SCHED;
            PG8_LDA(At, 1, 1); PG8_STAGE(PG8_SB(1, 0), b3, voffB); PG8_STAGE(PG8_SB(1, 1), b3 + hstep, voffB); PG8_STAGE(PG8_SA(1, 0), a3, voffA);
            PG8_WAIT_V(8); PG8_WAIT_L(0); PG8_BAR; PG8_MMA(1, 0, At, B0); PG8_MMA(1, 1, At, B1); PG8_BAR; PG8_SCHED;
            } else {
            PG8_LDB(B0, 0, 0); PG8_SCHED; PG8_LDA(At, 0, 0); PG8_STAGE(PG8_SA(1, 1), a1 + hstep, voffA);
            PG8_WAIT_L(8); PG8_BAR; PG8_WAIT_L(0); PG8_MMA(0, 0, At, B0); PG8_BAR; PG8_SCHED;
            PG8_LDB(B1, 0, 1); PG8_STAGE(PG8_SB(0, 0), b2, voffB);
            PG8_BAR; PG8_WAIT_L(0); PG8_MMA(0, 1, At, B1); PG8_BAR;
            PG8_LDA(At, 0, 1); PG8_STAGE(PG8_SA(0, 0), a2, voffA);
            PG8_BAR; PG8_WAIT_L(0); PG8_MMA(1, 0, At, B0); PG8_BAR; PG8_SCHED;
            PG8_STAGE(PG8_SB(0, 1), b2 + hstep, voffB);
            PG8_WAIT_V(6); PG8_BAR; PG8_MMA(1, 1, At, B1); PG8_BAR;
            PG8_LDB(B0, 1, 0); PG8_SCHED; PG8_LDA(At, 1, 0); PG8_STAGE(PG8_SA(0, 1), a2 + hstep, voffA);
            PG8_WAIT_L(8); PG8_BAR; PG8_WAIT_L(0); PG8_MMA(0, 0, At, B0); PG8_BAR; PG8_SCHED;
            PG8_LDB(B1, 1, 1); PG8_STAGE(PG8_SB(1, 0), b3, voffB);
            PG8_BAR; PG8_WAIT_L(0); PG8_MMA(0, 1, At, B1); PG8_BAR;
            PG8_LDA(At, 1, 1); PG8_STAGE(PG8_SA(1, 0), a3, voffA);
            PG8_BAR; PG8_WAIT_L(0); PG8_MMA(1, 0, At, B0); PG8_BAR; PG8_SCHED;
            PG8_STAGE(PG8_SB(1, 1), b3 + hstep, voffB);
            PG8_WAIT_V(6); PG8_BAR; PG8_MMA(1, 1, At, B1); PG8_BAR;
            }
        }
        if constexpr (ALIGN_EPI) { if (wr == 0) PG8_BAR; }
        if constexpr (!Epi::AFTER_DRAIN) { E(acc, cur, wr, wc, fr, fq); S.done(cur); }
        if (!has_next) break;
#pragma unroll
        for (int a = 0; a < 2; ++a)
#pragma unroll
            for (int b = 0; b < 2; ++b)
#pragma unroll
                for (int m = 0; m < 4; ++m)
#pragma unroll
                    for (int n = 0; n < 2; ++n) acc[a][b][m][n] = (f32x4){0.f, 0.f, 0.f, 0.f};
        cur = nxt; cA = nA; cB = nB; ++ui;
        if constexpr (ALIGN_EPI) { if (wr == 1) PG8_BAR; }
    }
    PG8_WAIT_V(0);
    if constexpr (!ALIGN_EPI) { if (wr == 0) PG8_BAR; }
    PG8_BAR;
    if constexpr (Epi::AFTER_DRAIN) { E.fused(acc, cur, wr, wc, fr, fq, lds, wid, lane); S.done(cur); }
#undef PG8_SA
#undef PG8_SB
#undef PG8_STAGE
#undef PG8_LDA
#undef PG8_LDB
#undef PG8_MMA
#undef PG8_WAIT_V
#undef PG8_WAIT_L
#undef PG8_BAR
#undef PG8_SCHED
}
}

constexpr int M = 16384, D = 1024, DEPTH = 4, NU = 3328, NWIN = 3208, NCHUNK = 256;
constexpr int MEM_LEN = 256;
constexpr int C_XS = 0, C_B = 512, C_C = 768, C_Z = 1024, C_R = 1536, C_K = 1792, C_V = 2048, C_G = 2304, C_Q = 2560, C_GX = 2816, C_WL = 3072, C_AL = 3136, C_DT = 3200;
constexpr int NMAIN = 3072, NSK = 144;
constexpr float NORM_EPS = 1e-6f, LNX_EPS = 64e-5f;

#define LAS __attribute__((address_space(3)))
#define GAS __attribute__((address_space(1)))
typedef unsigned short bf16;
typedef short bf16x8 __attribute__((ext_vector_type(8)));
typedef float f32x4 __attribute__((ext_vector_type(4)));

typedef __bf16 bf16v2_t __attribute__((ext_vector_type(2)));
__device__ __forceinline__ unsigned cvt2bf(float lo, float hi) { bf16v2_t v; v[0] = (__bf16)lo; v[1] = (__bf16)hi; return __builtin_bit_cast(unsigned, v); }
__device__ __forceinline__ unsigned f2bf(float f) { return cvt2bf(f, 0.f) & 0xffffu; }
__device__ __forceinline__ float bf2f(unsigned b) { return __uint_as_float(b << 16); }
__device__ __forceinline__ float us2f(short s) { return bf2f((unsigned)(unsigned short)s); }
typedef unsigned u32x2 __attribute__((ext_vector_type(2)));
typedef unsigned u32x4v __attribute__((ext_vector_type(4)));
__device__ __forceinline__ u32x2 pack4(float a, float b, float c, float d) { u32x2 o; o.x = cvt2bf(a, b); o.y = cvt2bf(c, d); return o; }
__device__ __forceinline__ bf16x8 pack8(const float (&v)[8]) { const u32x4v t = (u32x4v){cvt2bf(v[0], v[1]), cvt2bf(v[2], v[3]), cvt2bf(v[4], v[5]), cvt2bf(v[6], v[7])}; return __builtin_bit_cast(bf16x8, t); }
__device__ __forceinline__ float wave_sum(float v) {
#pragma unroll
    for (int o = 1; o < 64; o <<= 1) v += __shfl_xor(v, o);
    return v;
}
__device__ __forceinline__ float silu_f(float x) { return x * __builtin_amdgcn_rcpf(1.f + __expf(-x)); }
__device__ __forceinline__ float softplus_f(float x) { return fmaxf(x, 0.f) + __logf(1.f + __expf(-fabsf(x))); }
__device__ __forceinline__ float sigmoid_f(float x) { return __builtin_amdgcn_rcpf(1.f + __expf(-x)); }

__device__ __forceinline__ bf16x8 ld_frag(const LAS bf16* base, int ld, int row0, int k0, int lane) {
    return *(const LAS bf16x8*)(base + (row0 + (lane & 15)) * ld + k0 + (lane >> 4) * 8);
}
#define MFMA16(a, b, c) __builtin_amdgcn_mfma_f32_16x16x32_bf16((a), (b), (c), 0, 0, 0)
#define BAR_LDS() do { asm volatile("s_waitcnt lgkmcnt(0)" ::: "memory"); __builtin_amdgcn_s_barrier(); asm volatile("" ::: "memory"); } while (0)

#define XB_TMO      128
#define XB_XCNT(j)  (256  + 64 * (j))
#define XB_XSUB(j)  (1280 + 64 * (j))
#define XB_XGEN(j)  (2304 + 64 * (j))
#define XB_TOP      3328
#define XB_TOPGEN   3392
#define XCD_BAR_WORDS 3456
#define XB_SPIN_CAP (1u << 22)

__device__ __forceinline__ unsigned xb_ld(unsigned* p)              { return __hip_atomic_load(p, __ATOMIC_RELAXED, __HIP_MEMORY_SCOPE_AGENT); }
__device__ __forceinline__ unsigned xb_add(unsigned* p, unsigned v) { return __hip_atomic_fetch_add(p, v, __ATOMIC_RELAXED, __HIP_MEMORY_SCOPE_AGENT); }
__device__ __forceinline__ unsigned xb_xcc_id() { return (unsigned)__builtin_amdgcn_s_getreg((3 << 11) | 20) & 0xFu; }
#define XB_SPIN(cond, bar) do { unsigned _sp = 0; while (cond) { __builtin_amdgcn_s_sleep(1); \
    if ((++_sp & 255u) == 0u) { if (xb_ld(&(bar)[XB_TMO])) break; if (_sp > XB_SPIN_CAP) { atomicAdd(&(bar)[XB_TMO], 1u); break; } } } } while (0)

struct XcdBarrier {
    unsigned* bar; unsigned x;
    volatile LAS unsigned* st;
};

__device__ __forceinline__ XcdBarrier xcd_barrier_post(unsigned* bar, volatile LAS unsigned* st) {
    XcdBarrier b; b.bar = bar; b.x = xb_xcc_id(); b.st = st;
    if (otid() == 0) (void)xb_add(&bar[XB_XCNT(b.x)], 1u);
    return b;
}
__device__ __forceinline__ void xcd_barrier_complete(unsigned* bar, unsigned x, unsigned& nloc, unsigned& nx) {
    const unsigned G = gridDim.x * gridDim.y * gridDim.z;
    unsigned sum, cnt, mine, sp = 0u;
    for (;;) {
        sum = 0u; cnt = 0u; mine = 0u;
#pragma unroll
        for (unsigned j = 0; j < 16; ++j) { const unsigned c = xb_ld(&bar[XB_XCNT(j)]); sum += c; cnt += (c > 0u) ? 1u : 0u; }
        mine = xb_ld(&bar[XB_XCNT(x)]);
        if (sum == G) break;
        __builtin_amdgcn_s_sleep(1);
        if ((++sp & 255u) == 0u) { if (xb_ld(&bar[XB_TMO])) break; if (sp > XB_SPIN_CAP) { atomicAdd(&bar[XB_TMO], 1u); break; } }
    }
    nloc = mine > 0u ? mine : 1u; nx = cnt > 0u ? cnt : 1u;
}

__device__ __forceinline__ void xcd_barrier(const XcdBarrier& b) {
    asm volatile("s_waitcnt vmcnt(0)" ::: "memory");
    __syncthreads();
    if (otid() == 0) {
        unsigned* bar = b.bar;
        __builtin_amdgcn_s_waitcnt(0);
        unsigned nloc = b.st[0], nx = b.st[1];
        if (nloc == 0u) { xcd_barrier_complete(bar, b.x, nloc, nx); b.st[0] = nloc; b.st[1] = nx; }
        const unsigned old = xb_add(&bar[XB_XSUB(b.x)], 1u);
        const unsigned gen = old / nloc;
        if (old + 1u == (gen + 1u) * nloc) {
            __builtin_amdgcn_fence(__ATOMIC_RELEASE, "agent");
            asm volatile("s_waitcnt vmcnt(0)" ::: "memory");
            const unsigned og = xb_add(&bar[XB_TOP], 1u);
            const unsigned tg = og / nx;
            if (og + 1u == (tg + 1u) * nx) xb_add(&bar[XB_TOPGEN], 1u);
            else XB_SPIN(xb_ld(&bar[XB_TOPGEN]) == tg, bar);
            __builtin_amdgcn_fence(__ATOMIC_ACQUIRE, "agent");
            xb_add(&bar[XB_XGEN(b.x)], 1u);
            asm volatile("s_waitcnt vmcnt(0)" ::: "memory");
        } else {
            XB_SPIN(xb_ld(&bar[XB_XGEN(b.x)]) == gen, bar);
            __builtin_amdgcn_fence(__ATOMIC_ACQUIRE, "agent");
            asm volatile("s_waitcnt vmcnt(0)" ::: "memory");
        }
    }
    __syncthreads();
}


struct Params {
    const float *x, *mem, *mem_norm_w, *w_mem_kv, *pre_norm_w, *w_in, *conv_w, *conv_b, *dt_bias, *a_log, *d_skip, *ssm_norm_w,
                *shift_mu, *w0, *w2, *a0, *a2, *k_k, *k_a, *r_k, *lnx_w, *lnx_b, *w_out, *post_norm_w;
    float* out;
    unsigned char* ws;
};
constexpr size_t MiB = 1u << 20;
constexpr size_t WS_CTL = 0, WS_WIN = 1 * MiB, WS_WOUT = 27 * MiB, WS_KV = 35 * MiB, WS_H = 36 * MiB, WS_U = 68 * MiB, WS_R = 172 * MiB, WS_END = 256 * MiB;
constexpr size_t WS_W2T = WS_KV + 256 * 1024;
constexpr size_t WS_ST = WS_R, WS_CD = WS_R + 32 * MiB, WS_BS = WS_CD + 65536;
constexpr size_t WS_Q1 = WS_R + 34 * MiB, WS_Y0 = WS_R + 42 * MiB, WS_PCT = WS_R + 50 * MiB, WS_GC = WS_R + 58 * MiB, WS_S0 = WS_R + 66 * MiB, WS_PGT = WS_R + 74 * MiB, WS_GG = WS_R + 75 * MiB;
static_assert(WS_GG + 64 * 8192 <= WS_END && WS_BS + (size_t)16384 * 16 <= WS_Q1, "ws map");


constexpr size_t WS_PB = 128 * 1024;
constexpr int PB_PRENW = 1024, PB_CONVW = 5120, PB_CONVB = 21504, PB_DTB = 25600, PB_ALOG = 25632, PB_DSKIP = 25664, PB_SSMNW = 25728, PB_MU = 27776, PB_W0 = 32384, PB_W2 = 33408,
              PB_A0 = 98944, PB_A2 = 99968, PB_KK = 165504, PB_KA = 166528, PB_RK = 167552, PB_LNW = 168576, PB_LNB = 169600, PB_POSTNW = 170624, PB_END = 174720;
static_assert(WS_PB + (size_t)PB_END * 4 <= 1 * MiB, "blob inside the control MiB");
#define PBP(P, off) ((const float*)((P).ws + WS_PB) + (off))
__device__ __forceinline__ int win_src_col(int n) {
    if (n < 1536) return n;
    if (n < 2560) return n + 8;
    if (n < 3072) return n + 136;
    const int j = n - 3072; if (j < 64) return 2568 + j; if (j < 128) return 2632 + (j - 64); if (j < 136) return 1536 + (j - 128); return -1;
}
template <bool WIN>
__device__ __forceinline__ void transpose_tile(const float* src, int src_ld, bf16* dst, int K, int n0, int k0, LAS float* scr) {
    const int tid = otid(), kk = tid >> 3, ng = tid & 7;
    const int sc = WIN ? win_src_col(n0 + ng * 8) : (n0 + ng * 8);
    f32x4 v0 = (f32x4){0.f, 0.f, 0.f, 0.f}, v1 = v0;
    { const float* sp = src + (size_t)(k0 + kk) * src_ld + (sc >= 0 ? sc : 0); const f32x4 a0 = *(const f32x4*)sp, a1 = *(const f32x4*)(sp + 4); if (sc >= 0) { v0 = a0; v1 = a1; } }
    BAR_LDS();
#pragma unroll
    for (int j = 0; j < 4; ++j) { scr[(ng * 8 + j) * 65 + kk] = v0[j]; scr[(ng * 8 + 4 + j) * 65 + kk] = v1[j]; }
    BAR_LDS();
    const int n = tid >> 3, kg = tid & 7; float o[8];
#pragma unroll
    for (int j = 0; j < 8; ++j) o[j] = scr[n * 65 + kg * 8 + j];
    *(bf16x8*)(dst + (size_t)(n0 + n) * K + k0 + kg * 8) = pack8(o);
}
__device__ __forceinline__ void stage_prep_weights(const Params& P, LAS unsigned char* lds, int item) {
    LAS float* scr = (LAS float*)lds;
    constexpr int T_IN = (NU / 64) * (D / 64);
    constexpr int T_OUT = (D / 64) * (D / 64);
    if (item < DEPTH * T_IN) { const int l = item / T_IN, r = item % T_IN, nb = r / 16, kb = r % 16;
        transpose_tile<true>(P.w_in + (size_t)l * D * NWIN, NWIN, (bf16*)(P.ws + WS_WIN) + (size_t)l * NU * D, D, nb * 64, kb * 64, scr); }
    else { const int it = item - DEPTH * T_IN; const int l = it / T_OUT, r = it % T_OUT, nb = r / 16, kb = r % 16;
        transpose_tile<false>(P.w_out + (size_t)l * D * D, D, (bf16*)(P.ws + WS_WOUT) + (size_t)l * D * D, D, nb * 64, kb * 64, scr); }
}
constexpr int N_PREP_ITEMS = DEPTH * ((NU / 64) * (D / 64) + (D / 64) * (D / 64));


__device__ __forceinline__ void stage_blob(const Params& P, int gtid, int gthreads) {
    float* pb = (float*)(P.ws + WS_PB);
#define CPY(src, off, n) for (int i = gtid; i < (n); i += gthreads) pb[(off) + i] = (src)[i];
    CPY(P.mem_norm_w, 0, 1024) CPY(P.pre_norm_w, PB_PRENW, 4096) CPY(P.conv_w, PB_CONVW, 16384) CPY(P.conv_b, PB_CONVB, 4096) CPY(P.dt_bias, PB_DTB, 32) CPY(P.a_log, PB_ALOG, 32) CPY(P.d_skip, PB_DSKIP, 32)
    CPY(P.ssm_norm_w, PB_SSMNW, 2048) CPY(P.shift_mu, PB_MU, 4608) CPY(P.w0, PB_W0, 1024) CPY(P.w2, PB_W2, 65536) CPY(P.a0, PB_A0, 1024) CPY(P.a2, PB_A2, 65536) CPY(P.k_k, PB_KK, 1024) CPY(P.k_a, PB_KA, 1024)
    CPY(P.r_k, PB_RK, 1024) CPY(P.lnx_w, PB_LNW, 1024) CPY(P.lnx_b, PB_LNB, 1024) CPY(P.post_norm_w, PB_POSTNW, 4096)
#undef CPY
    bf16* wi = (bf16*)(P.ws + WS_W2T);
    for (int i = gtid; i < 65536; i += gthreads) { const int j = i & 63, ch = (i >> 6) & 63, h = (i >> 12) & 3, l = i >> 14;
        wi[i] = (bf16)f2bf(P.w2[((size_t)l * 64 + j) * 256 + h * 64 + ch]); wi[65536 + i] = (bf16)f2bf(P.a2[((size_t)l * 64 + j) * 256 + h * 64 + ch]); }
}
__device__ __forceinline__ void stage_memkv(const Params& P, LAS unsigned char* lds, int m) {
    LAS float* xs = (LAS float*)lds; LAS float* red = xs + 1024;
    const int tid = otid();
    const float v0 = P.mem[(size_t)m * D + tid], v1 = P.mem[(size_t)m * D + 512 + tid];
    float s = wave_sum(v0 * v0 + v1 * v1);
    if ((tid & 63) == 0) red[tid >> 6] = s;
    __syncthreads();
    float tot = 0.f;
#pragma unroll
    for (int w = 0; w < 8; ++w) tot += red[w];
    const float rstd = rsqrtf(tot * (1.f / D) + NORM_EPS);
    xs[tid] = v0 * rstd * P.mem_norm_w[tid]; xs[512 + tid] = v1 * rstd * P.mem_norm_w[512 + tid];
    __syncthreads();
    float acc = 0.f;
#pragma unroll 32
    for (int k = 0; k < D; ++k) acc += xs[k] * P.w_mem_kv[(size_t)k * 512 + tid];
    {   const int hh = (tid >> 6) & 3, d = tid & 63;
        if (tid < 256) ((bf16*)(P.ws + WS_KV))[(size_t)(hh * 256 + m) * 64 + d] = (bf16)f2bf(acc);
        else ((bf16*)(P.ws + WS_KV) + 65536)[(size_t)(hh * 64 + d) * 256 + m] = (bf16)f2bf(acc); }
    __syncthreads();
}

__device__ __forceinline__ void prenorm_row(const float* xrow, const float* w, bf16* orow, int lane) {
    const f32x4* xr = (const f32x4*)xrow + lane; const f32x4* wr = (const f32x4*)w + lane;
    f32x4 v[4]; float s = 0.f;
#pragma unroll
    for (int j = 0; j < 4; ++j) { v[j] = xr[64 * j]; s += (v[j].x * v[j].x + v[j].y * v[j].y) + (v[j].z * v[j].z + v[j].w * v[j].w); }
    const float rstd = rsqrtf(wave_sum(s) * (1.f / D) + NORM_EPS);
    unsigned long long* o8 = (unsigned long long*)orow + lane;
#pragma unroll
    for (int j = 0; j < 4; ++j) { const f32x4 ww = wr[64 * j];
        const unsigned lo = f2bf(v[j].x * rstd * ww.x) | (f2bf(v[j].y * rstd * ww.y) << 16), hi = f2bf(v[j].z * rstd * ww.z) | (f2bf(v[j].w * rstd * ww.w) << 16);
        o8[64 * j] = (unsigned long long)lo | ((unsigned long long)hi << 32); }
}
__device__ __forceinline__ void post_row(const bf16* orow, const float* xin, const float* pw, float* xout, const float* nw, bf16* hrow, int lane) {
    const f32x4* xr = (const f32x4*)xin + lane; const f32x4* pr = (const f32x4*)pw + lane;
    f32x4 v[4]; float s = 0.f;
#pragma unroll
    for (int j = 0; j < 4; ++j) { const u32x2 o2 = *((const u32x2*)orow + 64 * j + lane); v[j] = (f32x4){bf2f(o2.x & 0xffffu), bf2f(o2.x >> 16), bf2f(o2.y & 0xffffu), bf2f(o2.y >> 16)};
        s += (v[j].x * v[j].x + v[j].y * v[j].y) + (v[j].z * v[j].z + v[j].w * v[j].w); }
    const float rstd = rsqrtf(wave_sum(s) * (1.f / D) + NORM_EPS);
    float s2 = 0.f;
#pragma unroll
    for (int j = 0; j < 4; ++j) { const f32x4 xx = xr[64 * j], pp = pr[64 * j]; v[j] = xx + v[j] * rstd * pp; s2 += (v[j].x * v[j].x + v[j].y * v[j].y) + (v[j].z * v[j].z + v[j].w * v[j].w);
        ((f32x4*)xout + lane)[64 * j] = v[j]; }
    if (hrow) {
        const float rstd2 = rsqrtf(wave_sum(s2) * (1.f / D) + NORM_EPS);
        const f32x4* wr = (const f32x4*)nw + lane; unsigned long long* o8 = (unsigned long long*)hrow + lane;
#pragma unroll
        for (int j = 0; j < 4; ++j) { const f32x4 ww = wr[64 * j];
            const unsigned lo = f2bf(v[j].x * rstd2 * ww.x) | (f2bf(v[j].y * rstd2 * ww.y) << 16), hi = f2bf(v[j].z * rstd2 * ww.z) | (f2bf(v[j].w * rstd2 * ww.w) << 16);
            o8[64 * j] = (unsigned long long)lo | ((unsigned long long)hi << 32); }
    }
}

constexpr int XA_KLD = 72, XA_VLD = 264;
constexpr int XA_LDS = (256 * XA_KLD + 64 * XA_VLD) * 2;
__device__ __forceinline__ void stage_xattn(const Params& P, LAS unsigned char* lds, int item) {
    const int tid = otid(), lane = tid & 63, wave = tid >> 6, quad = lane >> 4, l15 = lane & 15;
    const int tile = item >> 2, h = item & 3, t0 = tile * 256;
    LAS bf16* Ks = (LAS bf16*)lds; LAS bf16* VT = Ks + 256 * XA_KLD;
    const bf16* KB = (const bf16*)(P.ws + WS_KV) + (size_t)h * 256 * 64; const bf16* VB = (const bf16*)(P.ws + WS_KV) + 65536 + (size_t)h * 64 * 256;
    const bf16* U = (const bf16*)(P.ws + WS_U); bf16* Y = (bf16*)(P.ws + WS_H);
    u32x4v kp[4], vp[4];
#pragma unroll
    for (int i = 0; i < 4; ++i) { const int e = tid + i * 512; kp[i] = *(const u32x4v*)(KB + e * 8); vp[i] = *(const u32x4v*)(VB + e * 8); }
    bf16x8 qf[2][2]; u32x2 gx[2][4];
#pragma unroll
    for (int rb = 0; rb < 2; ++rb) { const bf16* up = U + (size_t)(t0 + wave * 32 + rb * 16 + l15) * NU + h * 64;
#pragma unroll
        for (int s_ = 0; s_ < 2; ++s_) qf[rb][s_] = *(const bf16x8*)(up + C_Q + s_ * 32 + quad * 8);
#pragma unroll
        for (int db = 0; db < 4; ++db) gx[rb][db] = *(const u32x2*)(up + C_GX + db * 16 + quad * 4); }
#pragma unroll
    for (int i = 0; i < 4; ++i) { const int e = tid + i * 512;
        *(LAS u32x4v*)(Ks + (e >> 3) * XA_KLD + (e & 7) * 8) = kp[i]; *(LAS u32x4v*)(VT + (e >> 5) * XA_VLD + (e & 31) * 8) = vp[i]; }
    BAR_LDS();
#pragma unroll
    for (int rb = 0; rb < 2; ++rb) {
        f32x4 acc[16];
#pragma unroll
        for (int mb = 0; mb < 16; ++mb) { acc[mb] = (f32x4){0.f, 0.f, 0.f, 0.f};
#pragma unroll
            for (int s_ = 0; s_ < 2; ++s_) acc[mb] = MFMA16(ld_frag(Ks, XA_KLD, mb * 16, s_ * 32, lane), qf[rb][s_], acc[mb]); }
        float m_ = -3.0e38f;
#pragma unroll
        for (int mb = 0; mb < 16; ++mb)
#pragma unroll
            for (int r = 0; r < 4; ++r) { acc[mb][r] *= 0.125f; m_ = fmaxf(m_, acc[mb][r]); }
        m_ = fmaxf(m_, __shfl_xor(m_, 16)); m_ = fmaxf(m_, __shfl_xor(m_, 32));
        float sm = 0.f; u32x2 pk[16];
#pragma unroll
        for (int mb = 0; mb < 16; ++mb) { float p[4];
#pragma unroll
            for (int r = 0; r < 4; ++r) { p[r] = __expf(acc[mb][r] - m_); sm += p[r]; }
            pk[mb] = pack4(p[0], p[1], p[2], p[3]); }
        sm += __shfl_xor(sm, 16); sm += __shfl_xor(sm, 32);
        f32x4 o4[4];
#pragma unroll
        for (int db = 0; db < 4; ++db) o4[db] = (f32x4){0.f, 0.f, 0.f, 0.f};
#pragma unroll
        for (int ks = 0; ks < 8; ++ks) {
            bf16x8 pb; { const u32x4v t4 = (u32x4v){pk[2 * ks].x, pk[2 * ks].y, pk[2 * ks + 1].x, pk[2 * ks + 1].y}; pb = __builtin_bit_cast(bf16x8, t4); }
#pragma unroll
            for (int db = 0; db < 4; ++db) { const LAS bf16* vpn = VT + (db * 16 + l15) * XA_VLD + ks * 32 + quad * 4;
                const u32x2 v0 = *(const LAS u32x2*)vpn, v1 = *(const LAS u32x2*)(vpn + 16);
                const u32x4v t4 = (u32x4v){v0.x, v0.y, v1.x, v1.y};
                o4[db] = MFMA16(__builtin_bit_cast(bf16x8, t4), pb, o4[db]); } }
        const float inv = 1.f / sm; const int t = t0 + wave * 32 + rb * 16 + l15;
#pragma unroll
        for (int db = 0; db < 4; ++db) { const u32x2 g = gx[rb][db];
            *(u32x2*)(Y + (size_t)t * D + 768 + h * 64 + db * 16 + quad * 4) = pack4(o4[db][0] * inv * silu_f(bf2f(g.x & 0xffffu)), o4[db][1] * inv * silu_f(bf2f(g.x >> 16)),
                                                                                   o4[db][2] * inv * silu_f(bf2f(g.y & 0xffffu)), o4[db][3] * inv * silu_f(bf2f(g.y >> 16))); }
        __builtin_amdgcn_sched_barrier(0);
    }
    BAR_LDS();
}

__device__ __forceinline__ void conv_issue(const bf16* U, int ts, int col, bf16x8 (&rows)[11]) {
#pragma unroll
    for (int i = 0; i < 11; ++i) { const int tt = ts - 3 + i; rows[i] = *(const bf16x8*)(U + (size_t)(tt < 0 ? 0 : tt) * NU + col); }
}
__device__ __forceinline__ void conv_weights(const float* cw, const float* cb, int col, LAS float* cwS, int tid) {
    const int j = tid & 7, cg = tid >> 3;
    if (j < 5) { const float* src = j < 4 ? cw + j * 1024 + col : cb + col;
        const f32x4 w0 = *(const f32x4*)src, w1 = *(const f32x4*)(src + 4);
        *(LAS f32x4*)(cwS + j * 512 + cg * 8) = w0; *(LAS f32x4*)(cwS + j * 512 + cg * 8 + 4) = w1; }
}
__device__ __forceinline__ void conv_math(bf16x8 (&rows)[11], int ts, const LAS float* cwS, int cg, float (&o)[8][8]) {
    if (ts < 3) {
#pragma unroll
        for (int i = 0; i < 3; ++i) if (ts - 3 + i < 0) rows[i] = (bf16x8){0, 0, 0, 0, 0, 0, 0, 0}; }
    float w[5][8];
#pragma unroll
    for (int j = 0; j < 5; ++j) { const f32x4 w0 = *(const LAS f32x4*)(cwS + j * 512 + cg * 8), w1 = *(const LAS f32x4*)(cwS + j * 512 + cg * 8 + 4);
#pragma unroll
        for (int e = 0; e < 4; ++e) { w[j][e] = w0[e]; w[j][4 + e] = w1[e]; } }
#pragma unroll
    for (int tok = 0; tok < 8; ++tok)
#pragma unroll
        for (int k = 0; k < 8; ++k) {
            const float a = w[4][k] + w[0][k] * us2f(rows[tok][k]) + w[1][k] * us2f(rows[tok + 1][k]) + w[2][k] * us2f(rows[tok + 2][k]) + w[3][k] * us2f(rows[tok + 3][k]);
            o[tok][k] = silu_f(a); }
}
__device__ __forceinline__ void ssd_dt(float dtb, float A, float raw, LAS float* dtS, LAS float* acS, int tid) {
    if (tid < 256) { const int hh = tid >> 6, q = tid & 63;
        const float dt = softplus_f(raw + dtb);
        float v = dt * A;
#pragma unroll
        for (int o = 1; o < 64; o <<= 1) { const float t = __shfl_up(v, o); if (q >= o) v += t; }
        dtS[hh * 64 + q] = dt; acS[hh * 64 + q] = v; }
}
constexpr int S1_LDS = 2048 + (4 * 64 * 72 + 128 * 72) * 2;
__device__ __forceinline__ void stage_ssd_s1(const Params& P, int l, LAS unsigned char* lds, int first, int stride, int end) {
    const int tid = otid(), lane = tid & 63, wave = tid >> 6, quad = lane >> 4, l15 = lane & 15;
    LAS float* dtS = (LAS float*)lds; LAS float* acS = dtS + 256; LAS bf16* XT = (LAS bf16*)(lds + 2048); LAS bf16* BT = XT + 4 * 64 * 72;
    const bf16* U = (const bf16*)(P.ws + WS_U);
    const int tseg = tid & 7, cg = tid < 384 ? tid >> 3 : 0; const bool isx = cg < 32;
    const int j0 = isx ? cg * 8 : (cg - 32) * 8;
#define S1_COL(it) (isx ? C_XS + ((it) & 1) * 256 + j0 : C_B + ((it) & 1) * 128 + j0)
#define S1_RAW(it) (tid < 256 ? bf2f(U[(size_t)(((it) >> 1) * 64 + (tid & 63)) * NU + C_DT + ((it) & 1) * 4 + (tid >> 6)]) : 0.f)
    bf16x8 rows[11]; float raw = S1_RAW(first);
    conv_issue(U, (first >> 1) * 64 + tseg * 8, S1_COL(first), rows);
    LAS float* cwS = (LAS float*)(lds + S1_LDS);
    if (tid < 384) conv_weights(PBP(P, PB_CONVW) + (size_t)l * 4 * 1024, PBP(P, PB_CONVB) + l * 1024, S1_COL(first), cwS, tid);
    BAR_LDS();
    const int hq = l * 8 + (first & 1) * 4 + ((tid >> 6) & 3); const float dtb = PBP(P, PB_DTB)[hq], Aneg = -__expf(PBP(P, PB_ALOG)[hq]);
    for (int item = first; item < end; item += stride) {
    const int c = item >> 1, g = item & 1, t0 = c * 64, col = S1_COL(item);
    float o[8][8];
    conv_math(rows, t0 + tseg * 8, cwS, cg, o);
    ssd_dt(dtb, Aneg, raw, dtS, acS, tid);
    {   const int nx = item + stride < end ? item + stride : item;
        raw = S1_RAW(nx); conv_issue(U, (nx >> 1) * 64 + tseg * 8, S1_COL(nx), rows); }
    BAR_LDS();
    if (tid < 384) {
        const int hh = j0 >> 6, p0 = j0 & 63;
        float sc[8];
#pragma unroll
        for (int tok = 0; tok < 8; ++tok) { const int q = tseg * 8 + tok; sc[tok] = isx ? dtS[hh * 64 + q] * __expf(acS[hh * 64 + 63] - acS[hh * 64 + q]) : 1.f; }
        LAS bf16* dst = isx ? XT + (hh * 64 + p0) * 72 + tseg * 8 : BT + j0 * 72 + tseg * 8;
#pragma unroll
        for (int k = 0; k < 8; ++k) { float v[8];
#pragma unroll
            for (int tok = 0; tok < 8; ++tok) v[tok] = o[tok][k] * sc[tok];
            *(LAS bf16x8*)(dst + k * 72) = pack8(v); }
    }
    BAR_LDS();
    { const int hh = wave >> 1, nh = wave & 1, h = g * 4 + hh;
        bf16* ST = (bf16*)(P.ws + WS_ST) + ((size_t)(c * 8 + h) * 64) * 128;
#pragma unroll
        for (int pb = 0; pb < 4; ++pb)
#pragma unroll
            for (int nb = 0; nb < 4; ++nb) { f32x4 acc = (f32x4){0.f, 0.f, 0.f, 0.f};
#pragma unroll
                for (int ks = 0; ks < 2; ++ks) acc = MFMA16(ld_frag(BT, 72, nh * 64 + nb * 16, ks * 32, lane), ld_frag(XT + hh * 64 * 72, 72, pb * 16, ks * 32, lane), acc);
                *(u32x2*)(ST + (size_t)(pb * 16 + l15) * 128 + nh * 64 + nb * 16 + quad * 4) = pack4(acc[0], acc[1], acc[2], acc[3]); }
        if (tid < 4) ((float*)(P.ws + WS_CD))[c * 8 + g * 4 + tid] = __expf(acS[tid * 64 + 63]);
    }
    BAR_LDS();
    }
#undef S1_COL
#undef S1_RAW
}
__device__ __forceinline__ void stage_ssd_scan(const Params& P, LAS unsigned char* lds, int blk) {
    const int tid = otid(), pi = tid & 63, seg = tid >> 6;
    LAS float* cdS = (LAS float*)lds; LAS float* segL = cdS + 256; LAS float* segD = segL + 8 * 128;
    bf16* ST = (bf16*)(P.ws + WS_ST); const float* CD = (const float*)(P.ws + WS_CD);
    const int e0 = blk * 128 + pi * 2, h = (blk * 128) >> 13;
    if (tid < 256) cdS[tid] = CD[tid * 8 + h];
    unsigned v[32];
#pragma unroll
    for (int k = 0; k < 32; ++k) v[k] = *(const unsigned*)(ST + (size_t)(seg * 32 + k) * 65536 + e0);
    BAR_LDS();
    float L0 = 0.f, L1 = 0.f, Dt = 1.f;
#pragma unroll
    for (int k = 0; k < 32; ++k) { const float d = cdS[seg * 32 + k]; L0 = L0 * d + bf2f(v[k] & 0xffffu); L1 = L1 * d + bf2f(v[k] >> 16); Dt *= d; }
    segL[seg * 128 + pi * 2] = L0; segL[seg * 128 + pi * 2 + 1] = L1; if (pi == 0) segD[seg] = Dt;
    BAR_LDS();
    float c0 = 0.f, c1 = 0.f;
    for (int s2 = 0; s2 < seg; ++s2) { const float d = segD[s2]; c0 = c0 * d + segL[s2 * 128 + pi * 2]; c1 = c1 * d + segL[s2 * 128 + pi * 2 + 1]; }
#pragma unroll
    for (int k = 0; k < 32; ++k) { const float d = cdS[seg * 32 + k]; const unsigned o = f2bf(c0) | (f2bf(c1) << 16);
        c0 = c0 * d + bf2f(v[k] & 0xffffu); c1 = c1 * d + bf2f(v[k] >> 16);
        *(unsigned*)(ST + (size_t)(seg * 32 + k) * 65536 + e0) = o; }
    BAR_LDS();
}
constexpr int S3_LDS = 3072 + (2 * 64 * 136 + 4 * 64 * 72 + 8 * 32 * 72) * 2;
__device__ __forceinline__ void stage_ssd_s3(const Params& P, int l, LAS unsigned char* lds, int first, int stride, int end) {
    const int tid = otid(), lane = tid & 63, wave = tid >> 6, quad = lane >> 4, l15 = lane & 15;
    LAS float* dtS = (LAS float*)lds; LAS float* acS = dtS + 256; LAS float* red = acS + 256;
    LAS bf16* Cn = (LAS bf16*)(lds + 3072); LAS bf16* Bn = Cn + 64 * 136; LAS bf16* XT = Bn + 64 * 136; LAS bf16* SCw = XT + 4 * 64 * 72 + wave * 32 * 72;
    const bf16* U = (const bf16*)(P.ws + WS_U); bf16* Y = (bf16*)(P.ws + WS_H);
    const int hh = wave >> 1, qh = wave & 1;
    const int tseg = tid & 7, cg = tid >> 3; const int kind = cg < 32 ? 0 : (cg < 48 ? 1 : 2);
    const int j0 = kind == 0 ? cg * 8 : (kind == 1 ? (cg - 32) * 8 : (cg - 48) * 8);
#define S3_COL(it) (kind == 0 ? C_XS + ((it) & 1) * 256 + j0 : (kind == 1 ? C_B + ((it) & 1) * 128 + j0 : C_C + ((it) & 1) * 128 + j0))
#define S3_RAW(it) (tid < 256 ? bf2f(U[(size_t)(((it) >> 1) * 64 + (tid & 63)) * NU + C_DT + ((it) & 1) * 4 + (tid >> 6)]) : 0.f)
    bf16x8 rows[11]; float raw = S3_RAW(first);
    conv_issue(U, (first >> 1) * 64 + tseg * 8, S3_COL(first), rows);
    LAS float* cwS = (LAS float*)(lds + S3_LDS);
    conv_weights(PBP(P, PB_CONVW) + (size_t)l * 4 * 1024, PBP(P, PB_CONVB) + l * 1024, S3_COL(first), cwS, tid);
    LAS float* nwS = cwS + 2560; if (tid < 256) nwS[tid] = PBP(P, PB_SSMNW)[l * 512 + (first & 1) * 256 + tid];
    BAR_LDS();
    const int hq = l * 8 + (first & 1) * 4 + ((tid >> 6) & 3); const float dtb = PBP(P, PB_DTB)[hq], Aneg = -__expf(PBP(P, PB_ALOG)[hq]);
    const float dsk = PBP(P, PB_DSKIP)[l * 8 + (first & 1) * 4 + hh];
    for (int item = first; item < end; item += stride) {
    const int tid = otid(), lane = tid & 63, wave = tid >> 6, quad = lane >> 4, l15 = lane & 15, hh = wave >> 1, qh = wave & 1;
    const int tseg = tid & 7, cg = tid >> 3; const int kind = cg < 32 ? 0 : (cg < 48 ? 1 : 2); const int j0 = kind == 0 ? cg * 8 : (kind == 1 ? (cg - 32) * 8 : (cg - 48) * 8);
    LAS bf16* SCw = XT + 4 * 64 * 72 + wave * 32 * 72;
    const int c = item >> 1, g = item & 1, t0 = c * 64, h = g * 4 + hh;
    u32x2 zz[2][4];
#pragma unroll
    for (int qb = 0; qb < 2; ++qb)
#pragma unroll
        for (int pb = 0; pb < 4; ++pb) zz[qb][pb] = *(const u32x2*)(U + (size_t)(t0 + qh * 32 + qb * 16 + l15) * NU + C_Z + h * 64 + pb * 16 + quad * 4);
    {   float o[8][8];
        conv_math(rows, t0 + tseg * 8, cwS, cg, o);
        ssd_dt(dtb, Aneg, raw, dtS, acS, tid);
        {   const int nx = item + stride < end ? item + stride : item;
            raw = S3_RAW(nx); conv_issue(U, (nx >> 1) * 64 + tseg * 8, S3_COL(nx), rows); }
        BAR_LDS();
        if (kind == 0) { const int hh2 = j0 >> 6, p0 = j0 & 63;
#pragma unroll
            for (int k = 0; k < 8; ++k) { float v[8];
#pragma unroll
                for (int tok = 0; tok < 8; ++tok) v[tok] = o[tok][k] * dtS[hh2 * 64 + tseg * 8 + tok];
                *(LAS bf16x8*)(XT + (hh2 * 64 + p0 + k) * 72 + tseg * 8) = pack8(v); }
        } else { LAS bf16* dst = (kind == 1 ? Bn : Cn) + (tseg * 8) * 136 + j0;
#pragma unroll
            for (int tok = 0; tok < 8; ++tok) *(LAS bf16x8*)(dst + tok * 136) = pack8(o[tok]); }
    }
    const bf16* ST = (const bf16*)(P.ws + WS_ST) + ((size_t)(c * 8 + h) * 64) * 128;
    bf16x8 pf[4][4];
#pragma unroll
    for (int pb = 0; pb < 4; ++pb)
#pragma unroll
        for (int ks = 0; ks < 4; ++ks) pf[pb][ks] = *(const bf16x8*)(ST + (size_t)(pb * 16 + l15) * 128 + ks * 32 + quad * 8);
    BAR_LDS();
#pragma unroll
    for (int qb = 0; qb < 2; ++qb)
#pragma unroll
        for (int sb = 0; sb < 4; ++sb) { f32x4 acc = (f32x4){0.f, 0.f, 0.f, 0.f};
#pragma unroll
            for (int ks = 0; ks < 4; ++ks) acc = MFMA16(ld_frag(Bn, 136, sb * 16, ks * 32, lane), ld_frag(Cn, 136, qh * 32 + qb * 16, ks * 32, lane), acc);
            const int q = qh * 32 + qb * 16 + l15; const float aq = acS[hh * 64 + q]; float v[4];
#pragma unroll
            for (int r = 0; r < 4; ++r) { const int s_ = sb * 16 + quad * 4 + r; v[r] = (s_ <= q) ? acc[r] * __expf(aq - acS[hh * 64 + s_]) : 0.f; }
            *(LAS u32x2*)(SCw + (qb * 16 + l15) * 72 + sb * 16 + quad * 4) = pack4(v[0], v[1], v[2], v[3]); }
    asm volatile("s_waitcnt lgkmcnt(0)" ::: "memory");
    f32x4 y[2][4];
    float ssq[2] = {0.f, 0.f};
#pragma unroll
    for (int qb = 0; qb < 2; ++qb)
#pragma unroll
        for (int pb = 0; pb < 4; ++pb) { f32x4 yd = (f32x4){0.f, 0.f, 0.f, 0.f}, yo = (f32x4){0.f, 0.f, 0.f, 0.f};
#pragma unroll
            for (int ks = 0; ks < 2; ++ks) yd = MFMA16(ld_frag(XT + hh * 64 * 72, 72, pb * 16, ks * 32, lane), ld_frag(SCw, 72, qb * 16, ks * 32, lane), yd);
#pragma unroll
            for (int ks = 0; ks < 4; ++ks) yo = MFMA16(pf[pb][ks], ld_frag(Cn, 136, qh * 32 + qb * 16, ks * 32, lane), yo);
            const int q = qh * 32 + qb * 16 + l15; const float eq = __expf(acS[hh * 64 + q]), idt = __builtin_amdgcn_rcpf(dtS[hh * 64 + q]);
            const u32x2 z2 = zz[qb][pb];
#pragma unroll
            for (int r = 0; r < 4; ++r) { const int p = pb * 16 + quad * 4 + r;
                const float xs = bf2f(XT[(hh * 64 + p) * 72 + q]) * idt;
                const unsigned zw = r < 2 ? z2.x : z2.y; const float z = bf2f((r & 1) ? (zw >> 16) : (zw & 0xffffu));
                const float v = (yd[r] + eq * yo[r] + dsk * xs) * silu_f(z);
                y[qb][pb][r] = v; ssq[qb] += v * v; } }
#pragma unroll
    for (int qb = 0; qb < 2; ++qb) { float s_ = ssq[qb]; s_ += __shfl_xor(s_, 16); s_ += __shfl_xor(s_, 32);
        if (quad == 0) red[hh * 64 + qh * 32 + qb * 16 + l15] = s_; }
    BAR_LDS();
#pragma unroll
    for (int qb = 0; qb < 2; ++qb) { const int q = qh * 32 + qb * 16 + l15;
        const float tot = red[q] + red[64 + q] + red[128 + q] + red[192 + q]; const float rstd = rsqrtf(tot * (1.f / 256.f) + NORM_EPS);
#pragma unroll
        for (int pb = 0; pb < 4; ++pb) { const int p = pb * 16 + quad * 4; const f32x4 nw = *(const LAS f32x4*)(nwS + hh * 64 + p);
            *(u32x2*)(Y + (size_t)(t0 + q) * D + h * 64 + p) = pack4(y[qb][pb][0] * rstd * nw[0], y[qb][pb][1] * rstd * nw[1], y[qb][pb][2] * rstd * nw[2], y[qb][pb][3] * rstd * nw[3]); } }
    BAR_LDS();
    }
#undef S3_COL
#undef S3_RAW
}

constexpr int RW_AT = 0, RW_RT = 9216, RW_KT = 18432, RW_BT = 27648, RW_VT = 36864, RW_KHT = 46080, RW_BHT = 55296, RW_X1T = 64512, RW_X2T = 73728,
              RW_MAK = 82944, RW_MRK = 92160, RW_MRB = 101376, RW_MAB = 110592, RW_TOT = 128000, RW_WC = 130048, RW_AAF = 130304, RW_END = 146688;
constexpr int RW_RHS2 = RW_KT;
constexpr int RW_LATW = RW_X1T, RW_LATA = RW_X2T, RW_W2T = RW_MAK, RW_A2T = RW_MRK, RW_AWF = RW_MAB;
constexpr int RW_MOFF = RW_AAF, RW_TB = RW_AAF + 9216, RW_RPT = RW_MAK;
__device__ __forceinline__ float tanh_f(float x) { return 1.f - 2.f * __builtin_amdgcn_rcpf(1.f + __expf(2.f * x)); }

__device__ __forceinline__ void stage_rwkv_p1(const Params& P, int l, LAS unsigned char* lds, int first, int stride, int end) {
    const int tid = otid(), lane = tid & 63, wave = __builtin_amdgcn_readfirstlane(tid >> 6), quad = lane >> 4, l15 = lane & 15;
    const int h = first & 3;
    LAS bf16* At = (LAS bf16*)(lds + RW_AT); LAS bf16* Rt = (LAS bf16*)(lds + RW_RT); LAS bf16* Kt = (LAS bf16*)(lds + RW_KT); LAS bf16* Bt = (LAS bf16*)(lds + RW_BT);
    LAS bf16* VT = (LAS bf16*)(lds + RW_VT); LAS bf16* KhT = (LAS bf16*)(lds + RW_KHT); LAS bf16* BhT = (LAS bf16*)(lds + RW_BHT);
    LAS bf16* X1T = (LAS bf16*)(lds + RW_X1T); LAS bf16* X2T = (LAS bf16*)(lds + RW_X2T);
    LAS bf16* Mak = (LAS bf16*)(lds + RW_MAK); LAS bf16* Mrk = (LAS bf16*)(lds + RW_MRK); LAS bf16* Mrb = (LAS bf16*)(lds + RW_MRB);
    LAS float* Mab = (LAS float*)(lds + RW_MAB); LAS float* RHS2 = (LAS float*)(lds + RW_RHS2);
    LAS float* tot = (LAS float*)(lds + RW_TOT); LAS float* wCs = (LAS float*)(lds + RW_WC); LAS float* aaF = (LAS float*)(lds + RW_AAF); LAS float* awF = (LAS float*)(lds + RW_AWF);
    LAS bf16* latw = (LAS bf16*)(lds + RW_LATW); LAS bf16* lata = (LAS bf16*)(lds + RW_LATA); LAS bf16* w2T = (LAS bf16*)(lds + RW_W2T); LAS bf16* a2T = (LAS bf16*)(lds + RW_A2T);
    LAS bf16* Moff = (LAS bf16*)(lds + RW_MOFF); LAS bf16* Tb = (LAS bf16*)(lds + RW_TB);
    const bf16* U = (const bf16*)(P.ws + WS_U);
    const float* mu = PBP(P, PB_MU) + (size_t)l * 1152;
    bf16x8 cr, ck, cv, pr, pk, pv, cw, ca, pw, pa;
#define P1_ISSUE_A(pi_) do { const int tg_ = ((pi_) >> 2) * 64 + (tid >> 3); const bf16* uc_ = U + (size_t)tg_ * NU + C_WL + (tid & 7) * 8; const bf16* up2_ = tg_ > 0 ? uc_ - NU : uc_; \
        cw = *(const bf16x8*)uc_; ca = *(const bf16x8*)(uc_ + 64); pw = *(const bf16x8*)up2_; pa = *(const bf16x8*)(up2_ + 64); } while (0)
#define P1_ISSUE_B(pi_) do { const int tg_ = ((pi_) >> 2) * 64 + (tid >> 3); const bf16* ucr_ = U + (size_t)tg_ * NU + h * 64 + (tid & 7) * 8; const bf16* upr_ = tg_ > 0 ? ucr_ - NU : ucr_; \
        cr = *(const bf16x8*)(ucr_ + C_R); ck = *(const bf16x8*)(ucr_ + C_K); cv = *(const bf16x8*)(ucr_ + C_V); pr = *(const bf16x8*)(upr_ + C_R); pk = *(const bf16x8*)(upr_ + C_K); pv = *(const bf16x8*)(upr_ + C_V); } while (0)
    P1_ISSUE_A(first);
    const bf16* wt = (const bf16*)(P.ws + WS_W2T) + (size_t)((l * 4 + h) * 64 + (tid >> 3)) * 64 + (tid & 7) * 8;
    const bf16x8 w2i = *(const bf16x8*)wt, a2i = *(const bf16x8*)(wt + 65536);
    for (int pi = first; pi < end; pi += stride) {
    const int tid = otid(), lane = tid & 63, quad = lane >> 4, l15 = lane & 15;
    const int c = pi >> 2, t0 = c * 64;
    P1_ISSUE_B(pi);
    f32x4 muw[2], mua[2], kc[8][2];
#pragma unroll
    for (int q4 = 0; q4 < 2; ++q4) { const int gch4 = h * 64 + (tid & 7) * 8 + q4 * 4, pc4 = l * 256 + gch4;
        muw[q4] = *(const f32x4*)(mu + 1024 + (tid & 7) * 8 + q4 * 4); mua[q4] = *(const f32x4*)(mu + 1088 + (tid & 7) * 8 + q4 * 4);
        kc[0][q4] = *(const f32x4*)(mu + gch4); kc[1][q4] = *(const f32x4*)(mu + 256 + gch4); kc[2][q4] = *(const f32x4*)(mu + 512 + gch4);
        kc[3][q4] = *(const f32x4*)(PBP(P, PB_W0) + pc4); kc[4][q4] = *(const f32x4*)(PBP(P, PB_A0) + pc4); kc[5][q4] = *(const f32x4*)(PBP(P, PB_KK) + pc4);
        kc[6][q4] = *(const f32x4*)(PBP(P, PB_KA) + pc4); kc[7][q4] = *(const f32x4*)(PBP(P, PB_RK) + pc4); }
    {   const int t = tid >> 3, jg = tid & 7, tg = t0 + t;
        if (tg == 0) { pw = (bf16x8){0, 0, 0, 0, 0, 0, 0, 0}; pa = pw; pr = pw; pk = pw; pv = pw; }
        float ow[8], oa[8];
#pragma unroll
        for (int jj = 0; jj < 8; ++jj) {
            const float c1 = us2f(cw[jj]), p1 = us2f(pw[jj]); ow[jj] = tanh_f(c1 + (p1 - c1) * muw[jj >> 2][jj & 3]);
            const float c2 = us2f(ca[jj]), p2 = us2f(pa[jj]); oa[jj] = c2 + (p2 - c2) * mua[jj >> 2][jj & 3]; }
        *(LAS bf16x8*)(latw + t * 72 + jg * 8) = pack8(ow); *(LAS bf16x8*)(lata + t * 72 + jg * 8) = pack8(oa);
        *(LAS bf16x8*)(w2T + t * 72 + jg * 8) = w2i; *(LAS bf16x8*)(a2T + t * 72 + jg * 8) = a2i;
    }
    BAR_LDS();
    {   const int tb = wave & 3; const bool isA = wave >= 4;
        const LAS bf16* Am = isA ? lata : latw; const LAS bf16* Bm = isA ? a2T : w2T; LAS float* Of = isA ? aaF : awF; const int ofs = isA ? 64 : 68;
#pragma unroll
        for (int cb = 0; cb < 4; ++cb) { f32x4 acc = (f32x4){0.f, 0.f, 0.f, 0.f};
#pragma unroll
            for (int ks = 0; ks < 2; ++ks) acc = MFMA16(ld_frag(Am, 72, tb * 16, ks * 32, lane), ld_frag(Bm, 72, cb * 16, ks * 32, lane), acc);
#pragma unroll
            for (int r = 0; r < 4; ++r) Of[(tb * 16 + quad * 4 + r) * ofs + cb * 16 + l15] = acc[r]; }
    }
    BAR_LDS();
    {   const int t = tid >> 3, cg = tid & 7, tg = t0 + t, ch0 = cg * 8, gch = h * 64 + ch0;
        float rr[8], k2[8], vv[8], kkn[8], aS[8], lw[8], Lc[8];
        float ss = 0.f, bsum = 0.f;
#pragma unroll
        for (int jj = 0; jj < 8; ++jj) {
            float a_ = us2f(cr[jj]), b_ = us2f(pr[jj]); const float r = a_ + (b_ - a_) * kc[0][jj >> 2][jj & 3];
            a_ = us2f(ck[jj]); b_ = us2f(pk[jj]); const float k = a_ + (b_ - a_) * kc[1][jj >> 2][jj & 3];
            a_ = us2f(cv[jj]); b_ = us2f(pv[jj]); const float v = a_ + (b_ - a_) * kc[2][jj >> 2][jj & 3];
            const float aw = awF[t * 68 + ch0 + jj] + kc[3][jj >> 2][jj & 3], aa = aaF[t * 64 + ch0 + jj] + kc[4][jj >> 2][jj & 3];
            lw[jj] = -0.60653066f * sigmoid_f(aw); const float a = sigmoid_f(aa);
            const float kr = k * kc[5][jj >> 2][jj & 3]; ss += kr * kr; kkn[jj] = kr;
            k2[jj] = k * (1.f + (a - 1.f) * kc[6][jj >> 2][jj & 3]); aS[jj] = a; rr[jj] = r; vv[jj] = v;
            bsum += r * k2[jj] * kc[7][jj >> 2][jj & 3]; Lc[jj] = lw[jj]; }
        { const int nx = pi + stride < end ? pi + stride : pi; P1_ISSUE_A(nx); }
#pragma unroll
        for (int o = 1; o < 8; o <<= 1) { ss += __shfl_xor(ss, o); bsum += __shfl_xor(bsum, o); }
        const float inv = 1.f / fmaxf(sqrtf(ss), 1e-12f);
        if (cg == 0) ((float*)(P.ws + WS_BS))[(size_t)tg * 4 + h] = bsum;
#pragma unroll
        for (int o = 8; o < 64; o <<= 1)
#pragma unroll
            for (int jj = 0; jj < 8; ++jj) { const float tmp = __shfl_up(Lc[jj], o); if (lane >= o) Lc[jj] += tmp; }
        if ((lane >> 3) == 7) {
#pragma unroll
            for (int jj = 0; jj < 8; ++jj) tot[wave * 64 + ch0 + jj] = Lc[jj]; }
        BAR_LDS();
        float oA[8], oR[8], oK[8], oB[8];
#pragma unroll
        for (int jj = 0; jj < 8; ++jj) { float base = 0.f, LC = 0.f;
#pragma unroll
            for (int w2 = 0; w2 < 8; ++w2) { const float tv = tot[w2 * 64 + ch0 + jj]; base += w2 < wave ? tv : 0.f; LC += tv; }
            const float L = Lc[jj] + base; const float kk = kkn[jj] * inv, b = kk * aS[jj];
            const float eL = __expf(L), eiL = __expf(-L), eh = __expf(LC - L);
            oA[jj] = -kk * __expf(L - lw[jj]); oR[jj] = rr[jj] * eL; oK[jj] = k2[jj] * eiL; oB[jj] = b * eiL;
            VT[(ch0 + jj) * 72 + t] = (bf16)f2bf(vv[jj]); KhT[(ch0 + jj) * 72 + t] = (bf16)f2bf(k2[jj] * eh); BhT[(ch0 + jj) * 72 + t] = (bf16)f2bf(b * eh);
            if (t == 63) wCs[ch0 + jj] = __expf(LC); }
        *(LAS bf16x8*)(At + t * 72 + ch0) = pack8(oA); *(LAS bf16x8*)(Rt + t * 72 + ch0) = pack8(oR); *(LAS bf16x8*)(Kt + t * 72 + ch0) = pack8(oK); *(LAS bf16x8*)(Bt + t * 72 + ch0) = pack8(oB);
    }
    BAR_LDS();
    {   const int mat = wave >> 1, half = wave & 1;
        const LAS bf16* Am = mat < 2 ? At : Rt; const LAS bf16* Bm = (mat == 0 || mat == 3) ? Bt : Kt;
        LAS bf16* Ob = mat == 1 ? Mak : (mat == 2 ? Mrk : Mrb);
#pragma unroll
        for (int tbi = 0; tbi < 2; ++tbi)
#pragma unroll
            for (int sb = 0; sb < 4; ++sb) { const int tb = half * 2 + tbi; f32x4 acc = (f32x4){0.f, 0.f, 0.f, 0.f};
                if (sb <= tb) {
#pragma unroll
                    for (int ks = 0; ks < 2; ++ks) acc = MFMA16(ld_frag(Am, 72, tb * 16, ks * 32, lane), ld_frag(Bm, 72, sb * 16, ks * 32, lane), acc); }
#pragma unroll
                for (int r = 0; r < 4; ++r) { const int t = tb * 16 + quad * 4 + r, s_ = sb * 16 + l15;
                    const bool keep = mat < 2 ? (s_ < t) : (s_ <= t); const float val = keep ? acc[r] : 0.f;
                    if (mat == 0) { Mab[t * 68 + s_] = val; Moff[t * 72 + s_] = (bf16)(sb < tb ? f2bf(val) : 0u); } else Ob[t * 72 + s_] = (bf16)f2bf(val); } }
    }
    BAR_LDS();
    if (wave == 0) {
        for (int e = lane; e < 320; e += 64) *(LAS u32x4v*)(Tb + e * 8) = (u32x4v){0u, 0u, 0u, 0u};
        const int b = quad, cc = l15;
        unsigned ma = (unsigned)(uintptr_t)(Mab + (16 * b) * 68 + 16 * b); asm volatile("" : "+v"(ma)); const LAS float* Mv = (const LAS float*)(uintptr_t)ma;
        float x[16], mrow[16][16];
#pragma unroll
        for (int t = 1; t < 16; ++t)
#pragma unroll
            for (int s_ = 0; s_ < t; ++s_) mrow[t][s_] = Mv[t * 68 + s_];
#pragma unroll
        for (int t = 0; t < 16; ++t) { float a = t == cc ? 1.f : 0.f;
#pragma unroll
            for (int s_ = 0; s_ < t; ++s_) a += mrow[t][s_] * x[s_];
            x[t] = a; }
#pragma unroll
        for (int t = 0; t < 16; ++t) Tb[(b * 16 + t) * 40 + cc] = (bf16)f2bf(x[t]);
    } else {
        for (int tile = wave - 1; tile < 16; tile += 7) { const int tb = tile >> 2, ib = tile & 3; f32x4 acc = (f32x4){0.f, 0.f, 0.f, 0.f};
#pragma unroll
            for (int ks = 0; ks < 2; ++ks) acc = MFMA16(ld_frag(Mak, 72, tb * 16, ks * 32, lane), ld_frag(VT, 72, ib * 16, ks * 32, lane), acc);
#pragma unroll
            for (int r = 0; r < 4; ++r) RHS2[(tb * 16 + quad * 4 + r) * 68 + ib * 16 + l15] = acc[r]; }
    }
    BAR_LDS();
    {   LAS bf16* XTw = (wave < 4 ? X1T : X2T) + (wave & 3) * 16 * 72; LAS bf16* Rp = (LAS bf16*)(lds + RW_RPT) + wave * 512;
        for (int e = lane; e < 144; e += 64) *(LAS u32x4v*)(XTw + e * 8) = (u32x4v){0u, 0u, 0u, 0u};
        *(LAS u32x4v*)(Rp + lane * 8) = (u32x4v){0u, 0u, 0u, 0u};
#pragma unroll
        for (int b = 0; b < 4; ++b) {
            f32x4 acc;
#pragma unroll
            for (int r = 0; r < 4; ++r) { const int t = 16 * b + quad * 4 + r; acc[r] = wave < 4 ? bf2f(At[t * 72 + wave * 16 + l15]) : RHS2[t * 68 + (wave - 4) * 16 + l15]; }
            asm volatile("s_waitcnt lgkmcnt(0)" ::: "memory");
            if (b >= 1) acc = MFMA16(ld_frag(Moff, 72, 16 * b, 0, lane), ld_frag(XTw, 72, 0, 0, lane), acc);
            if (b == 3) acc = MFMA16(ld_frag(Moff, 72, 48, 32, lane), ld_frag(XTw, 72, 0, 32, lane), acc);
            *(LAS u32x2*)(Rp + l15 * 32 + quad * 4) = pack4(acc[0], acc[1], acc[2], acc[3]);
            asm volatile("s_waitcnt lgkmcnt(0)" ::: "memory");
            const f32x4 xb = MFMA16(ld_frag(Tb + b * 640, 40, 0, 0, lane), ld_frag(Rp, 32, 0, 0, lane), ((f32x4){0.f, 0.f, 0.f, 0.f}));
            *(LAS u32x2*)(XTw + l15 * 72 + 16 * b + quad * 4) = pack4(xb[0], xb[1], xb[2], xb[3]);
            asm volatile("s_waitcnt lgkmcnt(0)" ::: "memory");
        }
    }
    BAR_LDS();
    {   const int mat = wave >> 1, half = wave & 1;
        bf16* Q1g = (bf16*)(P.ws + WS_Q1) + (size_t)pi * 4096; bf16* Y0g = (bf16*)(P.ws + WS_Y0) + (size_t)pi * 4096;
        bf16* PcTg = (bf16*)(P.ws + WS_PCT) + (size_t)pi * 4096; bf16* Gcg = (bf16*)(P.ws + WS_GC) + (size_t)pi * 4096;
        const LAS bf16* A1 = (mat == 0 || mat == 2) ? X1T : (mat == 1 ? VT : KhT);
        const LAS bf16* B1 = mat == 0 ? Mrb : (mat == 1 ? Mrk : (mat == 2 ? BhT : VT));
        const LAS bf16* A2 = mat == 1 ? X2T : BhT; const LAS bf16* B2 = mat == 1 ? Mrb : X2T;
#pragma unroll
        for (int rbi = 0; rbi < 2; ++rbi)
#pragma unroll
            for (int cb = 0; cb < 4; ++cb) { const int rb = half * 2 + rbi; f32x4 acc = (f32x4){0.f, 0.f, 0.f, 0.f};
#pragma unroll
                for (int ks = 0; ks < 2; ++ks) acc = MFMA16(ld_frag(A1, 72, rb * 16, ks * 32, lane), ld_frag(B1, 72, cb * 16, ks * 32, lane), acc);
                if (mat == 1 || mat == 3) {
#pragma unroll
                    for (int ks = 0; ks < 2; ++ks) acc = MFMA16(ld_frag(A2, 72, rb * 16, ks * 32, lane), ld_frag(B2, 72, cb * 16, ks * 32, lane), acc); }
                const int r0 = rb * 16 + quad * 4, cl = cb * 16 + l15;
                if (mat == 0) { const u32x2 rt = *(const LAS u32x2*)(Rt + cl * 72 + r0);
                    *(u32x2*)(Q1g + cl * 64 + r0) = pack4(acc[0] + bf2f(rt.x & 0xffffu), acc[1] + bf2f(rt.x >> 16), acc[2] + bf2f(rt.y & 0xffffu), acc[3] + bf2f(rt.y >> 16)); }
                else if (mat == 1) *(u32x2*)(Y0g + cl * 64 + r0) = pack4(acc[0], acc[1], acc[2], acc[3]);
                else if (mat == 2) { const float wc = wCs[cl];
                    *(u32x2*)(PcTg + cl * 64 + r0) = pack4(acc[0] + (r0 == cl ? wc : 0.f), acc[1] + (r0 + 1 == cl ? wc : 0.f), acc[2] + (r0 + 2 == cl ? wc : 0.f), acc[3] + (r0 + 3 == cl ? wc : 0.f)); }
                else *(u32x2*)(Gcg + ((cb * 64 + lane) * 4 + rb) * 4) = pack4(acc[0], acc[1], acc[2], acc[3]); }
    }
    BAR_LDS();
    }
#undef P1_ISSUE_A
#undef P1_ISSUE_B
}

constexpr int CH_PT = 0, CH_SB = 8 * 9216, CH_END = CH_SB + 8 * 2304;
__device__ __forceinline__ void chain_step(f32x4 (&acc)[4], const LAS bf16* PTs, LAS bf16* Sb, const u32x4v (&gf)[2], bool withG, int lane) {
    const int quad = lane >> 4, l15 = lane & 15;
#pragma unroll
    for (int jb = 0; jb < 4; ++jb) *(LAS u32x2*)(Sb + l15 * 72 + jb * 16 + quad * 4) = pack4(acc[jb][0], acc[jb][1], acc[jb][2], acc[jb][3]);
    asm volatile("s_waitcnt lgkmcnt(0)" ::: "memory");
    const bf16x8 b0 = ld_frag(Sb, 72, 0, 0, lane), b1 = ld_frag(Sb, 72, 0, 32, lane);
#pragma unroll
    for (int jb = 0; jb < 4; ++jb) { f32x4 n = (f32x4){0.f, 0.f, 0.f, 0.f};
        if (withG) { const unsigned g0 = gf[jb >> 1][(jb & 1) * 2], g1 = gf[jb >> 1][(jb & 1) * 2 + 1]; n = (f32x4){bf2f(g0 & 0xffffu), bf2f(g0 >> 16), bf2f(g1 & 0xffffu), bf2f(g1 >> 16)}; }
        n = MFMA16(ld_frag(PTs, 72, jb * 16, 0, lane), b0, n); n = MFMA16(ld_frag(PTs, 72, jb * 16, 32, lane), b1, n);
        acc[jb] = n; }
    asm volatile("s_waitcnt lgkmcnt(0)" ::: "memory");
}

__device__ __forceinline__ void stage_rwkv_compose(const Params& P, LAS unsigned char* lds, int task) {
    const int tid = otid(), lane = tid & 63, wave = __builtin_amdgcn_readfirstlane(tid >> 6), quad = lane >> 4, l15 = lane & 15;
    const int gI = task >> 2, h = task & 3, kind = wave >> 2, rb = wave & 3;
    LAS bf16* PTs = (LAS bf16*)(lds + CH_PT); LAS bf16* Sb = (LAS bf16*)(lds + CH_SB) + wave * 16 * 72;
    f32x4 acc[4];
#pragma unroll
    for (int jb = 0; jb < 4; ++jb)
#pragma unroll
        for (int r = 0; r < 4; ++r) acc[jb][r] = (kind == 0 && (jb * 16 + quad * 4 + r) == (rb * 16 + l15)) ? 1.f : 0.f;
    for (int bt = 0; bt < 2; ++bt) {
        const size_t pi0 = (size_t)((gI * 16 + bt * 8) * 4 + h);
        u32x4v pt[8], gf[8][2];
#pragma unroll
        for (int s_ = 0; s_ < 8; ++s_) { pt[s_] = *(const u32x4v*)((const bf16*)(P.ws + WS_PCT) + (pi0 + 4 * s_) * 4096 + tid * 8);
            gf[s_][0] = (u32x4v){0u, 0u, 0u, 0u}; gf[s_][1] = gf[s_][0];
            if (kind == 1) { const bf16* gp = (const bf16*)(P.ws + WS_GC) + (pi0 + 4 * s_) * 4096 + (rb * 64 + lane) * 16; gf[s_][0] = *(const u32x4v*)gp; gf[s_][1] = *(const u32x4v*)(gp + 8); } }
        BAR_LDS();
#pragma unroll
        for (int s_ = 0; s_ < 8; ++s_) *(LAS u32x4v*)(PTs + s_ * 4608 + (tid >> 3) * 72 + (tid & 7) * 8) = pt[s_];
        BAR_LDS();
#pragma unroll
        for (int s_ = 0; s_ < 8; ++s_) chain_step(acc, PTs + s_ * 4608, Sb, gf[s_], kind == 1, lane);
    }
    if (kind == 0) { bf16* PgTg = (bf16*)(P.ws + WS_PGT) + (size_t)task * 4096;
#pragma unroll
        for (int jb = 0; jb < 4; ++jb)
#pragma unroll
            for (int r = 0; r < 4; ++r) PgTg[(jb * 16 + quad * 4 + r) * 64 + rb * 16 + l15] = (bf16)f2bf(acc[jb][r]);
    } else { bf16* Ggg = (bf16*)(P.ws + WS_GG) + (size_t)task * 4096;
#pragma unroll
        for (int jb = 0; jb < 4; ++jb) *(u32x2*)(Ggg + ((rb * 64 + lane) * 4 + jb) * 4) = pack4(acc[jb][0], acc[jb][1], acc[jb][2], acc[jb][3]); }
    BAR_LDS();
}

__device__ __forceinline__ void stage_rwkv_chain(const Params& P, LAS unsigned char* lds, int task) {
    const int tid = otid(), lane = tid & 63, wave = __builtin_amdgcn_readfirstlane(tid >> 6);
    const int gI = task >> 2, h = task & 3, rb = wave & 3, nsteps = gI + 16;
    LAS bf16* PTs = (LAS bf16*)(lds + CH_PT); LAS bf16* Sb = (LAS bf16*)(lds + CH_SB) + wave * 16 * 72;
    f32x4 acc[4];
#pragma unroll
    for (int jb = 0; jb < 4; ++jb) acc[jb] = (f32x4){0.f, 0.f, 0.f, 0.f};
    for (int s0 = 0; s0 < nsteps; s0 += 8) {
        u32x4v pt[8], gf[8][2];
#pragma unroll
        for (int s_ = 0; s_ < 8; ++s_) { const int sg = s0 + s_;
            pt[s_] = (u32x4v){0u, 0u, 0u, 0u}; gf[s_][0] = pt[s_]; gf[s_][1] = pt[s_];
            if (sg < nsteps) {
                const bool grp = sg < gI; const size_t idx = grp ? (size_t)(sg * 4 + h) : (size_t)((gI * 16 + sg - gI) * 4 + h);
                const bf16* ptp = (const bf16*)(P.ws + (grp ? WS_PGT : WS_PCT)) + idx * 4096; const bf16* gp = (const bf16*)(P.ws + (grp ? WS_GG : WS_GC)) + idx * 4096 + (rb * 64 + lane) * 16;
                pt[s_] = *(const u32x4v*)(ptp + tid * 8);
                if (wave < 4) { gf[s_][0] = *(const u32x4v*)gp; gf[s_][1] = *(const u32x4v*)(gp + 8); } } }
        BAR_LDS();
#pragma unroll
        for (int s_ = 0; s_ < 8; ++s_) *(LAS u32x4v*)(PTs + s_ * 4608 + (tid >> 3) * 72 + (tid & 7) * 8) = pt[s_];
        BAR_LDS();
        if (wave < 4) {
#pragma unroll
            for (int s_ = 0; s_ < 8; ++s_) { const int sg = s0 + s_;
                if (sg < nsteps) {
                    if (sg >= gI) {
                        const int quad = lane >> 4, l15 = lane & 15;
#pragma unroll
                        for (int jb = 0; jb < 4; ++jb) *(LAS u32x2*)(Sb + l15 * 72 + jb * 16 + quad * 4) = pack4(acc[jb][0], acc[jb][1], acc[jb][2], acc[jb][3]);
                        asm volatile("s_waitcnt lgkmcnt(0)" ::: "memory");
                        bf16* S0g = (bf16*)(P.ws + WS_S0) + (size_t)((gI * 16 + sg - gI) * 4 + h) * 4096 + (rb * 16 + (lane >> 2)) * 64 + (lane & 3) * 16;
                        const LAS bf16* sp = Sb + (lane >> 2) * 72 + (lane & 3) * 16;
                        *(u32x4v*)S0g = *(const LAS u32x4v*)sp; *(u32x4v*)(S0g + 8) = *(const LAS u32x4v*)(sp + 8);
                        asm volatile("s_waitcnt lgkmcnt(0)" ::: "memory"); }
                    chain_step(acc, PTs + s_ * 4608, Sb, gf[s_], true, lane); } }
        }
    }
    BAR_LDS();
}

constexpr int YW_LD = 72, YW_Y0 = 0, YW_V = 16 * YW_LD, YW_G = YW_V + 17 * YW_LD, YW_Q = YW_G + 17 * YW_LD, YW_O = YW_Q + 16 * YW_LD, YW_ELEMS = YW_O + 16 * YW_LD, YW_BYTES = YW_ELEMS * 2;
struct YS { bf16x8 f[4][2]; };
__device__ __forceinline__ void y_issue_s(const Params& P, int pi, int lane, YS& S) {
    const int quad = lane >> 4, l15 = lane & 15; const bf16* S0g = (const bf16*)(P.ws + WS_S0) + (size_t)pi * 4096;
#pragma unroll
    for (int ib = 0; ib < 4; ++ib) { const bf16* sp = S0g + (ib * 16 + l15) * 64 + quad * 8; S.f[ib][0] = *(const bf16x8*)sp; S.f[ib][1] = *(const bf16x8*)(sp + 32); }
}
struct YL { u32x4v y0[2], q[2], v[3], g[3]; float bs; };
__device__ __forceinline__ void y_issue(const Params& P, int pi, int tb, int lane, YL& T) {
    const int c = pi >> 2, h = pi & 3, r8 = lane >> 3, c8 = (lane & 7) * 8, t0 = c * 64 + tb * 16;
    const bf16* Q1g = (const bf16*)(P.ws + WS_Q1) + (size_t)pi * 4096 + (tb * 16) * 64; const bf16* Y0g = (const bf16*)(P.ws + WS_Y0) + (size_t)pi * 4096 + (tb * 16) * 64;
    const bf16* U = (const bf16*)(P.ws + WS_U) + h * 64 + c8;
#pragma unroll
    for (int k = 0; k < 2; ++k) { T.y0[k] = *(const u32x4v*)(Y0g + (k * 8 + r8) * 64 + c8); T.q[k] = *(const u32x4v*)(Q1g + (k * 8 + r8) * 64 + c8); }
#pragma unroll
    for (int k = 0; k < 3; ++k) { int tr = t0 - 1 + k * 8 + r8; tr = tr < 0 ? 0 : (tr > t0 + 15 ? t0 + 15 : tr);
        T.v[k] = *(const u32x4v*)(U + (size_t)tr * NU + C_V); T.g[k] = *(const u32x4v*)(U + (size_t)tr * NU + C_G); }
    T.bs = ((const float*)(P.ws + WS_BS))[(size_t)(t0 + (lane & 15)) * 4 + h];
}
__device__ __forceinline__ void y_compute(const Params& P, const LAS float* ycs, LAS bf16* ysw, const YS& S, int pi, int tb, int lane, const YL& T) {
    const int c = pi >> 2, h = pi & 3, quad = lane >> 4, l15 = lane & 15, r8 = lane >> 3, c8 = (lane & 7) * 8, t0 = c * 64 + tb * 16;
    bf16* Y = (bf16*)(P.ws + WS_H);
#pragma unroll
    for (int k = 0; k < 2; ++k) { *(LAS u32x4v*)(ysw + YW_Y0 + (k * 8 + r8) * YW_LD + c8) = T.y0[k]; *(LAS u32x4v*)(ysw + YW_Q + (k * 8 + r8) * YW_LD + c8) = T.q[k]; }
#pragma unroll
    for (int k = 0; k < 3; ++k) { const int rr = k * 8 + r8; if (rr < 17) { u32x4v vv = T.v[k], gg = T.g[k];
            if (t0 == 0 && rr == 0) { vv = (u32x4v){0u, 0u, 0u, 0u}; gg = vv; }
            *(LAS u32x4v*)(ysw + YW_V + rr * YW_LD + c8) = vv; *(LAS u32x4v*)(ysw + YW_G + rr * YW_LD + c8) = gg; } }
    asm volatile("s_waitcnt lgkmcnt(0)" ::: "memory");
    const bf16x8 q0 = ld_frag(ysw + YW_Q, YW_LD, 0, 0, lane), q1 = ld_frag(ysw + YW_Q, YW_LD, 0, 32, lane);
    f32x4 y[4];
#pragma unroll
    for (int ib = 0; ib < 4; ++ib) { const u32x2 t = *(const LAS u32x2*)(ysw + YW_Y0 + l15 * YW_LD + ib * 16 + quad * 4);
        y[ib] = (f32x4){bf2f(t.x & 0xffffu), bf2f(t.x >> 16), bf2f(t.y & 0xffffu), bf2f(t.y >> 16)};
        y[ib] = MFMA16(S.f[ib][0], q0, y[ib]); y[ib] = MFMA16(S.f[ib][1], q1, y[ib]); }
    float s_ = 0.f;
#pragma unroll
    for (int ib = 0; ib < 4; ++ib) s_ += (y[ib][0] + y[ib][1]) + (y[ib][2] + y[ib][3]);
    s_ += __shfl_xor(s_, 16); s_ += __shfl_xor(s_, 32);
    const float mean = s_ * (1.f / 64.f);
    float q = 0.f;
#pragma unroll
    for (int ib = 0; ib < 4; ++ib)
#pragma unroll
        for (int r = 0; r < 4; ++r) { const float d = y[ib][r] - mean; q += d * d; }
    q += __shfl_xor(q, 16); q += __shfl_xor(q, 32);
    const float rstd = rsqrtf(q * (1.f / 64.f) + LNX_EPS);
    const float bs = __shfl(T.bs, l15);
#pragma unroll
    for (int ib = 0; ib < 4; ++ib) { const int cl = ib * 16 + quad * 4;
        const f32x4 muv = *(const LAS f32x4*)(ycs + cl), mug = *(const LAS f32x4*)(ycs + 64 + cl), lnw = *(const LAS f32x4*)(ycs + 128 + cl), lnb = *(const LAS f32x4*)(ycs + 192 + cl);
        const u32x2 vc = *(const LAS u32x2*)(ysw + YW_V + (l15 + 1) * YW_LD + cl), vp = *(const LAS u32x2*)(ysw + YW_V + l15 * YW_LD + cl);
        const u32x2 gc = *(const LAS u32x2*)(ysw + YW_G + (l15 + 1) * YW_LD + cl), gp = *(const LAS u32x2*)(ysw + YW_G + l15 * YW_LD + cl);
        float o[4];
#pragma unroll
        for (int r = 0; r < 4; ++r) {
            const unsigned wv = r < 2 ? vc.x : vc.y, wvp = r < 2 ? vp.x : vp.y, wg = r < 2 ? gc.x : gc.y, wgp = r < 2 ? gp.x : gp.y;
            const float cv = bf2f((r & 1) ? (wv >> 16) : (wv & 0xffffu)), pv = bf2f((r & 1) ? (wvp >> 16) : (wvp & 0xffffu));
            const float cg = bf2f((r & 1) ? (wg >> 16) : (wg & 0xffffu)), pg = bf2f((r & 1) ? (wgp >> 16) : (wgp & 0xffffu));
            const float v = cv + (pv - cv) * muv[r], g = cg + (pg - cg) * mug[r];
            const float yn = (y[ib][r] - mean) * rstd * lnw[r] + lnb[r];
            o[r] = (yn + bs * v) * silu_f(g); }
        *(LAS u32x2*)(ysw + YW_O + l15 * YW_LD + cl) = pack4(o[0], o[1], o[2], o[3]); }
    asm volatile("s_waitcnt lgkmcnt(0)" ::: "memory");
#pragma unroll
    for (int k = 0; k < 2; ++k) *(u32x4v*)(Y + (size_t)(t0 + k * 8 + r8) * D + 512 + h * 64 + c8) = *(const LAS u32x4v*)(ysw + YW_O + (k * 8 + r8) * YW_LD + c8);
    asm volatile("s_waitcnt lgkmcnt(0)" ::: "memory");
}
__device__ __forceinline__ void stage_rwkv_y(const Params& P, const LAS float* ycs, LAS bf16* ysw, int pa, int pb, int lane) {
    YS Sa, Sb; YL A, B;
#define YSB __builtin_amdgcn_sched_barrier(0)
    y_issue_s(P, pa, lane, Sa); y_issue(P, pa, 0, lane, A); YSB;
    y_issue(P, pa, 1, lane, B); YSB; y_compute(P, ycs, ysw, Sa, pa, 0, lane, A); YSB;
    y_issue(P, pa, 2, lane, A); YSB; y_compute(P, ycs, ysw, Sa, pa, 1, lane, B); YSB;
    y_issue(P, pa, 3, lane, B); y_issue_s(P, pb, lane, Sb); YSB; y_compute(P, ycs, ysw, Sa, pa, 2, lane, A); YSB;
    y_issue(P, pb, 0, lane, A); YSB; y_compute(P, ycs, ysw, Sa, pa, 3, lane, B); YSB;
    y_issue(P, pb, 1, lane, B); YSB; y_compute(P, ycs, ysw, Sb, pb, 0, lane, A); YSB;
    y_issue(P, pb, 2, lane, A); YSB; y_compute(P, ycs, ysw, Sb, pb, 1, lane, B); YSB;
    y_issue(P, pb, 3, lane, B); YSB; y_compute(P, ycs, ysw, Sb, pb, 2, lane, A); YSB;
    y_compute(P, ycs, ysw, Sb, pb, 3, lane, B);
#undef YSB
}

constexpr int SK_KS = 128, SK_LD = 136, SK_BUF = NSK * SK_LD;
constexpr int SK_LDS = 2 * SK_BUF * 2;
__device__ __forceinline__ void stage_skinny(const Params& P, int l, LAS unsigned char* lds, int blk) {
    const int tid = otid(), lane = tid & 63, wave = tid >> 6, quad = lane >> 4, l15 = lane & 15;
    LAS bf16* Bs = (LAS bf16*)lds;
    const bf16* H = (const bf16*)(P.ws + WS_H) + (size_t)(blk * 64 + (wave & 3) * 16 + l15) * D + quad * 8;
    const bf16* W = (const bf16*)(P.ws + WS_WIN) + ((size_t)l * NU + NMAIN) * D;
    const int ct0 = (wave >> 2) * 5, nct = (wave >> 2) ? 4 : 5;
    f32x4 acc[5];
#pragma unroll
    for (int i = 0; i < 5; ++i) acc[i] = (f32x4){0.f, 0.f, 0.f, 0.f};
    u32x4v bp[5]; bf16x8 af[4];
#define SK_LOAD(s_) do { _Pragma("unroll") for (int i = 0; i < 5; ++i) { const int e = tid + i * 512; const int e2 = e < 2304 ? e : 2303; bp[i] = *(const u32x4v*)(W + (size_t)(e2 >> 4) * D + (s_) * SK_KS + (e2 & 15) * 8); } \
        _Pragma("unroll") for (int ks = 0; ks < 4; ++ks) af[ks] = *(const bf16x8*)(H + (s_) * SK_KS + ks * 32); } while (0)
#define SK_STORE(b_) do { _Pragma("unroll") for (int i = 0; i < 5; ++i) { const int e = tid + i * 512; if (e < 2304) *(LAS u32x4v*)(Bs + (b_) * SK_BUF + (e >> 4) * SK_LD + (e & 15) * 8) = bp[i]; } } while (0)
    SK_LOAD(0);
    SK_STORE(0);
    bf16x8 ac[4];
#pragma unroll
    for (int ks = 0; ks < 4; ++ks) ac[ks] = af[ks];
    BAR_LDS();
    for (int s_ = 0; s_ < 8; ++s_) {
        const int sn = s_ + 1 < 8 ? s_ + 1 : 7;
        SK_LOAD(sn);
        const LAS bf16* Bb = Bs + (s_ & 1) * SK_BUF;
#pragma unroll
        for (int i = 0; i < 5; ++i) if (i < nct) {
#pragma unroll
            for (int ks = 0; ks < 4; ++ks) acc[i] = MFMA16(ld_frag(Bb, SK_LD, (ct0 + i) * 16, ks * 32, lane), ac[ks], acc[i]); }
        BAR_LDS();
        SK_STORE((s_ + 1) & 1);
#pragma unroll
        for (int ks = 0; ks < 4; ++ks) ac[ks] = af[ks];
        BAR_LDS();
    }
    bf16* Uo = (bf16*)(P.ws + WS_U) + (size_t)(blk * 64 + (wave & 3) * 16 + l15) * NU + NMAIN + quad * 4;
#pragma unroll
    for (int i = 0; i < 5; ++i) if (i < nct) *(u32x2*)(Uo + (ct0 + i) * 16) = pack4(acc[i][0], acc[i][1], acc[i][2], acc[i][3]);
#undef SK_LOAD
#undef SK_STORE
}

constexpr int NT = 512;
constexpr int DUP_SUB = -1;
constexpr int REP_XA = 1, REP_S1 = 1, REP_P1 = 1, REP_OUT = 1, REP_SS3 = 1, REP_CMP = 1, REP_Y = 1;
constexpr int LDS_BYTES = 147456, MISC_OFF = LDS_BYTES - 256;
constexpr int CW_BAR = 4096;
static_assert(XA_LDS <= MISC_OFF && S3_LDS + 11264 <= MISC_OFF && S1_LDS + 10240 <= MISC_OFF && RW_END <= MISC_OFF && CH_END <= MISC_OFF && SK_LDS <= MISC_OFF && pg8::STAGE_BYTES <= MISC_OFF, "LDS map");

__global__ void __launch_bounds__(NT, 2) mega_fwd(Params P) {
    extern __shared__ __attribute__((aligned(16))) unsigned char lds_raw[];
    LAS unsigned char* lds_base = (LAS unsigned char*)lds_raw;
    volatile LAS unsigned* MISC = (volatile LAS unsigned*)(lds_base + MISC_OFF);
    const int tid = otid(), wave = __builtin_amdgcn_readfirstlane(tid >> 6), G = gridDim.x, bx = blockIdx.x;
    if (tid < 64) MISC[tid] = 0u;
    __syncthreads();
    XcdBarrier bar = xcd_barrier_post((unsigned*)(P.ws + WS_CTL) + CW_BAR, MISC + 8);
    {
        LAS unsigned char* lds = lds_base; const int gw = bx * 8 + wave, NGW = G * 8;
        stage_blob(P, bx * NT + tid, G * NT);
        for (int it = bx; it < N_PREP_ITEMS; it += G) stage_prep_weights(P, lds, it);
        for (int m = bx; m < MEM_LEN; m += G) stage_memkv(P, lds, m);
        for (int m = gw; m < M; m += NGW) prenorm_row(P.x + (size_t)m * D, P.pre_norm_w, (bf16*)(P.ws + WS_H) + (size_t)m * D, tid & 63);
        xcd_barrier(bar);
    }
    constexpr int PER = 6 + (DUP_SUB >= 0 ? 1 : 0), NPH = 1 + DEPTH * PER;
#pragma unroll 1
    for (int ph = 1; ph < NPH; ++ph) {
        Params Q;
        {   uintptr_t w_ = (uintptr_t)P.ws, o_ = (uintptr_t)P.out, x_ = (uintptr_t)P.x;
            asm volatile("" : "+s"(w_), "+s"(o_), "+s"(x_));
            Q.ws = (unsigned char*)(GAS unsigned char*)w_; Q.out = (float*)(GAS float*)o_; Q.x = (const float*)(GAS const float*)x_; }
        unsigned lds_a = (unsigned)(uintptr_t)lds_base; asm volatile("" : "+s"(lds_a)); LAS unsigned char* lds = (LAS unsigned char*)(uintptr_t)lds_a;
        int bx = blockIdx.x, G = gridDim.x; asm volatile("" : "+s"(bx), "+s"(G));
        const int tid = otid(), wave = __builtin_amdgcn_readfirstlane(tid >> 6), gw = bx * 8 + wave, NGW = G * 8;
        const int l = (ph - 1) / PER, s_ = (ph - 1) % PER, sub = (DUP_SUB >= 0 && s_ > DUP_SUB) ? s_ - 1 : s_;
        if (sub == 0) {
            pg8::Gemm g{(const bf16*)(Q.ws + WS_H), (const bf16*)(Q.ws + WS_WIN) + (size_t)l * NU * D, M, NMAIN, D};
            pg8::StaticOrder S; S.init(M, NMAIN, G, bx);
            pg8::EpiBf16 E{(bf16*)(Q.ws + WS_U), NU};
            pg8::gemm_phase<pg8::EpiBf16, pg8::StaticOrder, true, true>(lds, g, S, E);
            for (int it = bx; it < M / 64; it += G) stage_skinny(Q, l, lds, it);
        } else if (sub == 1) {
            for (int r_ = 0; r_ < REP_XA; ++r_) for (int it = bx; it < (M / 256) * 4; it += G) stage_xattn(Q, lds, it);
            for (int r_ = 0; r_ < REP_S1; ++r_) stage_ssd_s1(Q, l, lds, bx, G, NCHUNK * 2);
            for (int r_ = 0; r_ < REP_P1; ++r_) stage_rwkv_p1(Q, l, lds, bx, G, NCHUNK * 4);
        } else if (sub == 2) {
            if (bx < 64) for (int r_ = 0; r_ < REP_CMP; ++r_) stage_rwkv_compose(Q, lds, bx);
            else for (int it = bx - 64; it < 512; it += G - 64) stage_ssd_scan(Q, lds, it);
        } else if (sub == 3) {
            if (bx < 64) { for (int r_ = 0; r_ < REP_OUT; ++r_) stage_rwkv_chain(Q, lds, bx);
                {   LAS float* ycs = (LAS float*)lds; const int hy = bx & 3;
                    if (tid < 256) { const int a_ = tid >> 6, ch = hy * 64 + (tid & 63);
                        const int off = a_ == 0 ? PB_MU + l * 1152 + 512 + ch : (a_ == 1 ? PB_MU + l * 1152 + 768 + ch : (a_ == 2 ? PB_LNW + l * 256 + ch : PB_LNB + l * 256 + ch));
                        ycs[tid] = PBP(Q, 0)[off]; }
                    asm volatile("s_waitcnt vmcnt(0)" ::: "memory"); __syncthreads();
                    for (int r_ = 0; r_ < REP_Y; ++r_) stage_rwkv_y(Q, ycs, (LAS bf16*)(lds + 1024 + wave * YW_BYTES), ((bx >> 2) * 16 + wave) * 4 + hy, ((bx >> 2) * 16 + wave + 8) * 4 + hy, tid & 63); } }
            else for (int r_ = 0; r_ < REP_SS3; ++r_) stage_ssd_s3(Q, l, lds, bx - 64, G - 64, NCHUNK * 2);
        } else if (sub == 4) {
            pg8::Gemm g{(const bf16*)(Q.ws + WS_H), (const bf16*)(Q.ws + WS_WOUT) + (size_t)l * D * D, M, D, D};
            pg8::StaticOrder S; S.init(M, D, G, bx);
            pg8::EpiBf16 E{(bf16*)(Q.ws + WS_U), D};
            pg8::gemm_phase<pg8::EpiBf16, pg8::StaticOrder, true, true>(lds, g, S, E);
        } else {
            const float* xin = l == 0 ? Q.x : Q.out;
            for (int m = gw; m < M; m += NGW)
                post_row((const bf16*)(Q.ws + WS_U) + (size_t)m * D, xin + (size_t)m * D, PBP(Q, PB_POSTNW) + l * D, Q.out + (size_t)m * D,
                         l + 1 < DEPTH ? PBP(Q, PB_PRENW) + (l + 1) * D : nullptr, l + 1 < DEPTH ? (bf16*)(Q.ws + WS_H) + (size_t)m * D : nullptr, tid & 63);
        }
        if (ph + 1 < NPH) { XcdBarrier b2 = bar; asm volatile("" : "+s"(b2.x), "+s"(b2.bar)); xcd_barrier(b2); }
    }
}

extern "C" void kernel_launch(void* const* d_in, const int* in_sizes, int n_in, void* d_out, int out_size, void* d_ws, size_t ws_size, hipStream_t stream) {
    static int grid = 0;
    if (grid == 0) {
        if (n_in != 24 || in_sizes[0] != M * D || out_size != M * D || ws_size < WS_END) { fprintf(stderr, "kernel_launch: unexpected shapes n_in %d in0 %d out %d ws %zu\n", n_in, n_in > 0 ? in_sizes[0] : -1, out_size, ws_size); grid = -1; return; }
        int dev = 0, cus = 0, per_cu = 0;
        if (hipGetDevice(&dev) != hipSuccess || hipDeviceGetAttribute(&cus, hipDeviceAttributeMultiprocessorCount, dev) != hipSuccess) { grid = -1; return; }
        if (hipFuncSetAttribute((const void*)mega_fwd, hipFuncAttributeMaxDynamicSharedMemorySize, LDS_BYTES) != hipSuccess) { fprintf(stderr, "kernel_launch: hipFuncSetAttribute failed\n"); grid = -1; return; }
        if (hipOccupancyMaxActiveBlocksPerMultiprocessor(&per_cu, (const void*)mega_fwd, NT, LDS_BYTES) != hipSuccess || per_cu < 1) fprintf(stderr, "kernel_launch: occupancy query says %d\n", per_cu);
        (void)hipGetLastError();
        grid = cus;
    }
    if (grid < 0) return;
    if (hipMemsetAsync((char*)d_ws + WS_CTL, 0, 1 * MiB, stream) != hipSuccess) return;
    Params P{};
    const float** pp = (const float**)&P;
    for (int i = 0; i < 24; ++i) pp[i] = (const float*)d_in[i];
    P.out = (float*)d_out; P.ws = (unsigned char*)d_ws;
    hipLaunchKernelGGL(mega_fwd, dim3(grid), dim3(NT), LDS_BYTES, stream, P);
}
```
